# Optimizing an MI355X kernel written in HIP

```python
import jax
import jax.numpy as jnp
from jax import lax
import numpy as np

D_MODEL = 1024
BATCH = 8
SEQ = 2048
DEPTH = 2

CTX_LEN = 256
GRID_W = 64
N_HEADS = 4
HEAD_DIM = 64
MIX_W = N_HEADS * HEAD_DIM
N_KV = 2
KV_W = N_KV * HEAD_DIM
Q_PER_KV = N_HEADS // N_KV
RET_CHUNK = 128
Q_LORA = 256
KV_LORA = 128
MLA_NOPE = 64
MLA_ROPE = 32
MLA_V = 64
WINDOW = 128
Q_BLOCK = 128
N_BRANCH = 4
N_EXPERTS = 32
N_GROUPS = 4
EXPERTS_PER_GROUP = N_EXPERTS // N_GROUPS
TOP_K = 2
D_EXPERT = 1024
MOE_BLOCK = 128
ROPE_BASE = 10000.0
EPS = 1e-6
NEG_INF = -1e30

RET_COLS = 4 * MIX_W
MLA_COLS = Q_LORA + KV_LORA + MLA_ROPE
GQA_COLS = MIX_W + 2 * KV_W
WIN_COLS = MIX_W + 2 * KV_W
N_IN = RET_COLS + MLA_COLS + GQA_COLS + WIN_COLS

kernel_name = 'hybrid_prefix_diffusion_block'

F32 = jnp.float32


def rmsnorm(x, g):
    xf = x.astype(F32)
    y = xf * lax.rsqrt(jnp.mean(xf * xf, axis=-1, keepdims=True) + EPS)
    return (y * g.astype(F32)).astype(x.dtype)


def axial_rope_tables(n_tokens, rot_dim):
    rows = n_tokens // GRID_W
    row = jnp.broadcast_to(jnp.arange(rows)[:, None], (rows, GRID_W)).reshape(-1).astype(F32)
    col = jnp.broadcast_to(jnp.arange(GRID_W)[None, :], (rows, GRID_W)).reshape(-1).astype(F32)
    n_f = rot_dim // 4
    inv = ROPE_BASE ** (-jnp.arange(n_f, dtype=F32) / n_f)
    ang = jnp.concatenate([row[:, None] * inv, col[:, None] * inv], axis=-1)
    return jnp.cos(ang), jnp.sin(ang)


def apply_rope(x, cos, sin):
    half = x.shape[-1] // 2
    shp = (x.shape[1],) + (1,) * (x.ndim - 3) + (half,)
    c = cos.reshape(shp)
    s = sin.reshape(shp)
    xf = x.astype(F32)
    x1, x2 = xf[..., :half], xf[..., half:]
    return jnp.concatenate([x1 * c - x2 * s, x2 * c + x1 * s], axis=-1).astype(x.dtype)


def attend(q, k, v, scale, sink=None):
    s = jnp.einsum('bqgrd,bkgd->bgrqk', q, k).astype(F32) * scale
    if sink is not None:
        sk = jnp.broadcast_to(sink.astype(F32)[None, :, :, None, None], s.shape[:-1] + (1,))
        s = jnp.concatenate([s, sk], axis=-1)
    p = jax.nn.softmax(s, axis=-1)
    if sink is not None:
        p = p[..., :-1]
    return jnp.einsum('bgrqk,bkge->bqgre', p.astype(v.dtype), v)


def dense_block_attend(q, k, v, scale):
    B_, L_ = q.shape[:2]
    n = L_ // Q_BLOCK
    qb = jnp.swapaxes(q.reshape((B_, n, Q_BLOCK) + q.shape[2:]), 0, 1)
    ob = lax.map(lambda qc: attend(qc, k, v, scale), qb)
    return jnp.swapaxes(ob, 0, 1).reshape((B_, L_) + ob.shape[3:])


def retention_scan(q, k, v, log_g, s0, strict):
    B_, H_, L_, _ = q.shape
    dv = v.shape[-1]
    C = RET_CHUNK
    n = L_ // C
    idx = jnp.arange(C, dtype=F32)
    diff = idx[:, None] - idx[None, :]
    mask = (diff > 0) if strict else (diff >= 0)
    lg = log_g.astype(F32)
    dmat = jnp.where(mask, jnp.exp(lg[:, None, None] * jnp.where(mask, diff, 0.0)), 0.0).astype(q.dtype)
    xi = jnp.exp(lg[:, None] * (idx + 1.0))[..., None].astype(q.dtype)
    zeta = jnp.exp(lg[:, None] * (C - 1.0 - idx))[..., None].astype(q.dtype)
    g_chunk = jnp.exp(lg * C)[:, None, None].astype(q.dtype)

    def chunks(a):
        return jnp.moveaxis(a.reshape(B_, H_, n, C, a.shape[-1]), 2, 0)

    def step(state, qkv):
        qc, kc, vc = qkv
        inner = jnp.einsum('bhid,bhjd->bhij', qc, kc) * dmat
        o = jnp.einsum('bhij,bhje->bhie', inner, vc) + jnp.einsum('bhid,bhde->bhie', qc * xi, state)
        state = g_chunk * state + jnp.einsum('bhjd,bhje->bhde', kc * zeta, vc)
        return state, o

    s_final, o = lax.scan(step, s0, (chunks(q), chunks(k), chunks(v)))
    return jnp.moveaxis(o, 0, 2).reshape(B_, H_, L_, dv), s_final


def split_ret(z, rope):
    B_, T_ = z.shape[:2]
    q, k, v, g = (z[..., i * MIX_W:(i + 1) * MIX_W].reshape(B_, T_, N_HEADS, HEAD_DIM) for i in range(4))
    if rope is not None:
        q = apply_rope(q, *rope)
        k = apply_rope(k, *rope)
    tr = lambda a: jnp.transpose(a, (0, 2, 1, 3))
    return tr(q) * (HEAD_DIM ** -0.5), tr(k), tr(v), g.reshape(B_, T_, MIX_W)


def retention_out(o, g):
    of = o.astype(F32)
    mu = jnp.mean(of, axis=-1, keepdims=True)
    var = jnp.mean(jnp.square(of - mu), axis=-1, keepdims=True)
    y = (of - mu) * lax.rsqrt(var + EPS)
    B_, H_, T_, dv = o.shape
    y = jnp.transpose(y, (0, 2, 1, 3)).reshape(B_, T_, H_ * dv)
    return (y * jax.nn.silu(g.astype(F32))).astype(g.dtype)


def retention_mixer(p, pc, rope, decay, ctx_out):
    q, k, v, g = split_ret(p, rope)
    qc, kc, vc, gc = split_ret(pc, None)
    lg = -jnp.exp(decay.astype(F32))
    flip = lambda a: a[:, :, ::-1]
    s0 = jnp.zeros(q.shape[:2] + (HEAD_DIM, HEAD_DIM), q.dtype)
    oc_f, s_f = retention_scan(qc, kc, vc, lg[0], s0, False)
    oc_b, s_b = retention_scan(flip(qc), flip(kc), flip(vc), lg[1], s0, True)
    o_f, _ = retention_scan(q, k, v, lg[0], s_f, False)
    o_b, _ = retention_scan(flip(q), flip(k), flip(v), lg[1], s_b, True)
    y = retention_out(o_f + flip(o_b), g)
    yc = retention_out(oc_f + flip(oc_b), gc) if ctx_out else None
    return y, yc


def mla_mixer(p, pc, rope, qn_g, w_uq, kvn_g, w_ukv, ctx_out):
    def project(z, rp):
        B_, T_ = z.shape[:2]
        q = (rmsnorm(z[..., :Q_LORA], qn_g) @ w_uq).reshape(B_, T_, N_HEADS, MLA_NOPE + MLA_ROPE)
        kv = (rmsnorm(z[..., Q_LORA:Q_LORA + KV_LORA], kvn_g) @ w_ukv).reshape(B_, T_, N_HEADS, MLA_NOPE + MLA_V)
        q_nope, q_rope = q[..., :MLA_NOPE], q[..., MLA_NOPE:]
        k_nope, v = kv[..., :MLA_NOPE], kv[..., MLA_NOPE:]
        k_rope = z[..., Q_LORA + KV_LORA:][:, :, None, :]
        if rp is not None:
            q_rope = apply_rope(q_rope, *rp)
            k_rope = apply_rope(k_rope, *rp)
        qf = jnp.concatenate([q_nope, q_rope], axis=-1)[:, :, :, None, :]
        kf = jnp.concatenate([k_nope, jnp.broadcast_to(k_rope, k_nope.shape[:-1] + (MLA_ROPE,))], axis=-1)
        return qf, kf, v

    scale = (MLA_NOPE + MLA_ROPE) ** -0.5
    q, k, v = project(p, rope)
    qc, kc, vc = project(pc, None)
    o = dense_block_attend(q, jnp.concatenate([k, kc], axis=1), jnp.concatenate([v, vc], axis=1), scale)
    y = o.reshape(o.shape[:2] + (N_HEADS * MLA_V,))
    yc = attend(qc, kc, vc, scale).reshape(pc.shape[:2] + (N_HEADS * MLA_V,)) if ctx_out else None
    return y, yc


def split_gqa(z):
    B_, T_ = z.shape[:2]
    q = z[..., :MIX_W].reshape(B_, T_, N_KV, Q_PER_KV, HEAD_DIM)
    k = z[..., MIX_W:MIX_W + KV_W].reshape(B_, T_, N_KV, HEAD_DIM)
    v = z[..., MIX_W + KV_W:].reshape(B_, T_, N_KV, HEAD_DIM)
    return q, k, v


def gqa_mixer(p, pc, rope, qn_g, kn_g, ctx_out):
    scale = HEAD_DIM ** -0.5
    q, k, v = split_gqa(p)
    q = apply_rope(rmsnorm(q, qn_g), *rope)
    k = apply_rope(rmsnorm(k, kn_g), *rope)
    qc, kc, vc = split_gqa(pc)
    qc = rmsnorm(qc, qn_g)
    kc = rmsnorm(kc, kn_g)
    o = dense_block_attend(q, jnp.concatenate([k, kc], axis=1), jnp.concatenate([v, vc], axis=1), scale)
    y = o.reshape(p.shape[:2] + (MIX_W,))
    yc = attend(qc, kc, vc, scale).reshape(pc.shape[:2] + (MIX_W,)) if ctx_out else None
    return y, yc


def window_mixer(p, pc, rope, sink, ctx_out):
    scale = HEAD_DIM ** -0.5
    C = Q_BLOCK
    q, k, v = split_gqa(p)
    q = apply_rope(q, *rope)
    k = apply_rope(k, *rope)
    qc, kc, vc = split_gqa(pc)
    B_, L_ = p.shape[:2]
    n = L_ // C
    qb = q.reshape(B_, n, C, N_KV, Q_PER_KV, HEAD_DIM)

    def band(a):
        ap = jnp.pad(a, ((0, 0), (C, C), (0, 0), (0, 0))).reshape(B_, n + 2, C, N_KV, a.shape[-1])
        return jnp.concatenate([ap[:, :-2], ap[:, 1:-1], ap[:, 2:]], axis=2)

    kb, vb = band(k), band(v)
    s_loc = jnp.einsum('bnqgrd,bnkgd->bngrqk', qb, kb).astype(F32) * scale
    qi = jnp.arange(C)
    kj = jnp.arange(3 * C) - C
    kabs = jnp.arange(n)[:, None, None] * C + kj[None, None, :]
    valid = (jnp.abs(kj[None, :] - qi[:, None]) <= WINDOW)[None] & (kabs >= 0) & (kabs < L_)
    s_loc = jnp.where(valid[None, :, None, None], s_loc, NEG_INF)
    s_ctx = jnp.einsum('bnqgrd,bkgd->bngrqk', qb, kc).astype(F32) * scale
    sink_gr = sink.reshape(N_KV, Q_PER_KV)
    sink_col = jnp.broadcast_to(sink_gr.astype(F32)[None, None, :, :, None, None], s_loc.shape[:-1] + (1,))
    pr = jax.nn.softmax(jnp.concatenate([s_loc, s_ctx, sink_col], axis=-1), axis=-1).astype(v.dtype)
    n_ctx = kc.shape[1]
    o = (jnp.einsum('bngrqk,bnkge->bnqgre', pr[..., :3 * C], vb)
         + jnp.einsum('bngrqk,bkge->bnqgre', pr[..., 3 * C:3 * C + n_ctx], vc))
    y = o.reshape(B_, L_, MIX_W)
    yc = attend(qc, kc, vc, scale, sink=sink_gr).reshape(pc.shape[:2] + (MIX_W,)) if ctx_out else None
    return y, yc


def merge_branches(h, ys, w_gate, w_branch, w_out):
    gates = jax.nn.sigmoid(h @ w_gate).reshape(h.shape[:2] + (N_BRANCH, D_MODEL))
    proj = jnp.einsum('btim,imd->btid', jnp.stack(ys, axis=2), w_branch)
    return jnp.sum(gates * proj, axis=2) @ w_out


def moe_ffn(t, w_router, b_router, w1, w3, w2):
    N = t.shape[0]
    s = jax.nn.sigmoid((t @ w_router).astype(F32))
    sel = s + b_router.astype(F32)
    grp_score = jnp.sum(lax.top_k(sel.reshape(N, N_GROUPS, EXPERTS_PER_GROUP), TOP_K)[0], axis=-1)
    grp = jnp.argmax(grp_score, axis=-1)
    in_grp = (jnp.arange(N_EXPERTS) // EXPERTS_PER_GROUP)[None, :] == grp[:, None]
    _, e_idx = lax.top_k(jnp.where(in_grp, sel, NEG_INF), TOP_K)
    gw = jnp.take_along_axis(s, e_idx, axis=-1)
    gw = gw / jnp.sum(gw, axis=-1, keepdims=True)

    A = N * TOP_K
    flat_e = e_idx.reshape(-1)
    flat_t = jnp.repeat(jnp.arange(N), TOP_K)
    flat_w = gw.reshape(-1)
    order = jnp.argsort(flat_e)
    e_sorted = flat_e[order]
    counts = jnp.bincount(flat_e, length=N_EXPERTS)
    padded = (counts + MOE_BLOCK - 1) // MOE_BLOCK * MOE_BLOCK
    start_s = jnp.cumsum(counts) - counts
    end_p = jnp.cumsum(padded)
    start_p = end_p - padded
    dest = start_p[e_sorted] + jnp.arange(A) - start_s[e_sorted]
    n_blocks = -(-A // MOE_BLOCK) + N_EXPERTS
    P = n_blocks * MOE_BLOCK
    tok_buf = jnp.full((P,), N, dtype=flat_t.dtype).at[dest].set(flat_t[order])
    w_buf = jnp.zeros((P,), t.dtype).at[dest].set(flat_w[order].astype(t.dtype))
    blk_e = jnp.minimum(jnp.searchsorted(end_p, jnp.arange(n_blocks) * MOE_BLOCK, side='right'), N_EXPERTS - 1)
    t_pad = jnp.concatenate([t, jnp.zeros((1, t.shape[1]), t.dtype)], axis=0)
    xb = t_pad[tok_buf].reshape(n_blocks, MOE_BLOCK, t.shape[1])

    def expert_block(args):
        xblk, e = args
        hid = jax.nn.silu(xblk @ w1[e]) * (xblk @ w3[e])
        return hid @ w2[e]

    yb = lax.map(expert_block, (xb, blk_e))
    y = yb.reshape(P, t.shape[1]) * w_buf[:, None]
    return jax.ops.segment_sum(y, tok_buf, num_segments=N + 1)[:N]


def setup_inputs(seed: int = 0) -> dict:
    key = jax.random.key(seed)
    ks = jax.random.split(key, 32)
    nrm = lambda k, shape, sc: jax.random.normal(k, shape, F32) * sc
    D = D_MODEL
    base_decay = jnp.log(-jnp.log(1.0 - 2.0 ** (-5.0 - jnp.arange(N_HEADS, dtype=F32))))
    return {
        'x': nrm(ks[0], (BATCH, SEQ, D), 1.0),
        'c': nrm(ks[1], (BATCH, D), 1.0),
        'ctx': nrm(ks[2], (BATCH, CTX_LEN, D), 1.0),
        'c_ctx': nrm(ks[3], (D,), 1.0),
        'w_ada': nrm(ks[4], (DEPTH, D, 6 * D), 0.5 * D ** -0.5),
        'b_ada': nrm(ks[5], (DEPTH, 6 * D), 0.02),
        'norm1_g': 1.0 + nrm(ks[6], (DEPTH, D), 0.02),
        'norm2_g': 1.0 + nrm(ks[7], (DEPTH, D), 0.02),
        'w_in': nrm(ks[8], (DEPTH, D, N_IN), D ** -0.5),
        'w_gate': nrm(ks[9], (DEPTH, D, N_BRANCH * D), D ** -0.5),
        'w_branch': nrm(ks[10], (DEPTH, N_BRANCH, MIX_W, D), MIX_W ** -0.5),
        'w_out': nrm(ks[11], (DEPTH, D, D), D ** -0.5),
        'ret_decay': base_decay + nrm(ks[12], (DEPTH, 2, N_HEADS), 0.1),
        'mla_qn_g': 1.0 + nrm(ks[13], (DEPTH, Q_LORA), 0.02),
        'mla_w_uq': nrm(ks[14], (DEPTH, Q_LORA, N_HEADS * (MLA_NOPE + MLA_ROPE)), Q_LORA ** -0.5),
        'mla_kvn_g': 1.0 + nrm(ks[15], (DEPTH, KV_LORA), 0.02),
        'mla_w_ukv': nrm(ks[16], (DEPTH, KV_LORA, N_HEADS * (MLA_NOPE + MLA_V)), KV_LORA ** -0.5),
        'gqa_qn_g': 1.0 + nrm(ks[17], (DEPTH, HEAD_DIM), 0.02),
        'gqa_kn_g': 1.0 + nrm(ks[18], (DEPTH, HEAD_DIM), 0.02),
        'win_sink': nrm(ks[19], (DEPTH, N_HEADS), 0.5),
        'w_router': nrm(ks[20], (D, N_EXPERTS), D ** -0.5),
        'b_router': nrm(ks[21], (N_EXPERTS,), 0.01),
        'w1': nrm(ks[22], (DEPTH, N_EXPERTS, D, D_EXPERT), D ** -0.5),
        'w3': nrm(ks[23], (DEPTH, N_EXPERTS, D, D_EXPERT), D ** -0.5),
        'w2': nrm(ks[24], (DEPTH, N_EXPERTS, D_EXPERT, D), D_EXPERT ** -0.5),
        'final_norm_g': 1.0 + nrm(ks[25], (D,), 0.02),
    }


def reference(x, c, ctx, c_ctx, w_ada, b_ada, norm1_g, norm2_g, w_in, w_gate, w_branch, w_out,
              ret_decay, mla_qn_g, mla_w_uq, mla_kvn_g, mla_w_ukv, gqa_qn_g, gqa_kn_g, win_sink,
              w_router, b_router, w1, w3, w2, final_norm_g):
    B_, L_, D = x.shape
    rope64 = axial_rope_tables(L_, HEAD_DIM)
    rope32 = axial_rope_tables(L_, MLA_ROPE)
    silu_c = jax.nn.silu(c)
    silu_cc = jax.nn.silu(c_ctx)
    o_mla = RET_COLS
    o_gqa = o_mla + MLA_COLS
    o_win = o_gqa + GQA_COLS
    xc = ctx
    for l in range(DEPTH):
        need_ctx = l < DEPTH - 1
        sh1, sc1, g1, sh2, sc2, g2 = jnp.split((silu_c @ w_ada[l] + b_ada[l])[:, None, :], 6, axis=-1)
        csh1, csc1, cg1, csh2, csc2, cg2 = jnp.split(silu_cc @ w_ada[l] + b_ada[l], 6, axis=-1)
        h = rmsnorm(x, norm1_g[l]) * (1.0 + sc1) + sh1
        hc = rmsnorm(xc, norm1_g[l]) * (1.0 + csc1) + csh1
        p = h @ w_in[l]
        pc = hc @ w_in[l]
        y_ret, yc_ret = retention_mixer(p[..., :o_mla], pc[..., :o_mla], rope64, ret_decay[l], need_ctx)
        y_mla, yc_mla = mla_mixer(p[..., o_mla:o_gqa], pc[..., o_mla:o_gqa], rope32, mla_qn_g[l],
                                  mla_w_uq[l], mla_kvn_g[l], mla_w_ukv[l], need_ctx)
        y_gqa, yc_gqa = gqa_mixer(p[..., o_gqa:o_win], pc[..., o_gqa:o_win], rope64, gqa_qn_g[l],
                                  gqa_kn_g[l], need_ctx)
        y_win, yc_win = window_mixer(p[..., o_win:], pc[..., o_win:], rope64, win_sink[l], need_ctx)
        x = x + g1 * merge_branches(h, [y_ret, y_mla, y_gqa, y_win], w_gate[l], w_branch[l], w_out[l])
        if need_ctx:
            xc = xc + cg1 * merge_branches(hc, [yc_ret, yc_mla, yc_gqa, yc_win], w_gate[l], w_branch[l], w_out[l])
        h2 = rmsnorm(x, norm2_g[l]) * (1.0 + sc2) + sh2
        if need_ctx:
            hc2 = rmsnorm(xc, norm2_g[l]) * (1.0 + csc2) + csh2
            toks = jnp.concatenate([h2.reshape(-1, D), hc2.reshape(-1, D)], axis=0)
            f = moe_ffn(toks, w_router, b_router, w1[l], w3[l], w2[l])
            x = x + g2 * f[:B_ * L_].reshape(x.shape)
            xc = xc + cg2 * f[B_ * L_:].reshape(xc.shape)
        else:
            f = moe_ffn(h2.reshape(-1, D), w_router, b_router, w1[l], w3[l], w2[l])
            x = x + g2 * f.reshape(x.shape)
    return rmsnorm(x, final_norm_g)
```

```cpp
#include <hip/hip_runtime.h>
#include <hip/hip_cooperative_groups.h>
#include <cstdio>
#include <cstdint>
namespace cg = cooperative_groups;

#define LAS __attribute__((address_space(3)))
#define GAS __attribute__((address_space(1)))
typedef unsigned short bf16_t;
typedef short bf16x8 __attribute__((ext_vector_type(8)));
typedef short s16x4 __attribute__((ext_vector_type(4)));
typedef float f32x4 __attribute__((ext_vector_type(4)));
typedef float f32x2 __attribute__((ext_vector_type(2)));
typedef float f32x16 __attribute__((ext_vector_type(16)));
typedef unsigned u32x4 __attribute__((ext_vector_type(4)));
typedef unsigned u32x2 __attribute__((ext_vector_type(2)));

#ifndef MK_ONE_LAUNCH
#define MK_ONE_LAUNCH 1
#endif

constexpr int DM = 1024, NBATCH = 8, SEQ = 2048, CTXL = 256;
constexpr int TL = NBATCH * SEQ, TC = NBATCH * CTXL, TT = TL + TC;
constexpr int NIN = 2464, NINP = 2560, NGATE = 4096, NBG = NINP + NGATE;
constexpr int QP = 3072;
constexpr int NEXP = 32, MAXTILES = 176;
constexpr float EPS = 1e-6f, LOG2E = 1.4426950408889634f;
constexpr int P_RET = 0, P_MLA = 1024, P_GQA = 1440, P_WIN = 1952;
constexpr int Q_RETQ = 0, Q_RETK = 256, Q_RETV = 512, Q_RETG = 768;
constexpr int Q_MLAQ = 1024, Q_MLAK = 1408, Q_MLAV = 1792;
constexpr int Q_GQAQ = 2048, Q_GQAK = 2304, Q_GQAV = 2432;
constexpr int Q_WINQ = 2560, Q_WINK = 2816, Q_WINV = 2944;

constexpr size_t MiB = 1u << 20;
constexpr size_t WS_CTL = 0, CTL_ZERO_BYTES = 1 * MiB;
constexpr size_t WS_ADA = 1 * MiB;
constexpr size_t WS_ROPE = WS_ADA + 512 * 1024;
constexpr size_t WS_WRP = WS_ROPE + 768 * 1024;
constexpr size_t WS_TOKINV = 3 * MiB;
constexpr size_t WS_TOKE = WS_TOKINV + (size_t)NEXP * TT * 4;
constexpr size_t WS_TOKW = WS_TOKE + (size_t)TT * 2 * 4;
constexpr size_t WS_WSM = 6 * MiB;
constexpr size_t WS_WIN = 8 * MiB;
constexpr size_t WS_WBR = 34 * MiB;
constexpr size_t WS_WOUT = 38 * MiB;
constexpr size_t WS_W13 = 42 * MiB;
constexpr size_t WS_W2 = 298 * MiB;
constexpr size_t WS_X = 426 * MiB;
constexpr size_t WS_H = 498 * MiB;
constexpr size_t WS_QKV = 534 * MiB;
constexpr size_t WS_Y = 642 * MiB;
constexpr size_t WS_MRG = 678 * MiB;
constexpr size_t WS_P = 714 * MiB;
constexpr size_t WS_G = 804 * MiB;
constexpr size_t WS_HID = 714 * MiB;
constexpr size_t WS_Y2 = 804 * MiB;
constexpr size_t WS_END = 948 * MiB;
static_assert(WS_TOKW + (size_t)TT * 8 <= WS_WSM && WS_HID + (size_t)MAXTILES * 256 * 2048 <= WS_Y2 && WS_Y2 + (size_t)MAXTILES * 256 * 2048 <= WS_END, "ws map");
static_assert(WS_P + (size_t)TT * NINP * 2 <= WS_G && WS_G + (size_t)TT * NGATE * 2 <= WS_END && WS_END <= 1024 * MiB, "ws map");
constexpr int CW_BAR = 4096;
constexpr int CW_CNT = 16384;
constexpr int CW_WQ = 16640;

constexpr int LDS_MISC = 131072, LDS_BYTES = 147456;

__device__ __forceinline__ unsigned f2bf(float f) { unsigned u = __builtin_bit_cast(unsigned, f); return (u + 0x7fffu + ((u >> 16) & 1u)) >> 16; }
__device__ __forceinline__ unsigned pk2(float lo, float hi) { typedef __bf16 bf2 __attribute__((ext_vector_type(2))); f32x2 v = {lo, hi}; bf2 b = __builtin_convertvector(v, bf2); return __builtin_bit_cast(unsigned, b); }
__device__ __forceinline__ float bf2f(unsigned short b) { return __builtin_bit_cast(float, (unsigned)b << 16); }
__device__ __forceinline__ float bflo(unsigned w) { return __builtin_bit_cast(float, w << 16); }
__device__ __forceinline__ float bfhi(unsigned w) { return __builtin_bit_cast(float, w & 0xffff0000u); }
__device__ __forceinline__ float wave_sum(float v) {
#pragma unroll
    for (int o = 1; o < 64; o <<= 1) v += __shfl_xor(v, o);
    return v;
}
__device__ __forceinline__ float fast_exp2(float x) { return __builtin_amdgcn_exp2f(x); }
__device__ __forceinline__ float fast_rcp(float x) { return __builtin_amdgcn_rcpf(x); }
__device__ __forceinline__ float sigmoidf_(float x) { return fast_rcp(1.f + fast_exp2(-x * LOG2E)); }
#define LDS_WAIT() asm volatile("s_waitcnt lgkmcnt(0)" ::: "memory")
#define VM_WAIT() asm volatile("s_waitcnt vmcnt(0)" ::: "memory")

#define XB_TMO      128
#define XB_XCNT(j)  (256  + 64 * (j))
#define XB_XSUB(j)  (1280 + 64 * (j))
#define XB_XGEN(j)  (2304 + 64 * (j))
#define XB_TOP      3328
#define XB_TOPGEN   3392
#define XCD_BAR_WORDS 3456
#define XB_SPIN_CAP (1u << 18)
__device__ __forceinline__ unsigned xb_ld(unsigned* p)              { return __hip_atomic_load(p, __ATOMIC_RELAXED, __HIP_MEMORY_SCOPE_AGENT); }
__device__ __forceinline__ unsigned xb_add(unsigned* p, unsigned v) { return __hip_atomic_fetch_add(p, v, __ATOMIC_RELAXED, __HIP_MEMORY_SCOPE_AGENT); }
__device__ __forceinline__ unsigned xb_xcc_id() { return (unsigned)__builtin_amdgcn_s_getreg((3 << 11) | 20) & 0xFu; }
#define XB_SPIN(cond, bar) do { unsigned _sp = 0; while (cond) { __builtin_amdgcn_s_sleep(1); \
    if ((++_sp & 255u) == 0u) { if (xb_ld(&(bar)[XB_TMO])) break; if (_sp > XB_SPIN_CAP) { atomicAdd(&(bar)[XB_TMO], 1u); break; } } } } while (0)
struct XcdBarrier { unsigned* bar; unsigned x; volatile LAS unsigned* st; };
__device__ __forceinline__ XcdBarrier xcd_barrier_post(unsigned* bar, volatile LAS unsigned* st) {
    XcdBarrier b; b.bar = bar; b.x = xb_xcc_id(); b.st = st;
    if (threadIdx.x == 0) (void)xb_add(&bar[XB_XCNT(b.x)], 1u);
    return b;
}
__device__ __forceinline__ void xcd_barrier_complete(unsigned* bar, unsigned x, unsigned& nloc, unsigned& nx) {
    const unsigned G = gridDim.x * gridDim.y * gridDim.z;
    unsigned sum, cnt, mine, sp = 0u;
    for (;;) {
        sum = 0u; cnt = 0u; mine = 0u;
#pragma unroll
        for (unsigned j = 0; j < 16; ++j) { const unsigned c = xb_ld(&bar[XB_XCNT(j)]); sum += c; cnt += (c > 0u) ? 1u : 0u; mine = (j == x) ? c : mine; }
        if (sum == G) break;
        __builtin_amdgcn_s_sleep(1);
        if ((++sp & 255u) == 0u) { if (xb_ld(&bar[XB_TMO])) break; if (sp > XB_SPIN_CAP) { atomicAdd(&bar[XB_TMO], 1u); break; } }
    }
    nloc = mine > 0u ? mine : 1u; nx = cnt > 0u ? cnt : 1u;
}
__device__ __forceinline__ void xcd_barrier(const XcdBarrier& b) {
    asm volatile("s_waitcnt vmcnt(0)" ::: "memory");
    __syncthreads();
    if (threadIdx.x == 0) {
        unsigned* bar = b.bar;
        __builtin_amdgcn_s_waitcnt(0);
        unsigned nloc = b.st[0], nx = b.st[1];
        if (nloc == 0u) { xcd_barrier_complete(bar, b.x, nloc, nx); b.st[0] = nloc; b.st[1] = nx; }
        const unsigned old = xb_add(&bar[XB_XSUB(b.x)], 1u);
        const unsigned gen = old / nloc;
        if (old + 1u == (gen + 1u) * nloc) {
            __builtin_amdgcn_fence(__ATOMIC_RELEASE, "agent");
            asm volatile("s_waitcnt vmcnt(0)" ::: "memory");
            const unsigned og = xb_add(&bar[XB_TOP], 1u);
            const unsigned tg = og / nx;
            if (og + 1u == (tg + 1u) * nx) xb_add(&bar[XB_TOPGEN], 1u);
            else XB_SPIN(xb_ld(&bar[XB_TOPGEN]) == tg, bar);
            __builtin_amdgcn_fence(__ATOMIC_ACQUIRE, "agent");
            xb_add(&bar[XB_XGEN(b.x)], 1u);
            asm volatile("s_waitcnt vmcnt(0)" ::: "memory");
        } else {
            XB_SPIN(xb_ld(&bar[XB_XGEN(b.x)]) == gen, bar);
            __builtin_amdgcn_fence(__ATOMIC_ACQUIRE, "agent");
            asm volatile("s_waitcnt vmcnt(0)" ::: "memory");
        }
    }
    __syncthreads();
}

namespace pg8 {
constexpr int BM = 256, BK = 64, HALF = 128, HTB = HALF * BK * 2, STAGE_BYTES = 8 * HTB;
__host__ __device__ __forceinline__ int lds_byte(int r, int c) { const int st = (r >> 4) * 2 + (c >> 5), rr = r & 15, cc = c & 31, ob = rr * 64 + cc * 2; return st * 1024 + (ob ^ (((ob >> 9) & 1) << 5)); }
__host__ __device__ __forceinline__ void stage_rc(int b, int& R, int& C) { const int st = b / 1024, sb = b % 1024, swz = sb ^ (((sb >> 9) & 1) << 5); R = (st >> 1) * 16 + swz / 64; C = (st & 1) * 32 + (swz % 64) / 2; }
__host__ __device__ __forceinline__ int perm32(int rho) { const int n = rho >> 4, i = rho & 15; return 8 * (i >> 2) + 4 * n + (i & 3); }
struct Unit { int pm, pn, aux; };
__device__ __forceinline__ void tile_order(int L, int nM, int nN, int& pm, int& pn) {
    const int nwg = nM * nN; int wgid = L; { const int q = nwg / 8, r = nwg % 8, xcd = wgid % 8, off = wgid / 8; wgid = (xcd < r ? xcd * (q + 1) : r * (q + 1) + (xcd - r) * q) + off; }
    const int nig = 8 * nN, gid = wgid / nig, fm = gid * 8, gsz = (nM - fm) < 8 ? (nM - fm) : 8;
    pm = fm + ((wgid % nig) % gsz); pn = (wgid % nig) / gsz;
}
template <class Epi, class Sched, bool GATHER>
__device__ __forceinline__ void gemm_phase(LAS unsigned char* lds, const int tid, const int K, const int lda, const int ldb, const Sched& S, const Epi& E) {
    const int wid = __builtin_amdgcn_readfirstlane(tid >> 6), lane = tid & 63, wr = wid >> 2, wc = wid & 3, fr = lane & 15, fq = lane >> 4;
    const int nt = K / BK;
    int sR[2], sC[2]; unsigned voffB[2];
#pragma unroll
    for (int i = 0; i < 2; ++i) { int R, C; stage_rc(tid * 16 + i * 8192, R, C); sR[i] = R; sC[i] = C; const int Rb = Epi::PERM ? ((R & ~31) + perm32(R & 31)) : R; voffB[i] = (unsigned)(Rb * ldb + C) * 2u; }
    const size_t kstep = (size_t)(BK * 2);
    const size_t hstepB = (size_t)HALF * ldb * 2;
    const unsigned ldsw = (unsigned)wid * 1024u;
    const int aoff = lds_byte(wr * 64 + fr, fq * 8), boff = lds_byte(wc * 32 + fr, fq * 8);
#define PG8_SA(b, h) (((b) * 2 + (h)) * HTB)
#define PG8_SB(b, h) ((4 + (b) * 2 + (h)) * HTB)
#define PG8_STAGE_B(bufoff, gbase) do { _Pragma("unroll") for (int _i = 0; _i < 2; ++_i) \
        __builtin_amdgcn_global_load_lds((const unsigned*)((const char*)(gbase) + voffB[_i]), (LAS unsigned*)(lds + (bufoff) + ldsw + _i * 8192), 16, 0, 0); } while (0)
#define PG8_STAGE_A(bufoff, gbase, off) do { _Pragma("unroll") for (int _i = 0; _i < 2; ++_i) \
        __builtin_amdgcn_global_load_lds((const unsigned*)((const char*)(gbase) + (off)[_i]), (LAS unsigned*)(lds + (bufoff) + ldsw + _i * 8192), 16, 0, 0); } while (0)
#define PG8_LDA(dst, b, h) do { _Pragma("unroll") for (int m = 0; m < 4; ++m) _Pragma("unroll") for (int k = 0; k < 2; ++k) dst[m][k] = *(const LAS bf16x8*)(lds + PG8_SA(b, h) + aoff + m * 2048 + k * 1024); } while (0)
#define PG8_LDB(dst, b, h) do { _Pragma("unroll") for (int n = 0; n < 2; ++n) _Pragma("unroll") for (int k = 0; k < 2; ++k) dst[n][k] = *(const LAS bf16x8*)(lds + PG8_SB(b, h) + boff + n * 2048 + k * 1024); } while (0)
#define PG8_MMA(ai, bj, At, Bt) do { __builtin_amdgcn_s_setprio(1); _Pragma("unroll") for (int m = 0; m < 4; ++m) _Pragma("unroll") for (int n = 0; n < 2; ++n) _Pragma("unroll") for (int k = 0; k < 2; ++k) \
        acc[ai][bj][m][n] = __builtin_amdgcn_mfma_f32_16x16x32_bf16(Bt[n][k], At[m][k], acc[ai][bj][m][n], 0, 0, 0); __builtin_amdgcn_s_setprio(0); } while (0)
#define PG8_WAIT_V(n) asm volatile("s_waitcnt vmcnt(" #n ")" ::: "memory")
#define PG8_WAIT_L(n) asm volatile("s_waitcnt lgkmcnt(" #n ")" ::: "memory")
#define PG8_BAR __builtin_amdgcn_s_barrier()
#define PG8_SCHED __builtin_amdgcn_sched_barrier(0)
#define PG8_OFFS(dst, u) do { _Pragma("unroll") for (int _h = 0; _h < 2; ++_h) _Pragma("unroll") for (int _i = 0; _i < 2; ++_i) { \
        const int _r = sR[_i] + _h * HALF; const int _row = GATHER ? S.arow(u, _r) : _r; dst[_h][_i] = (unsigned)(_row * lda + sC[_i]) * 2u; } } while (0)
    Unit cur, nxt; int ui = 0;
    if (!S.next(0, cur)) return;
    f32x4 acc[2][2][4][2];
#pragma unroll
    for (int a = 0; a < 2; ++a)
#pragma unroll
        for (int b = 0; b < 2; ++b)
#pragma unroll
            for (int m = 0; m < 4; ++m)
#pragma unroll
                for (int n = 0; n < 2; ++n) acc[a][b][m][n] = (f32x4){0.f, 0.f, 0.f, 0.f};
    bf16x8 At[4][2], B0[2][2], B1[2][2];
    const char* cA; const char* cB; S.ptrs(cur, cA, cB);
    unsigned offC[2][2], offN[2][2];
    PG8_OFFS(offC, cur);
    PG8_STAGE_B(PG8_SB(0, 0), cB); PG8_STAGE_B(PG8_SB(0, 1), cB + hstepB); PG8_STAGE_A(PG8_SA(0, 0), cA, offC[0]); PG8_STAGE_A(PG8_SA(0, 1), cA, offC[1]);
    if (wr == 1) PG8_BAR;
    PG8_WAIT_V(2); PG8_BAR;
    PG8_STAGE_B(PG8_SB(1, 0), cB + kstep); PG8_STAGE_A(PG8_SA(1, 0), cA + kstep, offC[0]); PG8_STAGE_B(PG8_SB(1, 1), cB + hstepB + kstep);
    PG8_WAIT_V(6); PG8_BAR;
    for (;;) {
        const bool has_next = S.next(ui + 1, nxt);
        const char* nA = cA; const char* nB = cB;
        if (has_next) { S.ptrs(nxt, nA, nB); PG8_OFFS(offN, nxt); }
        else {
#pragma unroll
            for (int h = 0; h < 2; ++h)
#pragma unroll
                for (int i = 0; i < 2; ++i) offN[h][i] = offC[h][i];
        }
        for (int t = 0; t < nt; t += 2) {
            const bool last = (t == nt - 2);
            const char* a1 = cA + (size_t)(t + 1) * kstep;
            const char* a2 = last ? nA : cA + (size_t)(t + 2) * kstep; const char* b2 = last ? nB : cB + (size_t)(t + 2) * kstep;
            const char* a3 = a2 + kstep; const char* b3 = b2 + kstep;
            unsigned o2[2][2];
#pragma unroll
            for (int h = 0; h < 2; ++h)
#pragma unroll
                for (int i = 0; i < 2; ++i) o2[h][i] = last ? offN[h][i] : offC[h][i];
            PG8_LDB(B0, 0, 0); PG8_LDB(B1, 0, 1); PG8_SCHED; PG8_LDA(At, 0, 0); PG8_STAGE_A(PG8_SA(1, 1), a1, offC[1]);
            PG8_WAIT_V(8); PG8_WAIT_L(0); PG8_BAR; PG8_MMA(0, 0, At, B0); PG8_MMA(0, 1, At, B1); PG8_BAR; PG8_SCHED;
            PG8_LDA(At, 0, 1); PG8_STAGE_B(PG8_SB(0, 0), b2); PG8_STAGE_B(PG8_SB(0, 1), b2 + hstepB); PG8_STAGE_A(PG8_SA(0, 0), a2, o2[0]);
            PG8_WAIT_V(8); PG8_WAIT_L(0); PG8_BAR; PG8_MMA(1, 0, At, B0); PG8_MMA(1, 1, At, B1); PG8_BAR; PG8_SCHED;
            PG8_LDB(B0, 1, 0); PG8_LDB(B1, 1, 1); PG8_SCHED; PG8_LDA(At, 1, 0); PG8_STAGE_A(PG8_SA(0, 1), a2, o2[1]);
            PG8_WAIT_V(8); PG8_WAIT_L(0); PG8_BAR; PG8_MMA(0, 0, At, B0); PG8_MMA(0, 1, At, B1); PG8_BAR; PG8_SCHED;
            PG8_LDA(At, 1, 1); PG8_STAGE_B(PG8_SB(1, 0), b3); PG8_STAGE_B(PG8_SB(1, 1), b3 + hstepB); PG8_STAGE_A(PG8_SA(1, 0), a3, o2[0]);
            PG8_WAIT_V(8); PG8_WAIT_L(0); PG8_BAR; PG8_MMA(1, 0, At, B0); PG8_MMA(1, 1, At, B1); PG8_BAR; PG8_SCHED;
        }
        if (wr == 0) PG8_BAR;
        E(acc, cur, wr, wc, fr, fq);
        if (!has_next) break;
        if (S.fresh(nxt)) {
#pragma unroll
            for (int a = 0; a < 2; ++a)
#pragma unroll
                for (int b = 0; b < 2; ++b)
#pragma unroll
                    for (int m = 0; m < 4; ++m)
#pragma unroll
                        for (int n = 0; n < 2; ++n) acc[a][b][m][n] = (f32x4){0.f, 0.f, 0.f, 0.f};
        }
        cur = nxt; cA = nA; cB = nB; ++ui;
#pragma unroll
        for (int h = 0; h < 2; ++h)
#pragma unroll
            for (int i = 0; i < 2; ++i) offC[h][i] = offN[h][i];
        if (wr == 1) PG8_BAR;
    }
    PG8_WAIT_V(0);
    PG8_BAR;
#undef PG8_SA
#undef PG8_SB
#undef PG8_STAGE_A
#undef PG8_STAGE_B
#undef PG8_LDA
#undef PG8_LDB
#undef PG8_MMA
#undef PG8_WAIT_V
#undef PG8_WAIT_L
#undef PG8_BAR
#undef PG8_SCHED
#undef PG8_OFFS
}
}

struct Args { const float* in[26]; float* out; unsigned char* ws; int ph_lo, ph_hi; };
typedef const __attribute__((address_space(4))) Args* KArgs;
enum { I_X = 0, I_C, I_CTX, I_CCTX, I_WADA, I_BADA, I_N1G, I_N2G, I_WIN, I_WGATE, I_WBR, I_WOUT, I_DECAY, I_QNG, I_WUQ, I_KVNG, I_WUKV, I_GQN, I_GKN, I_SINK, I_WR, I_BR, I_W1, I_W3, I_W2, I_FNG };
constexpr int NWAVES = 8, NTHREADS = 512;

__device__ __forceinline__ void cvt_item(const float* src, int N, int k0, int n0, const float* kscale, bf16_t* dst, int Kd, LAS unsigned char* scr, int lane) {
    const int kk = lane >> 4, n4 = lane & 15, ncol = n0 + 4 * n4;
    f32x4 v[16];
#pragma unroll
    for (int j = 0; j < 16; ++j) {
        const int k = k0 + 4 * j + kk;
        v[j] = (ncol < N) ? *(const GAS f32x4*)(src + (size_t)k * N + ncol) : (f32x4){0.f, 0.f, 0.f, 0.f};
    }
    if (kscale) {
#pragma unroll
        for (int j = 0; j < 16; ++j) v[j] = v[j] * kscale[k0 + 4 * j + kk];
    }
    LAS unsigned short* s16 = (LAS unsigned short*)scr;
#pragma unroll
    for (int j = 0; j < 16; ++j)
#pragma unroll
        for (int i = 0; i < 4; ++i) s16[(4 * n4 + i) * 66 + 4 * j + kk] = (unsigned short)f2bf(v[j][i]);
    LDS_WAIT(); asm volatile("" ::: "memory");
    const LAS unsigned* s32 = (const LAS unsigned*)scr;
    const int c = lane & 7;
#pragma unroll
    for (int jj = 0; jj < 8; ++jj) {
        const int n = (lane >> 3) + 8 * jj;
        u32x4 o; o.x = s32[n * 33 + 4 * c]; o.y = s32[n * 33 + 4 * c + 1]; o.z = s32[n * 33 + 4 * c + 2]; o.w = s32[n * 33 + 4 * c + 3];
        *(GAS u32x4*)(dst + (size_t)n * Kd + k0 + 8 * c) = o;
    }
    LDS_WAIT(); asm volatile("" ::: "memory");
}

__device__ __forceinline__ void p0_prologue(KArgs a, LAS unsigned char* lds, int tid, int lane, int wave, int G, int c) {
    unsigned char* ws = a->ws;
    if (c < 192) {
        LAS float* st = (LAS float*)lds;
        LAS float* red = (LAS float*)(lds + 36864);
        for (int idx = tid; idx < 9 * 1024; idx += NTHREADS) { const int r = idx >> 10, k = idx & 1023; const float v = r < 8 ? a->in[I_C][r * 1024 + k] : a->in[I_CCTX][k]; st[idx] = v / (1.f + __expf(-v)); }
        __syncthreads();
        const int l = c / 96, n0 = (c % 96) * 64;
        float acc[9];
#pragma unroll
        for (int r = 0; r < 9; ++r) acc[r] = 0.f;
        const float* wp = a->in[I_WADA] + ((size_t)l * 1024 + wave * 128) * 6144 + n0 + lane;
#pragma unroll 4
        for (int k = 0; k < 128; ++k) { const float wv = wp[(size_t)k * 6144];
#pragma unroll
            for (int r = 0; r < 9; ++r) acc[r] += st[r * 1024 + wave * 128 + k] * wv; }
#pragma unroll
        for (int r = 0; r < 9; ++r) red[(wave * 9 + r) * 64 + lane] = acc[r];
        __syncthreads();
        for (int idx = tid; idx < 9 * 64; idx += NTHREADS) { const int r = idx >> 6, n = idx & 63; float s = 0.f;
#pragma unroll
            for (int w = 0; w < 8; ++w) s += red[(w * 9 + r) * 64 + n];
            ((float*)(ws + WS_ADA))[((size_t)l * 9 + r) * 6144 + n0 + n] = s + a->in[I_BADA][l * 6144 + n0 + n]; }
        __syncthreads();
    }
    const int gw = c * NWAVES + wave, NGW = G * NWAVES;
    {
        float* rope = (float*)(ws + WS_ROPE);
        for (int idx = gw * 64 + lane; idx < 2048 * 48; idx += NGW * 64) {
            const int pos = idx / 48, j = idx % 48, row = pos >> 6, col = pos & 63;
            if (j < 32) { const int i = j, f = i & 15; const float inv = powf(10000.f, -(float)f / 16.f); const float ang = (float)(i < 16 ? row : col) * inv;
                rope[pos * 32 + i] = cosf(ang); rope[2048 * 32 + pos * 32 + i] = sinf(ang); }
            else { const int i = j - 32, f = i & 7; const float inv = powf(10000.f, -(float)f / 8.f); const float ang = (float)(i < 8 ? row : col) * inv;
                rope[2 * 2048 * 32 + pos * 16 + i] = cosf(ang); rope[2 * 2048 * 32 + 2048 * 16 + pos * 16 + i] = sinf(ang); }
        }
        float* wrp = (float*)(ws + WS_WRP);
        for (int idx = gw * 64 + lane; idx < 32768; idx += NGW * 64) { const int half = idx >> 14, q = (idx >> 12) & 3, e = (idx >> 8) & 15, s = idx & 255;
            wrp[idx] = a->in[I_WR][(256 * q + s) * 32 + 16 * half + e]; }
    }
    LAS unsigned char* scr = lds + 57344 + wave * 8448;
    constexpr int N_EXP_ITEMS = 2 * 32 * 3 * 256;
    constexpr int I_IN = 16 * 40, I_GT = 16 * 64, I_BRN = 4 * 16, I_OUT = 16 * 16, I_UQ = 4 * 6, I_UKV = 2 * 8;
    constexpr int PER_L = I_IN + I_GT + 4 * I_BRN + I_OUT + I_UQ + I_UKV;
    constexpr int NITEMS = N_EXP_ITEMS + 2 * PER_L;
    for (int it = gw; it < NITEMS; it += NGW) {
        if (it < N_EXP_ITEMS) {
            const int j = it >> 8, r = it & 255, l = j / 96, jj = j % 96, e = jj / 3, kind = jj % 3, kb = r >> 4, nb = r & 15;
            const size_t eo = ((size_t)l * 32 + e) * 1048576;
            if (kind < 2) { const float* src = (kind == 0 ? a->in[I_W1] : a->in[I_W3]) + eo;
                bf16_t* dst = (bf16_t*)(ws + WS_W13) + ((size_t)l * 32 + e) * 2097152 + (size_t)(256 * (nb >> 1) + 128 * kind + 64 * (nb & 1)) * 1024;
                cvt_item(src, 1024, kb * 64, nb * 64, nullptr, dst, 1024, scr, lane); }
            else { bf16_t* dst = (bf16_t*)(ws + WS_W2) + eo + (size_t)(nb * 64) * 1024; cvt_item(a->in[I_W2] + eo, 1024, kb * 64, nb * 64, nullptr, dst, 1024, scr, lane); }
            continue;
        }
        int r = it - N_EXP_ITEMS; const int l = r / PER_L; r -= l * PER_L;
        if (r < I_IN) { const int kb = r / 40, nb = r % 40; cvt_item(a->in[I_WIN] + (size_t)l * 1024 * NIN, NIN, kb * 64, nb * 64, nullptr, (bf16_t*)(ws + WS_WIN) + ((size_t)l * NBG + nb * 64) * 1024, 1024, scr, lane); continue; } r -= I_IN;
        if (r < I_GT) { const int kb = r >> 6, nb = r & 63; cvt_item(a->in[I_WGATE] + (size_t)l * 1024 * 4096, 4096, kb * 64, nb * 64, nullptr, (bf16_t*)(ws + WS_WIN) + ((size_t)l * NBG + NINP + nb * 64) * 1024, 1024, scr, lane); continue; } r -= I_GT;
        if (r < 4 * I_BRN) { const int i = r / I_BRN, rr = r % I_BRN, kb = rr >> 4, nb = rr & 15; cvt_item(a->in[I_WBR] + ((size_t)l * 4 + i) * 256 * 1024, 1024, kb * 64, nb * 64, nullptr, (bf16_t*)(ws + WS_WBR) + (((size_t)l * 4 + i) * 1024 + nb * 64) * 256, 256, scr, lane); continue; } r -= 4 * I_BRN;
        if (r < I_OUT) { const int kb = r >> 4, nb = r & 15; cvt_item(a->in[I_WOUT] + (size_t)l * 1048576, 1024, kb * 64, nb * 64, nullptr, (bf16_t*)(ws + WS_WOUT) + (size_t)l * 1048576 + (size_t)(nb * 64) * 1024, 1024, scr, lane); continue; } r -= I_OUT;
        if (r < I_UQ) { const int kb = r / 6, nb = r % 6; cvt_item(a->in[I_WUQ] + (size_t)l * 256 * 384, 384, kb * 64, nb * 64, a->in[I_QNG] + l * 256, (bf16_t*)(ws + WS_WSM) + ((size_t)l * 384 + nb * 64) * 256, 256, scr, lane); continue; } r -= I_UQ;
        { const int kb = r >> 3, nb = r & 7; cvt_item(a->in[I_WUKV] + (size_t)l * 128 * 512, 512, kb * 64, nb * 64, a->in[I_KVNG] + l * 128, (bf16_t*)(ws + WS_WSM) + 2 * 384 * 256 + ((size_t)l * 512 + nb * 64) * 128, 128, scr, lane); }
    }
}

__device__ __forceinline__ void moe_tables(const unsigned* ctl, int l, LAS unsigned char* lds, int tid) {
    LAS int* tb = (LAS int*)(lds + LDS_MISC + 1024); LAS int* cn = (LAS int*)(lds + LDS_MISC + 1280);
    __syncthreads();
    if (tid < 32) cn[tid] = (int)__hip_atomic_load(ctl + CW_CNT + l * 32 + tid, __ATOMIC_RELAXED, __HIP_MEMORY_SCOPE_AGENT);
    __syncthreads();
    if (tid == 0) { int s = 0; for (int e = 0; e < 32; ++e) { tb[e] = s; s += (cn[e] + 255) >> 8; } tb[32] = s; }
    __syncthreads();
}

__device__ __forceinline__ void phase_rownorm(KArgs a, int mode, LAS unsigned char* lds, int lane, int wave, int G, int c) {
    unsigned char* ws = a->ws;
    const int gw = c * NWAVES + wave, NGW = G * NWAVES;
    const float* ada = (const float*)(ws + WS_ADA);
    float* X = (float*)(ws + WS_X);
    const LAS int* tb = (const LAS int*)(lds + LDS_MISC + 1024);
    const int nrows = (mode == 2) ? TL : TT;
    const int lprev = mode - 1, lcur = (mode == 2) ? 0 : mode;
    for (int row = gw; row < nrows; row += NGW) {
        const int b = row < TL ? (row >> 11) : 8;
        const float* src = (mode == 0) ? (row < TL ? a->in[I_X] + (size_t)row * 1024 : a->in[I_CTX] + (size_t)(row - TL) * 1024) : X + (size_t)row * 1024;
        f32x4 v[4];
#pragma unroll
        for (int j = 0; j < 4; ++j) v[j] = *(const GAS f32x4*)(src + 4 * lane + 256 * j);
        if (mode != 0) {
            const int* te = (const int*)(ws + WS_TOKE); const float* tw = (const float*)(ws + WS_TOKW);
            const int e0 = te[row * 2], e1 = te[row * 2 + 1]; const float w0 = tw[row * 2], w1 = tw[row * 2 + 1];
            const size_t s0 = (size_t)(tb[e0 >> 20] * 256 + (e0 & 0xfffff)), s1 = (size_t)(tb[e1 >> 20] * 256 + (e1 & 0xfffff));
            const bf16_t* Y2 = (const bf16_t*)(ws + WS_Y2);
            const float* g2 = ada + ((size_t)lprev * 9 + b) * 6144 + 5120;
#pragma unroll
            for (int j = 0; j < 4; ++j) {
                const u32x2 y0 = *(const GAS u32x2*)(Y2 + s0 * 1024 + 4 * lane + 256 * j), y1 = *(const GAS u32x2*)(Y2 + s1 * 1024 + 4 * lane + 256 * j);
                const f32x4 gg = *(const GAS f32x4*)(g2 + 4 * lane + 256 * j);
                f32x4 f; f.x = w0 * bflo(y0.x) + w1 * bflo(y1.x); f.y = w0 * bfhi(y0.x) + w1 * bfhi(y1.x); f.z = w0 * bflo(y0.y) + w1 * bflo(y1.y); f.w = w0 * bfhi(y0.y) + w1 * bfhi(y1.y);
                v[j] = v[j] + gg * f;
            }
            if (mode == 1) {
#pragma unroll
                for (int j = 0; j < 4; ++j) *(GAS f32x4*)(X + (size_t)row * 1024 + 4 * lane + 256 * j) = v[j];
            }
        }
        float ss = 0.f;
#pragma unroll
        for (int j = 0; j < 4; ++j) ss += (v[j].x * v[j].x + v[j].y * v[j].y) + (v[j].z * v[j].z + v[j].w * v[j].w);
        const float rstd = 1.0f / sqrtf(wave_sum(ss) * (1.f / 1024.f) + EPS);
        if (mode == 2) {
#pragma unroll
            for (int j = 0; j < 4; ++j) { const f32x4 g = *(const GAS f32x4*)(a->in[I_FNG] + 4 * lane + 256 * j); *(GAS f32x4*)(a->out + (size_t)row * 1024 + 4 * lane + 256 * j) = v[j] * rstd * g; }
        } else {
            const float* gn = a->in[I_N1G] + lcur * 1024; const float* sh = ada + ((size_t)lcur * 9 + b) * 6144; const float* sc = sh + 1024;
            bf16_t* H = (bf16_t*)(ws + WS_H) + (size_t)row * 1024;
#pragma unroll
            for (int j = 0; j < 4; ++j) { const int c = 4 * lane + 256 * j; const f32x4 g = *(const GAS f32x4*)(gn + c), s1 = *(const GAS f32x4*)(sc + c), s0 = *(const GAS f32x4*)(sh + c);
                const f32x4 h = v[j] * rstd * g * (s1 + 1.0f) + s0; u32x2 o; o.x = pk2(h.x, h.y); o.y = pk2(h.z, h.w); *(GAS u32x2*)(H + c) = o; }
        }
    }
}

using pg8::Unit;
struct SchedB {
    int layer, G, c; const char* H; const char* W;
    __device__ __forceinline__ bool next(int i, Unit& u) const {
        const int L = i * G + c; u.aux = 0;
        if (layer == 0) { if (L >= 72 * 26) return false; pg8::tile_order(L, 72, 26, u.pm, u.pn); return true; }
        if (L < 64 * 16) { pg8::tile_order(L, 64, 16, u.pm, u.pn); u.pn += 10; return true; }
        const int L2 = L - 64 * 16; if (L2 >= 72 * 10) return false; pg8::tile_order(L2, 72, 10, u.pm, u.pn); return true;
    }
    __device__ __forceinline__ void ptrs(const Unit& u, const char*& A, const char*& B) const { A = H + (size_t)u.pm * 256 * 1024 * 2; B = W + (size_t)u.pn * 256 * 1024 * 2; }
    __device__ __forceinline__ int arow(const Unit&, int r) const { return r; }
    __device__ __forceinline__ bool fresh(const Unit&) const { return true; }
};
struct EpiB {
    static constexpr bool PERM = true;
    bf16_t* P; bf16_t* Gt;
    __device__ __forceinline__ void operator()(f32x4 (&acc)[2][2][4][2], const Unit& u, int wr, int wc, int fr, int fq) const {
        const int row0 = u.pm * 256 + wr * 64 + fr;
        const bool gate = u.pn >= 10;
        bf16_t* base = gate ? Gt + (size_t)(u.pn - 10) * 256 + wc * 32 + 8 * fq : P + (size_t)u.pn * 256 + wc * 32 + 8 * fq;
        const size_t ld = gate ? NGATE : NINP;
#pragma unroll
        for (int ai = 0; ai < 2; ++ai)
#pragma unroll
            for (int m = 0; m < 4; ++m) { bf16_t* rowp = base + (size_t)(row0 + ai * 128 + m * 16) * ld;
#pragma unroll
                for (int bj = 0; bj < 2; ++bj) { f32x4 v0 = acc[ai][bj][m][0], v1 = acc[ai][bj][m][1];
                    if (gate) {
#pragma unroll
                        for (int j = 0; j < 4; ++j) { v0[j] = fmaxf(sigmoidf_(v0[j]), 1e-6f); v1[j] = fmaxf(sigmoidf_(v1[j]), 1e-6f); } }
                    u32x4 w; w.x = pk2(v0[0], v0[1]); w.y = pk2(v0[2], v0[3]); w.z = pk2(v1[0], v1[1]); w.w = pk2(v1[2], v1[3]);
                    *(GAS u32x4*)(rowp + bj * 128) = w; } }
    }
};
struct SchedE {
    int G, c, nM; const char* Y; const char* W;
    __device__ __forceinline__ bool next(int j, Unit& u) const { const int L = (j >> 2) * G + c; if (L >= nM * 4) return false; pg8::tile_order(L, nM, 4, u.pm, u.pn); u.aux = j & 3; return true; }
    __device__ __forceinline__ void ptrs(const Unit& u, const char*& A, const char*& B) const { A = Y + ((size_t)u.pm * 256 * 1024 + u.aux * 256) * 2; B = W + ((size_t)u.aux * 1024 + u.pn * 256) * 256 * 2; }
    __device__ __forceinline__ int arow(const Unit&, int r) const { return r; }
    __device__ __forceinline__ bool fresh(const Unit& u) const { return u.aux == 0; }
};
struct EpiE {
    static constexpr bool PERM = true;
    const bf16_t* Gt; bf16_t* M;
    __device__ __forceinline__ void operator()(f32x4 (&acc)[2][2][4][2], const Unit& u, int wr, int wc, int fr, int fq) const {
        const int row0 = u.pm * 256 + wr * 64 + fr, col0 = u.pn * 256 + wc * 32 + 8 * fq, i = u.aux;
#pragma unroll
        for (int ai = 0; ai < 2; ++ai)
#pragma unroll
            for (int m = 0; m < 4; ++m) { const size_t row = (size_t)(row0 + ai * 128 + m * 16);
#pragma unroll
                for (int bj = 0; bj < 2; ++bj) {
                    const u32x4 g = *(const GAS u32x4*)(Gt + row * NGATE + i * 1024 + col0 + bj * 128);
                    f32x4 s0 = {bflo(g.x), bfhi(g.x), bflo(g.y), bfhi(g.y)}, s1 = {bflo(g.z), bfhi(g.z), bflo(g.w), bfhi(g.w)};
                    if (i < 3) {
                        const u32x4 gn = *(const GAS u32x4*)(Gt + row * NGATE + (i + 1) * 1024 + col0 + bj * 128);
                        const f32x4 d0 = {bflo(gn.x), bfhi(gn.x), bflo(gn.y), bfhi(gn.y)}, d1 = {bflo(gn.z), bfhi(gn.z), bflo(gn.w), bfhi(gn.w)};
#pragma unroll
                        for (int j = 0; j < 4; ++j) { s0[j] *= fast_rcp(d0[j]); s1[j] *= fast_rcp(d1[j]); }
                        acc[ai][bj][m][0] = acc[ai][bj][m][0] * s0; acc[ai][bj][m][1] = acc[ai][bj][m][1] * s1;
                    } else {
                        const f32x4 v0 = acc[ai][bj][m][0] * s0, v1 = acc[ai][bj][m][1] * s1;
                        u32x4 w; w.x = pk2(v0[0], v0[1]); w.y = pk2(v0[2], v0[3]); w.z = pk2(v1[0], v1[1]); w.w = pk2(v1[2], v1[3]);
                        *(GAS u32x4*)(M + row * 1024 + col0 + bj * 128) = w;
                    }
                } }
    }
};
struct SchedF {
    int G, c, nM; const char* A0; const char* W;
    __device__ __forceinline__ bool next(int i, Unit& u) const { const int L = i * G + c; u.aux = 0; if (L >= nM * 4) return false; pg8::tile_order(L, nM, 4, u.pm, u.pn); return true; }
    __device__ __forceinline__ void ptrs(const Unit& u, const char*& A, const char*& B) const { A = A0 + (size_t)u.pm * 256 * 1024 * 2; B = W + (size_t)u.pn * 256 * 1024 * 2; }
    __device__ __forceinline__ int arow(const Unit&, int r) const { return r; }
    __device__ __forceinline__ bool fresh(const Unit&) const { return true; }
};
struct EpiF {
    static constexpr bool PERM = false;
    const float* xin; const float* cin; const float* Xs; float* X; const float* ada_l; int layer;
    __device__ __forceinline__ void operator()(f32x4 (&acc)[2][2][4][2], const Unit& u, int wr, int wc, int fr, int fq) const {
        const int row0 = u.pm * 256 + wr * 64 + fr, col0 = u.pn * 256 + wc * 32 + 4 * fq;
#pragma unroll
        for (int ai = 0; ai < 2; ++ai)
#pragma unroll
            for (int m = 0; m < 4; ++m) { const int row = row0 + ai * 128 + m * 16; const int b = row < TL ? (row >> 11) : 8;
                const float* src = (layer == 0) ? (row < TL ? xin + (size_t)row * 1024 : cin + (size_t)(row - TL) * 1024) : Xs + (size_t)row * 1024;
                const float* g1 = ada_l + (size_t)b * 6144 + 2048;
#pragma unroll
                for (int bj = 0; bj < 2; ++bj)
#pragma unroll
                    for (int n = 0; n < 2; ++n) { const int c = col0 + bj * 128 + n * 16;
                        const f32x4 xs = *(const GAS f32x4*)(src + c), gg = *(const GAS f32x4*)(g1 + c);
                        *(GAS f32x4*)(X + (size_t)row * 1024 + c) = xs + gg * acc[ai][bj][m][n]; } }
    }
};
struct SchedMoe {
    int G, c, npn, gather; const LAS int* tb; const LAS int* cn; const int* tokinv; const char* A0; const char* W; size_t wstride;
    __device__ __forceinline__ bool next(int i, Unit& u) const {
        const int L = i * G + c; if (L >= tb[32] * npn) return false;
        const int rt = L / npn; u.pm = rt; u.pn = L - rt * npn; int e = 0;
#pragma unroll
        for (int k = 1; k < 32; ++k) e += (rt >= tb[k]) ? 1 : 0;
        u.aux = e | ((rt - tb[e]) << 8); return true;
    }
    __device__ __forceinline__ void ptrs(const Unit& u, const char*& A, const char*& B) const {
        A = gather ? A0 : A0 + (size_t)u.pm * 256 * 1024 * 2; B = W + (size_t)(u.aux & 255) * wstride + (size_t)u.pn * 256 * 1024 * 2; }
    __device__ __forceinline__ int arow(const Unit& u, int r) const { const int e = u.aux & 255, idx = (u.aux >> 8) * 256 + r; return idx < cn[e] ? tokinv[(size_t)e * TT + idx] : 0; }
    __device__ __forceinline__ bool fresh(const Unit&) const { return true; }
};
struct EpiH {
    static constexpr bool PERM = true;
    bf16_t* HID;
    __device__ __forceinline__ void operator()(f32x4 (&acc)[2][2][4][2], const Unit& u, int wr, int wc, int fr, int fq) const {
        const int row0 = u.pm * 256 + wr * 64 + fr, col0 = u.pn * 128 + wc * 32 + 8 * fq;
#pragma unroll
        for (int ai = 0; ai < 2; ++ai)
#pragma unroll
            for (int m = 0; m < 4; ++m) { f32x4 h0, h1;
#pragma unroll
                for (int j = 0; j < 4; ++j) { const float a0 = acc[ai][0][m][0][j], a1 = acc[ai][0][m][1][j];
                    h0[j] = a0 * sigmoidf_(a0) * acc[ai][1][m][0][j]; h1[j] = a1 * sigmoidf_(a1) * acc[ai][1][m][1][j]; }
                u32x4 w; w.x = pk2(h0[0], h0[1]); w.y = pk2(h0[2], h0[3]); w.z = pk2(h1[0], h1[1]); w.w = pk2(h1[2], h1[3]);
                *(GAS u32x4*)(HID + (size_t)(row0 + ai * 128 + m * 16) * 1024 + col0) = w; }
    }
};
struct EpiI {
    static constexpr bool PERM = true;
    bf16_t* Y2;
    __device__ __forceinline__ void operator()(f32x4 (&acc)[2][2][4][2], const Unit& u, int wr, int wc, int fr, int fq) const {
        const int row0 = u.pm * 256 + wr * 64 + fr, col0 = u.pn * 256 + wc * 32 + 8 * fq;
#pragma unroll
        for (int ai = 0; ai < 2; ++ai)
#pragma unroll
            for (int m = 0; m < 4; ++m)
#pragma unroll
                for (int bj = 0; bj < 2; ++bj) { const f32x4 v0 = acc[ai][bj][m][0], v1 = acc[ai][bj][m][1];
                    u32x4 w; w.x = pk2(v0[0], v0[1]); w.y = pk2(v0[2], v0[3]); w.z = pk2(v1[0], v1[1]); w.w = pk2(v1[2], v1[3]);
                    *(GAS u32x4*)(Y2 + (size_t)(row0 + ai * 128 + m * 16) * 1024 + col0 + bj * 128) = w; }
    }
};

__device__ __forceinline__ void rope_item_desc(int item, int& src, int& dst, float& scale, int& normsel) {
    normsel = 0; scale = 1.f;
    if (item < 4) { src = P_RET + item * 64; dst = Q_RETQ + item * 64; scale = 0.125f; }
    else if (item < 8) { src = P_RET + 256 + (item - 4) * 64; dst = Q_RETK + (item - 4) * 64; }
    else if (item < 12) { src = P_GQA + (item - 8) * 64; dst = Q_GQAQ + (item - 8) * 64; scale = 0.125f * LOG2E; normsel = 1; }
    else if (item < 14) { src = P_GQA + 256 + (item - 12) * 64; dst = Q_GQAK + (item - 12) * 64; normsel = 2; }
    else if (item < 16) { src = P_WIN + 256 + (item - 14) * 64; dst = Q_WINK + (item - 14) * 64; }
    else { src = P_WIN + (item - 16) * 64; dst = Q_WINQ + (item - 16) * 64; scale = 0.125f * LOG2E; }
}
__device__ __forceinline__ void phase_post(KArgs a, int l, int lane, int wave, int G, int c) {
    unsigned char* ws = a->ws;
    const int gw = c * NWAVES + wave, NGW = G * NWAVES;
    const bf16_t* P = (const bf16_t*)(ws + WS_P); bf16_t* Q = (bf16_t*)(ws + WS_QKV);
    const float* cos64 = (const float*)(ws + WS_ROPE); const float* sin64 = cos64 + 2048 * 32; const float* cos32 = sin64 + 2048 * 32; const float* sin32 = cos32 + 2048 * 16;
    const float* qng = a->in[I_GQN] + l * 64; const float* kng = a->in[I_GKN] + l * 64;
    for (int row = gw; row < TT; row += NGW) {
        const bool islat = row < TL; const int pos = row & 2047;
        const bf16_t* prow = P + (size_t)row * NINP; bf16_t* qrow = Q + (size_t)row * QP;
        const int i2 = (lane & 15) * 2;
        float c0 = 1.f, c1 = 1.f, s0 = 0.f, s1 = 0.f;
        if (islat) { const f32x2 cc = *(const GAS f32x2*)(cos64 + pos * 32 + i2), ss = *(const GAS f32x2*)(sin64 + pos * 32 + i2); c0 = cc.x; c1 = cc.y; s0 = ss.x; s1 = ss.y; }
#pragma unroll
        for (int it = 0; it < 5; ++it) {
            int src, dst, normsel; float scale; rope_item_desc(it * 4 + (lane >> 4), src, dst, scale, normsel);
            const unsigned w1 = *(const GAS unsigned*)(prow + src + i2), w2 = *(const GAS unsigned*)(prow + src + 32 + i2);
            float x1a = bflo(w1), x1b = bfhi(w1), x2a = bflo(w2), x2b = bfhi(w2);
            if (it >= 2 && it <= 3) {
                float ss = x1a * x1a + x1b * x1b + x2a * x2a + x2b * x2b;
                ss += __shfl_xor(ss, 1); ss += __shfl_xor(ss, 2); ss += __shfl_xor(ss, 4); ss += __shfl_xor(ss, 8);
                if (normsel) { const float rstd = 1.0f / sqrtf(ss * (1.f / 64.f) + EPS); const float* g = normsel == 1 ? qng : kng;
                    x1a *= rstd * g[i2]; x1b *= rstd * g[i2 + 1]; x2a *= rstd * g[32 + i2]; x2b *= rstd * g[33 + i2]; }
            }
            const float o1a = (x1a * c0 - x2a * s0) * scale, o1b = (x1b * c1 - x2b * s1) * scale, o2a = (x2a * c0 + x1a * s0) * scale, o2b = (x2b * c1 + x1b * s1) * scale;
            *(GAS unsigned*)(qrow + dst + i2) = pk2(o1a, o1b); *(GAS unsigned*)(qrow + dst + 32 + i2) = pk2(o2a, o2b);
        }
#pragma unroll
        for (int rep = 0; rep < 2; ++rep) { const int c = lane + 64 * rep;
            if (c < 96) { int src, dst; if (c < 64) { src = 512 + 8 * c; dst = Q_RETV + 8 * c; } else if (c < 80) { src = P_GQA + 384 + 8 * (c - 64); dst = Q_GQAV + 8 * (c - 64); } else { src = P_WIN + 384 + 8 * (c - 80); dst = Q_WINV + 8 * (c - 80); }
                *(GAS u32x4*)(qrow + dst) = *(const GAS u32x4*)(prow + src); } }
    }
    const bf16_t* Wuq = (const bf16_t*)(ws + WS_WSM) + (size_t)l * 384 * 256; const bf16_t* Wukv = (const bf16_t*)(ws + WS_WSM) + 2 * 384 * 256 + (size_t)l * 512 * 128;
    const float qscale = 0.10206207261596577f * LOG2E;
    for (int grp = gw; grp < TT / 16; grp += NGW) {
        const int tk = lane & 15, kq = lane >> 4, row = grp * 16 + tk; const bool islat = row < TL; const int pos = row & 2047;
        const bf16_t* prow = P + (size_t)row * NINP + P_MLA; bf16_t* qrow = Q + (size_t)row * QP;
        bf16x8 zq[8], zkv[4]; float sq = 0.f, skv = 0.f;
#pragma unroll
        for (int s = 0; s < 8; ++s) { zq[s] = *(const GAS bf16x8*)(prow + 32 * s + 8 * kq);
#pragma unroll
            for (int j = 0; j < 8; ++j) { const float f = bf2f((unsigned short)zq[s][j]); sq += f * f; } }
#pragma unroll
        for (int s = 0; s < 4; ++s) { zkv[s] = *(const GAS bf16x8*)(prow + 256 + 32 * s + 8 * kq);
#pragma unroll
            for (int j = 0; j < 8; ++j) { const float f = bf2f((unsigned short)zkv[s][j]); skv += f * f; } }
        sq += __shfl_xor(sq, 16); sq += __shfl_xor(sq, 32); skv += __shfl_xor(skv, 16); skv += __shfl_xor(skv, 32);
        const float rq = (1.0f / sqrtf(sq * (1.f / 256.f) + EPS)) * qscale, rkv = 1.0f / sqrtf(skv * (1.f / 128.f) + EPS);
        f32x4 cr = {1.f, 1.f, 1.f, 1.f}, sr = {0.f, 0.f, 0.f, 0.f};
        if (islat) { cr = *(const GAS f32x4*)(cos32 + pos * 16 + 4 * kq); sr = *(const GAS f32x4*)(sin32 + pos * 16 + 4 * kq); }
#pragma unroll 1
        for (int h = 0; h < 4; ++h) {
            f32x4 acc[6];
#pragma unroll
            for (int p = 0; p < 6; ++p) { acc[p] = (f32x4){0.f, 0.f, 0.f, 0.f};
#pragma unroll
                for (int s = 0; s < 8; ++s) { const bf16x8 w = *(const GAS bf16x8*)(Wuq + (size_t)(16 * (6 * h + p) + tk) * 256 + 32 * s + 8 * kq);
                    acc[p] = __builtin_amdgcn_mfma_f32_16x16x32_bf16(w, zq[s], acc[p], 0, 0, 0); } }
#pragma unroll
            for (int p = 0; p < 4; ++p) { const f32x4 v = acc[p] * rq; u32x2 o; o.x = pk2(v[0], v[1]); o.y = pk2(v[2], v[3]); *(GAS u32x2*)(qrow + Q_MLAQ + h * 96 + 16 * p + 4 * kq) = o; }
            { const f32x4 x1 = acc[4] * rq, x2 = acc[5] * rq; const f32x4 o1 = x1 * cr - x2 * sr, o2 = x2 * cr + x1 * sr;
              u32x2 w1; w1.x = pk2(o1[0], o1[1]); w1.y = pk2(o1[2], o1[3]); u32x2 w2; w2.x = pk2(o2[0], o2[1]); w2.y = pk2(o2[2], o2[3]);
              *(GAS u32x2*)(qrow + Q_MLAQ + h * 96 + 64 + 4 * kq) = w1; *(GAS u32x2*)(qrow + Q_MLAQ + h * 96 + 80 + 4 * kq) = w2; }
        }
#pragma unroll 1
        for (int h = 0; h < 4; ++h) {
#pragma unroll
            for (int p = 0; p < 8; ++p) { f32x4 acc = {0.f, 0.f, 0.f, 0.f};
#pragma unroll
                for (int s = 0; s < 4; ++s) { const bf16x8 w = *(const GAS bf16x8*)(Wukv + (size_t)(16 * (8 * h + p) + tk) * 128 + 32 * s + 8 * kq);
                    acc = __builtin_amdgcn_mfma_f32_16x16x32_bf16(w, zkv[s], acc, 0, 0, 0); }
                const f32x4 v = acc * rkv; u32x2 o; o.x = pk2(v[0], v[1]); o.y = pk2(v[2], v[3]);
                const int col = p < 4 ? Q_MLAK + h * 96 + 16 * p + 4 * kq : Q_MLAV + h * 64 + 16 * (p - 4) + 4 * kq;
                *(GAS u32x2*)(qrow + col) = o; }
        }
        { const u32x2 a1 = *(const GAS u32x2*)(prow + 384 + 4 * kq), a2 = *(const GAS u32x2*)(prow + 400 + 4 * kq);
          const f32x4 x1 = {bflo(a1.x), bfhi(a1.x), bflo(a1.y), bfhi(a1.y)}, x2 = {bflo(a2.x), bfhi(a2.x), bflo(a2.y), bfhi(a2.y)};
          const f32x4 o1 = x1 * cr - x2 * sr, o2 = x2 * cr + x1 * sr;
          u32x2 w1; w1.x = pk2(o1[0], o1[1]); w1.y = pk2(o1[2], o1[3]); u32x2 w2; w2.x = pk2(o2[0], o2[1]); w2.y = pk2(o2[2], o2[3]);
#pragma unroll
          for (int h = 0; h < 4; ++h) { *(GAS u32x2*)(qrow + Q_MLAK + h * 96 + 64 + 4 * kq) = w1; *(GAS u32x2*)(qrow + Q_MLAK + h * 96 + 80 + 4 * kq) = w2; } }
    }
}

__device__ __forceinline__ void phase_router(KArgs a, int l, int nrows, LAS unsigned char* lds, int lane, int wave, int G, int c) {
    unsigned char* ws = a->ws;
    const int gw = c * NWAVES + wave, NGW = G * NWAVES;
    const float* X = (const float*)(ws + WS_X); bf16_t* H = (bf16_t*)(ws + WS_H);
    const float* ada = (const float*)(ws + WS_ADA); const float* wrp = (const float*)(ws + WS_WRP);
    const float* gn = a->in[I_N2G] + l * 1024; const float* brt = a->in[I_BR];
    unsigned* ctl = (unsigned*)(ws + WS_CTL);
    int* tokinv = (int*)(ws + WS_TOKINV); int* toke = (int*)(ws + WS_TOKE); float* tokw = (float*)(ws + WS_TOKW);
    LAS float* lg = (LAS float*)(lds + wave * 2048);
    for (int grp = gw; grp < nrows / 16; grp += NGW) {
        const int tk = lane & 15, q = lane >> 4, row = grp * 16 + tk, b = row < TL ? (row >> 11) : 8;
        const float* xr = X + (size_t)row * 1024 + 256 * q;
        float ss = 0.f;
#pragma unroll 8
        for (int s4 = 0; s4 < 64; ++s4) { const f32x4 v = *(const GAS f32x4*)(xr + 4 * s4); ss += (v.x * v.x + v.y * v.y) + (v.z * v.z + v.w * v.w); }
        ss += __shfl_xor(ss, 16); ss += __shfl_xor(ss, 32);
        const float rstd = 1.0f / sqrtf(ss * (1.f / 1024.f) + EPS);
        const float* sh = ada + ((size_t)l * 9 + b) * 6144 + 3072 + 256 * q; const float* sc = sh + 1024; const float* g = gn + 256 * q;
        const float* w0p = wrp + ((0 * 4 + q) * 16 + tk) * 256; const float* w1p = wrp + ((1 * 4 + q) * 16 + tk) * 256;
        bf16_t* hrow = H + (size_t)row * 1024 + 256 * q;
        f32x4 acc0 = {0.f, 0.f, 0.f, 0.f}, acc1 = {0.f, 0.f, 0.f, 0.f};
#pragma unroll 4
        for (int s4 = 0; s4 < 64; ++s4) {
            const f32x4 v = *(const GAS f32x4*)(xr + 4 * s4), gg = *(const GAS f32x4*)(g + 4 * s4), s1 = *(const GAS f32x4*)(sc + 4 * s4), s0 = *(const GAS f32x4*)(sh + 4 * s4);
            const f32x4 h = v * rstd * gg * (s1 + 1.0f) + s0;
            u32x2 o; o.x = pk2(h.x, h.y); o.y = pk2(h.z, h.w); *(GAS u32x2*)(hrow + 4 * s4) = o;
            const f32x4 w0 = *(const GAS f32x4*)(w0p + 4 * s4), w1 = *(const GAS f32x4*)(w1p + 4 * s4);
#pragma unroll
            for (int j = 0; j < 4; ++j) { acc0 = __builtin_amdgcn_mfma_f32_16x16x4f32(h[j], w0[j], acc0, 0, 0, 0); acc1 = __builtin_amdgcn_mfma_f32_16x16x4f32(h[j], w1[j], acc1, 0, 0, 0); }
        }
#pragma unroll
        for (int r = 0; r < 4; ++r) { lg[(4 * q + r) * 32 + tk] = acc0[r]; lg[(4 * q + r) * 32 + 16 + tk] = acc1[r]; }
        LDS_WAIT(); asm volatile("" ::: "memory");
        if (lane < 16) {
            const LAS float* my = lg + lane * 32;
            float gs[4];
#pragma unroll
            for (int g4 = 0; g4 < 4; ++g4) { float m1 = -1e30f, m2 = -1e30f;
#pragma unroll
                for (int j = 0; j < 8; ++j) { const int e = g4 * 8 + j; const float s = 1.0f / (1.0f + __expf(-my[e])); const float v = s + brt[e];
                    if (v > m1) { m2 = m1; m1 = v; } else if (v > m2) m2 = v; }
                gs[g4] = m1 + m2; }
            int gsel = 0; float gb = gs[0];
#pragma unroll
            for (int g4 = 1; g4 < 4; ++g4) if (gs[g4] > gb) { gb = gs[g4]; gsel = g4; }
            float v1 = -1e30f, v2 = -1e30f, s1v = 0.f, s2v = 0.f; int e1 = 0, e2 = 0;
#pragma unroll
            for (int j = 0; j < 8; ++j) { const int e = gsel * 8 + j; const float s = 1.0f / (1.0f + __expf(-my[e])); const float v = s + brt[e];
                if (v > v1) { v2 = v1; e2 = e1; s2v = s1v; v1 = v; e1 = e; s1v = s; } else if (v > v2) { v2 = v; e2 = e; s2v = s; } }
            const float inv = 1.0f / (s1v + s2v);
            const int myrow = grp * 16 + lane;
            const int p1 = (int)__hip_atomic_fetch_add(ctl + CW_CNT + l * 32 + e1, 1u, __ATOMIC_RELAXED, __HIP_MEMORY_SCOPE_AGENT);
            const int p2 = (int)__hip_atomic_fetch_add(ctl + CW_CNT + l * 32 + e2, 1u, __ATOMIC_RELAXED, __HIP_MEMORY_SCOPE_AGENT);
            tokinv[(size_t)e1 * TT + p1] = myrow; tokinv[(size_t)e2 * TT + p2] = myrow;
            toke[myrow * 2] = (e1 << 20) | p1; toke[myrow * 2 + 1] = (e2 << 20) | p2;
            tokw[myrow * 2] = s1v * inv; tokw[myrow * 2 + 1] = s2v * inv;
        }
        LDS_WAIT(); asm volatile("" ::: "memory");
    }
}

__device__ __forceinline__ int crow(int r, int hi) { return (r & 3) + 8 * (r >> 2) + 4 * hi; }
__device__ __forceinline__ s16x4 tr_read(const LAS unsigned char* p) { typedef short v4s __attribute__((ext_vector_type(4))); return __builtin_bit_cast(s16x4, __builtin_amdgcn_ds_read_tr16_b64_v4i16((LAS v4s*)p)); }
constexpr int AT_KB = 0, AT_VB = 32768, AT_SCR = 49152, AT_SCRW = 8448;
template <int DQK>
__device__ __forceinline__ void attn_unit(const bf16_t* Q, bf16_t* Y, const int kind, const int b, const int hq, const int qb, const bool ctxq, const float sinkl2, const float lf2, const float lb2,
                                          LAS unsigned char* lds, const int tid, const int lane, const int wave) {
    constexpr int KS = DQK == 64 ? 128 : 256, CH = DQK / 8, NS = DQK / 16;
    int qcol, kcol, vcol, ycol, gcol = 0;
    if (kind == 0) { qcol = Q_MLAQ + hq * 96; kcol = Q_MLAK + hq * 96; vcol = Q_MLAV + hq * 64; ycol = 256 + hq * 64; }
    else if (kind == 1) { qcol = Q_GQAQ + hq * 64; kcol = Q_GQAK + (hq >> 1) * 64; vcol = Q_GQAV + (hq >> 1) * 64; ycol = 512 + hq * 64; }
    else if (kind == 2) { qcol = Q_RETQ + hq * 64; kcol = Q_RETK + hq * 64; vcol = Q_RETV + hq * 64; ycol = hq * 64; gcol = Q_RETG + hq * 64; }
    else { qcol = Q_WINQ + hq * 64; kcol = Q_WINK + (hq >> 1) * 64; vcol = Q_WINV + (hq >> 1) * 64; ycol = 768 + hq * 64; }
    const int r32 = lane & 31, hi = lane >> 5;
    const int qrow0 = (ctxq ? TL + b * 256 : b * 2048 + qb * 256) + 32 * wave;
    const int qpos = (ctxq ? 0 : qb * 256) + 32 * wave + r32;
    int lt0 = 0, nlat = 32;
    if (ctxq) nlat = 0;
    else if (kind == 3) { lt0 = 4 * qb - 2 < 0 ? 0 : 4 * qb - 2; const int lt1 = 4 * qb + 6 > 32 ? 32 : 4 * qb + 6; nlat = lt1 - lt0; }
    const int ntile = 4 + nlat;
    bf16x8 qf[NS];
#pragma unroll
    for (int s = 0; s < NS; ++s) qf[s] = *(const GAS bf16x8*)(Q + (size_t)(qrow0 + r32) * QP + qcol + 16 * s + 8 * hi);
    const int krow_a = tid / CH, kch_a = tid % CH, krow_b = (tid + 512) / CH, kch_b = (tid + 512) % CH;
    const bool kb_on = (DQK == 96) && (tid < 256);
    const int vrow = tid >> 3, vch = tid & 7;
    const unsigned kdst_a = AT_KB + krow_a * KS + ((kch_a ^ (krow_a & 7)) * 16), kdst_b = AT_KB + krow_b * KS + ((kch_b ^ (krow_b & 7)) * 16), vdst = AT_VB + vrow * 128 + vch * 16;
    u32x4 rka, rkb = {0u, 0u, 0u, 0u}, rv;
#define AT_TILE_ROW0(t) ((t) < 4 ? TL + b * 256 + 64 * (t) : b * 2048 + 64 * (lt0 + (t) - 4))
#define AT_LOAD(t) do { const size_t r0_ = (size_t)AT_TILE_ROW0(t); rka = *(const GAS u32x4*)(Q + (r0_ + krow_a) * QP + kcol + 8 * kch_a); \
        if (kb_on) rkb = *(const GAS u32x4*)(Q + (r0_ + krow_b) * QP + kcol + 8 * kch_b); rv = *(const GAS u32x4*)(Q + (r0_ + vrow) * QP + vcol + 8 * vch); } while (0)
#define AT_STORE(buf) do { *(LAS u32x4*)(lds + (buf) * 16384 + kdst_a) = rka; if (kb_on) *(LAS u32x4*)(lds + (buf) * 16384 + kdst_b) = rkb; *(LAS u32x4*)(lds + (buf) * 8192 + vdst) = rv; } while (0)
    AT_LOAD(0); AT_STORE(0);
    __syncthreads();
    float m = -INFINITY, lsum = 0.f;
    f32x16 o0 = {}, o1 = {};
    LAS float* stage = (LAS float*)(lds + AT_SCR + wave * AT_SCRW); LAS float* fac = stage + 32 * 65;
    const int i16 = lane & 15, q4 = i16 >> 2, p4 = i16 & 3, g1 = (lane >> 4) & 1;
    const unsigned vrd = AT_VB + (4 * hi + q4) * 128 + (16 * g1 + 4 * p4) * 2;
    const unsigned krd = AT_KB + r32 * KS;
    for (int t = 0; t < ntile; ++t) {
        const int cur = t & 1; const bool more = t + 1 < ntile;
        if (more) AT_LOAD(t + 1);
        const bool isctx = t < 4; const int kpos0 = isctx ? 64 * t : 64 * (lt0 + t - 4);
        bool skip = false;
        if (kind == 3 && !isctx) { const int qw0 = qb * 256 + 32 * wave; skip = (kpos0 + 63 < qw0 - 128) || (kpos0 > qw0 + 31 + 128); }
        if (!skip) {
            f32x16 p0 = {}, p1 = {};
            const LAS unsigned char* kb = lds + cur * 16384 + krd;
#pragma unroll
            for (int s = 0; s < NS; ++s) {
                const unsigned off = (unsigned)(((2 * s + hi) ^ (r32 & 7)) * 16);
                const bf16x8 ka0 = *(const LAS bf16x8*)(kb + off), ka1 = *(const LAS bf16x8*)(kb + 32 * KS + off);
                p0 = __builtin_amdgcn_mfma_f32_32x32x16_bf16(ka0, qf[s], p0, 0, 0, 0); p1 = __builtin_amdgcn_mfma_f32_32x32x16_bf16(ka1, qf[s], p1, 0, 0, 0);
            }
            if (kind == 2) {
                if (isctx && !ctxq) {
#pragma unroll
                    for (int r = 0; r < 16; ++r) { const int mm = kpos0 + crow(r, hi);
                        p0[r] *= fast_exp2(lf2 * (float)(256 + qpos - mm)) + fast_exp2(lb2 * (float)(2048 - qpos + mm));
                        p1[r] *= fast_exp2(lf2 * (float)(256 + qpos - mm - 32)) + fast_exp2(lb2 * (float)(2048 - qpos + mm + 32)); }
                } else {
#pragma unroll
                    for (int r = 0; r < 16; ++r) { const int d0 = qpos - (kpos0 + crow(r, hi)), d1 = d0 - 32;
                        p0[r] *= fast_exp2((d0 >= 0 ? lf2 : -lb2) * (float)d0); p1[r] *= fast_exp2((d1 >= 0 ? lf2 : -lb2) * (float)d1); }
                }
            } else {
                if (kind == 3 && !isctx) {
#pragma unroll
                    for (int r = 0; r < 16; ++r) { const int d0 = kpos0 + crow(r, hi) - qpos, d1 = d0 + 32;
                        if (d0 > 128 || d0 < -128) p0[r] = -INFINITY; if (d1 > 128 || d1 < -128) p1[r] = -INFINITY; }
                }
                float tm = fmaxf(p0[0], p1[0]);
#pragma unroll
                for (int r = 1; r < 16; ++r) tm = fmaxf(tm, fmaxf(p0[r], p1[r]));
                tm = fmaxf(tm, __shfl_xor(tm, 32));
                const float mn = fmaxf(m, tm), f = fast_exp2(m - mn); m = mn;
                float ps = 0.f;
#pragma unroll
                for (int r = 0; r < 16; ++r) { p0[r] = fast_exp2(p0[r] - mn); p1[r] = fast_exp2(p1[r] - mn); ps += p0[r] + p1[r]; }
                lsum = lsum * f + ps;
                if (hi == 0) fac[r32] = f;
                LDS_WAIT(); asm volatile("" ::: "memory");
#pragma unroll
                for (int r = 0; r < 16; ++r) { const float fr_ = fac[crow(r, hi)]; o0[r] *= fr_; o1[r] *= fr_; }
            }
            const LAS unsigned char* vb = lds + cur * 8192 + vrd;
#define AT_PV(PU, u) do { _Pragma("unroll") for (int s = 0; s < 2; ++s) { \
                u32x4 pw; pw.x = pk2(PU[8 * s], PU[8 * s + 1]); pw.y = pk2(PU[8 * s + 2], PU[8 * s + 3]); pw.z = pk2(PU[8 * s + 4], PU[8 * s + 5]); pw.w = pk2(PU[8 * s + 6], PU[8 * s + 7]); \
                const bf16x8 pa = __builtin_bit_cast(bf16x8, pw); const LAS unsigned char* vp = vb + (32 * (u) + 16 * s) * 128; \
                { const s16x4 lo = tr_read(vp), h2 = tr_read(vp + 8 * 128); const bf16x8 vf = {lo[0], lo[1], lo[2], lo[3], h2[0], h2[1], h2[2], h2[3]}; o0 = __builtin_amdgcn_mfma_f32_32x32x16_bf16(pa, vf, o0, 0, 0, 0); } \
                { const s16x4 lo = tr_read(vp + 64), h2 = tr_read(vp + 64 + 8 * 128); const bf16x8 vf = {lo[0], lo[1], lo[2], lo[3], h2[0], h2[1], h2[2], h2[3]}; o1 = __builtin_amdgcn_mfma_f32_32x32x16_bf16(pa, vf, o1, 0, 0, 0); } } } while (0)
            AT_PV(p0, 0); AT_PV(p1, 1);
#undef AT_PV
        }
        if (more) AT_STORE(cur ^ 1);
        __syncthreads();
    }
#undef AT_LOAD
#undef AT_STORE
#undef AT_TILE_ROW0
#pragma unroll
    for (int r = 0; r < 16; ++r) { stage[crow(r, hi) * 65 + r32] = o0[r]; stage[crow(r, hi) * 65 + 32 + r32] = o1[r]; }
    LDS_WAIT(); asm volatile("" ::: "memory");
    float x[32];
#pragma unroll
    for (int j = 0; j < 32; ++j) x[j] = stage[r32 * 65 + 32 * hi + j];
    const size_t orow = (size_t)(qrow0 + r32);
    if (kind == 2) {
        float s = 0.f;
#pragma unroll
        for (int j = 0; j < 32; ++j) s += x[j];
        s += __shfl_xor(s, 32); const float mean = s * (1.f / 64.f); float v = 0.f;
#pragma unroll
        for (int j = 0; j < 32; ++j) { x[j] -= mean; v += x[j] * x[j]; }
        v += __shfl_xor(v, 32); const float rstd = 1.0f / sqrtf(v * (1.f / 64.f) + EPS);
        const bf16_t* gp = Q + orow * QP + gcol + 32 * hi;
#pragma unroll
        for (int c = 0; c < 4; ++c) { const u32x4 gw = *(const GAS u32x4*)(gp + 8 * c);
#pragma unroll
            for (int j = 0; j < 4; ++j) { const float ga = bflo(gw[j]), gb = bfhi(gw[j]); x[8 * c + 2 * j] *= rstd * ga * sigmoidf_(ga); x[8 * c + 2 * j + 1] *= rstd * gb * sigmoidf_(gb); } }
    } else {
        float lt = lsum + __shfl_xor(lsum, 32);
        if (kind == 3) lt += fast_exp2(sinkl2 - m);
        const float inv = 1.0f / lt;
#pragma unroll
        for (int j = 0; j < 32; ++j) x[j] *= inv;
    }
    bf16_t* yp = Y + orow * 1024 + ycol + 32 * hi;
#pragma unroll
    for (int c = 0; c < 4; ++c) { u32x4 w; w.x = pk2(x[8 * c], x[8 * c + 1]); w.y = pk2(x[8 * c + 2], x[8 * c + 3]); w.z = pk2(x[8 * c + 4], x[8 * c + 5]); w.w = pk2(x[8 * c + 6], x[8 * c + 7]); *(GAS u32x4*)(yp + 8 * c) = w; }
    LDS_WAIT(); asm volatile("" ::: "memory");
}
__device__ __forceinline__ void phase_mix(KArgs a, int l, LAS unsigned char* lds, int tid, int lane, int wave) {
    unsigned char* ws = a->ws; unsigned* ctl = (unsigned*)(ws + WS_CTL);
    const bf16_t* Q = (const bf16_t*)(ws + WS_QKV); bf16_t* Y = (bf16_t*)(ws + WS_Y);
    const int nunits = l == 0 ? 1152 : 1024;
    LAS int* slot = (LAS int*)(lds + LDS_MISC + 2048);
    for (;;) {
        if (tid == 0) slot[0] = (int)__hip_atomic_fetch_add(ctl + CW_WQ + 64 * l, 1u, __ATOMIC_RELAXED, __HIP_MEMORY_SCOPE_AGENT);
        __syncthreads();
        const int u = slot[0];
        __syncthreads();
        if (u >= nunits) break;
        int kind, b, hq, qb; bool ctxq;
        if (u < 1024) { kind = u >> 8; const int r = u & 255; b = r >> 5; hq = (r >> 3) & 3; qb = r & 7; ctxq = false; }
        else { const int r = u - 1024; kind = r >> 5; b = (r >> 2) & 7; hq = r & 3; qb = 0; ctxq = true; }
        const float lf2 = -__expf(a->in[I_DECAY][l * 8 + hq]) * LOG2E, lb2 = -__expf(a->in[I_DECAY][l * 8 + 4 + hq]) * LOG2E;
        const float sk = a->in[I_SINK][l * 4 + hq] * LOG2E;
        int tid2 = tid; asm volatile("" : "+v"(tid2));
        const int lane2 = tid2 & 63;
        if (kind == 0) attn_unit<96>(Q, Y, 0, b, hq, qb, ctxq, sk, lf2, lb2, lds, tid2, lane2, wave);
        else attn_unit<64>(Q, Y, kind, b, hq, qb, ctxq, sk, lf2, lb2, lds, tid2, lane2, wave);
    }
}

#ifndef MK_BAR_XCD
#define MK_BAR_XCD 0
#endif
constexpr int NPHASE = 20;
#ifndef PH_MASK
#define PH_MASK 0x3ff
#endif
#define PH_ON(b) ((PH_MASK >> (b)) & 1)
__global__ void __launch_bounds__(NTHREADS, 2) fwd_kernel(Args a_byval) {
    extern __shared__ __attribute__((aligned(16))) unsigned char lds_raw[];
    LAS unsigned char* lds0 = (LAS unsigned char*)lds_raw;
    { LAS unsigned char* lds = lds0; const int t0 = threadIdx.x; for (int u = t0; u < (LDS_BYTES - LDS_MISC) / 4; u += NTHREADS) ((LAS unsigned*)(lds + LDS_MISC))[u] = 0u; }
    __syncthreads();
    const int ph_lo = a_byval.ph_lo, ph_hi = a_byval.ph_hi;
#if MK_ONE_LAUNCH && MK_BAR_XCD
    XcdBarrier bar = xcd_barrier_post((unsigned*)(a_byval.ws + WS_CTL) + CW_BAR, (volatile LAS unsigned*)(lds0 + LDS_MISC));
#endif
    for (int ph = ph_lo; ph < ph_hi; ++ph) {
        KArgs a = (KArgs)__builtin_amdgcn_kernarg_segment_ptr(); asm volatile("" : "+s"(a));
        int tid = threadIdx.x; asm volatile("" : "+v"(tid));
        unsigned ldso = 0; asm volatile("" : "+s"(ldso)); LAS unsigned char* lds = lds0 + ldso;
        int G = gridDim.x, c = blockIdx.x; asm volatile("" : "+s"(G), "+s"(c));
        const int lane = tid & 63, wave = __builtin_amdgcn_readfirstlane(tid >> 6);
        unsigned char* ws = a->ws;
        unsigned* ctl = (unsigned*)(ws + WS_CTL);
        const float* ada = (const float*)(ws + WS_ADA);
        if (ph == 0) { if (PH_ON(0)) p0_prologue(a, lds, tid, lane, wave, G, c); }
        else if (ph == NPHASE - 1) { if (PH_ON(1)) { moe_tables(ctl, 1, lds, tid); phase_rownorm(a, 2, lds, lane, wave, G, c); } }
        else {
            const int l = (ph - 1) / 9, k = (ph - 1) % 9;
            if (k == 0) { if (PH_ON(1)) { if (l == 1) moe_tables(ctl, 0, lds, tid); phase_rownorm(a, l, lds, lane, wave, G, c); } }
            else if (k == 1) { if (PH_ON(2)) {
                SchedB S{l, G, c, (const char*)(ws + WS_H), (const char*)(ws + WS_WIN) + (size_t)l * NBG * 1024 * 2};
                EpiB E{(bf16_t*)(ws + WS_P), (bf16_t*)(ws + WS_G)};
                pg8::gemm_phase<EpiB, SchedB, false>(lds, tid, 1024, 1024, 1024, S, E); }
            } else if (k == 2) { if (PH_ON(3)) phase_post(a, l, lane, wave, G, c); }
            else if (k == 3) { if (PH_ON(4)) phase_mix(a, l, lds, tid, lane, wave); }
            else if (k == 4) { if (PH_ON(5)) {
                SchedE S{G, c, l == 0 ? 72 : 64, (const char*)(ws + WS_Y), (const char*)(ws + WS_WBR) + (size_t)l * 4 * 1024 * 256 * 2};
                EpiE E{(const bf16_t*)(ws + WS_G), (bf16_t*)(ws + WS_MRG)};
                pg8::gemm_phase<EpiE, SchedE, false>(lds, tid, 256, 1024, 256, S, E); }
            } else if (k == 5) { if (PH_ON(6)) {
                SchedF S{G, c, l == 0 ? 72 : 64, (const char*)(ws + WS_MRG), (const char*)(ws + WS_WOUT) + (size_t)l * 1048576 * 2};
                EpiF E{a->in[I_X], a->in[I_CTX], (const float*)(ws + WS_X), (float*)(ws + WS_X), ada + (size_t)l * 9 * 6144, l};
                pg8::gemm_phase<EpiF, SchedF, false>(lds, tid, 1024, 1024, 1024, S, E); }
            } else if (k == 6) { if (PH_ON(7)) phase_router(a, l, l == 0 ? TT : TL, lds, lane, wave, G, c); }
            else if (k == 7) { if (PH_ON(8)) {
                moe_tables(ctl, l, lds, tid);
                SchedMoe S{G, c, 8, 1, (const LAS int*)(lds + LDS_MISC + 1024), (const LAS int*)(lds + LDS_MISC + 1280), (const int*)(ws + WS_TOKINV), (const char*)(ws + WS_H), (const char*)(ws + WS_W13) + (size_t)l * 32 * 4 * MiB, 4 * MiB};
                EpiH E{(bf16_t*)(ws + WS_HID)};
                pg8::gemm_phase<EpiH, SchedMoe, true>(lds, tid, 1024, 1024, 1024, S, E); }
            } else if (PH_ON(9)) {
                moe_tables(ctl, l, lds, tid);
                SchedMoe S{G, c, 4, 0, (const LAS int*)(lds + LDS_MISC + 1024), (const LAS int*)(lds + LDS_MISC + 1280), (const int*)(ws + WS_TOKINV), (const char*)(ws + WS_HID), (const char*)(ws + WS_W2) + (size_t)l * 32 * 2 * MiB, 2 * MiB};
                EpiI E{(bf16_t*)(ws + WS_Y2)};
                pg8::gemm_phase<EpiI, SchedMoe, false>(lds, tid, 1024, 1024, 1024, S, E);
            }
        }
#if MK_ONE_LAUNCH
        if (ph + 1 < ph_hi) {
#if MK_BAR_XCD
            if (ph == ph_lo) cg::this_grid().sync(); else xcd_barrier(bar);
#else
            cg::this_grid().sync();
#endif
        }
#endif
    }
}

extern "C" void kernel_launch(void* const* d_in, const int* in_sizes, int n_in, void* d_out, int out_size, void* d_ws, size_t ws_size, hipStream_t stream) {
    static int grid = 0;
    if (grid == 0) {
        if (n_in != 26 || out_size != TL * DM || ws_size < WS_END) { fprintf(stderr, "kernel_launch: unexpected problem (n_in %d, out %d, ws %zu)\n", n_in, out_size, ws_size); grid = -1; return; }
        int dev = 0, cus = 0, per_cu = 0;
        (void)hipGetDevice(&dev); (void)hipDeviceGetAttribute(&cus, hipDeviceAttributeMultiprocessorCount, dev);
        if (hipFuncSetAttribute((const void*)fwd_kernel, hipFuncAttributeMaxDynamicSharedMemorySize, LDS_BYTES) != hipSuccess) { fprintf(stderr, "kernel_launch: hipFuncSetAttribute failed\n"); grid = -1; return; }
        if (hipOccupancyMaxActiveBlocksPerMultiprocessor(&per_cu, (const void*)fwd_kernel, NTHREADS, LDS_BYTES) != hipSuccess || per_cu < 1) { fprintf(stderr, "kernel_launch: occupancy query says %d blocks per CU\n", per_cu); (void)hipGetLastError(); per_cu = 1; }
        grid = cus;
        if (grid < 1) grid = 256;
    }
    if (grid < 0) return;
    (void)hipMemsetAsync((char*)d_ws + WS_CTL, 0, CTL_ZERO_BYTES, stream);
    Args a{};
    for (int i = 0; i < 26; ++i) a.in[i] = (const float*)d_in[i];
    a.out = (float*)d_out; a.ws = (unsigned char*)d_ws;
#if MK_ONE_LAUNCH
    a.ph_lo = 0; a.ph_hi = NPHASE;
    void* args[] = {&a};
    hipError_t e = hipLaunchCooperativeKernel((const void*)fwd_kernel, dim3(grid), dim3(NTHREADS), args, LDS_BYTES, stream);
    if (e != hipSuccess) fprintf(stderr, "kernel_launch: cooperative launch failed: %s (grid %d)\n", hipGetErrorString(e), grid);
#else
    for (int ph = 0; ph < NPHASE; ++ph) { a.ph_lo = ph; a.ph_hi = ph + 1; hipLaunchKernelGGL(fwd_kernel, dim3(grid), dim3(NTHREADS), LDS_BYTES, stream, a); }
#endif
}
```

```cpp
#include <hip/hip_runtime.h>
#include <hip/hip_cooperative_groups.h>
#include <cstdio>
#include <cstdint>
namespace cg = cooperative_groups;

#define LAS __attribute__((address_space(3)))
#define GAS __attribute__((address_space(1)))
typedef unsigned short bf16_t;
typedef short bf16x8 __attribute__((ext_vector_type(8)));
typedef short s16x4 __attribute__((ext_vector_type(4)));
typedef float f32x4 __attribute__((ext_vector_type(4)));
typedef float f32x2 __attribute__((ext_vector_type(2)));
typedef float f32x16 __attribute__((ext_vector_type(16)));
typedef unsigned u32x4 __attribute__((ext_vector_type(4)));
typedef unsigned u32x2 __attribute__((ext_vector_type(2)));

#ifndef MK_ONE_LAUNCH
#define MK_ONE_LAUNCH 1
#endif

constexpr int DM = 1024, NBATCH = 8, SEQ = 2048, CTXL = 256;
constexpr int TL = NBATCH * SEQ, TC = NBATCH * CTXL, TT = TL + TC;
constexpr int NIN = 2464, NINP = 2560, NGATE = 4096, NBG = NINP + NGATE;
constexpr int QP = 3072;
constexpr int NEXP = 32, MAXTILES = 176;
constexpr float EPS = 1e-6f, LOG2E = 1.4426950408889634f;
constexpr int P_RET = 0, P_MLA = 1024, P_GQA = 1440, P_WIN = 1952;
constexpr int Q_RETQ = 0, Q_RETK = 256, Q_RETV = 512, Q_RETG = 768;
constexpr int Q_MLAQ = 1024, Q_MLAK = 1408, Q_MLAV = 1792;
constexpr int Q_GQAQ = 2048, Q_GQAK = 2304, Q_GQAV = 2432;
constexpr int Q_WINQ = 2560, Q_WINK = 2816, Q_WINV = 2944;

constexpr size_t MiB = 1u << 20;
constexpr size_t WS_CTL = 0, CTL_ZERO_BYTES = 1 * MiB;
constexpr size_t WS_ADA = 1 * MiB;
constexpr size_t WS_ROPE = WS_ADA + 512 * 1024;
constexpr size_t WS_WRP = WS_ROPE + 768 * 1024;
constexpr size_t WS_TOKINV = 3 * MiB;
constexpr size_t WS_TOKE = WS_TOKINV + (size_t)NEXP * TT * 4;
constexpr size_t WS_TOKW = WS_TOKE + (size_t)TT * 2 * 4;
constexpr size_t WS_WSM = 6 * MiB;
constexpr size_t WS_WIN = 8 * MiB;
constexpr size_t WS_WBR = 34 * MiB;
constexpr size_t WS_WOUT = 38 * MiB;
constexpr size_t WS_W13 = 42 * MiB;
constexpr size_t WS_W2 = 298 * MiB;
constexpr size_t WS_X = 426 * MiB;
constexpr size_t WS_H = 498 * MiB;
constexpr size_t WS_QKV = 534 * MiB;
constexpr size_t WS_Y = 642 * MiB;
constexpr size_t WS_MRG = 678 * MiB;
constexpr size_t WS_P = 714 * MiB;
constexpr size_t WS_G = 804 * MiB;
constexpr size_t WS_HID = 714 * MiB;
constexpr size_t WS_Y2 = 804 * MiB;
constexpr size_t WS_END = 948 * MiB;
static_assert(WS_TOKW + (size_t)TT * 8 <= WS_WSM && WS_HID + (size_t)MAXTILES * 256 * 2048 <= WS_Y2 && WS_Y2 + (size_t)MAXTILES * 256 * 2048 <= WS_END, "ws map");
static_assert(WS_P + (size_t)TT * NINP * 2 <= WS_G && WS_G + (size_t)TT * NGATE * 2 <= WS_END && WS_END <= 1024 * MiB, "ws map");
constexpr int CW_BAR = 4096;
constexpr int CW_CNT = 16384;
constexpr int CW_WQ = 16640;

constexpr int LDS_MISC = 131072, LDS_BYTES = 147456;

__device__ __forceinline__ unsigned f2bf(float f) { unsigned u = __builtin_bit_cast(unsigned, f); return (u + 0x7fffu + ((u >> 16) & 1u)) >> 16; }
__device__ __forceinline__ unsigned pk2(float lo, float hi) { typedef __bf16 bf2 __attribute__((ext_vector_type(2))); f32x2 v = {lo, hi}; bf2 b = __builtin_convertvector(v, bf2); return __builtin_bit_cast(unsigned, b); }
__device__ __forceinline__ float bf2f(unsigned short b) { return __builtin_bit_cast(float, (unsigned)b << 16); }
__device__ __forceinline__ float bflo(unsigned w) { return __builtin_bit_cast(float, w << 16); }
__device__ __forceinline__ float bfhi(unsigned w) { return __builtin_bit_cast(float, w & 0xffff0000u); }
template <int M> __device__ __forceinline__ float xadd(float v) {
    if constexpr (M == 32) { unsigned a = __builtin_bit_cast(unsigned, v), b = a; asm volatile("" : "+v"(b));
        auto r = __builtin_amdgcn_permlane32_swap(a, b, false, false); const unsigned r0 = r[0], r1 = r[1];
        return __uint_as_float(r0) + __uint_as_float(r1); }
    else return v + __builtin_bit_cast(float, __builtin_amdgcn_ds_swizzle(__builtin_bit_cast(int, v), (M << 10) | 0x1f));
}
__device__ __forceinline__ float xmax32(float v) { unsigned a = __builtin_bit_cast(unsigned, v), b = a; asm volatile("" : "+v"(b));
    auto r = __builtin_amdgcn_permlane32_swap(a, b, false, false); const unsigned r0 = r[0], r1 = r[1]; return fmaxf(__uint_as_float(r0), __uint_as_float(r1)); }
__device__ __forceinline__ float wave_sum(float v) { v = xadd<1>(v); v = xadd<2>(v); v = xadd<4>(v); v = xadd<8>(v); v = xadd<16>(v); return xadd<32>(v); }
__device__ __forceinline__ float fast_exp2(float x) { return __builtin_amdgcn_exp2f(x); }
__device__ __forceinline__ float fast_rcp(float x) { return __builtin_amdgcn_rcpf(x); }
__device__ __forceinline__ float sigmoidf_(float x) { return fast_rcp(1.f + fast_exp2(-x * LOG2E)); }
__device__ __forceinline__ int lane_id() { return (int)__builtin_amdgcn_mbcnt_hi(~0u, __builtin_amdgcn_mbcnt_lo(~0u, 0u)); }
__device__ __forceinline__ void glds16(const void* gsrc, unsigned lds_dst) { unsigned keep;
    asm volatile("s_mov_b32 %0, m0\n\ts_mov_b32 m0, %2\n\ts_nop 0\n\tglobal_load_lds_dwordx4 %1, off\n\ts_mov_b32 m0, %0" : "=&s"(keep) : "v"(gsrc), "s"(lds_dst) : "memory"); }
#define LDS_WAIT() asm volatile("s_waitcnt lgkmcnt(0)" ::: "memory")
#define VM_WAIT() asm volatile("s_waitcnt vmcnt(0)" ::: "memory")

#define XB_TMO      128
#define XB_XCNT(j)  (256  + 64 * (j))
#define XB_XSUB(j)  (1280 + 64 * (j))
#define XB_XGEN(j)  (2304 + 64 * (j))
#define XB_TOP      3328
#define XB_TOPGEN   3392
#define XCD_BAR_WORDS 3456
#define XB_SPIN_CAP (1u << 18)
__device__ __forceinline__ unsigned xb_ld(unsigned* p)              { return __hip_atomic_load(p, __ATOMIC_RELAXED, __HIP_MEMORY_SCOPE_AGENT); }
__device__ __forceinline__ unsigned xb_add(unsigned* p, unsigned v) { return __hip_atomic_fetch_add(p, v, __ATOMIC_RELAXED, __HIP_MEMORY_SCOPE_AGENT); }
__device__ __forceinline__ unsigned xb_xcc_id() { return (unsigned)__builtin_amdgcn_s_getreg((3 << 11) | 20) & 0xFu; }
#define XB_SPIN(cond, bar) do { unsigned _sp = 0; while (cond) { __builtin_amdgcn_s_sleep(1); \
    if ((++_sp & 255u) == 0u) { if (xb_ld(&(bar)[XB_TMO])) break; if (_sp > XB_SPIN_CAP) { atomicAdd(&(bar)[XB_TMO], 1u); break; } } } } while (0)
struct XcdBarrier { unsigned* bar; unsigned x; volatile LAS unsigned* st; int wave; };
__device__ __forceinline__ XcdBarrier xcd_barrier_post(unsigned* bar, volatile LAS unsigned* st, int wave) {
    XcdBarrier b; b.bar = bar; b.x = xb_xcc_id(); b.st = st; b.wave = wave;
    if (wave == 0 && lane_id() == 0) (void)xb_add(&bar[XB_XCNT(b.x)], 1u);
    return b;
}
__device__ __forceinline__ void xcd_barrier_complete(unsigned* bar, unsigned x, unsigned& nloc, unsigned& nx) {
    const unsigned G = gridDim.x * gridDim.y * gridDim.z;
    unsigned sum, cnt, mine, sp = 0u;
    for (;;) {
        sum = 0u; cnt = 0u; mine = 0u;
#pragma unroll
        for (unsigned j = 0; j < 16; ++j) { const unsigned c = xb_ld(&bar[XB_XCNT(j)]); sum += c; cnt += (c > 0u) ? 1u : 0u; }
        mine = xb_ld(&bar[XB_XCNT(x)]);
        if (sum == G) break;
        __builtin_amdgcn_s_sleep(1);
        if ((++sp & 255u) == 0u) { if (xb_ld(&bar[XB_TMO])) break; if (sp > XB_SPIN_CAP) { atomicAdd(&bar[XB_TMO], 1u); break; } }
    }
    nloc = mine > 0u ? mine : 1u; nx = cnt > 0u ? cnt : 1u;
}
__device__ __forceinline__ void xcd_barrier(const XcdBarrier& b) {
    asm volatile("s_waitcnt vmcnt(0)" ::: "memory");
    __syncthreads();
    if (b.wave == 0 && lane_id() == 0) {
        unsigned* bar = b.bar; asm volatile("" : "+s"(bar));
        __builtin_amdgcn_s_waitcnt(0);
        unsigned nloc = b.st[0], nx = b.st[1];
        if (nloc == 0u) { xcd_barrier_complete(bar, b.x, nloc, nx); b.st[0] = nloc; b.st[1] = nx; }
        const unsigned old = xb_add(&bar[XB_XSUB(b.x)], 1u);
        const unsigned gen = old / nloc;
        if (old + 1u == (gen + 1u) * nloc) {
            __builtin_amdgcn_fence(__ATOMIC_RELEASE, "agent");
            asm volatile("s_waitcnt vmcnt(0)" ::: "memory");
            const unsigned og = xb_add(&bar[XB_TOP], 1u);
            const unsigned tg = og / nx;
            if (og + 1u == (tg + 1u) * nx) xb_add(&bar[XB_TOPGEN], 1u);
            else XB_SPIN(xb_ld(&bar[XB_TOPGEN]) == tg, bar);
            __builtin_amdgcn_fence(__ATOMIC_ACQUIRE, "agent");
            xb_add(&bar[XB_XGEN(b.x)], 1u);
            asm volatile("s_waitcnt vmcnt(0)" ::: "memory");
        } else {
            XB_SPIN(xb_ld(&bar[XB_XGEN(b.x)]) == gen, bar);
            __builtin_amdgcn_fence(__ATOMIC_ACQUIRE, "agent");
            asm volatile("s_waitcnt vmcnt(0)" ::: "memory");
        }
    }
    __syncthreads();
}

namespace pg8 {
constexpr int BM = 256, BK = 64, HALF = 128, HTB = HALF * BK * 2, STAGE_BYTES = 8 * HTB;
__host__ __device__ __forceinline__ int lds_byte(int r, int c) { const int st = (r >> 4) * 2 + (c >> 5), rr = r & 15, cc = c & 31, ob = rr * 64 + cc * 2; return st * 1024 + (ob ^ (((ob >> 9) & 1) << 5)); }
__host__ __device__ __forceinline__ void stage_rc(int b, int& R, int& C) { const int st = b / 1024, sb = b % 1024, swz = sb ^ (((sb >> 9) & 1) << 5); R = (st >> 1) * 16 + swz / 64; C = (st & 1) * 32 + (swz % 64) / 2; }
__host__ __device__ __forceinline__ int perm32(int rho) { const int n = rho >> 4, i = rho & 15; return 8 * (i >> 2) + 4 * n + (i & 3); }
struct Unit { int pm, pn, aux; };
__device__ __forceinline__ void tile_order(int L, int nM, int nN, int& pm, int& pn) {
    const int nwg = nM * nN; int wgid = L; { const int q = nwg / 8, r = nwg % 8, xcd = wgid % 8, off = wgid / 8; wgid = (xcd < r ? xcd * (q + 1) : r * (q + 1) + (xcd - r) * q) + off; }
    const int nig = 8 * nN, gid = wgid / nig, fm = gid * 8, gsz = (nM - fm) < 8 ? (nM - fm) : 8;
    pm = fm + ((wgid % nig) % gsz); pn = (wgid % nig) / gsz;
}
template <class Epi, class Sched, bool GATHER>
__device__ __forceinline__ void gemm_phase(LAS unsigned char* lds, const int tid, const int K, const int lda, const int ldb, const Sched& S, const Epi& E) {
    const int wid = __builtin_amdgcn_readfirstlane(tid >> 6), lane = tid & 63, wr = wid >> 2, wc = wid & 3, fr = lane & 15, fq = lane >> 4;
    const int nt = K / BK;
    int sR[2], sC[2]; unsigned voffB[2];
#pragma unroll
    for (int i = 0; i < 2; ++i) { int R, C; stage_rc(tid * 16 + i * 8192, R, C); sR[i] = R; sC[i] = C; const int Rb = Epi::PERM ? ((R & ~31) + perm32(R & 31)) : R; voffB[i] = (unsigned)(Rb * ldb + C) * 2u; }
    const size_t kstep = (size_t)(BK * 2);
    const size_t hstepB = (size_t)HALF * ldb * 2;
    const unsigned ldsw = (unsigned)wid * 1024u;
    const int aoff = lds_byte(wr * 64 + fr, fq * 8), boff = lds_byte(wc * 32 + fr, fq * 8);
#define PG8_SA(b, h) (((b) * 2 + (h)) * HTB)
#define PG8_SB(b, h) ((4 + (b) * 2 + (h)) * HTB)
#define PG8_STAGE_B(bufoff, gbase) do { _Pragma("unroll") for (int _i = 0; _i < 2; ++_i) \
        __builtin_amdgcn_global_load_lds((const unsigned*)((const char*)(gbase) + voffB[_i]), (LAS unsigned*)(lds + (bufoff) + ldsw + _i * 8192), 16, 0, 0); } while (0)
#define PG8_STAGE_A(bufoff, gbase, off) do { _Pragma("unroll") for (int _i = 0; _i < 2; ++_i) \
        __builtin_amdgcn_global_load_lds((const unsigned*)((const char*)(gbase) + (off)[_i]), (LAS unsigned*)(lds + (bufoff) + ldsw + _i * 8192), 16, 0, 0); } while (0)
#define PG8_LDA(dst, b, h) do { _Pragma("unroll") for (int m = 0; m < 4; ++m) _Pragma("unroll") for (int k = 0; k < 2; ++k) dst[m][k] = *(const LAS bf16x8*)(lds + PG8_SA(b, h) + aoff + m * 2048 + k * 1024); } while (0)
#define PG8_LDB(dst, b, h) do { _Pragma("unroll") for (int n = 0; n < 2; ++n) _Pragma("unroll") for (int k = 0; k < 2; ++k) dst[n][k] = *(const LAS bf16x8*)(lds + PG8_SB(b, h) + boff + n * 2048 + k * 1024); } while (0)
#define PG8_MMA(ai, bj, At, Bt) do { __builtin_amdgcn_s_setprio(1); _Pragma("unroll") for (int m = 0; m < 4; ++m) _Pragma("unroll") for (int n = 0; n < 2; ++n) _Pragma("unroll") for (int k = 0; k < 2; ++k) \
        acc[ai][bj][m][n] = __builtin_amdgcn_mfma_f32_16x16x32_bf16(Bt[n][k], At[m][k], acc[ai][bj][m][n], 0, 0, 0); __builtin_amdgcn_s_setprio(0); } while (0)
#define PG8_WAIT_V(n) asm volatile("s_waitcnt vmcnt(" #n ")" ::: "memory")
#define PG8_WAIT_L(n) asm volatile("s_waitcnt lgkmcnt(" #n ")" ::: "memory")
#define PG8_BAR __builtin_amdgcn_s_barrier()
#define PG8_SCHED __builtin_amdgcn_sched_barrier(0)
#define PG8_OFFS(dst, u) do { _Pragma("unroll") for (int _h = 0; _h < 2; ++_h) _Pragma("unroll") for (int _i = 0; _i < 2; ++_i) { \
        const int _r = sR[_i] + _h * HALF; const int _row = GATHER ? S.arow(u, _r) : _r; dst[_h][_i] = (unsigned)(_row * lda + sC[_i]) * 2u; } } while (0)
    Unit cur, nxt; int ui = 0;
    if (!S.next(0, cur)) return;
    f32x4 acc[2][2][4][2];
#pragma unroll
    for (int a = 0; a < 2; ++a)
#pragma unroll
        for (int b = 0; b < 2; ++b)
#pragma unroll
            for (int m = 0; m < 4; ++m)
#pragma unroll
                for (int n = 0; n < 2; ++n) acc[a][b][m][n] = (f32x4){0.f, 0.f, 0.f, 0.f};
    bf16x8 At[4][2], B0[2][2], B1[2][2];
    const char* cA; const char* cB; S.ptrs(cur, cA, cB);
    unsigned offC[2][2], offN[2][2];
    PG8_OFFS(offC, cur);
    PG8_STAGE_B(PG8_SB(0, 0), cB); PG8_STAGE_B(PG8_SB(0, 1), cB + hstepB); PG8_STAGE_A(PG8_SA(0, 0), cA, offC[0]); PG8_STAGE_A(PG8_SA(0, 1), cA, offC[1]);
    if (wr == 1) PG8_BAR;
    PG8_WAIT_V(2); PG8_BAR;
    PG8_STAGE_B(PG8_SB(1, 0), cB + kstep); PG8_STAGE_A(PG8_SA(1, 0), cA + kstep, offC[0]); PG8_STAGE_B(PG8_SB(1, 1), cB + hstepB + kstep);
    PG8_WAIT_V(6); PG8_BAR;
    for (;;) {
        const bool has_next = S.next(ui + 1, nxt);
        const char* nA = cA; const char* nB = cB;
        if (has_next) { S.ptrs(nxt, nA, nB); PG8_OFFS(offN, nxt); }
        else {
#pragma unroll
            for (int h = 0; h < 2; ++h)
#pragma unroll
                for (int i = 0; i < 2; ++i) offN[h][i] = offC[h][i];
        }
        for (int tsec = 0; tsec < nt; tsec += (Epi::MID ? 4 : nt)) {
        if constexpr (Epi::MID) { if (tsec != 0) { int fr_ = fr, fq_ = fq; asm volatile("" : "+v"(fr_), "+v"(fq_)); E.mid(acc, cur, tsec >> 2, wr, wc, fr_, fq_); } }
        for (int t = tsec; t < tsec + (Epi::MID ? 4 : nt); t += 2) {
            const bool last = (t == nt - 2);
            const char* a1 = cA + (size_t)(t + 1) * kstep;
            const char* a2 = last ? nA : cA + (size_t)(t + 2) * kstep; const char* b2 = last ? nB : cB + (size_t)(t + 2) * kstep;
            const char* a3 = a2 + kstep; const char* b3 = b2 + kstep;
            unsigned o2[2][2];
#pragma unroll
            for (int h = 0; h < 2; ++h)
#pragma unroll
                for (int i = 0; i < 2; ++i) o2[h][i] = last ? offN[h][i] : offC[h][i];
            PG8_LDB(B0, 0, 0); PG8_LDB(B1, 0, 1); PG8_SCHED; PG8_LDA(At, 0, 0); PG8_STAGE_A(PG8_SA(1, 1), a1, offC[1]);
            PG8_WAIT_V(8); PG8_WAIT_L(0); PG8_BAR; PG8_MMA(0, 0, At, B0); PG8_MMA(0, 1, At, B1); PG8_BAR; PG8_SCHED;
            PG8_LDA(At, 0, 1); PG8_STAGE_B(PG8_SB(0, 0), b2); PG8_STAGE_B(PG8_SB(0, 1), b2 + hstepB); PG8_STAGE_A(PG8_SA(0, 0), a2, o2[0]);
            PG8_WAIT_V(8); PG8_WAIT_L(0); PG8_BAR; PG8_MMA(1, 0, At, B0); PG8_MMA(1, 1, At, B1); PG8_BAR; PG8_SCHED;
            PG8_LDB(B0, 1, 0); PG8_LDB(B1, 1, 1); PG8_SCHED; PG8_LDA(At, 1, 0); PG8_STAGE_A(PG8_SA(0, 1), a2, o2[1]);
            PG8_WAIT_V(8); PG8_WAIT_L(0); PG8_BAR; PG8_MMA(0, 0, At, B0); PG8_MMA(0, 1, At, B1); PG8_BAR; PG8_SCHED;
            PG8_LDA(At, 1, 1); PG8_STAGE_B(PG8_SB(1, 0), b3); PG8_STAGE_B(PG8_SB(1, 1), b3 + hstepB); PG8_STAGE_A(PG8_SA(1, 0), a3, o2[0]);
            PG8_WAIT_V(8); PG8_WAIT_L(0); PG8_BAR; PG8_MMA(1, 0, At, B0); PG8_MMA(1, 1, At, B1); PG8_BAR; PG8_SCHED;
        }
        }
        if (wr == 0) PG8_BAR;
        { int fr_ = fr, fq_ = fq; asm volatile("" : "+v"(fr_), "+v"(fq_)); E(acc, cur, wr, wc, fr_, fq_); }
        if (!has_next) break;
        if (S.fresh(nxt)) {
#pragma unroll
            for (int a = 0; a < 2; ++a)
#pragma unroll
                for (int b = 0; b < 2; ++b)
#pragma unroll
                    for (int m = 0; m < 4; ++m)
#pragma unroll
                        for (int n = 0; n < 2; ++n) acc[a][b][m][n] = (f32x4){0.f, 0.f, 0.f, 0.f};
        }
        cur = nxt; cA = nA; cB = nB; ++ui;
#pragma unroll
        for (int h = 0; h < 2; ++h)
#pragma unroll
            for (int i = 0; i < 2; ++i) offC[h][i] = offN[h][i];
        if (wr == 1) PG8_BAR;
    }
    PG8_WAIT_V(0);
    PG8_BAR;
#undef PG8_SA
#undef PG8_SB
#undef PG8_STAGE_A
#undef PG8_STAGE_B
#undef PG8_LDA
#undef PG8_LDB
#undef PG8_MMA
#undef PG8_WAIT_V
#undef PG8_WAIT_L
#undef PG8_BAR
#undef PG8_SCHED
#undef PG8_OFFS
}
}

struct Args { const float* in[26]; float* out; unsigned char* ws; int ph_lo, ph_hi; };
typedef const __attribute__((address_space(4))) Args* KArgs;
enum { I_X = 0, I_C, I_CTX, I_CCTX, I_WADA, I_BADA, I_N1G, I_N2G, I_WIN, I_WGATE, I_WBR, I_WOUT, I_DECAY, I_QNG, I_WUQ, I_KVNG, I_WUKV, I_GQN, I_GKN, I_SINK, I_WR, I_BR, I_W1, I_W3, I_W2, I_FNG };
constexpr int NWAVES = 8, NTHREADS = 512;

struct CvtDesc { const float* src; const float* kscale; bf16_t* dst; int N, k0, n0, Kd, nvalid, rmap; };
__device__ __forceinline__ void cvt_load(const CvtDesc& d, int lane, f32x4 (&v)[16]) {
    const int kk = lane >> 4, n4 = lane & 15, ncol = d.n0 + 4 * n4;
#pragma unroll
    for (int j = 0; j < 16; ++j) {
        const int k = d.k0 + 4 * j + kk;
        v[j] = (4 * n4 < d.nvalid) ? *(const GAS f32x4*)(d.src + (size_t)k * d.N + ncol) : (f32x4){0.f, 0.f, 0.f, 0.f};
    }
}
__device__ __forceinline__ void cvt_store(const CvtDesc& d, f32x4 (&v)[16], LAS unsigned char* scr, int lane) {
    const int kk = lane >> 4, n4 = lane & 15;
    if (d.kscale) {
#pragma unroll
        for (int j = 0; j < 16; ++j) v[j] = v[j] * d.kscale[d.k0 + 4 * j + kk];
    }
    LAS unsigned short* s16 = (LAS unsigned short*)scr;
#pragma unroll
    for (int j = 0; j < 16; ++j)
#pragma unroll
        for (int i = 0; i < 4; ++i) s16[(4 * n4 + i) * 66 + 4 * j + kk] = (unsigned short)f2bf(v[j][i]);
    LDS_WAIT(); asm volatile("" ::: "memory");
    const LAS unsigned* s32 = (const LAS unsigned*)scr;
    const int c = lane & 7;
#pragma unroll
    for (int jj = 0; jj < 8; ++jj) {
        const int n = (lane >> 3) + 8 * jj;
        u32x4 o; o.x = s32[n * 33 + 4 * c]; o.y = s32[n * 33 + 4 * c + 1]; o.z = s32[n * 33 + 4 * c + 2]; o.w = s32[n * 33 + 4 * c + 3];
        const int prow = d.rmap == 0 ? n : (d.rmap == 1 ? (n & 31) + 128 * (n >> 5) : 32 * (n >> 4) + 8 * ((n >> 2) & 3) + (n & 3));
        *(GAS u32x4*)(d.dst + (size_t)prow * d.Kd + d.k0 + 8 * c) = o;
    }
    LDS_WAIT(); asm volatile("" ::: "memory");
}
constexpr int CV_EXP_ITEMS = 2 * 32 * 3 * 256;
constexpr int CV_IN = 16 * 40, CV_GT = 16 * 64, CV_BRN = 4 * 16, CV_OUT = 16 * 16, CV_UQ = 4 * 6, CV_UKV = 2 * 8;
constexpr int CV_PER_L = CV_IN + CV_GT + 4 * CV_BRN + CV_OUT + CV_UQ + CV_UKV;
constexpr int CV_NITEMS = CV_EXP_ITEMS + 2 * CV_PER_L;
__device__ __forceinline__ void cvt_decode(KArgs a, unsigned char* ws, int it, CvtDesc& d) {
    d.kscale = nullptr; d.N = 1024; d.Kd = 1024; d.nvalid = 64; d.rmap = 0;
    if (it < CV_EXP_ITEMS) {
        const int j = it >> 8, r = it & 255, l = j / 96, jj = j % 96, e = jj / 3, kind = jj % 3, kb = r >> 4, nb = r & 15;
        const size_t eo = ((size_t)l * 32 + e) * 1048576;
        d.k0 = kb * 64; d.n0 = nb * 64;
        if (kind < 2) { d.src = (kind == 0 ? a->in[I_W1] : a->in[I_W3]) + eo;
            d.dst = (bf16_t*)(ws + WS_W13) + ((size_t)l * 32 + e) * 2097152 + (size_t)(256 * (nb >> 1) + 128 * kind + 64 * (nb & 1)) * 1024; }
        else { d.src = a->in[I_W2] + eo; d.dst = (bf16_t*)(ws + WS_W2) + eo + (size_t)(nb * 64) * 1024; }
        return;
    }
    int r = it - CV_EXP_ITEMS; const int l = r / CV_PER_L; r -= l * CV_PER_L;
    if (r < CV_IN) {
        const int kb = r / 40, hb = r % 40, t = hb >> 2, wc = hb & 3; int src0 = -1, nv = 64;
        if (t < 5) src0 = 256 * t + 64 * wc;
        else if (t == 5) { if (wc < 2) src0 = 1280 + 64 * wc; else if (wc == 2) { src0 = 1408; nv = 32; } }
        else if (t == 6) src0 = P_GQA + 64 * wc;
        else if (t == 7) src0 = wc < 2 ? P_GQA + 256 + 64 * wc : P_GQA + 384 + 64 * (wc - 2);
        else if (t == 8) src0 = P_WIN + 64 * wc;
        else src0 = wc < 2 ? P_WIN + 256 + 64 * wc : P_WIN + 384 + 64 * (wc - 2);
        d.src = a->in[I_WIN] + (size_t)l * 1024 * NIN; d.N = NIN; d.k0 = kb * 64; d.n0 = src0 < 0 ? 0 : src0; d.nvalid = src0 < 0 ? 0 : nv; d.rmap = 1;
        d.dst = (bf16_t*)(ws + WS_WIN) + ((size_t)l * NBG + 256 * t + 32 * wc) * 1024; return; } r -= CV_IN;
    if (r < CV_GT) {
        const int kb = r >> 6, nb = r & 63, i = nb >> 4, tg = nb & 15;
        d.src = a->in[I_WGATE] + (size_t)l * 1024 * 4096; d.N = 4096; d.k0 = kb * 64; d.n0 = i * 1024 + 64 * tg; d.rmap = 2;
        d.dst = (bf16_t*)(ws + WS_WIN) + ((size_t)l * NBG + NINP + 256 * tg + 128 * (i >> 1) + 4 * (i & 1)) * 1024; return; } r -= CV_GT;
    if (r < 4 * CV_BRN) { const int i = r / CV_BRN, rr = r % CV_BRN, kb = rr >> 4, nb = rr & 15; d.src = a->in[I_WBR] + ((size_t)l * 4 + i) * 256 * 1024; d.k0 = kb * 64; d.n0 = nb * 64;
        d.dst = (bf16_t*)(ws + WS_WBR) + ((size_t)l * 1024 + nb * 64) * 1024 + 256 * i; return; } r -= 4 * CV_BRN;
    if (r < CV_OUT) { const int kb = r >> 4, nb = r & 15; d.src = a->in[I_WOUT] + (size_t)l * 1048576; d.k0 = kb * 64; d.n0 = nb * 64; d.dst = (bf16_t*)(ws + WS_WOUT) + (size_t)l * 1048576 + (size_t)(nb * 64) * 1024; return; } r -= CV_OUT;
    if (r < CV_UQ) { const int kb = r / 6, nb = r % 6; d.src = a->in[I_WUQ] + (size_t)l * 256 * 384; d.N = 384; d.k0 = kb * 64; d.n0 = nb * 64; d.kscale = a->in[I_QNG] + l * 256; d.dst = (bf16_t*)(ws + WS_WSM) + ((size_t)l * 384 + nb * 64) * 256; d.Kd = 256; return; } r -= CV_UQ;
    { const int kb = r >> 3, nb = r & 7; d.src = a->in[I_WUKV] + (size_t)l * 128 * 512; d.N = 512; d.k0 = kb * 64; d.n0 = nb * 64; d.kscale = a->in[I_KVNG] + l * 128; d.dst = (bf16_t*)(ws + WS_WSM) + 2 * 384 * 256 + ((size_t)l * 512 + nb * 64) * 128; d.Kd = 128; }
}

__device__ __forceinline__ void p0_prologue(KArgs a, LAS unsigned char* lds, int tid, int lane, int wave, int G, int c) {
    unsigned char* ws = a->ws;
    if (c < 192) {
        LAS float* st = (LAS float*)lds;
        LAS float* red = (LAS float*)(lds + 36864);
        for (int idx = tid; idx < 9 * 1024; idx += NTHREADS) { const int r = idx >> 10, k = idx & 1023; const float v = r < 8 ? a->in[I_C][r * 1024 + k] : a->in[I_CCTX][k]; st[idx] = v / (1.f + __expf(-v)); }
        __syncthreads();
        const int l = c / 96, n0 = (c % 96) * 64;
        float acc[9];
#pragma unroll
        for (int r = 0; r < 9; ++r) acc[r] = 0.f;
        const float* wp = a->in[I_WADA] + ((size_t)l * 1024 + wave * 128) * 6144 + n0 + lane;
#pragma unroll 4
        for (int k = 0; k < 128; ++k) { const float wv = wp[(size_t)k * 6144];
#pragma unroll
            for (int r = 0; r < 9; ++r) acc[r] += st[r * 1024 + wave * 128 + k] * wv; }
#pragma unroll
        for (int r = 0; r < 9; ++r) red[(wave * 9 + r) * 64 + lane] = acc[r];
        __syncthreads();
        for (int idx = tid; idx < 9 * 64; idx += NTHREADS) { const int r = idx >> 6, n = idx & 63; float s = 0.f;
#pragma unroll
            for (int w = 0; w < 8; ++w) s += red[(w * 9 + r) * 64 + n];
            ((float*)(ws + WS_ADA))[((size_t)l * 9 + r) * 6144 + n0 + n] = s + a->in[I_BADA][l * 6144 + n0 + n]; }
        __syncthreads();
    }
    const int gw = c * NWAVES + wave, NGW = G * NWAVES;
    {
        float* rope = (float*)(ws + WS_ROPE);
        for (int idx = gw * 64 + lane; idx < 2048 * 48; idx += NGW * 64) {
            const int pos = idx / 48, j = idx % 48, row = pos >> 6, col = pos & 63;
            if (j < 32) { const int i = j, f = i & 15; const float inv = powf(10000.f, -(float)f / 16.f); const float ang = (float)(i < 16 ? row : col) * inv;
                rope[pos * 32 + i] = cosf(ang); rope[2048 * 32 + pos * 32 + i] = sinf(ang); }
            else { const int i = j - 32, f = i & 7; const float inv = powf(10000.f, -(float)f / 8.f); const float ang = (float)(i < 8 ? row : col) * inv;
                rope[2 * 2048 * 32 + pos * 16 + i] = cosf(ang); rope[2 * 2048 * 32 + 2048 * 16 + pos * 16 + i] = sinf(ang); }
        }
        float* wrp = (float*)(ws + WS_WRP);
        for (int idx = gw * 64 + lane; idx < 32768; idx += NGW * 64) { const int half = idx >> 14, w = (idx >> 11) & 7, q = (idx >> 9) & 3, e = (idx >> 5) & 15, s = idx & 31;
            wrp[idx] = a->in[I_WR][(128 * w + 32 * q + s) * 32 + 16 * half + e]; }
    }
    LAS unsigned char* scr = lds + 57344 + wave * 8448;
    {
        int it = gw;
        if (it < CV_NITEMS) {
            CvtDesc dA, dB; f32x4 va[16], vb[16];
            cvt_decode(a, ws, it, dA); cvt_load(dA, lane, va);
            for (;;) {
                const int itB = it + NGW; const bool hasB = itB < CV_NITEMS;
                if (hasB) { cvt_decode(a, ws, itB, dB); cvt_load(dB, lane, vb); }
                cvt_store(dA, va, scr, lane);
                if (!hasB) break;
                const int itA = itB + NGW; const bool hasA = itA < CV_NITEMS;
                if (hasA) { cvt_decode(a, ws, itA, dA); cvt_load(dA, lane, va); }
                cvt_store(dB, vb, scr, lane);
                if (!hasA) break;
                it = itA;
            }
        }
    }
}

__device__ __forceinline__ void moe_tables(const unsigned* ctl, int l, LAS unsigned char* lds, int tid) {
    LAS int* tb = (LAS int*)(lds + LDS_MISC + 1024); LAS int* cn = (LAS int*)(lds + LDS_MISC + 1280);
    __syncthreads();
    if (tid < 32) cn[tid] = (int)__hip_atomic_load(ctl + CW_CNT + l * 32 + tid, __ATOMIC_RELAXED, __HIP_MEMORY_SCOPE_AGENT);
    __syncthreads();
    if (tid == 0) { int s = 0; for (int e = 0; e < 32; ++e) { tb[e] = s; s += (cn[e] + 255) >> 8; } tb[32] = s; }
    __syncthreads();
}

__device__ __forceinline__ void phase_rownorm(KArgs a, int mode, LAS unsigned char* lds, int lane, int wave, int G, int c) {
    unsigned char* ws = a->ws;
    const int gw = c * NWAVES + wave, NGW = G * NWAVES;
    const float* ada = (const float*)(ws + WS_ADA);
    float* X = (float*)(ws + WS_X);
    const LAS int* tb = (const LAS int*)(lds + LDS_MISC + 1024);
    const int nrows = (mode == 2) ? TL : TT;
    const int lprev = mode - 1, lcur = (mode == 2) ? 0 : mode;
    constexpr int R = 3;
    for (int base = gw; base < nrows; base += R * NGW) {
        f32x4 v[R][4]; int rows[R]; bool ok[R];
#pragma unroll
        for (int r = 0; r < R; ++r) { rows[r] = base + r * NGW; ok[r] = rows[r] < nrows; if (!ok[r]) rows[r] = base; }
#pragma unroll
        for (int r = 0; r < R; ++r) {
            const int row = rows[r];
            const float* src = (mode == 0) ? (row < TL ? a->in[I_X] + (size_t)row * 1024 : a->in[I_CTX] + (size_t)(row - TL) * 1024) : X + (size_t)row * 1024;
#pragma unroll
            for (int j = 0; j < 4; ++j) v[r][j] = *(const GAS f32x4*)(src + 4 * lane + 256 * j);
        }
        if (mode != 0) {
            const int* te = (const int*)(ws + WS_TOKE); const float* tw = (const float*)(ws + WS_TOKW);
            const bf16_t* Y2 = (const bf16_t*)(ws + WS_Y2);
            u32x2 y0[R][4], y1[R][4]; float w0[R], w1[R];
#pragma unroll
            for (int r = 0; r < R; ++r) {
                const int row = rows[r];
                const int e0 = te[row * 2], e1 = te[row * 2 + 1]; w0[r] = tw[row * 2]; w1[r] = tw[row * 2 + 1];
                const size_t s0 = (size_t)(tb[e0 >> 20] * 256 + (e0 & 0xfffff)), s1 = (size_t)(tb[e1 >> 20] * 256 + (e1 & 0xfffff));
#pragma unroll
                for (int j = 0; j < 4; ++j) { y0[r][j] = *(const GAS u32x2*)(Y2 + s0 * 1024 + 4 * lane + 256 * j); y1[r][j] = *(const GAS u32x2*)(Y2 + s1 * 1024 + 4 * lane + 256 * j); }
            }
#pragma unroll
            for (int r = 0; r < R; ++r) {
                const int row = rows[r]; const int b = row < TL ? (row >> 11) : 8;
                const float* g2 = ada + ((size_t)lprev * 9 + b) * 6144 + 5120;
#pragma unroll
                for (int j = 0; j < 4; ++j) {
                    const f32x4 gg = *(const GAS f32x4*)(g2 + 4 * lane + 256 * j);
                    f32x4 f; f.x = w0[r] * bflo(y0[r][j].x) + w1[r] * bflo(y1[r][j].x); f.y = w0[r] * bfhi(y0[r][j].x) + w1[r] * bfhi(y1[r][j].x);
                    f.z = w0[r] * bflo(y0[r][j].y) + w1[r] * bflo(y1[r][j].y); f.w = w0[r] * bfhi(y0[r][j].y) + w1[r] * bfhi(y1[r][j].y);
                    v[r][j] = v[r][j] + gg * f;
                }
                if (mode == 1 && ok[r]) {
#pragma unroll
                    for (int j = 0; j < 4; ++j) *(GAS f32x4*)(X + (size_t)row * 1024 + 4 * lane + 256 * j) = v[r][j];
                }
            }
        }
#pragma unroll
        for (int r = 0; r < R; ++r) {
            const int row = rows[r]; const int b = row < TL ? (row >> 11) : 8;
            float ss = 0.f;
#pragma unroll
            for (int j = 0; j < 4; ++j) ss += (v[r][j].x * v[r][j].x + v[r][j].y * v[r][j].y) + (v[r][j].z * v[r][j].z + v[r][j].w * v[r][j].w);
            const float rstd = 1.0f / sqrtf(wave_sum(ss) * (1.f / 1024.f) + EPS);
            if (ok[r]) {
                if (mode == 2) {
#pragma unroll
                    for (int j = 0; j < 4; ++j) { const f32x4 g = *(const GAS f32x4*)(a->in[I_FNG] + 4 * lane + 256 * j); *(GAS f32x4*)(a->out + (size_t)row * 1024 + 4 * lane + 256 * j) = v[r][j] * rstd * g; }
                } else {
                    const float* gn = a->in[I_N1G] + lcur * 1024; const float* sh = ada + ((size_t)lcur * 9 + b) * 6144; const float* sc = sh + 1024;
                    bf16_t* H = (bf16_t*)(ws + WS_H) + (size_t)row * 1024;
#pragma unroll
                    for (int j = 0; j < 4; ++j) { const int cc = 4 * lane + 256 * j; const f32x4 g = *(const GAS f32x4*)(gn + cc), s1 = *(const GAS f32x4*)(sc + cc), s0 = *(const GAS f32x4*)(sh + cc);
                        const f32x4 h = v[r][j] * rstd * g * (s1 + 1.0f) + s0; u32x2 o; o.x = pk2(h.x, h.y); o.y = pk2(h.z, h.w); *(GAS u32x2*)(H + cc) = o; }
                }
            }
        }
    }
}

using pg8::Unit;
struct SchedB {
    int layer, G, c; const char* H; const char* W;
    __device__ __forceinline__ bool next(int i, Unit& u) const {
        const int L = i * G + c; u.aux = 0;
        if (layer == 0) { if (L >= 72 * 26) return false; pg8::tile_order(L, 72, 26, u.pm, u.pn); return true; }
        if (L < 64 * 16) { pg8::tile_order(L, 64, 16, u.pm, u.pn); u.pn += 10; return true; }
        const int L2 = L - 64 * 16; if (L2 >= 72 * 10) return false; pg8::tile_order(L2, 72, 10, u.pm, u.pn); return true;
    }
    __device__ __forceinline__ void ptrs(const Unit& u, const char*& A, const char*& B) const { A = H + (size_t)u.pm * 256 * 1024 * 2; B = W + (size_t)u.pn * 256 * 1024 * 2; }
    __device__ __forceinline__ int arow(const Unit&, int r) const { return r; }
    __device__ __forceinline__ bool fresh(const Unit&) const { return true; }
};
struct EpiB {
    static constexpr bool PERM = true, MID = false;
    bf16_t* P; bf16_t* Gt; bf16_t* Q; const float* cos64; const float* sin64; const float* qng; const float* kng;
    __device__ __forceinline__ void operator()(f32x4 (&acc)[2][2][4][2], const Unit& u, int wr, int wc, int fr, int fq) const {
        const int row0 = u.pm * 256 + wr * 64 + fr;
        if (u.pn >= 10) {
            const int d0 = (u.pn - 10) * 64 + 16 * wc + 4 * fq;
#pragma unroll
            for (int ai = 0; ai < 2; ++ai)
#pragma unroll
                for (int m = 0; m < 4; ++m) { bf16_t* gp = Gt + (size_t)(row0 + ai * 128 + m * 16) * NGATE + d0;
                    f32x4 g[4];
#pragma unroll
                    for (int i = 0; i < 4; ++i)
#pragma unroll
                        for (int j = 0; j < 4; ++j) g[i][j] = fmaxf(sigmoidf_(acc[ai][i >> 1][m][i & 1][j]), 1e-6f);
#pragma unroll
                    for (int i = 0; i < 4; ++i) { f32x4 r = g[i];
                        if (i < 3) {
#pragma unroll
                            for (int j = 0; j < 4; ++j) r[j] *= fast_rcp(g[i + 1][j]); }
                        u32x2 w; w.x = pk2(r[0], r[1]); w.y = pk2(r[2], r[3]); *(GAS u32x2*)(gp + i * 1024) = w; } }
            return;
        }
        const int t = u.pn;
        bf16_t* dst; size_t ld; int col; int mode = 0;
        float scale = 1.f; const float* gain = nullptr;
        if (t == 4) { dst = P; ld = NINP; col = P_MLA + 64 * wc; }
        else if (t == 5) { dst = P; ld = NINP; col = 1280 + 64 * wc; mode = wc < 3 ? 0 : 3; }
        else { dst = Q; ld = QP;
            if (t == 0) { col = Q_RETQ + 64 * wc; mode = 1; scale = 0.125f; }
            else if (t == 1) { col = Q_RETK + 64 * wc; mode = 1; }
            else if (t == 2) col = Q_RETV + 64 * wc;
            else if (t == 3) col = Q_RETG + 64 * wc;
            else if (t == 6) { col = Q_GQAQ + 64 * wc; mode = 2; scale = 0.125f * LOG2E; gain = qng; }
            else if (t == 7) { if (wc < 2) { col = Q_GQAK + 64 * wc; mode = 2; gain = kng; } else col = Q_GQAV + 64 * (wc - 2); }
            else if (t == 8) { col = Q_WINQ + 64 * wc; mode = 1; scale = 0.125f * LOG2E; }
            else { if (wc < 2) { col = Q_WINK + 64 * wc; mode = 1; } else col = Q_WINV + 64 * (wc - 2); } }
        if (mode == 3) return;
        f32x4 ga0 = {1.f, 1.f, 1.f, 1.f}, ga1 = ga0, gb0 = ga0, gb1 = ga0;
        if (mode == 2) { ga0 = *(const GAS f32x4*)(gain + 8 * fq); ga1 = *(const GAS f32x4*)(gain + 8 * fq + 4); gb0 = *(const GAS f32x4*)(gain + 32 + 8 * fq); gb1 = *(const GAS f32x4*)(gain + 32 + 8 * fq + 4); }
        const bool half_only = (t == 5 && wc == 2);
#pragma unroll
        for (int ai = 0; ai < 2; ++ai)
#pragma unroll
            for (int m = 0; m < 4; ++m) {
                const int row = row0 + ai * 128 + m * 16;
                f32x4 a0 = acc[ai][0][m][0], a1 = acc[ai][0][m][1], b0 = acc[ai][1][m][0], b1 = acc[ai][1][m][1];
                if (mode == 2) {
                    float ss = 0.f;
#pragma unroll
                    for (int j = 0; j < 4; ++j) ss += a0[j] * a0[j] + a1[j] * a1[j] + b0[j] * b0[j] + b1[j] * b1[j];
                    ss = xadd<16>(ss); ss = xadd<32>(ss);
                    const float rstd = 1.0f / sqrtf(ss * (1.f / 64.f) + EPS);
                    a0 = a0 * rstd * ga0; a1 = a1 * rstd * ga1; b0 = b0 * rstd * gb0; b1 = b1 * rstd * gb1;
                }
                if (mode >= 1) {
                    if (row < TL) { const int pos = row & 2047;
                        const f32x4 c0 = *(const GAS f32x4*)(cos64 + pos * 32 + 8 * fq), c1 = *(const GAS f32x4*)(cos64 + pos * 32 + 8 * fq + 4);
                        const f32x4 s0 = *(const GAS f32x4*)(sin64 + pos * 32 + 8 * fq), s1 = *(const GAS f32x4*)(sin64 + pos * 32 + 8 * fq + 4);
                        const f32x4 o0 = a0 * c0 - b0 * s0, o1 = a1 * c1 - b1 * s1, p0 = b0 * c0 + a0 * s0, p1 = b1 * c1 + a1 * s1;
                        a0 = o0; a1 = o1; b0 = p0; b1 = p1; }
                    a0 = a0 * scale; a1 = a1 * scale; b0 = b0 * scale; b1 = b1 * scale;
                }
                bf16_t* rp = dst + (size_t)row * ld + col + 8 * fq;
                u32x4 w; w.x = pk2(a0[0], a0[1]); w.y = pk2(a0[2], a0[3]); w.z = pk2(a1[0], a1[1]); w.w = pk2(a1[2], a1[3]);
                *(GAS u32x4*)rp = w;
                if (!half_only) { u32x4 w2; w2.x = pk2(b0[0], b0[1]); w2.y = pk2(b0[2], b0[3]); w2.z = pk2(b1[0], b1[1]); w2.w = pk2(b1[2], b1[3]); *(GAS u32x4*)(rp + 32) = w2; }
            }
    }
};
struct SchedE {
    int G, c, nM; const char* Y; const char* W;
    __device__ __forceinline__ bool next(int i, Unit& u) const { const int L = i * G + c; u.aux = 0; if (L >= nM * 4) return false; pg8::tile_order(L, nM, 4, u.pm, u.pn); return true; }
    __device__ __forceinline__ void ptrs(const Unit& u, const char*& A, const char*& B) const { A = Y + (size_t)u.pm * 256 * 1024 * 2; B = W + (size_t)u.pn * 256 * 1024 * 2; }
    __device__ __forceinline__ int arow(const Unit&, int r) const { return r; }
    __device__ __forceinline__ bool fresh(const Unit&) const { return true; }
};
struct EpiE {
    static constexpr bool PERM = true, MID = true;
    const bf16_t* Gt; bf16_t* M;
    __device__ __forceinline__ void mid(f32x4 (&acc)[2][2][4][2], const Unit& u, int i, int wr, int wc, int fr, int fq) const {
        const int row0 = u.pm * 256 + wr * 64 + fr;
        const int col0 = u.pn * 256 + wc * 32 + 8 * fq;
#pragma unroll
        for (int ai = 0; ai < 2; ++ai)
#pragma unroll
            for (int m = 0; m < 4; ++m) { const bf16_t* gp = Gt + (size_t)(row0 + ai * 128 + m * 16) * NGATE + (i - 1) * 1024 + col0;
#pragma unroll
                for (int bj = 0; bj < 2; ++bj) {
                    const u32x4 g = *(const GAS u32x4*)(gp + bj * 128);
                    const f32x4 s0 = {bflo(g.x), bfhi(g.x), bflo(g.y), bfhi(g.y)}, s1 = {bflo(g.z), bfhi(g.z), bflo(g.w), bfhi(g.w)};
                    acc[ai][bj][m][0] = acc[ai][bj][m][0] * s0; acc[ai][bj][m][1] = acc[ai][bj][m][1] * s1;
                    asm volatile("" ::: "memory");
                } }
    }
    __device__ __forceinline__ void operator()(f32x4 (&acc)[2][2][4][2], const Unit& u, int wr, int wc, int fr, int fq) const {
        const int row0 = u.pm * 256 + wr * 64 + fr, col0 = u.pn * 256 + wc * 32 + 8 * fq;
#pragma unroll
        for (int ai = 0; ai < 2; ++ai)
#pragma unroll
            for (int m = 0; m < 4; ++m) { const size_t row = (size_t)(row0 + ai * 128 + m * 16);
#pragma unroll
                for (int bj = 0; bj < 2; ++bj) {
                    const u32x4 g = *(const GAS u32x4*)(Gt + row * NGATE + 3 * 1024 + col0 + bj * 128);
                    const f32x4 s0 = {bflo(g.x), bfhi(g.x), bflo(g.y), bfhi(g.y)}, s1 = {bflo(g.z), bfhi(g.z), bflo(g.w), bfhi(g.w)};
                    const f32x4 v0 = acc[ai][bj][m][0] * s0, v1 = acc[ai][bj][m][1] * s1;
                    u32x4 w; w.x = pk2(v0[0], v0[1]); w.y = pk2(v0[2], v0[3]); w.z = pk2(v1[0], v1[1]); w.w = pk2(v1[2], v1[3]);
                    *(GAS u32x4*)(M + row * 1024 + col0 + bj * 128) = w;
                } }
    }
};
struct SchedE_old {
    int G, c, nM; const char* Y; const char* W;
    __device__ __forceinline__ bool next(int j, Unit& u) const { const int L = (j >> 2) * G + c; if (L >= nM * 4) return false; pg8::tile_order(L, nM, 4, u.pm, u.pn); u.aux = j & 3; return true; }
    __device__ __forceinline__ void ptrs(const Unit& u, const char*& A, const char*& B) const { A = Y + ((size_t)u.pm * 256 * 1024 + u.aux * 256) * 2; B = W + ((size_t)u.aux * 1024 + u.pn * 256) * 256 * 2; }
    __device__ __forceinline__ int arow(const Unit&, int r) const { return r; }
    __device__ __forceinline__ bool fresh(const Unit& u) const { return u.aux == 0; }
};
struct EpiE_old {
    static constexpr bool PERM = true, MID = false;
    const bf16_t* Gt; bf16_t* M;
    __device__ __forceinline__ void operator()(f32x4 (&acc)[2][2][4][2], const Unit& u, int wr, int wc, int fr, int fq) const {
        const int row0 = u.pm * 256 + wr * 64 + fr, col0 = u.pn * 256 + wc * 32 + 8 * fq, i = u.aux;
#pragma unroll
        for (int ai = 0; ai < 2; ++ai)
#pragma unroll
            for (int m = 0; m < 4; ++m) { const size_t row = (size_t)(row0 + ai * 128 + m * 16);
#pragma unroll
                for (int bj = 0; bj < 2; ++bj) {
                    const u32x4 g = *(const GAS u32x4*)(Gt + row * NGATE + i * 1024 + col0 + bj * 128);
                    f32x4 s0 = {bflo(g.x), bfhi(g.x), bflo(g.y), bfhi(g.y)}, s1 = {bflo(g.z), bfhi(g.z), bflo(g.w), bfhi(g.w)};
                    if (i < 3) {
                        const u32x4 gn = *(const GAS u32x4*)(Gt + row * NGATE + (i + 1) * 1024 + col0 + bj * 128);
                        const f32x4 d0 = {bflo(gn.x), bfhi(gn.x), bflo(gn.y), bfhi(gn.y)}, d1 = {bflo(gn.z), bfhi(gn.z), bflo(gn.w), bfhi(gn.w)};
#pragma unroll
                        for (int j = 0; j < 4; ++j) { s0[j] *= fast_rcp(d0[j]); s1[j] *= fast_rcp(d1[j]); }
                        acc[ai][bj][m][0] = acc[ai][bj][m][0] * s0; acc[ai][bj][m][1] = acc[ai][bj][m][1] * s1;
                    } else {
                        const f32x4 v0 = acc[ai][bj][m][0] * s0, v1 = acc[ai][bj][m][1] * s1;
                        u32x4 w; w.x = pk2(v0[0], v0[1]); w.y = pk2(v0[2], v0[3]); w.z = pk2(v1[0], v1[1]); w.w = pk2(v1[2], v1[3]);
                        *(GAS u32x4*)(M + row * 1024 + col0 + bj * 128) = w;
                    }
                } }
    }
};
struct SchedF {
    int G, c, nM; const char* A0; const char* W;
    __device__ __forceinline__ bool next(int i, Unit& u) const { const int L = i * G + c; u.aux = 0; if (L >= nM * 4) return false; pg8::tile_order(L, nM, 4, u.pm, u.pn); return true; }
    __device__ __forceinline__ void ptrs(const Unit& u, const char*& A, const char*& B) const { A = A0 + (size_t)u.pm * 256 * 1024 * 2; B = W + (size_t)u.pn * 256 * 1024 * 2; }
    __device__ __forceinline__ int arow(const Unit&, int r) const { return r; }
    __device__ __forceinline__ bool fresh(const Unit&) const { return true; }
};
struct EpiF {
    static constexpr bool PERM = false, MID = false;
    const float* xin; const float* cin; const float* Xs; float* X; const float* ada_l; int layer;
    __device__ __forceinline__ void operator()(f32x4 (&acc)[2][2][4][2], const Unit& u, int wr, int wc, int fr, int fq) const {
        const int row0 = u.pm * 256 + wr * 64 + fr, col0 = u.pn * 256 + wc * 32 + 4 * fq;
#pragma unroll
        for (int ai = 0; ai < 2; ++ai)
#pragma unroll
            for (int m = 0; m < 4; ++m) { const int row = row0 + ai * 128 + m * 16; const int b = row < TL ? (row >> 11) : 8;
                const float* src = (layer == 0) ? (row < TL ? xin + (size_t)row * 1024 : cin + (size_t)(row - TL) * 1024) : Xs + (size_t)row * 1024;
                const float* g1 = ada_l + (size_t)b * 6144 + 2048;
#pragma unroll
                for (int bj = 0; bj < 2; ++bj)
#pragma unroll
                    for (int n = 0; n < 2; ++n) { const int c = col0 + bj * 128 + n * 16;
                        const f32x4 xs = *(const GAS f32x4*)(src + c), gg = *(const GAS f32x4*)(g1 + c);
                        *(GAS f32x4*)(X + (size_t)row * 1024 + c) = xs + gg * acc[ai][bj][m][n]; } }
    }
};
struct SchedMoe {
    int G, c, npn, gather; const LAS int* tb; const LAS int* cn; const int* tokinv; const char* A0; const char* W; size_t wstride;
    __device__ __forceinline__ bool next(int i, Unit& u) const {
        const int L = i * G + c; if (L >= tb[32] * npn) return false;
        const int rt = L / npn; u.pm = rt; u.pn = L - rt * npn; int e = 0;
#pragma unroll
        for (int k = 1; k < 32; ++k) e += (rt >= tb[k]) ? 1 : 0;
        u.aux = e | ((rt - tb[e]) << 8); return true;
    }
    __device__ __forceinline__ void ptrs(const Unit& u, const char*& A, const char*& B) const {
        A = gather ? A0 : A0 + (size_t)u.pm * 256 * 1024 * 2; B = W + (size_t)(u.aux & 255) * wstride + (size_t)u.pn * 256 * 1024 * 2; }
    __device__ __forceinline__ int arow(const Unit& u, int r) const { const int e = u.aux & 255, idx = (u.aux >> 8) * 256 + r; return idx < cn[e] ? tokinv[(size_t)e * TT + idx] : 0; }
    __device__ __forceinline__ bool fresh(const Unit&) const { return true; }
};
struct EpiH {
    static constexpr bool PERM = true, MID = false;
    bf16_t* HID;
    __device__ __forceinline__ void operator()(f32x4 (&acc)[2][2][4][2], const Unit& u, int wr, int wc, int fr, int fq) const {
        const int row0 = u.pm * 256 + wr * 64 + fr, col0 = u.pn * 128 + wc * 32 + 8 * fq;
#pragma unroll
        for (int ai = 0; ai < 2; ++ai)
#pragma unroll
            for (int m = 0; m < 4; ++m) { f32x4 h0, h1;
#pragma unroll
                for (int j = 0; j < 4; ++j) { const float a0 = acc[ai][0][m][0][j], a1 = acc[ai][0][m][1][j];
                    h0[j] = a0 * sigmoidf_(a0) * acc[ai][1][m][0][j]; h1[j] = a1 * sigmoidf_(a1) * acc[ai][1][m][1][j]; }
                u32x4 w; w.x = pk2(h0[0], h0[1]); w.y = pk2(h0[2], h0[3]); w.z = pk2(h1[0], h1[1]); w.w = pk2(h1[2], h1[3]);
                *(GAS u32x4*)(HID + (size_t)(row0 + ai * 128 + m * 16) * 1024 + col0) = w; }
    }
};
struct EpiI {
    static constexpr bool PERM = true, MID = false;
    bf16_t* Y2;
    __device__ __forceinline__ void operator()(f32x4 (&acc)[2][2][4][2], const Unit& u, int wr, int wc, int fr, int fq) const {
        const int row0 = u.pm * 256 + wr * 64 + fr, col0 = u.pn * 256 + wc * 32 + 8 * fq;
#pragma unroll
        for (int ai = 0; ai < 2; ++ai)
#pragma unroll
            for (int m = 0; m < 4; ++m)
#pragma unroll
                for (int bj = 0; bj < 2; ++bj) { const f32x4 v0 = acc[ai][bj][m][0], v1 = acc[ai][bj][m][1];
                    u32x4 w; w.x = pk2(v0[0], v0[1]); w.y = pk2(v0[2], v0[3]); w.z = pk2(v1[0], v1[1]); w.w = pk2(v1[2], v1[3]);
                    *(GAS u32x4*)(Y2 + (size_t)(row0 + ai * 128 + m * 16) * 1024 + col0 + bj * 128) = w; }
    }
};

__device__ __forceinline__ void rope_item_desc(int item, int& src, int& dst, float& scale, int& normsel) {
    normsel = 0; scale = 1.f;
    if (item < 4) { src = P_RET + item * 64; dst = Q_RETQ + item * 64; scale = 0.125f; }
    else if (item < 8) { src = P_RET + 256 + (item - 4) * 64; dst = Q_RETK + (item - 4) * 64; }
    else if (item < 12) { src = P_GQA + (item - 8) * 64; dst = Q_GQAQ + (item - 8) * 64; scale = 0.125f * LOG2E; normsel = 1; }
    else if (item < 14) { src = P_GQA + 256 + (item - 12) * 64; dst = Q_GQAK + (item - 12) * 64; normsel = 2; }
    else if (item < 16) { src = P_WIN + 256 + (item - 14) * 64; dst = Q_WINK + (item - 14) * 64; }
    else { src = P_WIN + (item - 16) * 64; dst = Q_WINQ + (item - 16) * 64; scale = 0.125f * LOG2E; }
}
__device__ __forceinline__ void phase_post(KArgs a, int l, LAS unsigned char* lds, int lane, int wave, int G, int c) {
    unsigned char* ws = a->ws;
    const bf16_t* P = (const bf16_t*)(ws + WS_P); bf16_t* Q = (bf16_t*)(ws + WS_QKV);
    const float* cos32 = (const float*)(ws + WS_ROPE) + 2 * 2048 * 32; const float* sin32 = cos32 + 2048 * 16;
    const bf16_t* Wuq = (const bf16_t*)(ws + WS_WSM) + (size_t)l * 384 * 256; const bf16_t* Wukv = (const bf16_t*)(ws + WS_WSM) + 2 * 384 * 256 + (size_t)l * 512 * 128;
    const float qscale = 0.10206207261596577f * LOG2E;
    const unsigned ldsb = (unsigned)(uintptr_t)lds;
    constexpr int LQ = 0, LKV = 49152;
    for (int u = c; u < (TT / 128) * 4; u += G) {
        const int h = u & 3, rb = u >> 2;
        for (int p = wave; p < 80; p += NWAVES) {
            if (p < 48) { const int row = 2 * p + (lane >> 5), ch = (lane & 31) ^ (row & 7);
                glds16(Wuq + (size_t)(96 * h + row) * 256 + 8 * ch, (unsigned)__builtin_amdgcn_readfirstlane((int)(ldsb + LQ + p * 1024))); }
            else { const int p2 = p - 48, row = 4 * p2 + (lane >> 4), ch = (lane & 15) ^ (row & 7);
                glds16(Wukv + (size_t)(128 * h + row) * 128 + 8 * ch, (unsigned)__builtin_amdgcn_readfirstlane((int)(ldsb + LKV + p2 * 1024))); }
        }
        const int tk = lane & 15, kq = lane >> 4, row = rb * 128 + wave * 16 + tk; const bool islat = row < TL; const int pos = row & 2047;
        const bf16_t* prow = P + (size_t)row * NINP + P_MLA; bf16_t* qrow = Q + (size_t)row * QP;
        bf16x8 zq[8], zkv[4]; float sq = 0.f, skv = 0.f;
#pragma unroll
        for (int s2 = 0; s2 < 8; ++s2) zq[s2] = *(const GAS bf16x8*)(prow + 32 * s2 + 8 * kq);
#pragma unroll
        for (int s2 = 0; s2 < 4; ++s2) zkv[s2] = *(const GAS bf16x8*)(prow + 256 + 32 * s2 + 8 * kq);
        const u32x2 kr1 = *(const GAS u32x2*)(prow + 384 + 4 * kq), kr2 = *(const GAS u32x2*)(prow + 400 + 4 * kq);
#pragma unroll
        for (int s2 = 0; s2 < 8; ++s2)
#pragma unroll
            for (int j = 0; j < 8; ++j) { const float f = bf2f((unsigned short)zq[s2][j]); sq += f * f; }
#pragma unroll
        for (int s2 = 0; s2 < 4; ++s2)
#pragma unroll
            for (int j = 0; j < 8; ++j) { const float f = bf2f((unsigned short)zkv[s2][j]); skv += f * f; }
        sq = xadd<16>(sq); sq = xadd<32>(sq); skv = xadd<16>(skv); skv = xadd<32>(skv);
        const float rq = (1.0f / sqrtf(sq * (1.f / 256.f) + EPS)) * qscale, rkv = 1.0f / sqrtf(skv * (1.f / 128.f) + EPS);
        f32x4 cr = {1.f, 1.f, 1.f, 1.f}, sr = {0.f, 0.f, 0.f, 0.f};
        if (islat) { cr = *(const GAS f32x4*)(cos32 + pos * 16 + 4 * kq); sr = *(const GAS f32x4*)(sin32 + pos * 16 + 4 * kq); }
        asm volatile("s_waitcnt vmcnt(0)\n\ts_barrier" ::: "memory");
        f32x4 acc[6];
#pragma unroll
        for (int p = 0; p < 6; ++p) {
            bf16x8 w[8];
#pragma unroll
            for (int s2 = 0; s2 < 8; ++s2) w[s2] = *(const LAS bf16x8*)(lds + LQ + (16 * p + tk) * 512 + (((4 * s2 + kq) ^ (tk & 7)) * 16));
            acc[p] = (f32x4){0.f, 0.f, 0.f, 0.f};
#pragma unroll
            for (int s2 = 0; s2 < 8; ++s2) acc[p] = __builtin_amdgcn_mfma_f32_16x16x32_bf16(w[s2], zq[s2], acc[p], 0, 0, 0);
        }
#pragma unroll
        for (int p = 0; p < 4; ++p) { const f32x4 v = acc[p] * rq; u32x2 o; o.x = pk2(v[0], v[1]); o.y = pk2(v[2], v[3]); *(GAS u32x2*)(qrow + Q_MLAQ + h * 96 + 16 * p + 4 * kq) = o; }
        { const f32x4 x1 = acc[4] * rq, x2 = acc[5] * rq; const f32x4 o1 = x1 * cr - x2 * sr, o2 = x2 * cr + x1 * sr;
          u32x2 w1; w1.x = pk2(o1[0], o1[1]); w1.y = pk2(o1[2], o1[3]); u32x2 w2; w2.x = pk2(o2[0], o2[1]); w2.y = pk2(o2[2], o2[3]);
          *(GAS u32x2*)(qrow + Q_MLAQ + h * 96 + 64 + 4 * kq) = w1; *(GAS u32x2*)(qrow + Q_MLAQ + h * 96 + 80 + 4 * kq) = w2; }
#pragma unroll
        for (int p = 0; p < 8; ++p) {
            bf16x8 w[4];
#pragma unroll
            for (int s2 = 0; s2 < 4; ++s2) w[s2] = *(const LAS bf16x8*)(lds + LKV + (16 * p + tk) * 256 + (((4 * s2 + kq) ^ (tk & 7)) * 16));
            f32x4 ac = {0.f, 0.f, 0.f, 0.f};
#pragma unroll
            for (int s2 = 0; s2 < 4; ++s2) ac = __builtin_amdgcn_mfma_f32_16x16x32_bf16(w[s2], zkv[s2], ac, 0, 0, 0);
            const f32x4 v = ac * rkv; u32x2 o; o.x = pk2(v[0], v[1]); o.y = pk2(v[2], v[3]);
            const int col = p < 4 ? Q_MLAK + h * 96 + 16 * p + 4 * kq : Q_MLAV + h * 64 + 16 * (p - 4) + 4 * kq;
            *(GAS u32x2*)(qrow + col) = o;
        }
        if (h == 0) {
            const f32x4 x1 = {bflo(kr1.x), bfhi(kr1.x), bflo(kr1.y), bfhi(kr1.y)}, x2 = {bflo(kr2.x), bfhi(kr2.x), bflo(kr2.y), bfhi(kr2.y)};
            const f32x4 o1 = x1 * cr - x2 * sr, o2 = x2 * cr + x1 * sr;
            u32x2 w1; w1.x = pk2(o1[0], o1[1]); w1.y = pk2(o1[2], o1[3]); u32x2 w2; w2.x = pk2(o2[0], o2[1]); w2.y = pk2(o2[2], o2[3]);
#pragma unroll
            for (int hh = 0; hh < 4; ++hh) { *(GAS u32x2*)(qrow + Q_MLAK + hh * 96 + 64 + 4 * kq) = w1; *(GAS u32x2*)(qrow + Q_MLAK + hh * 96 + 80 + 4 * kq) = w2; }
        }
        asm volatile("s_waitcnt lgkmcnt(0)\n\ts_barrier" ::: "memory");
    }
}

__device__ __forceinline__ void phase_router(KArgs a, int l, int nrows, LAS unsigned char* lds, int tid, int lane, int wave, int G, int c) {
    unsigned char* ws = a->ws;
    const float* X = (const float*)(ws + WS_X); bf16_t* H = (bf16_t*)(ws + WS_H);
    const float* ada = (const float*)(ws + WS_ADA); const float* wrp = (const float*)(ws + WS_WRP);
    const float* gn = a->in[I_N2G] + l * 1024; const float* brt = a->in[I_BR];
    unsigned* ctl = (unsigned*)(ws + WS_CTL);
    int* tokinv = (int*)(ws + WS_TOKINV); int* toke = (int*)(ws + WS_TOKE); float* tokw = (float*)(ws + WS_TOKW);
    const int tk = lane & 15, q = lane >> 4;
    f32x4 wr0[8], wr1[8];
    { const float* p0 = wrp + (((0 * 8 + wave) * 4 + q) * 16 + tk) * 32; const float* p1 = wrp + (((1 * 8 + wave) * 4 + q) * 16 + tk) * 32;
#pragma unroll
      for (int s = 0; s < 8; ++s) { wr0[s] = *(const GAS f32x4*)(p0 + 4 * s); wr1[s] = *(const GAS f32x4*)(p1 + 4 * s); } }
    LAS float* hb = (LAS float*)lds;
    LAS float* part = (LAS float*)(lds + 16 * 4112);
    LAS float* lgs = part + 8 * 16 * 32;
    for (int g = c; g < nrows / 16; g += G) {
        f32x4 v[2][4];
#pragma unroll
        for (int rr = 0; rr < 2; ++rr) { const float* xr = X + (size_t)(g * 16 + 2 * wave + rr) * 1024;
#pragma unroll
            for (int j = 0; j < 4; ++j) v[rr][j] = *(const GAS f32x4*)(xr + 4 * lane + 256 * j); }
#pragma unroll
        for (int rr = 0; rr < 2; ++rr) {
            const int row = g * 16 + 2 * wave + rr, b = row < TL ? (row >> 11) : 8;
            float ss = 0.f;
#pragma unroll
            for (int j = 0; j < 4; ++j) ss += (v[rr][j].x * v[rr][j].x + v[rr][j].y * v[rr][j].y) + (v[rr][j].z * v[rr][j].z + v[rr][j].w * v[rr][j].w);
            const float rstd = 1.0f / sqrtf(wave_sum(ss) * (1.f / 1024.f) + EPS);
            const float* sh = ada + ((size_t)l * 9 + b) * 6144 + 3072; const float* sc = sh + 1024;
#pragma unroll
            for (int j = 0; j < 4; ++j) { const int cc = 4 * lane + 256 * j; const f32x4 gg = *(const GAS f32x4*)(gn + cc), s1 = *(const GAS f32x4*)(sc + cc), s0 = *(const GAS f32x4*)(sh + cc);
                const f32x4 h = v[rr][j] * rstd * gg * (s1 + 1.0f) + s0;
                u32x2 o; o.x = pk2(h.x, h.y); o.y = pk2(h.z, h.w); *(GAS u32x2*)(H + (size_t)row * 1024 + cc) = o;
                *(LAS f32x4*)(hb + (2 * wave + rr) * 1028 + cc) = h; }
        }
        __syncthreads();
        f32x4 acc0 = {0.f, 0.f, 0.f, 0.f}, acc1 = {0.f, 0.f, 0.f, 0.f};
#pragma unroll
        for (int s = 0; s < 8; ++s) { const f32x4 a4 = *(const LAS f32x4*)(hb + tk * 1028 + 128 * wave + 32 * q + 4 * s);
#pragma unroll
            for (int j = 0; j < 4; ++j) { acc0 = __builtin_amdgcn_mfma_f32_16x16x4f32(a4[j], wr0[s][j], acc0, 0, 0, 0); acc1 = __builtin_amdgcn_mfma_f32_16x16x4f32(a4[j], wr1[s][j], acc1, 0, 0, 0); } }
#pragma unroll
        for (int r = 0; r < 4; ++r) { part[(wave * 16 + 4 * q + r) * 32 + tk] = acc0[r]; part[(wave * 16 + 4 * q + r) * 32 + 16 + tk] = acc1[r]; }
        __syncthreads();
        { float sum = 0.f;
#pragma unroll
          for (int w = 0; w < 8; ++w) sum += part[w * 512 + tid];
          lgs[tid] = sum; }
        __syncthreads();
        if (wave == 0 && lane < 16) {
            const LAS float* my = lgs + lane * 32;
            float gs[4];
#pragma unroll
            for (int g4 = 0; g4 < 4; ++g4) { float m1 = -1e30f, m2 = -1e30f;
#pragma unroll
                for (int j = 0; j < 8; ++j) { const int e = g4 * 8 + j; const float sg = 1.0f / (1.0f + __expf(-my[e])); const float vv = sg + brt[e];
                    if (vv > m1) { m2 = m1; m1 = vv; } else if (vv > m2) m2 = vv; }
                gs[g4] = m1 + m2; }
            int gsel = 0; float gb = gs[0];
#pragma unroll
            for (int g4 = 1; g4 < 4; ++g4) if (gs[g4] > gb) { gb = gs[g4]; gsel = g4; }
            float v1 = -1e30f, v2 = -1e30f, s1v = 0.f, s2v = 0.f; int e1 = 0, e2 = 0;
#pragma unroll
            for (int j = 0; j < 8; ++j) { const int e = gsel * 8 + j; const float sg = 1.0f / (1.0f + __expf(-my[e])); const float vv = sg + brt[e];
                if (vv > v1) { v2 = v1; e2 = e1; s2v = s1v; v1 = vv; e1 = e; s1v = sg; } else if (vv > v2) { v2 = vv; e2 = e; s2v = sg; } }
            const float inv = 1.0f / (s1v + s2v);
            const int myrow = g * 16 + lane;
            const int p1 = (int)__hip_atomic_fetch_add(ctl + CW_CNT + l * 32 + e1, 1u, __ATOMIC_RELAXED, __HIP_MEMORY_SCOPE_AGENT);
            const int p2 = (int)__hip_atomic_fetch_add(ctl + CW_CNT + l * 32 + e2, 1u, __ATOMIC_RELAXED, __HIP_MEMORY_SCOPE_AGENT);
            tokinv[(size_t)e1 * TT + p1] = myrow; tokinv[(size_t)e2 * TT + p2] = myrow;
            toke[myrow * 2] = (e1 << 20) | p1; toke[myrow * 2 + 1] = (e2 << 20) | p2;
            tokw[myrow * 2] = s1v * inv; tokw[myrow * 2 + 1] = s2v * inv;
        }
    }
    __syncthreads();
}

__device__ __forceinline__ int crow(int r, int hi) { return (r & 3) + 8 * (r >> 2) + 4 * hi; }
__device__ __forceinline__ s16x4 tr_read(const LAS unsigned char* p) { typedef short v4s __attribute__((ext_vector_type(4))); return __builtin_bit_cast(s16x4, __builtin_amdgcn_ds_read_tr16_b64_v4i16((LAS v4s*)p)); }
constexpr int AT_FAC = 124928, AT_SCRW = 8448;
__device__ __forceinline__ void at_wait_bar(int n) {
    switch (n) {
        case 0: asm volatile("s_waitcnt vmcnt(0)\n\ts_barrier" ::: "memory"); break;
        case 2: asm volatile("s_waitcnt vmcnt(2)\n\ts_barrier" ::: "memory"); break;
        case 3: asm volatile("s_waitcnt vmcnt(3)\n\ts_barrier" ::: "memory"); break;
        case 4: asm volatile("s_waitcnt vmcnt(4)\n\ts_barrier" ::: "memory"); break;
        case 6: asm volatile("s_waitcnt vmcnt(6)\n\ts_barrier" ::: "memory"); break;
        case 8: asm volatile("s_waitcnt vmcnt(8)\n\ts_barrier" ::: "memory"); break;
        case 9: asm volatile("s_waitcnt vmcnt(9)\n\ts_barrier" ::: "memory"); break;
        default: asm volatile("s_waitcnt vmcnt(0)\n\ts_barrier" ::: "memory"); break;
    }
}
template <int kind>
__device__ __forceinline__ void attn_unit(const bf16_t* Q, bf16_t* Y, const int b, const int hq, const int qb, const bool ctxq, const float sinkl2, const float lf2, const float lb2,
                                          LAS unsigned char* lds, const int tid, const int lane, const int wave, const int tilecap) {
    constexpr int DQK = kind == 0 ? 96 : 64;
    constexpr int KS = DQK == 64 ? 128 : 256, NS = DQK / 16, SLOTK = 64 * KS, SLOT = SLOTK + 8192, NL = DQK == 64 ? 2 : 3, NSLOT = DQK == 64 ? 6 : 5;
    constexpr float THR = 8.0f;
    constexpr int KW = 2, KP = NS / KW;
    static_assert(NSLOT * SLOT <= AT_FAC && 8 * AT_SCRW <= AT_FAC && AT_FAC + 1024 <= LDS_MISC, "attention LDS map");
    int qcol, kcol, vcol, ycol, gcol = 0;
    if (kind == 0) { qcol = Q_MLAQ + hq * 96; kcol = Q_MLAK + hq * 96; vcol = Q_MLAV + hq * 64; ycol = 256 + hq * 64; }
    else if (kind == 1) { qcol = Q_GQAQ + hq * 64; kcol = Q_GQAK + (hq >> 1) * 64; vcol = Q_GQAV + (hq >> 1) * 64; ycol = 512 + hq * 64; }
    else if (kind == 2) { qcol = Q_RETQ + hq * 64; kcol = Q_RETK + hq * 64; vcol = Q_RETV + hq * 64; ycol = hq * 64; gcol = Q_RETG + hq * 64; }
    else { qcol = Q_WINQ + hq * 64; kcol = Q_WINK + (hq >> 1) * 64; vcol = Q_WINV + (hq >> 1) * 64; ycol = 768 + hq * 64; }
    const int r32 = lane & 31, hi = lane >> 5;
    const int qrow0 = (ctxq ? TL + b * 256 : b * 2048 + qb * 256) + 32 * wave;
    const int qpos = (ctxq ? 0 : qb * 256) + 32 * wave + r32;
    int lt0 = 0, nlat = 32;
    if (ctxq) nlat = 0;
    else if (kind == 3) { lt0 = 4 * qb - 2 < 0 ? 0 : 4 * qb - 2; const int lt1 = 4 * qb + 6 > 32 ? 32 : 4 * qb + 6; nlat = lt1 - lt0; }
    const int ntile = (4 + nlat) < tilecap ? (4 + nlat) : tilecap;
    bf16x8 qf[NS];
#pragma unroll
    for (int s = 0; s < NS; ++s) qf[s] = *(const GAS bf16x8*)(Q + (size_t)(qrow0 + r32) * QP + qcol + 16 * s + 8 * hi);
    f32x4 cfa = {}, cfq = {}, cba = {}, cbq = {}; float g32f = 0.f, g32b = 0.f;
    if constexpr (kind == 2) {
#pragma unroll
        for (int i = 0; i < 4; ++i) { cfa[i] = fast_exp2(lf2 * (float)(3 - i)); cfq[i] = fast_exp2(lf2 * (float)(28 - 4 * hi - 8 * i)); cba[i] = fast_exp2(lb2 * (float)i); cbq[i] = fast_exp2(lb2 * (float)(8 * i + 4 * hi)); }
        g32f = fast_exp2(32.f * lf2); g32b = fast_exp2(32.f * lb2);
    }
    int ksrc[DQK == 64 ? 1 : 2], vsrc;
    if constexpr (DQK == 64) { const int row = 8 * wave + (lane >> 3), ch = (lane & 7) ^ (row & 7); ksrc[0] = row * QP + kcol + 8 * ch; }
    else {
#pragma unroll
        for (int n = 0; n < 2; ++n) { const int row = 4 * (2 * wave + n) + (lane >> 4); int ch = (lane & 15) ^ (row & 7); if (ch >= 12) ch = 0; ksrc[n] = row * QP + kcol + 8 * ch; }
    }
    { const int row = 8 * wave + (lane >> 3); vsrc = row * QP + vcol + 8 * (lane & 7); }
#define AT_TILE_ROW0(t) ((t) < 4 ? TL + b * 256 + 64 * (t) : b * 2048 + 64 * (lt0 + (t) - 4))
#define AT_ISSUE(t) do { const bf16_t* tb_ = Q + (size_t)AT_TILE_ROW0(t) * QP; const unsigned sl_ = (unsigned)__builtin_amdgcn_readfirstlane((int)(ldsb + ((t) % NSLOT) * SLOT + wave * 1024 * (DQK == 64 ? 1 : 2))); \
        if constexpr (DQK == 64) { glds16(tb_ + ksrc[0], sl_); glds16(tb_ + vsrc, sl_ + SLOTK); } \
        else { glds16(tb_ + ksrc[0], sl_); glds16(tb_ + ksrc[DQK == 64 ? 0 : 1], sl_ + 1024); glds16(tb_ + vsrc, (unsigned)__builtin_amdgcn_readfirstlane((int)(ldsb + ((t) % NSLOT) * SLOT + SLOTK + wave * 1024))); } } while (0)
    const unsigned ldsb = (unsigned)(uintptr_t)lds;
    const unsigned krd = r32 * KS + 16 * (hi ^ (r32 & 1)) + 32 * ((r32 & 7) >> 1);
#define AT_KLOAD(KF, t, S0, S1) do { unsigned ka_ = (unsigned)(uintptr_t)(lds + ((t) % NSLOT) * SLOT) + krd; asm volatile("" : "+v"(ka_)); \
        _Pragma("unroll") for (int s = (S0); s < (S1); ++s) { const LAS unsigned char* kp_ = (const LAS unsigned char*)(uintptr_t)(ka_ ^ (unsigned)(32 * s)); \
            KF[2 * (s - (S0))] = *(const LAS bf16x8*)(kp_); KF[2 * (s - (S0)) + 1] = *(const LAS bf16x8*)(kp_ + 32 * KS); } } while (0)
#define AT_QKMR(P0, P1, KF, PART) do { _Pragma("unroll") for (int s = (PART) * KW; s < ((PART) + 1) * KW; ++s) { \
        if ((PART) == 0 && s == 0) { const f32x16 z_ = {}; P0 = __builtin_amdgcn_mfma_f32_32x32x16_bf16(KF[0], qf[0], z_, 0, 0, 0); P1 = __builtin_amdgcn_mfma_f32_32x32x16_bf16(KF[1], qf[0], z_, 0, 0, 0); } \
        else { P0 = __builtin_amdgcn_mfma_f32_32x32x16_bf16(KF[2 * (s - (PART) * KW)], qf[s], P0, 0, 0, 0); P1 = __builtin_amdgcn_mfma_f32_32x32x16_bf16(KF[2 * (s - (PART) * KW) + 1], qf[s], P1, 0, 0, 0); } } } while (0)
#define AT_KPART(KF, t, PART) AT_KLOAD(KF, t, (PART) * KW, ((PART) + 1) * KW)
#define AT_QK(P0, P1, t) do { bf16x8 kf_[2 * KW]; _Pragma("unroll") for (int p_ = 0; p_ < KP; ++p_) { AT_KPART(kf_, t, p_); AT_QKMR(P0, P1, kf_, p_); } } while (0)
    const int qw0_ = qb * 256 + 32 * wave;
#define AT_SKIP(t) ((kind == 3 && (t) >= 4) && ((64 * (lt0 + (t) - 4) + 63 < qw0_ - 128) || (64 * (lt0 + (t) - 4) > qw0_ + 31 + 128)))
#pragma unroll
    for (int t = 0; t < NSLOT - 1; ++t) if (t < ntile) AT_ISSUE(t);
    { const int infl = (ntile - 1 < NSLOT - 2 ? ntile - 1 : NSLOT - 2); at_wait_bar(infl * NL); }
    float mref = 0.f, lsum = 0.f;
    bool shifted = false;
    f32x16 o0 = {}, o1 = {}, pa0, pa1, pb0 = {}, pb1 = {};
    AT_QK(pa0, pa1, 0);
    LAS float* stage = (LAS float*)(lds + wave * AT_SCRW); LAS float* fac = (LAS float*)(lds + AT_FAC) + wave * 32;
    const int i16 = lane & 15, q4 = i16 >> 2, p4 = i16 & 3, g1 = (lane >> 4) & 1;
    const unsigned vrd = SLOTK + (4 * hi + q4) * 128 + (16 * g1 + 4 * p4) * 2;
#define CR(r) (((r) & 3) + 8 * ((r) >> 2))
#define AT_VLOAD(VF, t, u) do { unsigned vb_ = (unsigned)(uintptr_t)(lds + ((t) % NSLOT) * SLOT) + vrd + (32 * (u)) * 128; asm volatile("" : "+v"(vb_)); const LAS unsigned char* vb = (const LAS unsigned char*)(uintptr_t)vb_; \
        _Pragma("unroll") for (int s2 = 0; s2 < 2; ++s2) _Pragma("unroll") for (int d0 = 0; d0 < 2; ++d0) { const LAS unsigned char* vp = vb + (16 * s2) * 128 + 64 * d0; \
            const s16x4 lo = tr_read(vp), h2 = tr_read(vp + 8 * 128); VF[2 * s2 + d0] = (bf16x8){lo[0], lo[1], lo[2], lo[3], h2[0], h2[1], h2[2], h2[3]}; } } while (0)
#define AT_PVM(PU, VF) do { _Pragma("unroll") for (int s = 0; s < 2; ++s) { \
        u32x4 pw; pw.x = pk2(PU[8 * s], PU[8 * s + 1]); pw.y = pk2(PU[8 * s + 2], PU[8 * s + 3]); pw.z = pk2(PU[8 * s + 4], PU[8 * s + 5]); pw.w = pk2(PU[8 * s + 6], PU[8 * s + 7]); \
        const bf16x8 pa = __builtin_bit_cast(bf16x8, pw); \
        o0 = __builtin_amdgcn_mfma_f32_32x32x16_bf16(pa, VF[2 * s], o0, 0, 0, 0); o1 = __builtin_amdgcn_mfma_f32_32x32x16_bf16(pa, VF[2 * s + 1], o1, 0, 0, 0); } } while (0)
#define SB0() __builtin_amdgcn_sched_barrier(0)
#define AT_STEP(PC0, PC1, PN0, PN1, t) do { \
        const bool more = (t) + 1 < ntile; \
        if (more) { const int last_infl = ((t) + NSLOT - 2 < ntile - 1) ? ((t) + NSLOT - 2) : (ntile - 1); \
            at_wait_bar((last_infl - ((t) + 1)) * NL); \
            if ((t) + NSLOT - 1 < ntile) AT_ISSUE((t) + NSLOT - 1); } \
        const bool isctx = (t) < 4; const int kpos0 = isctx ? 64 * (t) : 64 * (lt0 + (t) - 4); \
        int dbase = kpos0 + 4 * hi - qpos; asm volatile("" : "+v"(dbase)); \
        const bool skip = AT_SKIP(t), skipn = more ? AT_SKIP((t) + 1) : true; \
        bf16x8 kf[2 * KW]; bf16x8 vf[4]; \
        if (!skipn) { AT_KPART(kf, (t) + 1, 0); SB0(); } \
        if (kind == 2) { \
            if (!skipn) { AT_QKMR(PN0, PN1, kf, 0); SB0(); AT_KPART(kf, (t) + 1, 1); } \
            AT_VLOAD(vf, t, 0); SB0(); \
              \
            const int qw0r = (ctxq ? 0 : qb * 256) + 32 * wave; \
            const int tcls = (isctx && !ctxq) ? 3 : ((kpos0 + 63 <= qw0r) ? 0 : ((kpos0 >= qw0r + 32) ? 1 : 2)); \
            float mf0 = 0.f, mf1 = 0.f, mb0 = 0.f, mb1 = 0.f; \
            if (tcls == 0) { mf1 = fast_exp2(lf2 * (float)(qpos - kpos0 - 63)); mf0 = mf1 * g32f; } \
            else if (tcls == 1) { mb0 = fast_exp2(lb2 * (float)(kpos0 - qpos)); mb1 = mb0 * g32b; } \
            else if (tcls == 3) { mf1 = fast_exp2(lf2 * (float)(256 + qpos - kpos0 - 63)); mf0 = mf1 * g32f; mb0 = fast_exp2(lb2 * (float)(2048 - qpos + kpos0)); mb1 = mb0 * g32b; } \
            if (tcls == 2) { \
                _Pragma("unroll") for (int r = 0; r < 16; ++r) { const int d0 = -(dbase + CR(r)); PC0[r] *= fast_exp2((d0 >= 0 ? lf2 : -lb2) * (float)d0); } \
            } else { \
                const f32x4 fq_ = cfq * mf0, bq_ = cbq * mb0; \
                _Pragma("unroll") for (int r = 0; r < 16; ++r) PC0[r] *= cfa[r & 3] * fq_[r >> 2] + cba[r & 3] * bq_[r >> 2]; \
            } \
            SB0(); if (!skipn) { AT_QKMR(PN0, PN1, kf, 1); if (KP == 3) { SB0(); AT_KPART(kf, (t) + 1, 2); } } AT_PVM(PC0, vf); SB0(); AT_VLOAD(vf, t, 1); SB0(); \
            if (tcls == 2) { \
                _Pragma("unroll") for (int r = 0; r < 16; ++r) { const int d1 = -(dbase + CR(r)) - 32; PC1[r] *= fast_exp2((d1 >= 0 ? lf2 : -lb2) * (float)d1); } \
            } else { \
                const f32x4 fq_ = cfq * mf1, bq_ = cbq * mb1; \
                _Pragma("unroll") for (int r = 0; r < 16; ++r) PC1[r] *= cfa[r & 3] * fq_[r >> 2] + cba[r & 3] * bq_[r >> 2]; \
            } \
            SB0(); if (KP == 3 && !skipn) { AT_QKMR(PN0, PN1, kf, 2); } AT_PVM(PC1, vf); \
        } else if (!skip) { \
            if (kind == 3 && !isctx) { \
                _Pragma("unroll") for (int r = 0; r < 16; ++r) { const int d0 = dbase + CR(r), d1 = d0 + 32; \
                    if (d0 > 128 || d0 < -128) PC0[r] = -INFINITY; if (d1 > 128 || d1 < -128) PC1[r] = -INFINITY; } \
            } \
            float tm = fmaxf(PC0[0], PC1[0]); \
            _Pragma("unroll") for (int r = 1; r < 16; ++r) tm = fmaxf(tm, fmaxf(PC0[r], PC1[r])); \
            tm = xmax32(tm) - mref; \
            if (__any(tm > THR)) { \
                const float dl = (tm > THR) ? tm : 0.f; \
                mref += dl; shifted = true; \
                const float f = fast_exp2(-dl); lsum *= f; \
                if (hi == 0) fac[r32] = f; \
                LDS_WAIT(); asm volatile("" ::: "memory"); \
                _Pragma("unroll") for (int r = 0; r < 16; ++r) { const float fr_ = fac[crow(r, hi)]; o0[r] *= fr_; o1[r] *= fr_; } \
            } \
            if (shifted) { _Pragma("unroll") for (int r = 0; r < 16; ++r) { PC0[r] -= mref; PC1[r] -= mref; } } \
            SB0(); \
            if (!skipn) { AT_QKMR(PN0, PN1, kf, 0); SB0(); AT_KPART(kf, (t) + 1, 1); } \
            AT_VLOAD(vf, t, 0); SB0(); \
            float ps = 0.f; \
            _Pragma("unroll") for (int r = 0; r < 16; ++r) { PC0[r] = fast_exp2(PC0[r]); ps += PC0[r]; } \
            SB0(); if (!skipn) { AT_QKMR(PN0, PN1, kf, 1); if (KP == 3) { SB0(); AT_KPART(kf, (t) + 1, 2); } } AT_PVM(PC0, vf); SB0(); AT_VLOAD(vf, t, 1); SB0(); \
            _Pragma("unroll") for (int r = 0; r < 16; ++r) { PC1[r] = fast_exp2(PC1[r]); ps += PC1[r]; } \
            lsum += ps; \
            SB0(); if (KP == 3 && !skipn) { AT_QKMR(PN0, PN1, kf, 2); } AT_PVM(PC1, vf); \
        } else if (!skipn) { AT_QKMR(PN0, PN1, kf, 0); _Pragma("unroll") for (int p_ = 1; p_ < KP; ++p_) { AT_KPART(kf, (t) + 1, p_); AT_QKMR(PN0, PN1, kf, p_); } } \
        } while (0)
    for (int t = 0; t < ntile; t += 2) {
        AT_STEP(pa0, pa1, pb0, pb1, t);
        if (t + 1 < ntile) AT_STEP(pb0, pb1, pa0, pa1, t + 1);
    }
#undef AT_STEP
#undef AT_PVM
#undef AT_VLOAD
#undef AT_KLOAD
#undef AT_QKMR
#undef AT_KPART
#undef SB0
#undef AT_ISSUE
#undef AT_TILE_ROW0
#undef AT_QK
#undef AT_SKIP
#undef CR
    asm volatile("s_waitcnt lgkmcnt(0)\n\ts_barrier" ::: "memory");
#pragma unroll
    for (int r = 0; r < 16; ++r) { stage[crow(r, hi) * 65 + r32] = o0[r]; stage[crow(r, hi) * 65 + 32 + r32] = o1[r]; }
    LDS_WAIT(); asm volatile("" ::: "memory");
    float x[32];
#pragma unroll
    for (int j = 0; j < 32; ++j) x[j] = stage[r32 * 65 + 32 * hi + j];
    const size_t orow = (size_t)(qrow0 + r32);
    if (kind == 2) {
        float s = 0.f;
#pragma unroll
        for (int j = 0; j < 32; ++j) s += x[j];
        s = xadd<32>(s); const float mean = s * (1.f / 64.f); float v = 0.f;
#pragma unroll
        for (int j = 0; j < 32; ++j) { x[j] -= mean; v += x[j] * x[j]; }
        v = xadd<32>(v); const float rstd = 1.0f / sqrtf(v * (1.f / 64.f) + EPS);
        const bf16_t* gp = Q + orow * QP + gcol + 32 * hi;
#pragma unroll
        for (int c = 0; c < 4; ++c) { const u32x4 gw = *(const GAS u32x4*)(gp + 8 * c);
#pragma unroll
            for (int j = 0; j < 4; ++j) { const float ga = bflo(gw[j]), gb = bfhi(gw[j]); x[8 * c + 2 * j] *= rstd * ga * sigmoidf_(ga); x[8 * c + 2 * j + 1] *= rstd * gb * sigmoidf_(gb); } }
    } else {
        float lt = xadd<32>(lsum);
        if (kind == 3) lt += fast_exp2(sinkl2 - mref);
        const float inv = 1.0f / fmaxf(lt, 1e-30f);
#pragma unroll
        for (int j = 0; j < 32; ++j) x[j] *= inv;
    }
    bf16_t* yp = Y + orow * 1024 + ycol + 32 * hi;
#pragma unroll
    for (int c = 0; c < 4; ++c) { u32x4 w; w.x = pk2(x[8 * c], x[8 * c + 1]); w.y = pk2(x[8 * c + 2], x[8 * c + 3]); w.z = pk2(x[8 * c + 4], x[8 * c + 5]); w.w = pk2(x[8 * c + 6], x[8 * c + 7]); *(GAS u32x4*)(yp + 8 * c) = w; }
    asm volatile("s_waitcnt vmcnt(0) lgkmcnt(0)\n\ts_barrier" ::: "memory");
}
#ifndef PROBE_KMASK
#define PROBE_KMASK 0x1f
#endif
#ifndef PROBE_TILECAP
#define PROBE_TILECAP 1000
#endif
__device__ __forceinline__ void phase_mix(KArgs a, int lq, LAS unsigned char* lds, int tid, int lane, int wave, int G, int c) {
    const int l = lq & 1; const int kmask = (lq >= 2) ? PROBE_KMASK : 0x1f; const int tilecap = (lq >= 2) ? PROBE_TILECAP : 1000;
    unsigned char* ws = a->ws;
    const bf16_t* Q = (const bf16_t*)(ws + WS_QKV); bf16_t* Y = (bf16_t*)(ws + (lq >= 2 ? WS_MRG : WS_Y));
    const int nunits = l == 0 ? 1152 : 1024;
    const int vc = (G == 256) ? ((c & 7) * 32 + (c >> 3)) : c;
    for (int j = 0; ; ++j) {
        const int u = j * G + vc;
        if (u >= nunits) break;
        int kind, b, hq, qb; bool ctxq;
        if (u < 1024) { kind = u >> 8; const int r = u & 255; b = r >> 5; hq = (r >> 3) & 3; qb = r & 7; ctxq = false; }
        else { const int r = u - 1024; kind = r >> 5; b = (r >> 2) & 7; hq = r & 3; qb = 0; ctxq = true; }
        if (!((kmask >> (ctxq ? 4 : kind)) & 1)) continue;
        const float lf2 = -__expf(a->in[I_DECAY][l * 8 + hq]) * LOG2E, lb2 = -__expf(a->in[I_DECAY][l * 8 + 4 + hq]) * LOG2E;
        const float sk = a->in[I_SINK][l * 4 + hq] * LOG2E;
        int tid2 = tid; asm volatile("" : "+v"(tid2));
        const int lane2 = tid2 & 63;
        if (kind == 0) attn_unit<0>(Q, Y, b, hq, qb, ctxq, sk, lf2, lb2, lds, tid2, lane2, wave, tilecap);
        else if (kind == 1) attn_unit<1>(Q, Y, b, hq, qb, ctxq, sk, lf2, lb2, lds, tid2, lane2, wave, tilecap);
        else if (kind == 2) attn_unit<2>(Q, Y, b, hq, qb, ctxq, sk, lf2, lb2, lds, tid2, lane2, wave, tilecap);
        else attn_unit<3>(Q, Y, b, hq, qb, ctxq, sk, lf2, lb2, lds, tid2, lane2, wave, tilecap);
    }
}

#ifndef E_CHAIN
#define E_CHAIN 0
#endif
#ifndef MK_BAR_XCD
#define MK_BAR_XCD 1
#endif
constexpr int NPHASE = 20;
#ifndef PH_MASK
#define PH_MASK 0x3ff
#endif
#define PH_ON(b) ((PH_MASK >> (b)) & 1)
#ifndef PROBE_REPEAT
#define PROBE_REPEAT 0
#endif
__global__ void __launch_bounds__(NTHREADS, 2) fwd_kernel(Args a_byval) {
    extern __shared__ __attribute__((aligned(16))) unsigned char lds_raw[];
    LAS unsigned char* lds0 = (LAS unsigned char*)lds_raw;
    const int wave0 = __builtin_amdgcn_readfirstlane((int)threadIdx.x >> 6);
    { LAS unsigned char* lds = lds0; const int t0 = wave0 * 64 + lane_id(); for (int u = t0; u < (LDS_BYTES - LDS_MISC) / 4; u += NTHREADS) ((LAS unsigned*)(lds + LDS_MISC))[u] = 0u; }
    __syncthreads();
    const int ph_lo = a_byval.ph_lo, ph_hi = a_byval.ph_hi;
#if MK_ONE_LAUNCH && MK_BAR_XCD
    XcdBarrier bar = xcd_barrier_post((unsigned*)(a_byval.ws + WS_CTL) + CW_BAR, (volatile LAS unsigned*)(lds0 + LDS_MISC), wave0);
#endif
    for (int ph = ph_lo; ph < ph_hi; ++ph) {
#if PROBE_REPEAT
      const int nrep = 1 + ((PROBE_REPEAT >> ph) & 1);
      for (int rep = 0; rep < nrep; ++rep) {
#else
      constexpr int nrep = 1, rep = 0; {
#endif
#define PHASE_IDS \
        KArgs a = (KArgs)__builtin_amdgcn_kernarg_segment_ptr(); asm volatile("" : "+s"(a)); \
        int wave = wave0; asm volatile("" : "+s"(wave)); unsigned z_ = 0u; asm volatile("" : "+v"(z_)); \
        const int lane = (int)__builtin_amdgcn_mbcnt_hi(~0u, __builtin_amdgcn_mbcnt_lo(~0u, z_)); const int tid = wave * 64 + lane; \
        unsigned ldso = 0; asm volatile("" : "+s"(ldso)); LAS unsigned char* lds = lds0 + ldso; \
        int G = gridDim.x, c = blockIdx.x; asm volatile("" : "+s"(G), "+s"(c)); \
        unsigned char* ws = a->ws; unsigned* ctl = (unsigned*)(ws + WS_CTL); const float* ada = (const float*)(ws + WS_ADA); (void)ctl; (void)ada; (void)tid; (void)lane; (void)lds; (void)G; (void)c;
        if (ph == 0) { if (PH_ON(0)) { PHASE_IDS p0_prologue(a, lds, tid, lane, wave, G, c); } }
        else if (ph == NPHASE - 1) { if (PH_ON(1)) { PHASE_IDS moe_tables(ctl, 1, lds, tid); phase_rownorm(a, 2, lds, lane, wave, G, c); } }
        else {
            const int l = (ph - 1) / 9, k = (ph - 1) % 9;
            if (k == 0) { if (PH_ON(1)) { PHASE_IDS if (l == 1) moe_tables(ctl, 0, lds, tid); phase_rownorm(a, l, lds, lane, wave, G, c); } }
            else if (k == 1) { if (PH_ON(2)) { PHASE_IDS
                SchedB S{l, G, c, (const char*)(ws + WS_H), (const char*)(ws + WS_WIN) + (size_t)l * NBG * 1024 * 2};
                const float* rope_ = (const float*)(ws + WS_ROPE);
                EpiB E{(bf16_t*)(ws + WS_P), (bf16_t*)(ws + WS_G), (bf16_t*)(ws + WS_QKV), rope_, rope_ + 2048 * 32, a->in[I_GQN] + l * 64, a->in[I_GKN] + l * 64};
                pg8::gemm_phase<EpiB, SchedB, false>(lds, tid, 1024, 1024, 1024, S, E); }
            } else if (k == 2) { if (PH_ON(3)) { PHASE_IDS phase_post(a, l, lds, lane, wave, G, c); } }
            else if (k == 3) { if (PH_ON(4)) { PHASE_IDS phase_mix(a, l + 2 * rep, lds, tid, lane, wave, G, c); } }
            else if (k == 4) { if (PH_ON(5)) { PHASE_IDS
#if E_CHAIN
                SchedE_old S{G, c, l == 0 ? 72 : 64, (const char*)(ws + WS_Y), (const char*)(ws + WS_WBR) + (size_t)l * 4 * 1024 * 256 * 2};
                EpiE_old E{(const bf16_t*)(ws + WS_G), (bf16_t*)(ws + WS_MRG)};
                pg8::gemm_phase<EpiE_old, SchedE_old, false>(lds, tid, 256, 1024, 256, S, E); }
#else
                SchedE S{G, c, l == 0 ? 72 : 64, (const char*)(ws + WS_Y), (const char*)(ws + WS_WBR) + (size_t)l * 1048576 * 2};
                EpiE E{(const bf16_t*)(ws + WS_G), (bf16_t*)(ws + WS_MRG)};
                pg8::gemm_phase<EpiE, SchedE, false>(lds, tid, 1024, 1024, 1024, S, E); }
#endif
            } else if (k == 5) { if (PH_ON(6)) { PHASE_IDS
                SchedF S{G, c, l == 0 ? 72 : 64, (const char*)(ws + WS_MRG), (const char*)(ws + WS_WOUT) + (size_t)l * 1048576 * 2};
                EpiF E{a->in[I_X], a->in[I_CTX], (const float*)(ws + WS_X), (float*)(ws + WS_X), ada + (size_t)l * 9 * 6144, l};
                pg8::gemm_phase<EpiF, SchedF, false>(lds, tid, 1024, 1024, 1024, S, E); }
            } else if (k == 6) { if (PH_ON(7)) { PHASE_IDS phase_router(a, l, l == 0 ? TT : TL, lds, tid, lane, wave, G, c); } }
            else if (k == 7) { if (PH_ON(8)) { PHASE_IDS
                moe_tables(ctl, l, lds, tid);
                SchedMoe S{G, c, 8, 1, (const LAS int*)(lds + LDS_MISC + 1024), (const LAS int*)(lds + LDS_MISC + 1280), (const int*)(ws + WS_TOKINV), (const char*)(ws + WS_H), (const char*)(ws + WS_W13) + (size_t)l * 32 * 4 * MiB, 4 * MiB};
                EpiH E{(bf16_t*)(ws + WS_HID)};
                pg8::gemm_phase<EpiH, SchedMoe, true>(lds, tid, 1024, 1024, 1024, S, E); }
            } else if (PH_ON(9)) { PHASE_IDS
                moe_tables(ctl, l, lds, tid);
                SchedMoe S{G, c, 4, 0, (const LAS int*)(lds + LDS_MISC + 1024), (const LAS int*)(lds + LDS_MISC + 1280), (const int*)(ws + WS_TOKINV), (const char*)(ws + WS_HID), (const char*)(ws + WS_W2) + (size_t)l * 32 * 2 * MiB, 2 * MiB};
                EpiI E{(bf16_t*)(ws + WS_Y2)};
                pg8::gemm_phase<EpiI, SchedMoe, false>(lds, tid, 1024, 1024, 1024, S, E);
            }
        }
#if MK_ONE_LAUNCH
        if (ph + 1 < ph_hi || rep + 1 < nrep) {
#if MK_BAR_XCD
            if (ph == ph_lo) cg::this_grid().sync(); else xcd_barrier(bar);
#else
            cg::this_grid().sync();
#endif
        }
#endif
      }
    }
}

extern "C" void kernel_launch(void* const* d_in, const int* in_sizes, int n_in, void* d_out, int out_size, void* d_ws, size_t ws_size, hipStream_t stream) {
    static int grid = 0;
    if (grid == 0) {
        if (n_in != 26 || out_size != TL * DM || ws_size < WS_END) { fprintf(stderr, "kernel_launch: unexpected problem (n_in %d, out %d, ws %zu)\n", n_in, out_size, ws_size); grid = -1; return; }
        int dev = 0, cus = 0, per_cu = 0;
        (void)hipGetDevice(&dev); (void)hipDeviceGetAttribute(&cus, hipDeviceAttributeMultiprocessorCount, dev);
        if (hipFuncSetAttribute((const void*)fwd_kernel, hipFuncAttributeMaxDynamicSharedMemorySize, LDS_BYTES) != hipSuccess) { fprintf(stderr, "kernel_launch: hipFuncSetAttribute failed\n"); grid = -1; return; }
        if (hipOccupancyMaxActiveBlocksPerMultiprocessor(&per_cu, (const void*)fwd_kernel, NTHREADS, LDS_BYTES) != hipSuccess || per_cu < 1) { fprintf(stderr, "kernel_launch: occupancy query says %d blocks per CU\n", per_cu); (void)hipGetLastError(); per_cu = 1; }
        grid = cus;
        if (grid < 1) grid = 256;
    }
    if (grid < 0) return;
    (void)hipMemsetAsync((char*)d_ws + WS_CTL, 0, CTL_ZERO_BYTES, stream);
    Args a{};
    for (int i = 0; i < 26; ++i) a.in[i] = (const float*)d_in[i];
    a.out = (float*)d_out; a.ws = (unsigned char*)d_ws;
#if MK_ONE_LAUNCH
    a.ph_lo = 0; a.ph_hi = NPHASE;
    void* args[] = {&a};
    hipError_t e = hipLaunchCooperativeKernel((const void*)fwd_kernel, dim3(grid), dim3(NTHREADS), args, LDS_BYTES, stream);
    if (e != hipSuccess) fprintf(stderr, "kernel_launch: cooperative launch failed: %s (grid %d)\n", hipGetErrorString(e), grid);
#else
    for (int ph = 0; ph < NPHASE; ++ph) { a.ph_lo = ph; a.ph_hi = ph + 1; hipLaunchKernelGGL(fwd_kernel, dim3(grid), dim3(NTHREADS), LDS_BYTES, stream, a); }
#endif
}
```

```cpp
#include <hip/hip_runtime.h>
#include <hip/hip_cooperative_groups.h>
#include <cstdio>
#include <cstdint>
namespace cg = cooperative_groups;

#define LAS __attribute__((address_space(3)))
#define GAS __attribute__((address_space(1)))
typedef unsigned short bf16_t;
typedef short bf16x8 __attribute__((ext_vector_type(8)));
typedef short s16x4 __attribute__((ext_vector_type(4)));
typedef float f32x4 __attribute__((ext_vector_type(4)));
typedef float f32x2 __attribute__((ext_vector_type(2)));
typedef float f32x16 __attribute__((ext_vector_type(16)));
typedef unsigned u32x4 __attribute__((ext_vector_type(4)));
typedef unsigned u32x2 __attribute__((ext_vector_type(2)));

#ifndef MK_ONE_LAUNCH
#define MK_ONE_LAUNCH 1
#endif

constexpr int DM = 1024, NBATCH = 8, SEQ = 2048, CTXL = 256;
constexpr int TL = NBATCH * SEQ, TC = NBATCH * CTXL, TT = TL + TC;
constexpr int NIN = 2464, NINP = 2560, NGATE = 4096, NBG = NINP + NGATE;
constexpr int QP = 3072;
constexpr int NEXP = 32, MAXTILES = 176;
constexpr float EPS = 1e-6f, LOG2E = 1.4426950408889634f;
constexpr int P_RET = 0, P_MLA = 1024, P_GQA = 1440, P_WIN = 1952;
constexpr int Q_RETQ = 0, Q_RETK = 256, Q_RETV = 512, Q_RETG = 768;
constexpr int Q_MLAQ = 1024, Q_MLAK = 1408, Q_MLAV = 1792;
constexpr int Q_GQAQ = 2048, Q_GQAK = 2304, Q_GQAV = 2432;
constexpr int Q_WINQ = 2560, Q_WINK = 2816, Q_WINV = 2944;

constexpr size_t MiB = 1u << 20;
constexpr size_t WS_CTL = 0, CTL_ZERO_BYTES = 1 * MiB;
constexpr size_t WS_ADA = 1 * MiB;
constexpr size_t WS_ROPE = WS_ADA + 512 * 1024;
constexpr size_t WS_WRP = WS_ROPE + 768 * 1024;
constexpr size_t WS_TOKINV = 3 * MiB;
constexpr size_t WS_TOKE = WS_TOKINV + (size_t)NEXP * TT * 4;
constexpr size_t WS_TOKW = WS_TOKE + (size_t)TT * 2 * 4;
constexpr size_t WS_WSM = 6 * MiB;
constexpr size_t WS_WIN = 8 * MiB;
constexpr size_t WS_WBR = 34 * MiB;
constexpr size_t WS_WOUT = 38 * MiB;
constexpr size_t WS_W13 = 42 * MiB;
constexpr size_t WS_W2 = 298 * MiB;
constexpr size_t WS_X = 426 * MiB;
constexpr size_t WS_H = 498 * MiB;
constexpr size_t WS_QKV = 534 * MiB;
constexpr size_t WS_Y = 642 * MiB;
constexpr size_t WS_MRG = 678 * MiB;
constexpr size_t WS_P = 714 * MiB;
constexpr size_t WS_G = 804 * MiB;
constexpr size_t WS_HID = 714 * MiB;
constexpr size_t WS_Y2 = 804 * MiB;
constexpr size_t WS_END = 948 * MiB;
static_assert(WS_TOKW + (size_t)TT * 8 <= WS_WSM && WS_HID + (size_t)MAXTILES * 256 * 2048 <= WS_Y2 && WS_Y2 + (size_t)MAXTILES * 256 * 2048 <= WS_END, "ws map");
static_assert(WS_P + (size_t)TT * NINP * 2 <= WS_G && WS_G + (size_t)TT * NGATE * 2 <= WS_END && WS_END <= 1024 * MiB, "ws map");
constexpr int CW_BAR = 4096;
constexpr int CW_CNT = 16384;
constexpr int CW_WQ = 16640;

constexpr int LDS_MISC = 131072, LDS_BYTES = 147456;

__device__ __forceinline__ unsigned f2bf(float f) { unsigned u = __builtin_bit_cast(unsigned, f); return (u + 0x7fffu + ((u >> 16) & 1u)) >> 16; }
__device__ __forceinline__ unsigned pk2(float lo, float hi) { typedef __bf16 bf2 __attribute__((ext_vector_type(2))); f32x2 v = {lo, hi}; bf2 b = __builtin_convertvector(v, bf2); return __builtin_bit_cast(unsigned, b); }
__device__ __forceinline__ unsigned pk4_fp8(float a, float b, float c, float d) { int p = __builtin_amdgcn_cvt_pk_fp8_f32(a, b, 0, false); p = __builtin_amdgcn_cvt_pk_fp8_f32(c, d, p, true); return (unsigned)p; }
__device__ __forceinline__ float bf2f(unsigned short b) { return __builtin_bit_cast(float, (unsigned)b << 16); }
__device__ __forceinline__ float bflo(unsigned w) { return __builtin_bit_cast(float, w << 16); }
__device__ __forceinline__ float bfhi(unsigned w) { return __builtin_bit_cast(float, w & 0xffff0000u); }
template <int M> __device__ __forceinline__ float xadd(float v) {
    if constexpr (M == 32) { unsigned a = __builtin_bit_cast(unsigned, v), b = a; asm volatile("" : "+v"(b));
        auto r = __builtin_amdgcn_permlane32_swap(a, b, false, false); const unsigned r0 = r[0], r1 = r[1];
        return __uint_as_float(r0) + __uint_as_float(r1); }
    else return v + __builtin_bit_cast(float, __builtin_amdgcn_ds_swizzle(__builtin_bit_cast(int, v), (M << 10) | 0x1f));
}
__device__ __forceinline__ float xmax32(float v) { unsigned a = __builtin_bit_cast(unsigned, v), b = a; asm volatile("" : "+v"(b));
    auto r = __builtin_amdgcn_permlane32_swap(a, b, false, false); const unsigned r0 = r[0], r1 = r[1]; return fmaxf(__uint_as_float(r0), __uint_as_float(r1)); }
__device__ __forceinline__ float wave_sum(float v) { v = xadd<1>(v); v = xadd<2>(v); v = xadd<4>(v); v = xadd<8>(v); v = xadd<16>(v); return xadd<32>(v); }
__device__ __forceinline__ float fast_exp2(float x) { return __builtin_amdgcn_exp2f(x); }
__device__ __forceinline__ float fast_rcp(float x) { return __builtin_amdgcn_rcpf(x); }
__device__ __forceinline__ float sigmoidf_(float x) { return fast_rcp(1.f + fast_exp2(-x * LOG2E)); }
__device__ __forceinline__ int lane_id() { return (int)__builtin_amdgcn_mbcnt_hi(~0u, __builtin_amdgcn_mbcnt_lo(~0u, 0u)); }
__device__ __forceinline__ void glds16(const void* gsrc, unsigned lds_dst) { unsigned keep;
    asm volatile("s_mov_b32 %0, m0\n\ts_mov_b32 m0, %2\n\ts_nop 0\n\tglobal_load_lds_dwordx4 %1, off\n\ts_mov_b32 m0, %0" : "=&s"(keep) : "v"(gsrc), "s"(lds_dst) : "memory"); }
__device__ __forceinline__ const char* uniform_ptr(const char* p) { const unsigned long long v = (unsigned long long)(uintptr_t)p; const unsigned lo = (unsigned)__builtin_amdgcn_readfirstlane((int)(unsigned)v), hi = (unsigned)__builtin_amdgcn_readfirstlane((int)(unsigned)(v >> 32)); return (const char*)(uintptr_t)(((unsigned long long)hi << 32) | lo); }
__device__ __forceinline__ void glds16_sv(const void* sbase, unsigned voff, unsigned lds_dst) { unsigned keep;
    asm volatile("s_mov_b32 %0, m0\n\ts_mov_b32 m0, %3\n\ts_nop 0\n\tglobal_load_lds_dwordx4 %1, %2\n\ts_mov_b32 m0, %0" : "=&s"(keep) : "v"(voff), "s"(sbase), "s"(lds_dst) : "memory"); }
#define LDS_WAIT() asm volatile("s_waitcnt lgkmcnt(0)" ::: "memory")
#define VM_WAIT() asm volatile("s_waitcnt vmcnt(0)" ::: "memory")

#define XB_TMO      128
#define XB_XCNT(j)  (256  + 64 * (j))
#define XB_XSUB(j)  (1280 + 64 * (j))
#define XB_XGEN(j)  (2304 + 64 * (j))
#define XB_TOP      3328
#define XB_TOPGEN   3392
#define XCD_BAR_WORDS 3456
#define XB_SPIN_CAP (1u << 18)
__device__ __forceinline__ unsigned xb_ld(unsigned* p)              { return __hip_atomic_load(p, __ATOMIC_RELAXED, __HIP_MEMORY_SCOPE_AGENT); }
__device__ __forceinline__ unsigned xb_add(unsigned* p, unsigned v) { return __hip_atomic_fetch_add(p, v, __ATOMIC_RELAXED, __HIP_MEMORY_SCOPE_AGENT); }
__device__ __forceinline__ unsigned xb_xcc_id() { return (unsigned)__builtin_amdgcn_s_getreg((3 << 11) | 20) & 0xFu; }
#define XB_SPIN(cond, bar) do { unsigned _sp = 0; while (cond) { __builtin_amdgcn_s_sleep(1); \
    if ((++_sp & 255u) == 0u) { if (xb_ld(&(bar)[XB_TMO])) break; if (_sp > XB_SPIN_CAP) { atomicAdd(&(bar)[XB_TMO], 1u); break; } } } } while (0)
struct XcdBarrier { unsigned* bar; unsigned x; volatile LAS unsigned* st; int wave; };
__device__ __forceinline__ XcdBarrier xcd_barrier_post(unsigned* bar, volatile LAS unsigned* st, int wave) {
    XcdBarrier b; b.bar = bar; b.x = xb_xcc_id(); b.st = st; b.wave = wave;
    if (wave == 0 && lane_id() == 0) (void)xb_add(&bar[XB_XCNT(b.x)], 1u);
    return b;
}
__device__ __forceinline__ void xcd_barrier_complete(unsigned* bar, unsigned x, unsigned& nloc, unsigned& nx) {
    const unsigned G = gridDim.x * gridDim.y * gridDim.z;
    unsigned sum, cnt, mine, sp = 0u;
    for (;;) {
        sum = 0u; cnt = 0u; mine = 0u;
#pragma unroll
        for (unsigned j = 0; j < 16; ++j) { const unsigned c = xb_ld(&bar[XB_XCNT(j)]); sum += c; cnt += (c > 0u) ? 1u : 0u; }
        mine = xb_ld(&bar[XB_XCNT(x)]);
        if (sum == G) break;
        __builtin_amdgcn_s_sleep(1);
        if ((++sp & 255u) == 0u) { if (xb_ld(&bar[XB_TMO])) break; if (sp > XB_SPIN_CAP) { atomicAdd(&bar[XB_TMO], 1u); break; } }
    }
    nloc = mine > 0u ? mine : 1u; nx = cnt > 0u ? cnt : 1u;
}
__device__ __forceinline__ void xcd_barrier(const XcdBarrier& b) {
    asm volatile("s_waitcnt vmcnt(0)" ::: "memory");
    __syncthreads();
    if (b.wave == 0 && lane_id() == 0) {
        unsigned* bar = b.bar; asm volatile("" : "+s"(bar));
        __builtin_amdgcn_s_waitcnt(0);
        unsigned nloc = b.st[0], nx = b.st[1];
        if (nloc == 0u) { xcd_barrier_complete(bar, b.x, nloc, nx); b.st[0] = nloc; b.st[1] = nx; }
        const unsigned old = xb_add(&bar[XB_XSUB(b.x)], 1u);
        const unsigned gen = old / nloc;
        if (old + 1u == (gen + 1u) * nloc) {
            __builtin_amdgcn_fence(__ATOMIC_RELEASE, "agent");
            asm volatile("s_waitcnt vmcnt(0)" ::: "memory");
            const unsigned og = xb_add(&bar[XB_TOP], 1u);
            const unsigned tg = og / nx;
            if (og + 1u == (tg + 1u) * nx) xb_add(&bar[XB_TOPGEN], 1u);
            else XB_SPIN(xb_ld(&bar[XB_TOPGEN]) == tg, bar);
            __builtin_amdgcn_fence(__ATOMIC_ACQUIRE, "agent");
            xb_add(&bar[XB_XGEN(b.x)], 1u);
            asm volatile("s_waitcnt vmcnt(0)" ::: "memory");
        } else {
            XB_SPIN(xb_ld(&bar[XB_XGEN(b.x)]) == gen, bar);
            __builtin_amdgcn_fence(__ATOMIC_ACQUIRE, "agent");
            asm volatile("s_waitcnt vmcnt(0)" ::: "memory");
        }
    }
    __syncthreads();
}

namespace pg8 {
constexpr int BM = 256, BK = 64, HALF = 128, HTB = HALF * BK * 2, STAGE_BYTES = 8 * HTB;
__host__ __device__ __forceinline__ int lds_byte(int r, int c) { const int st = (r >> 4) * 2 + (c >> 5), rr = r & 15, cc = c & 31, ob = rr * 64 + cc * 2; return st * 1024 + (ob ^ (((ob >> 9) & 1) << 5)); }
__host__ __device__ __forceinline__ void stage_rc(int b, int& R, int& C) { const int st = b / 1024, sb = b % 1024, swz = sb ^ (((sb >> 9) & 1) << 5); R = (st >> 1) * 16 + swz / 64; C = (st & 1) * 32 + (swz % 64) / 2; }
__host__ __device__ __forceinline__ int perm32(int rho) { const int n = rho >> 4, i = rho & 15; return 8 * (i >> 2) + 4 * n + (i & 3); }
struct Unit { int pm, pn, aux; };
__device__ __forceinline__ void tile_order(int L, int nM, int nN, int& pm, int& pn) {
    const int nwg = nM * nN; int wgid = L; { const int q = nwg / 8, r = nwg % 8, xcd = wgid % 8, off = wgid / 8; wgid = (xcd < r ? xcd * (q + 1) : r * (q + 1) + (xcd - r) * q) + off; }
    const int nig = 8 * nN, gid = wgid / nig, fm = gid * 8, gsz = (nM - fm) < 8 ? (nM - fm) : 8;
    pm = fm + ((wgid % nig) % gsz); pn = (wgid % nig) / gsz;
}
typedef int i32x8 __attribute__((ext_vector_type(8)));
typedef int i32x4 __attribute__((ext_vector_type(4)));
struct Frag2 { bf16x8 k[2]; };
template <bool F8> struct FragT { typedef Frag2 type; };
template <> struct FragT<true> { typedef i32x8 type; };
__device__ __forceinline__ void frag_set(Frag2& f, int k, i32x4 v) { f.k[k] = __builtin_bit_cast(bf16x8, v); }
__device__ __forceinline__ void frag_set(i32x8& f, int k, i32x4 v) { if (k == 0) { f[0] = v[0]; f[1] = v[1]; f[2] = v[2]; f[3] = v[3]; } else { f[4] = v[0]; f[5] = v[1]; f[6] = v[2]; f[7] = v[3]; } }
__device__ __forceinline__ f32x4 mma1(const Frag2& w, const Frag2& x, f32x4 c, int, int) { c = __builtin_amdgcn_mfma_f32_16x16x32_bf16(w.k[0], x.k[0], c, 0, 0, 0); return __builtin_amdgcn_mfma_f32_16x16x32_bf16(w.k[1], x.k[1], c, 0, 0, 0); }
#ifndef FP8_ASM_MMA
#define FP8_ASM_MMA 1
#endif
__device__ __forceinline__ f32x4 mma1(const i32x8& w, const i32x8& x, f32x4 c, int sw, int sx) {
#if FP8_ASM_MMA
    asm volatile("v_mfma_scale_f32_16x16x128_f8f6f4 %0, %1, %2, %0, %3, %4 op_sel_hi:[0,0,0]" : "+v"(c) : "v"(w), "v"(x), "v"(sw), "v"(sx));
    return c;
#else
    return __builtin_amdgcn_mfma_scale_f32_16x16x128_f8f6f4(w, x, c, 0, 0, 0, sw, 0, sx);
#endif
}
template <class Epi, class Sched, bool GATHER, bool FP8 = false, int SW = 0x7f7f7f7f, int SX = 0x7f7f7f7f>
__device__ __forceinline__ void gemm_phase(LAS unsigned char* lds, const int tid, const int kb, const int lda, const int ldb, const Sched& S, const Epi& E) {
    const int wid = __builtin_amdgcn_readfirstlane(tid >> 6), lane = tid & 63, wr = wid >> 2, wc = wid & 3, fr = lane & 15, fq = lane >> 4;
    const int nt = kb / 128;
    int sR[2], sC[2]; unsigned voffB[2];
#pragma unroll
    for (int i = 0; i < 2; ++i) { int R, C; stage_rc(tid * 16 + i * 8192, R, C); sR[i] = R; sC[i] = C; const int Rb = Epi::PERM ? ((R & ~31) + perm32(R & 31)) : R; voffB[i] = (unsigned)(Rb * ldb + C * 2); }
    const size_t kstep = (size_t)(BK * 2);
    const size_t hstepB = (size_t)HALF * ldb;
    const unsigned ldsw = (unsigned)wid * 1024u; const unsigned ldsb_ = (unsigned)(uintptr_t)lds;
    const int aoff = lds_byte(wr * 64 + fr, fq * 8), boff = lds_byte(wc * 32 + fr, fq * 8);
#define PG8_SA(b, h) (((b) * 2 + (h)) * HTB)
#define PG8_SB(b, h) ((4 + (b) * 2 + (h)) * HTB)
#define PG8_STAGE_B(bufoff, gbase) do { _Pragma("unroll") for (int _i = 0; _i < 2; ++_i) \
        glds16_sv((const void*)(gbase), voffB[_i], (unsigned)__builtin_amdgcn_readfirstlane((int)(ldsb_ + (bufoff) + ldsw + _i * 8192))); } while (0)
#define PG8_STAGE_A(bufoff, gbase, off) do { _Pragma("unroll") for (int _i = 0; _i < 2; ++_i) \
        glds16_sv((const void*)(gbase), (off)[_i], (unsigned)__builtin_amdgcn_readfirstlane((int)(ldsb_ + (bufoff) + ldsw + _i * 8192))); } while (0)
#define PG8_LDA(dst, b, h) do { _Pragma("unroll") for (int m = 0; m < 4; ++m) _Pragma("unroll") for (int k = 0; k < 2; ++k) frag_set(dst[m], k, *(const LAS i32x4*)(lds + PG8_SA(b, h) + aoff + m * 2048 + k * 1024)); } while (0)
#define PG8_LDB(dst, b, h) do { _Pragma("unroll") for (int n = 0; n < 2; ++n) _Pragma("unroll") for (int k = 0; k < 2; ++k) frag_set(dst[n], k, *(const LAS i32x4*)(lds + PG8_SB(b, h) + boff + n * 2048 + k * 1024)); } while (0)
#define PG8_MMA(ai, bj, At, Bt) do { __builtin_amdgcn_s_setprio(1); _Pragma("unroll") for (int m = 0; m < 4; ++m) _Pragma("unroll") for (int n = 0; n < 2; ++n) { \
        acc[ai][bj][m][n] = mma1(Bt[n], At[m], acc[ai][bj][m][n], SW, SX); } \
        __builtin_amdgcn_s_setprio(0); } while (0)
#define PG8_WAIT_V(n) asm volatile("s_waitcnt vmcnt(" #n ")" ::: "memory")
#define PG8_WAIT_L(n) asm volatile("s_waitcnt lgkmcnt(" #n ")" ::: "memory")
#define PG8_BAR __builtin_amdgcn_s_barrier()
#define PG8_SCHED __builtin_amdgcn_sched_barrier(0)
#define PG8_OFFS(dst, u) do { _Pragma("unroll") for (int _h = 0; _h < 2; ++_h) _Pragma("unroll") for (int _i = 0; _i < 2; ++_i) { \
        const int _r = sR[_i] + _h * HALF; const int _row = GATHER ? S.arow(u, _r) : _r; dst[_h][_i] = (unsigned)(_row * lda + sC[_i] * 2); } } while (0)
    Unit cur, nxt; int ui = 0;
    if (!S.next(0, cur)) return;
    f32x4 acc[2][2][4][2];
#pragma unroll
    for (int a = 0; a < 2; ++a)
#pragma unroll
        for (int b = 0; b < 2; ++b)
#pragma unroll
            for (int m = 0; m < 4; ++m)
#pragma unroll
                for (int n = 0; n < 2; ++n) acc[a][b][m][n] = (f32x4){0.f, 0.f, 0.f, 0.f};
    typedef typename FragT<FP8>::type frag_t;
    frag_t At[4], B0[2], B1[2];
    const char* cA; const char* cB; S.ptrs(cur, cA, cB); cA = uniform_ptr(cA); cB = uniform_ptr(cB);
    asm volatile("s_nop 4" ::: "memory");
    unsigned offC[2][2], offN[2][2];
    PG8_OFFS(offC, cur);
    PG8_STAGE_B(PG8_SB(0, 0), cB); PG8_STAGE_B(PG8_SB(0, 1), cB + hstepB); PG8_STAGE_A(PG8_SA(0, 0), cA, offC[0]); PG8_STAGE_A(PG8_SA(0, 1), cA, offC[1]);
    if (wr == 1) PG8_BAR;
    PG8_WAIT_V(2); PG8_BAR;
    PG8_STAGE_B(PG8_SB(1, 0), cB + kstep); PG8_STAGE_A(PG8_SA(1, 0), cA + kstep, offC[0]); PG8_STAGE_B(PG8_SB(1, 1), cB + hstepB + kstep);
    PG8_WAIT_V(6); PG8_BAR;
    for (;;) {
        const bool has_next = S.next(ui + 1, nxt);
        const char* nA = cA; const char* nB = cB;
        if (has_next) { S.ptrs(nxt, nA, nB); nA = uniform_ptr(nA); nB = uniform_ptr(nB); asm volatile("s_nop 4" ::: "memory"); PG8_OFFS(offN, nxt); }
        else {
#pragma unroll
            for (int h = 0; h < 2; ++h)
#pragma unroll
                for (int i = 0; i < 2; ++i) offN[h][i] = offC[h][i];
        }
#pragma unroll 1
        for (int tsec = 0; tsec < nt; tsec += (Epi::MID ? 4 : nt)) {
        if constexpr (Epi::MID) { if (tsec != 0) { unsigned z_ = 0u; asm volatile("" : "+v"(z_)); const int l2_ = (int)__builtin_amdgcn_mbcnt_hi(~0u, __builtin_amdgcn_mbcnt_lo(~0u, z_)); E.mid(acc, cur, tsec >> 2, wr, wc, l2_ & 15, l2_ >> 4); } }
#pragma unroll 1
        for (int t = tsec; t < tsec + (Epi::MID ? 4 : nt); t += 2) {
            const bool last = (t == nt - 2);
            const char* a1 = cA + (size_t)(t + 1) * kstep;
            const char* a2 = last ? nA : cA + (size_t)(t + 2) * kstep; const char* b2 = last ? nB : cB + (size_t)(t + 2) * kstep;
            const char* a3 = a2 + kstep; const char* b3 = b2 + kstep;
            unsigned o2[2][2];
#pragma unroll
            for (int h = 0; h < 2; ++h)
#pragma unroll
                for (int i = 0; i < 2; ++i) o2[h][i] = last ? offN[h][i] : offC[h][i];
            PG8_LDB(B0, 0, 0); PG8_LDB(B1, 0, 1); PG8_SCHED; PG8_LDA(At, 0, 0); PG8_STAGE_A(PG8_SA(1, 1), a1, offC[1]);
            PG8_WAIT_V(8); PG8_WAIT_L(0); PG8_BAR; PG8_MMA(0, 0, At, B0); PG8_MMA(0, 1, At, B1); PG8_BAR; PG8_SCHED;
            PG8_LDA(At, 0, 1); PG8_STAGE_B(PG8_SB(0, 0), b2); PG8_STAGE_B(PG8_SB(0, 1), b2 + hstepB); PG8_STAGE_A(PG8_SA(0, 0), a2, o2[0]);
            PG8_WAIT_V(8); PG8_WAIT_L(0); PG8_BAR; PG8_MMA(1, 0, At, B0); PG8_MMA(1, 1, At, B1); PG8_BAR; PG8_SCHED;
            PG8_LDB(B0, 1, 0); PG8_LDB(B1, 1, 1); PG8_SCHED; PG8_LDA(At, 1, 0); PG8_STAGE_A(PG8_SA(0, 1), a2, o2[1]);
            PG8_WAIT_V(8); PG8_WAIT_L(0); PG8_BAR; PG8_MMA(0, 0, At, B0); PG8_MMA(0, 1, At, B1); PG8_BAR; PG8_SCHED;
            PG8_LDA(At, 1, 1); PG8_STAGE_B(PG8_SB(1, 0), b3); PG8_STAGE_B(PG8_SB(1, 1), b3 + hstepB); PG8_STAGE_A(PG8_SA(1, 0), a3, o2[0]);
            PG8_WAIT_V(8); PG8_WAIT_L(0); PG8_BAR; PG8_MMA(1, 0, At, B0); PG8_MMA(1, 1, At, B1); PG8_BAR; PG8_SCHED;
        }
        }
        if (wr == 0) PG8_BAR;
        if constexpr (FP8) asm volatile("s_nop 15\n\ts_nop 7" ::: "memory");
        { unsigned z_ = 0u; asm volatile("" : "+v"(z_)); const int l2_ = (int)__builtin_amdgcn_mbcnt_hi(~0u, __builtin_amdgcn_mbcnt_lo(~0u, z_)); E(acc, cur, wr, wc, l2_ & 15, l2_ >> 4); }
        if (!has_next) break;
        if (S.fresh(nxt)) {
#pragma unroll
            for (int a = 0; a < 2; ++a)
#pragma unroll
                for (int b = 0; b < 2; ++b)
#pragma unroll
                    for (int m = 0; m < 4; ++m)
#pragma unroll
                        for (int n = 0; n < 2; ++n) acc[a][b][m][n] = (f32x4){0.f, 0.f, 0.f, 0.f};
        }
        cur = nxt; cA = nA; cB = nB; ++ui;
#pragma unroll
        for (int h = 0; h < 2; ++h)
#pragma unroll
            for (int i = 0; i < 2; ++i) offC[h][i] = offN[h][i];
        if (wr == 1) PG8_BAR;
    }
    PG8_WAIT_V(0);
    PG8_BAR;
#undef PG8_SA
#undef PG8_SB
#undef PG8_STAGE_A
#undef PG8_STAGE_B
#undef PG8_LDA
#undef PG8_LDB
#undef PG8_MMA
#undef PG8_WAIT_V
#undef PG8_WAIT_L
#undef PG8_BAR
#undef PG8_SCHED
#undef PG8_OFFS
}
}

struct Args { const float* in[26]; float* out; unsigned char* ws; int ph_lo, ph_hi; };
typedef const __attribute__((address_space(4))) Args* KArgs;
enum { I_X = 0, I_C, I_CTX, I_CCTX, I_WADA, I_BADA, I_N1G, I_N2G, I_WIN, I_WGATE, I_WBR, I_WOUT, I_DECAY, I_QNG, I_WUQ, I_KVNG, I_WUKV, I_GQN, I_GKN, I_SINK, I_WR, I_BR, I_W1, I_W3, I_W2, I_FNG };
constexpr int NWAVES = 8, NTHREADS = 512;

struct CvtDesc { const float* src; const float* kscale; bf16_t* dst; int N, k0, n0, Kd, nvalid, rmap, fp8; };
__device__ __forceinline__ void cvt_load(const CvtDesc& d, int lane, f32x4 (&v)[16]) {
    const int kk = lane >> 4, n4 = lane & 15, ncol = d.n0 + 4 * n4;
#pragma unroll
    for (int j = 0; j < 16; ++j) {
        const int k = d.k0 + 4 * j + kk;
        v[j] = (4 * n4 < d.nvalid) ? *(const GAS f32x4*)(d.src + (size_t)k * d.N + ncol) : (f32x4){0.f, 0.f, 0.f, 0.f};
    }
}
__device__ __forceinline__ void cvt_store(const CvtDesc& d, f32x4 (&v)[16], LAS unsigned char* scr, int lane) {
    const int kk = lane >> 4, n4 = lane & 15;
    if (d.kscale) {
#pragma unroll
        for (int j = 0; j < 16; ++j) v[j] = v[j] * d.kscale[d.k0 + 4 * j + kk];
    }
    if (d.fp8) {
        LAS unsigned char* s8 = (LAS unsigned char*)scr;
#pragma unroll
        for (int j = 0; j < 16; ++j)
#pragma unroll
            for (int i = 0; i < 4; ++i) { const float x = 32.f * v[j][i]; s8[(4 * n4 + i) * 68 + 4 * j + kk] = (unsigned char)__builtin_amdgcn_cvt_pk_fp8_f32(x, x, 0, false); }
        LDS_WAIT(); asm volatile("" ::: "memory");
        const LAS unsigned* s32 = (const LAS unsigned*)scr;
        const int c = lane & 3;
#pragma unroll
        for (int jj = 0; jj < 4; ++jj) {
            const int n = (lane >> 2) + 16 * jj;
            u32x4 o; o.x = s32[n * 17 + 4 * c]; o.y = s32[n * 17 + 4 * c + 1]; o.z = s32[n * 17 + 4 * c + 2]; o.w = s32[n * 17 + 4 * c + 3];
            const int prow = d.rmap == 0 ? n : (d.rmap == 1 ? (n & 31) + 128 * (n >> 5) : 32 * (n >> 4) + 8 * ((n >> 2) & 3) + (n & 3));
            *(GAS u32x4*)((unsigned char*)d.dst + (size_t)prow * d.Kd + d.k0 + 16 * c) = o;
        }
        LDS_WAIT(); asm volatile("" ::: "memory");
        return;
    }
    LAS unsigned short* s16 = (LAS unsigned short*)scr;
#pragma unroll
    for (int j = 0; j < 16; ++j)
#pragma unroll
        for (int i = 0; i < 4; ++i) s16[(4 * n4 + i) * 66 + 4 * j + kk] = (unsigned short)f2bf(v[j][i]);
    LDS_WAIT(); asm volatile("" ::: "memory");
    const LAS unsigned* s32 = (const LAS unsigned*)scr;
    const int c = lane & 7;
#pragma unroll
    for (int jj = 0; jj < 8; ++jj) {
        const int n = (lane >> 3) + 8 * jj;
        u32x4 o; o.x = s32[n * 33 + 4 * c]; o.y = s32[n * 33 + 4 * c + 1]; o.z = s32[n * 33 + 4 * c + 2]; o.w = s32[n * 33 + 4 * c + 3];
        const int prow = d.rmap == 0 ? n : (d.rmap == 1 ? (n & 31) + 128 * (n >> 5) : 32 * (n >> 4) + 8 * ((n >> 2) & 3) + (n & 3));
        *(GAS u32x4*)(d.dst + (size_t)prow * d.Kd + d.k0 + 8 * c) = o;
    }
    LDS_WAIT(); asm volatile("" ::: "memory");
}
constexpr int CV_EXP_ITEMS = 2 * 32 * 3 * 256;
constexpr int CV_IN = 16 * 40, CV_GT = 16 * 64, CV_BRN = 4 * 16, CV_OUT = 16 * 16, CV_UQ = 4 * 6, CV_UKV = 2 * 8;
constexpr int CV_PER_L = CV_IN + CV_GT + 4 * CV_BRN + CV_OUT + CV_UQ + CV_UKV;
constexpr int CV_NITEMS = CV_EXP_ITEMS + 2 * CV_PER_L;
__device__ __forceinline__ void cvt_decode(KArgs a, unsigned char* ws, int it, CvtDesc& d) {
    d.kscale = nullptr; d.N = 1024; d.Kd = 1024; d.nvalid = 64; d.rmap = 0; d.fp8 = 0;
    if (it < CV_EXP_ITEMS) {
        d.fp8 = 1;
        const int j = it >> 8, r = it & 255, l = j / 96, jj = j % 96, e = jj / 3, kind = jj % 3, kb = r >> 4, nb = r & 15;
        const size_t eo = ((size_t)l * 32 + e) * 1048576;
        d.k0 = kb * 64; d.n0 = nb * 64;
        if (kind < 2) { d.src = (kind == 0 ? a->in[I_W1] : a->in[I_W3]) + eo;
            d.dst = (bf16_t*)(ws + WS_W13 + ((size_t)l * 32 + e) * 2097152 + (size_t)(256 * (nb >> 1) + 128 * kind + 64 * (nb & 1)) * 1024); }
        else { d.src = a->in[I_W2] + eo; d.dst = (bf16_t*)(ws + WS_W2 + eo + (size_t)(nb * 64) * 1024); }
        return;
    }
    int r = it - CV_EXP_ITEMS; const int l = r / CV_PER_L; r -= l * CV_PER_L;
    if (r < CV_IN) {
        const int kb = r / 40, hb = r % 40, t = hb >> 2, wc = hb & 3; int src0 = -1, nv = 64;
        if (t < 5) src0 = 256 * t + 64 * wc;
        else if (t == 5) { if (wc < 2) src0 = 1280 + 64 * wc; else if (wc == 2) { src0 = 1408; nv = 32; } }
        else if (t == 6) src0 = P_GQA + 64 * wc;
        else if (t == 7) src0 = wc < 2 ? P_GQA + 256 + 64 * wc : P_GQA + 384 + 64 * (wc - 2);
        else if (t == 8) src0 = P_WIN + 64 * wc;
        else src0 = wc < 2 ? P_WIN + 256 + 64 * wc : P_WIN + 384 + 64 * (wc - 2);
        d.src = a->in[I_WIN] + (size_t)l * 1024 * NIN; d.N = NIN; d.k0 = kb * 64; d.n0 = src0 < 0 ? 0 : src0; d.nvalid = src0 < 0 ? 0 : nv; d.rmap = 1;
        d.fp8 = 1; d.dst = (bf16_t*)(ws + WS_WIN + ((size_t)l * NBG + 256 * t + 32 * wc) * 1024); return; } r -= CV_IN;
    if (r < CV_GT) {
        const int kb = r >> 6, nb = r & 63, i = nb >> 4, tg = nb & 15;
        d.src = a->in[I_WGATE] + (size_t)l * 1024 * 4096; d.N = 4096; d.k0 = kb * 64; d.n0 = i * 1024 + 64 * tg; d.rmap = 2;
        d.fp8 = 1; d.dst = (bf16_t*)(ws + WS_WIN + ((size_t)l * NBG + NINP + 256 * tg + 128 * (i >> 1) + 4 * (i & 1)) * 1024); return; } r -= CV_GT;
    if (r < 4 * CV_BRN) { const int i = r / CV_BRN, rr = r % CV_BRN, kb = rr >> 4, nb = rr & 15; d.src = a->in[I_WBR] + ((size_t)l * 4 + i) * 256 * 1024; d.k0 = kb * 64; d.n0 = nb * 64;
        d.dst = (bf16_t*)(ws + WS_WBR) + ((size_t)l * 1024 + nb * 64) * 1024 + 256 * i; return; } r -= 4 * CV_BRN;
    if (r < CV_OUT) { const int kb = r >> 4, nb = r & 15; d.src = a->in[I_WOUT] + (size_t)l * 1048576; d.k0 = kb * 64; d.n0 = nb * 64; d.dst = (bf16_t*)(ws + WS_WOUT) + (size_t)l * 1048576 + (size_t)(nb * 64) * 1024; return; } r -= CV_OUT;
    if (r < CV_UQ) { const int kb = r / 6, nb = r % 6; d.src = a->in[I_WUQ] + (size_t)l * 256 * 384; d.N = 384; d.k0 = kb * 64; d.n0 = nb * 64; d.kscale = a->in[I_QNG] + l * 256; d.dst = (bf16_t*)(ws + WS_WSM) + ((size_t)l * 384 + nb * 64) * 256; d.Kd = 256; return; } r -= CV_UQ;
    { const int kb = r >> 3, nb = r & 7; d.src = a->in[I_WUKV] + (size_t)l * 128 * 512; d.N = 512; d.k0 = kb * 64; d.n0 = nb * 64; d.kscale = a->in[I_KVNG] + l * 128; d.dst = (bf16_t*)(ws + WS_WSM) + 2 * 384 * 256 + ((size_t)l * 512 + nb * 64) * 128; d.Kd = 128; }
}

__device__ __forceinline__ void p0_prologue(KArgs a, LAS unsigned char* lds, int tid, int lane, int wave, int G, int c) {
    unsigned char* ws = a->ws;
    if (c < 192) {
        LAS float* st = (LAS float*)lds;
        LAS float* red = (LAS float*)(lds + 36864);
        for (int idx = tid; idx < 9 * 1024; idx += NTHREADS) { const int r = idx >> 10, k = idx & 1023; const float v = r < 8 ? a->in[I_C][r * 1024 + k] : a->in[I_CCTX][k]; st[idx] = v / (1.f + __expf(-v)); }
        __syncthreads();
        const int l = c / 96, n0 = (c % 96) * 64;
        float acc[9];
#pragma unroll
        for (int r = 0; r < 9; ++r) acc[r] = 0.f;
        const float* wp = a->in[I_WADA] + ((size_t)l * 1024 + wave * 128) * 6144 + n0 + lane;
#pragma unroll 4
        for (int k = 0; k < 128; ++k) { const float wv = wp[(size_t)k * 6144];
#pragma unroll
            for (int r = 0; r < 9; ++r) acc[r] += st[r * 1024 + wave * 128 + k] * wv; }
#pragma unroll
        for (int r = 0; r < 9; ++r) red[(wave * 9 + r) * 64 + lane] = acc[r];
        __syncthreads();
        for (int idx = tid; idx < 9 * 64; idx += NTHREADS) { const int r = idx >> 6, n = idx & 63; float s = 0.f;
#pragma unroll
            for (int w = 0; w < 8; ++w) s += red[(w * 9 + r) * 64 + n];
            ((float*)(ws + WS_ADA))[((size_t)l * 9 + r) * 6144 + n0 + n] = s + a->in[I_BADA][l * 6144 + n0 + n]; }
        __syncthreads();
    }
    const int gw = c * NWAVES + wave, NGW = G * NWAVES;
    {
        float* rope = (float*)(ws + WS_ROPE);
        for (int idx = gw * 64 + lane; idx < 2048 * 48; idx += NGW * 64) {
            const int pos = idx / 48, j = idx % 48, row = pos >> 6, col = pos & 63;
            if (j < 32) { const int i = j, f = i & 15; const float inv = powf(10000.f, -(float)f / 16.f); const float ang = (float)(i < 16 ? row : col) * inv;
                rope[pos * 32 + i] = cosf(ang); rope[2048 * 32 + pos * 32 + i] = sinf(ang); }
            else { const int i = j - 32, f = i & 7; const float inv = powf(10000.f, -(float)f / 8.f); const float ang = (float)(i < 8 ? row : col) * inv;
                rope[2 * 2048 * 32 + pos * 16 + i] = cosf(ang); rope[2 * 2048 * 32 + 2048 * 16 + pos * 16 + i] = sinf(ang); }
        }
        float* wrp = (float*)(ws + WS_WRP);
        for (int idx = gw * 64 + lane; idx < 32768; idx += NGW * 64) { const int half = idx >> 14, w = (idx >> 11) & 7, q = (idx >> 9) & 3, e = (idx >> 5) & 15, s = idx & 31;
            wrp[idx] = a->in[I_WR][(128 * w + 32 * q + s) * 32 + 16 * half + e]; }
    }
    LAS unsigned char* scr = lds + 57344 + wave * 8448;
    {
        int it = gw;
        if (it < CV_NITEMS) {
            CvtDesc dA, dB; f32x4 va[16], vb[16];
            cvt_decode(a, ws, it, dA); cvt_load(dA, lane, va);
            for (;;) {
                const int itB = it + NGW; const bool hasB = itB < CV_NITEMS;
                if (hasB) { cvt_decode(a, ws, itB, dB); cvt_load(dB, lane, vb); }
                cvt_store(dA, va, scr, lane);
                if (!hasB) break;
                const int itA = itB + NGW; const bool hasA = itA < CV_NITEMS;
                if (hasA) { cvt_decode(a, ws, itA, dA); cvt_load(dA, lane, va); }
                cvt_store(dB, vb, scr, lane);
                if (!hasA) break;
                it = itA;
            }
        }
    }
}

__device__ __forceinline__ void moe_tables(const unsigned* ctl, int l, LAS unsigned char* lds, int tid) {
    LAS int* tb = (LAS int*)(lds + LDS_MISC + 1024); LAS int* cn = (LAS int*)(lds + LDS_MISC + 2304);
    __syncthreads();
    if (tid < 32) cn[tid] = (int)__hip_atomic_load(ctl + CW_CNT + l * 32 + tid, __ATOMIC_RELAXED, __HIP_MEMORY_SCOPE_AGENT);
    __syncthreads();
    if (tid == 0) { int s = 0; for (int e = 0; e < 32; ++e) { tb[e] = s; s += (cn[e] + 255) >> 8; } tb[32] = s; }
    __syncthreads();
    if (tid < MAXTILES) { LAS int* te = (LAS int*)(lds + LDS_MISC + 1024 + 48 * 4); int e = 0; for (int k = 1; k < 32; ++k) e += (tid >= tb[k]) ? 1 : 0; te[tid] = e | ((tid - tb[e]) << 8); }
    __syncthreads();
}

__device__ __forceinline__ void phase_rownorm(KArgs a, int mode, LAS unsigned char* lds, int lane, int wave, int G, int c) {
    unsigned char* ws = a->ws;
    const int gw = c * NWAVES + wave, NGW = G * NWAVES;
    const float* ada = (const float*)(ws + WS_ADA);
    float* X = (float*)(ws + WS_X);
    const LAS int* tb = (const LAS int*)(lds + LDS_MISC + 1024);
    const int nrows = (mode == 2) ? TL : TT;
    const int lprev = mode - 1, lcur = (mode == 2) ? 0 : mode;
    constexpr int R = 3;
    for (int base = gw; base < nrows; base += R * NGW) {
        f32x4 v[R][4]; int rows[R]; bool ok[R];
#pragma unroll
        for (int r = 0; r < R; ++r) { rows[r] = base + r * NGW; ok[r] = rows[r] < nrows; if (!ok[r]) rows[r] = base; }
#pragma unroll
        for (int r = 0; r < R; ++r) {
            const int row = rows[r];
            const float* src = (mode == 0) ? (row < TL ? a->in[I_X] + (size_t)row * 1024 : a->in[I_CTX] + (size_t)(row - TL) * 1024) : X + (size_t)row * 1024;
#pragma unroll
            for (int j = 0; j < 4; ++j) v[r][j] = *(const GAS f32x4*)(src + 4 * lane + 256 * j);
        }
        if (mode != 0) {
            const int* te = (const int*)(ws + WS_TOKE); const float* tw = (const float*)(ws + WS_TOKW);
            const bf16_t* Y2 = (const bf16_t*)(ws + WS_Y2);
            u32x2 y0[R][4], y1[R][4]; float w0[R], w1[R];
#pragma unroll
            for (int r = 0; r < R; ++r) {
                const int row = rows[r];
                const int e0 = te[row * 2], e1 = te[row * 2 + 1]; w0[r] = tw[row * 2]; w1[r] = tw[row * 2 + 1];
                const size_t s0 = (size_t)(tb[e0 >> 20] * 256 + (e0 & 0xfffff)), s1 = (size_t)(tb[e1 >> 20] * 256 + (e1 & 0xfffff));
#pragma unroll
                for (int j = 0; j < 4; ++j) { y0[r][j] = *(const GAS u32x2*)(Y2 + s0 * 1024 + 4 * lane + 256 * j); y1[r][j] = *(const GAS u32x2*)(Y2 + s1 * 1024 + 4 * lane + 256 * j); }
            }
#pragma unroll
            for (int r = 0; r < R; ++r) {
                const int row = rows[r]; const int b = row < TL ? (row >> 11) : 8;
                const float* g2 = ada + ((size_t)lprev * 9 + b) * 6144 + 5120;
#pragma unroll
                for (int j = 0; j < 4; ++j) {
                    const f32x4 gg = *(const GAS f32x4*)(g2 + 4 * lane + 256 * j);
                    f32x4 f; f.x = w0[r] * bflo(y0[r][j].x) + w1[r] * bflo(y1[r][j].x); f.y = w0[r] * bfhi(y0[r][j].x) + w1[r] * bfhi(y1[r][j].x);
                    f.z = w0[r] * bflo(y0[r][j].y) + w1[r] * bflo(y1[r][j].y); f.w = w0[r] * bfhi(y0[r][j].y) + w1[r] * bfhi(y1[r][j].y);
                    v[r][j] = v[r][j] + gg * f;
                }
                if (mode == 1 && ok[r]) {
#pragma unroll
                    for (int j = 0; j < 4; ++j) *(GAS f32x4*)(X + (size_t)row * 1024 + 4 * lane + 256 * j) = v[r][j];
                }
            }
        }
#pragma unroll
        for (int r = 0; r < R; ++r) {
            const int row = rows[r]; const int b = row < TL ? (row >> 11) : 8;
            float ss = 0.f;
#pragma unroll
            for (int j = 0; j < 4; ++j) ss += (v[r][j].x * v[r][j].x + v[r][j].y * v[r][j].y) + (v[r][j].z * v[r][j].z + v[r][j].w * v[r][j].w);
            const float rstd = 1.0f / sqrtf(wave_sum(ss) * (1.f / 1024.f) + EPS);
            if (ok[r]) {
                if (mode == 2) {
#pragma unroll
                    for (int j = 0; j < 4; ++j) { const f32x4 g = *(const GAS f32x4*)(a->in[I_FNG] + 4 * lane + 256 * j); *(GAS f32x4*)(a->out + (size_t)row * 1024 + 4 * lane + 256 * j) = v[r][j] * rstd * g; }
                } else {
                    const float* gn = a->in[I_N1G] + lcur * 1024; const float* sh = ada + ((size_t)lcur * 9 + b) * 6144; const float* sc = sh + 1024;
                    unsigned char* H = (unsigned char*)(ws + WS_H) + (size_t)row * 1024;
#pragma unroll
                    for (int j = 0; j < 4; ++j) { const int cc = 4 * lane + 256 * j; const f32x4 g = *(const GAS f32x4*)(gn + cc), s1 = *(const GAS f32x4*)(sc + cc), s0 = *(const GAS f32x4*)(sh + cc);
                        const f32x4 h = v[r][j] * rstd * g * (s1 + 1.0f) + s0; *(GAS unsigned*)(H + cc) = pk4_fp8(h.x, h.y, h.z, h.w); }
                }
            }
        }
    }
}

using pg8::Unit;
struct SchedB {
    int layer, G, c; const char* H; const char* W;
    __device__ __forceinline__ bool next(int i, Unit& u) const {
        const int L = i * G + c; u.aux = 0;
        if (layer == 0) { if (L >= 72 * 26) return false; pg8::tile_order(L, 72, 26, u.pm, u.pn); return true; }
        if (L < 64 * 16) { pg8::tile_order(L, 64, 16, u.pm, u.pn); u.pn += 10; return true; }
        const int L2 = L - 64 * 16; if (L2 >= 72 * 10) return false; pg8::tile_order(L2, 72, 10, u.pm, u.pn); return true;
    }
    __device__ __forceinline__ void ptrs(const Unit& u, const char*& A, const char*& B) const { A = H + (size_t)u.pm * 256 * 1024; B = W + (size_t)u.pn * 256 * 1024; }
    __device__ __forceinline__ int arow(const Unit&, int r) const { return r; }
    __device__ __forceinline__ bool fresh(const Unit&) const { return true; }
};
struct EpiB {
    static constexpr bool PERM = true, MID = false;
    bf16_t* P; bf16_t* Gt; bf16_t* Q; const float* cos64; const float* sin64; const float* qng; const float* kng;
    __device__ __forceinline__ void operator()(f32x4 (&acc)[2][2][4][2], const Unit& u, int wr, int wc, int fr, int fq) const {
        const int row0 = u.pm * 256 + wr * 64 + fr;
        if (u.pn >= 10) {
            const int d0 = (u.pn - 10) * 64 + 16 * wc + 4 * fq;
#pragma unroll
            for (int ai = 0; ai < 2; ++ai)
#pragma unroll
                for (int m = 0; m < 4; ++m) { bf16_t* gp = Gt + (size_t)(row0 + ai * 128 + m * 16) * NGATE + d0;
                    f32x4 g[4];
#pragma unroll
                    for (int i = 0; i < 4; ++i)
#pragma unroll
                        for (int j = 0; j < 4; ++j) g[i][j] = fmaxf(sigmoidf_(acc[ai][i >> 1][m][i & 1][j]), 1e-6f);
#pragma unroll
                    for (int i = 0; i < 4; ++i) { f32x4 r = g[i];
                        if (i < 3) {
#pragma unroll
                            for (int j = 0; j < 4; ++j) r[j] *= fast_rcp(g[i + 1][j]); }
                        u32x2 w; w.x = pk2(r[0], r[1]); w.y = pk2(r[2], r[3]); *(GAS u32x2*)(gp + i * 1024) = w; } }
            return;
        }
        const int t = u.pn;
        bf16_t* dst; size_t ld; int col; int mode = 0;
        float scale = 1.f; const float* gain = nullptr;
        if (t == 4) { dst = P; ld = NINP; col = P_MLA + 64 * wc; }
        else if (t == 5) { dst = P; ld = NINP; col = 1280 + 64 * wc; mode = wc < 3 ? 0 : 3; }
        else { dst = Q; ld = QP;
            if (t == 0) { col = Q_RETQ + 64 * wc; mode = 1; scale = 0.125f; }
            else if (t == 1) { col = Q_RETK + 64 * wc; mode = 1; }
            else if (t == 2) col = Q_RETV + 64 * wc;
            else if (t == 3) col = Q_RETG + 64 * wc;
            else if (t == 6) { col = Q_GQAQ + 64 * wc; mode = 2; scale = 0.125f * LOG2E; gain = qng; }
            else if (t == 7) { if (wc < 2) { col = Q_GQAK + 64 * wc; mode = 2; gain = kng; } else col = Q_GQAV + 64 * (wc - 2); }
            else if (t == 8) { col = Q_WINQ + 64 * wc; mode = 1; scale = 0.125f * LOG2E; }
            else { if (wc < 2) { col = Q_WINK + 64 * wc; mode = 1; } else col = Q_WINV + 64 * (wc - 2); } }
        if (mode == 3) return;
        f32x4 ga0 = {1.f, 1.f, 1.f, 1.f}, ga1 = ga0, gb0 = ga0, gb1 = ga0;
        if (mode == 2) { ga0 = *(const GAS f32x4*)(gain + 8 * fq); ga1 = *(const GAS f32x4*)(gain + 8 * fq + 4); gb0 = *(const GAS f32x4*)(gain + 32 + 8 * fq); gb1 = *(const GAS f32x4*)(gain + 32 + 8 * fq + 4); }
        const bool half_only = (t == 5 && wc == 2);
#pragma unroll
        for (int ai = 0; ai < 2; ++ai)
#pragma unroll
            for (int m = 0; m < 4; ++m) {
                const int row = row0 + ai * 128 + m * 16;
                f32x4 a0 = acc[ai][0][m][0], a1 = acc[ai][0][m][1], b0 = acc[ai][1][m][0], b1 = acc[ai][1][m][1];
                if (mode == 2) {
                    float ss = 0.f;
#pragma unroll
                    for (int j = 0; j < 4; ++j) ss += a0[j] * a0[j] + a1[j] * a1[j] + b0[j] * b0[j] + b1[j] * b1[j];
                    ss = xadd<16>(ss); ss = xadd<32>(ss);
                    const float rstd = __builtin_amdgcn_rsqf(ss * (1.f / 64.f) + EPS);
                    a0 = a0 * rstd * ga0; a1 = a1 * rstd * ga1; b0 = b0 * rstd * gb0; b1 = b1 * rstd * gb1;
                }
                if (mode >= 1) {
                    if (row < TL) { const int pos = row & 2047;
                        const f32x4 c0 = *(const GAS f32x4*)(cos64 + pos * 32 + 8 * fq), c1 = *(const GAS f32x4*)(cos64 + pos * 32 + 8 * fq + 4);
                        const f32x4 s0 = *(const GAS f32x4*)(sin64 + pos * 32 + 8 * fq), s1 = *(const GAS f32x4*)(sin64 + pos * 32 + 8 * fq + 4);
                        const f32x4 o0 = a0 * c0 - b0 * s0, o1 = a1 * c1 - b1 * s1, p0 = b0 * c0 + a0 * s0, p1 = b1 * c1 + a1 * s1;
                        a0 = o0; a1 = o1; b0 = p0; b1 = p1; }
                    a0 = a0 * scale; a1 = a1 * scale; b0 = b0 * scale; b1 = b1 * scale;
                }
                bf16_t* rp = dst + (size_t)row * ld + col + 8 * fq;
                u32x4 w; w.x = pk2(a0[0], a0[1]); w.y = pk2(a0[2], a0[3]); w.z = pk2(a1[0], a1[1]); w.w = pk2(a1[2], a1[3]);
                *(GAS u32x4*)rp = w;
                if (!half_only) { u32x4 w2; w2.x = pk2(b0[0], b0[1]); w2.y = pk2(b0[2], b0[3]); w2.z = pk2(b1[0], b1[1]); w2.w = pk2(b1[2], b1[3]); *(GAS u32x4*)(rp + 32) = w2; }
                asm volatile("" ::: "memory");
            }
    }
};
struct SchedE {
    int G, c, nM; const char* Y; const char* W;
    __device__ __forceinline__ bool next(int i, Unit& u) const { const int L = i * G + c; u.aux = 0; if (L >= nM * 4) return false; pg8::tile_order(L, nM, 4, u.pm, u.pn); return true; }
    __device__ __forceinline__ void ptrs(const Unit& u, const char*& A, const char*& B) const { A = Y + (size_t)u.pm * 256 * 1024 * 2; B = W + (size_t)u.pn * 256 * 1024 * 2; }
    __device__ __forceinline__ int arow(const Unit&, int r) const { return r; }
    __device__ __forceinline__ bool fresh(const Unit&) const { return true; }
};
struct EpiE {
    static constexpr bool PERM = true, MID = true;
    const bf16_t* Gt; bf16_t* M;
    __device__ __forceinline__ void mid(f32x4 (&acc)[2][2][4][2], const Unit& u, int i, int wr, int wc, int fr, int fq) const {
        const int row0 = u.pm * 256 + wr * 64 + fr;
        const int col0 = u.pn * 256 + wc * 32 + 8 * fq;
#pragma unroll
        for (int ai = 0; ai < 2; ++ai)
#pragma unroll
            for (int m = 0; m < 4; ++m) { const bf16_t* gp = Gt + (size_t)(row0 + ai * 128 + m * 16) * NGATE + (i - 1) * 1024 + col0;
#pragma unroll
                for (int bj = 0; bj < 2; ++bj) {
                    const u32x4 g = *(const GAS u32x4*)(gp + bj * 128);
                    const f32x4 s0 = {bflo(g.x), bfhi(g.x), bflo(g.y), bfhi(g.y)}, s1 = {bflo(g.z), bfhi(g.z), bflo(g.w), bfhi(g.w)};
                    acc[ai][bj][m][0] = acc[ai][bj][m][0] * s0; acc[ai][bj][m][1] = acc[ai][bj][m][1] * s1;
                    asm volatile("" ::: "memory");
                } }
    }
    __device__ __forceinline__ void operator()(f32x4 (&acc)[2][2][4][2], const Unit& u, int wr, int wc, int fr, int fq) const {
        const int row0 = u.pm * 256 + wr * 64 + fr, col0 = u.pn * 256 + wc * 32 + 8 * fq;
#pragma unroll
        for (int ai = 0; ai < 2; ++ai)
#pragma unroll
            for (int m = 0; m < 4; ++m) { const size_t row = (size_t)(row0 + ai * 128 + m * 16);
#pragma unroll
                for (int bj = 0; bj < 2; ++bj) {
                    const u32x4 g = *(const GAS u32x4*)(Gt + row * NGATE + 3 * 1024 + col0 + bj * 128);
                    const f32x4 s0 = {bflo(g.x), bfhi(g.x), bflo(g.y), bfhi(g.y)}, s1 = {bflo(g.z), bfhi(g.z), bflo(g.w), bfhi(g.w)};
                    const f32x4 v0 = acc[ai][bj][m][0] * s0, v1 = acc[ai][bj][m][1] * s1;
                    u32x4 w; w.x = pk2(v0[0], v0[1]); w.y = pk2(v0[2], v0[3]); w.z = pk2(v1[0], v1[1]); w.w = pk2(v1[2], v1[3]);
                    *(GAS u32x4*)(M + row * 1024 + col0 + bj * 128) = w;
                } }
    }
};
struct SchedF {
    int G, c, nM; const char* A0; const char* W;
    __device__ __forceinline__ bool next(int i, Unit& u) const { const int L = i * G + c; u.aux = 0; if (L >= nM * 4) return false; pg8::tile_order(L, nM, 4, u.pm, u.pn); return true; }
    __device__ __forceinline__ void ptrs(const Unit& u, const char*& A, const char*& B) const { A = A0 + (size_t)u.pm * 256 * 1024 * 2; B = W + (size_t)u.pn * 256 * 1024 * 2; }
    __device__ __forceinline__ int arow(const Unit&, int r) const { return r; }
    __device__ __forceinline__ bool fresh(const Unit&) const { return true; }
};
struct EpiF {
    static constexpr bool PERM = false, MID = false;
    const float* xin; const float* cin; const float* Xs; float* X; const float* ada_l; int layer;
    __device__ __forceinline__ void operator()(f32x4 (&acc)[2][2][4][2], const Unit& u, int wr, int wc, int fr, int fq) const {
        const int row0 = u.pm * 256 + wr * 64 + fr, col0 = u.pn * 256 + wc * 32 + 4 * fq;
#pragma unroll
        for (int ai = 0; ai < 2; ++ai)
#pragma unroll
            for (int m = 0; m < 4; ++m) { const int row = row0 + ai * 128 + m * 16; const int b = row < TL ? (row >> 11) : 8;
                const float* src = (layer == 0) ? (row < TL ? xin + (size_t)row * 1024 : cin + (size_t)(row - TL) * 1024) : Xs + (size_t)row * 1024;
                const float* g1 = ada_l + (size_t)b * 6144 + 2048;
#pragma unroll
                for (int bj = 0; bj < 2; ++bj)
#pragma unroll
                    for (int n = 0; n < 2; ++n) { const int c = col0 + bj * 128 + n * 16;
                        const f32x4 xs = *(const GAS f32x4*)(src + c), gg = *(const GAS f32x4*)(g1 + c);
                        *(GAS f32x4*)(X + (size_t)row * 1024 + c) = xs + gg * acc[ai][bj][m][n]; } }
    }
};
struct SchedMoe {
    int G, c, npn, gather; const LAS int* tb; const LAS int* cn; const int* tokinv; const char* A0; const char* W; size_t wstride;
    __device__ __forceinline__ bool next(int i, Unit& u) const {
        const int L = i * G + c; if (L >= __builtin_amdgcn_readfirstlane(tb[32]) * npn) return false;
        const int rt = L / npn; u.pm = rt; u.pn = L - rt * npn; u.aux = __builtin_amdgcn_readfirstlane(tb[48 + rt]); return true;
    }
    __device__ __forceinline__ void ptrs(const Unit& u, const char*& A, const char*& B) const {
        A = gather ? A0 : A0 + (size_t)u.pm * 256 * 1024; B = W + (size_t)(u.aux & 255) * wstride + (size_t)u.pn * 256 * 1024; }
    __device__ __forceinline__ int arow(const Unit& u, int r) const { const int e = u.aux & 255, idx = (u.aux >> 8) * 256 + r; return idx < cn[e] ? tokinv[(size_t)e * TT + idx] : 0; }
    __device__ __forceinline__ bool fresh(const Unit&) const { return true; }
};
struct EpiH {
    static constexpr bool PERM = true, MID = false;
    unsigned char* HID;
    __device__ __forceinline__ void operator()(f32x4 (&acc)[2][2][4][2], const Unit& u, int wr, int wc, int fr, int fq) const {
        const int row0 = u.pm * 256 + wr * 64 + fr, col0 = u.pn * 128 + wc * 32 + 8 * fq;
#pragma unroll
        for (int ai = 0; ai < 2; ++ai)
#pragma unroll
            for (int m = 0; m < 4; ++m) { f32x4 h0, h1;
#pragma unroll
                for (int j = 0; j < 4; ++j) { const float a0 = acc[ai][0][m][0][j], a1 = acc[ai][0][m][1][j];
                    h0[j] = a0 * sigmoidf_(a0) * acc[ai][1][m][0][j]; h1[j] = a1 * sigmoidf_(a1) * acc[ai][1][m][1][j]; }
                u32x2 w; w.x = pk4_fp8(4.f * h0[0], 4.f * h0[1], 4.f * h0[2], 4.f * h0[3]); w.y = pk4_fp8(4.f * h1[0], 4.f * h1[1], 4.f * h1[2], 4.f * h1[3]);
                *(GAS u32x2*)(HID + (size_t)(row0 + ai * 128 + m * 16) * 1024 + col0) = w; }
    }
};
struct EpiI {
    static constexpr bool PERM = true, MID = false;
    bf16_t* Y2;
    __device__ __forceinline__ void operator()(f32x4 (&acc)[2][2][4][2], const Unit& u, int wr, int wc, int fr, int fq) const {
        const int row0 = u.pm * 256 + wr * 64 + fr, col0 = u.pn * 256 + wc * 32 + 8 * fq;
#pragma unroll
        for (int ai = 0; ai < 2; ++ai)
#pragma unroll
            for (int m = 0; m < 4; ++m)
#pragma unroll
                for (int bj = 0; bj < 2; ++bj) { const f32x4 v0 = acc[ai][bj][m][0], v1 = acc[ai][bj][m][1];
                    u32x4 w; w.x = pk2(v0[0], v0[1]); w.y = pk2(v0[2], v0[3]); w.z = pk2(v1[0], v1[1]); w.w = pk2(v1[2], v1[3]);
                    *(GAS u32x4*)(Y2 + (size_t)(row0 + ai * 128 + m * 16) * 1024 + col0 + bj * 128) = w; }
    }
};

__device__ __forceinline__ void rope_item_desc(int item, int& src, int& dst, float& scale, int& normsel) {
    normsel = 0; scale = 1.f;
    if (item < 4) { src = P_RET + item * 64; dst = Q_RETQ + item * 64; scale = 0.125f; }
    else if (item < 8) { src = P_RET + 256 + (item - 4) * 64; dst = Q_RETK + (item - 4) * 64; }
    else if (item < 12) { src = P_GQA + (item - 8) * 64; dst = Q_GQAQ + (item - 8) * 64; scale = 0.125f * LOG2E; normsel = 1; }
    else if (item < 14) { src = P_GQA + 256 + (item - 12) * 64; dst = Q_GQAK + (item - 12) * 64; normsel = 2; }
    else if (item < 16) { src = P_WIN + 256 + (item - 14) * 64; dst = Q_WINK + (item - 14) * 64; }
    else { src = P_WIN + (item - 16) * 64; dst = Q_WINQ + (item - 16) * 64; scale = 0.125f * LOG2E; }
}
__device__ __forceinline__ void phase_post(KArgs a, int l, LAS unsigned char* lds, int lane, int wave, int G, int c) {
    unsigned char* ws = a->ws;
    const bf16_t* P = (const bf16_t*)(ws + WS_P); bf16_t* Q = (bf16_t*)(ws + WS_QKV);
    const float* cos32 = (const float*)(ws + WS_ROPE) + 2 * 2048 * 32; const float* sin32 = cos32 + 2048 * 16;
    const bf16_t* Wuq = (const bf16_t*)(ws + WS_WSM) + (size_t)l * 384 * 256; const bf16_t* Wukv = (const bf16_t*)(ws + WS_WSM) + 2 * 384 * 256 + (size_t)l * 512 * 128;
    const float qscale = 0.10206207261596577f * LOG2E;
    const unsigned ldsb = (unsigned)(uintptr_t)lds;
    constexpr int LQ = 0, LKV = 49152;
    for (int u = c; u < (TT / 128) * 4; u += G) {
        const int h = u & 3, rb = u >> 2;
        for (int p = wave; p < 80; p += NWAVES) {
            if (p < 48) { const int row = 2 * p + (lane >> 5), ch = (lane & 31) ^ (row & 7);
                glds16(Wuq + (size_t)(96 * h + row) * 256 + 8 * ch, (unsigned)__builtin_amdgcn_readfirstlane((int)(ldsb + LQ + p * 1024))); }
            else { const int p2 = p - 48, row = 4 * p2 + (lane >> 4), ch = (lane & 15) ^ (row & 7);
                glds16(Wukv + (size_t)(128 * h + row) * 128 + 8 * ch, (unsigned)__builtin_amdgcn_readfirstlane((int)(ldsb + LKV + p2 * 1024))); }
        }
        const int tk = lane & 15, kq = lane >> 4, row = rb * 128 + wave * 16 + tk; const bool islat = row < TL; const int pos = row & 2047;
        const bf16_t* prow = P + (size_t)row * NINP + P_MLA; bf16_t* qrow = Q + (size_t)row * QP;
        bf16x8 zq[8], zkv[4]; float sq = 0.f, skv = 0.f;
#pragma unroll
        for (int s2 = 0; s2 < 8; ++s2) zq[s2] = *(const GAS bf16x8*)(prow + 32 * s2 + 8 * kq);
#pragma unroll
        for (int s2 = 0; s2 < 4; ++s2) zkv[s2] = *(const GAS bf16x8*)(prow + 256 + 32 * s2 + 8 * kq);
        const u32x2 kr1 = *(const GAS u32x2*)(prow + 384 + 4 * kq), kr2 = *(const GAS u32x2*)(prow + 400 + 4 * kq);
#pragma unroll
        for (int s2 = 0; s2 < 8; ++s2)
#pragma unroll
            for (int j = 0; j < 8; ++j) { const float f = bf2f((unsigned short)zq[s2][j]); sq += f * f; }
#pragma unroll
        for (int s2 = 0; s2 < 4; ++s2)
#pragma unroll
            for (int j = 0; j < 8; ++j) { const float f = bf2f((unsigned short)zkv[s2][j]); skv += f * f; }
        sq = xadd<16>(sq); sq = xadd<32>(sq); skv = xadd<16>(skv); skv = xadd<32>(skv);
        const float rq = (1.0f / sqrtf(sq * (1.f / 256.f) + EPS)) * qscale, rkv = 1.0f / sqrtf(skv * (1.f / 128.f) + EPS);
        f32x4 cr = {1.f, 1.f, 1.f, 1.f}, sr = {0.f, 0.f, 0.f, 0.f};
        if (islat) { cr = *(const GAS f32x4*)(cos32 + pos * 16 + 4 * kq); sr = *(const GAS f32x4*)(sin32 + pos * 16 + 4 * kq); }
        asm volatile("s_waitcnt vmcnt(0)\n\ts_barrier" ::: "memory");
        f32x4 acc[6];
#pragma unroll
        for (int p = 0; p < 6; ++p) {
            bf16x8 w[8];
#pragma unroll
            for (int s2 = 0; s2 < 8; ++s2) w[s2] = *(const LAS bf16x8*)(lds + LQ + (16 * p + tk) * 512 + (((4 * s2 + kq) ^ (tk & 7)) * 16));
            acc[p] = (f32x4){0.f, 0.f, 0.f, 0.f};
#pragma unroll
            for (int s2 = 0; s2 < 8; ++s2) acc[p] = __builtin_amdgcn_mfma_f32_16x16x32_bf16(w[s2], zq[s2], acc[p], 0, 0, 0);
        }
#pragma unroll
        for (int p = 0; p < 4; ++p) { const f32x4 v = acc[p] * rq; u32x2 o; o.x = pk2(v[0], v[1]); o.y = pk2(v[2], v[3]); *(GAS u32x2*)(qrow + Q_MLAQ + h * 96 + 16 * p + 4 * kq) = o; }
        { const f32x4 x1 = acc[4] * rq, x2 = acc[5] * rq; const f32x4 o1 = x1 * cr - x2 * sr, o2 = x2 * cr + x1 * sr;
          u32x2 w1; w1.x = pk2(o1[0], o1[1]); w1.y = pk2(o1[2], o1[3]); u32x2 w2; w2.x = pk2(o2[0], o2[1]); w2.y = pk2(o2[2], o2[3]);
          *(GAS u32x2*)(qrow + Q_MLAQ + h * 96 + 64 + 4 * kq) = w1; *(GAS u32x2*)(qrow + Q_MLAQ + h * 96 + 80 + 4 * kq) = w2; }
#pragma unroll
        for (int p = 0; p < 8; ++p) {
            bf16x8 w[4];
#pragma unroll
            for (int s2 = 0; s2 < 4; ++s2) w[s2] = *(const LAS bf16x8*)(lds + LKV + (16 * p + tk) * 256 + (((4 * s2 + kq) ^ (tk & 7)) * 16));
            f32x4 ac = {0.f, 0.f, 0.f, 0.f};
#pragma unroll
            for (int s2 = 0; s2 < 4; ++s2) ac = __builtin_amdgcn_mfma_f32_16x16x32_bf16(w[s2], zkv[s2], ac, 0, 0, 0);
            const f32x4 v = ac * rkv; u32x2 o; o.x = pk2(v[0], v[1]); o.y = pk2(v[2], v[3]);
            const int col = p < 4 ? Q_MLAK + h * 96 + 16 * p + 4 * kq : Q_MLAV + h * 64 + 16 * (p - 4) + 4 * kq;
            *(GAS u32x2*)(qrow + col) = o;
        }
        if (h == 0) {
            const f32x4 x1 = {bflo(kr1.x), bfhi(kr1.x), bflo(kr1.y), bfhi(kr1.y)}, x2 = {bflo(kr2.x), bfhi(kr2.x), bflo(kr2.y), bfhi(kr2.y)};
            const f32x4 o1 = x1 * cr - x2 * sr, o2 = x2 * cr + x1 * sr;
            u32x2 w1; w1.x = pk2(o1[0], o1[1]); w1.y = pk2(o1[2], o1[3]); u32x2 w2; w2.x = pk2(o2[0], o2[1]); w2.y = pk2(o2[2], o2[3]);
#pragma unroll
            for (int hh = 0; hh < 4; ++hh) { *(GAS u32x2*)(qrow + Q_MLAK + hh * 96 + 64 + 4 * kq) = w1; *(GAS u32x2*)(qrow + Q_MLAK + hh * 96 + 80 + 4 * kq) = w2; }
        }
        asm volatile("s_waitcnt lgkmcnt(0)\n\ts_barrier" ::: "memory");
    }
}

__device__ __forceinline__ void phase_router(KArgs a, int l, int nrows, LAS unsigned char* lds, int tid, int lane, int wave, int G, int c) {
    unsigned char* ws = a->ws;
    const float* X = (const float*)(ws + WS_X); unsigned char* H = (unsigned char*)(ws + WS_H);
    const float* ada = (const float*)(ws + WS_ADA); const float* wrp = (const float*)(ws + WS_WRP);
    const float* gn = a->in[I_N2G] + l * 1024; const float* brt = a->in[I_BR];
    unsigned* ctl = (unsigned*)(ws + WS_CTL);
    int* tokinv = (int*)(ws + WS_TOKINV); int* toke = (int*)(ws + WS_TOKE); float* tokw = (float*)(ws + WS_TOKW);
    const int tk = lane & 15, q = lane >> 4;
    f32x4 wr0[8], wr1[8];
    { const float* p0 = wrp + (((0 * 8 + wave) * 4 + q) * 16 + tk) * 32; const float* p1 = wrp + (((1 * 8 + wave) * 4 + q) * 16 + tk) * 32;
#pragma unroll
      for (int s = 0; s < 8; ++s) { wr0[s] = *(const GAS f32x4*)(p0 + 4 * s); wr1[s] = *(const GAS f32x4*)(p1 + 4 * s); } }
    LAS float* hb = (LAS float*)lds;
    LAS float* part = (LAS float*)(lds + 16 * 4112);
    LAS float* lgs = part + 8 * 16 * 32;
    for (int g = c; g < nrows / 16; g += G) {
        f32x4 v[2][4];
#pragma unroll
        for (int rr = 0; rr < 2; ++rr) { const float* xr = X + (size_t)(g * 16 + 2 * wave + rr) * 1024;
#pragma unroll
            for (int j = 0; j < 4; ++j) v[rr][j] = *(const GAS f32x4*)(xr + 4 * lane + 256 * j); }
#pragma unroll
        for (int rr = 0; rr < 2; ++rr) {
            const int row = g * 16 + 2 * wave + rr, b = row < TL ? (row >> 11) : 8;
            float ss = 0.f;
#pragma unroll
            for (int j = 0; j < 4; ++j) ss += (v[rr][j].x * v[rr][j].x + v[rr][j].y * v[rr][j].y) + (v[rr][j].z * v[rr][j].z + v[rr][j].w * v[rr][j].w);
            const float rstd = 1.0f / sqrtf(wave_sum(ss) * (1.f / 1024.f) + EPS);
            const float* sh = ada + ((size_t)l * 9 + b) * 6144 + 3072; const float* sc = sh + 1024;
#pragma unroll
            for (int j = 0; j < 4; ++j) { const int cc = 4 * lane + 256 * j; const f32x4 gg = *(const GAS f32x4*)(gn + cc), s1 = *(const GAS f32x4*)(sc + cc), s0 = *(const GAS f32x4*)(sh + cc);
                const f32x4 h = v[rr][j] * rstd * gg * (s1 + 1.0f) + s0;
                *(GAS unsigned*)(H + (size_t)row * 1024 + cc) = pk4_fp8(h.x, h.y, h.z, h.w);
                *(LAS f32x4*)(hb + (2 * wave + rr) * 1028 + cc) = h; }
        }
        __syncthreads();
        f32x4 acc0 = {0.f, 0.f, 0.f, 0.f}, acc1 = {0.f, 0.f, 0.f, 0.f};
#pragma unroll
        for (int s = 0; s < 8; ++s) { const f32x4 a4 = *(const LAS f32x4*)(hb + tk * 1028 + 128 * wave + 32 * q + 4 * s);
#pragma unroll
            for (int j = 0; j < 4; ++j) { acc0 = __builtin_amdgcn_mfma_f32_16x16x4f32(a4[j], wr0[s][j], acc0, 0, 0, 0); acc1 = __builtin_amdgcn_mfma_f32_16x16x4f32(a4[j], wr1[s][j], acc1, 0, 0, 0); } }
#pragma unroll
        for (int r = 0; r < 4; ++r) { part[(wave * 16 + 4 * q + r) * 32 + tk] = acc0[r]; part[(wave * 16 + 4 * q + r) * 32 + 16 + tk] = acc1[r]; }
        __syncthreads();
        { float sum = 0.f;
#pragma unroll
          for (int w = 0; w < 8; ++w) sum += part[w * 512 + tid];
          lgs[tid] = sum; }
        __syncthreads();
        if (wave == 0 && lane < 16) {
            const LAS float* my = lgs + lane * 32;
            float gs[4];
#pragma unroll
            for (int g4 = 0; g4 < 4; ++g4) { float m1 = -1e30f, m2 = -1e30f;
#pragma unroll
                for (int j = 0; j < 8; ++j) { const int e = g4 * 8 + j; const float sg = 1.0f / (1.0f + __expf(-my[e])); const float vv = sg + brt[e];
                    if (vv > m1) { m2 = m1; m1 = vv; } else if (vv > m2) m2 = vv; }
                gs[g4] = m1 + m2; }
            int gsel = 0; float gb = gs[0];
#pragma unroll
            for (int g4 = 1; g4 < 4; ++g4) if (gs[g4] > gb) { gb = gs[g4]; gsel = g4; }
            float v1 = -1e30f, v2 = -1e30f, s1v = 0.f, s2v = 0.f; int e1 = 0, e2 = 0;
#pragma unroll
            for (int j = 0; j < 8; ++j) { const int e = gsel * 8 + j; const float sg = 1.0f / (1.0f + __expf(-my[e])); const float vv = sg + brt[e];
                if (vv > v1) { v2 = v1; e2 = e1; s2v = s1v; v1 = vv; e1 = e; s1v = sg; } else if (vv > v2) { v2 = vv; e2 = e; s2v = sg; } }
            const float inv = 1.0f / (s1v + s2v);
            const int myrow = g * 16 + lane;
            const int p1 = (int)__hip_atomic_fetch_add(ctl + CW_CNT + l * 32 + e1, 1u, __ATOMIC_RELAXED, __HIP_MEMORY_SCOPE_AGENT);
            const int p2 = (int)__hip_atomic_fetch_add(ctl + CW_CNT + l * 32 + e2, 1u, __ATOMIC_RELAXED, __HIP_MEMORY_SCOPE_AGENT);
            tokinv[(size_t)e1 * TT + p1] = myrow; tokinv[(size_t)e2 * TT + p2] = myrow;
            toke[myrow * 2] = (e1 << 20) | p1; toke[myrow * 2 + 1] = (e2 << 20) | p2;
            tokw[myrow * 2] = s1v * inv; tokw[myrow * 2 + 1] = s2v * inv;
        }
    }
    __syncthreads();
}

__device__ __forceinline__ int crow(int r, int hi) { return (r & 3) + 8 * (r >> 2) + 4 * hi; }
__device__ __forceinline__ s16x4 tr_read(const LAS unsigned char* p) { typedef short v4s __attribute__((ext_vector_type(4))); return __builtin_bit_cast(s16x4, __builtin_amdgcn_ds_read_tr16_b64_v4i16((LAS v4s*)p)); }
constexpr int AT_FAC = 124928, AT_SCRW = 8448;
__device__ __forceinline__ void at_wait_bar(int n) {
    switch (n) {
        case 0: asm volatile("s_waitcnt vmcnt(0)\n\ts_barrier" ::: "memory"); break;
        case 2: asm volatile("s_waitcnt vmcnt(2)\n\ts_barrier" ::: "memory"); break;
        case 3: asm volatile("s_waitcnt vmcnt(3)\n\ts_barrier" ::: "memory"); break;
        case 4: asm volatile("s_waitcnt vmcnt(4)\n\ts_barrier" ::: "memory"); break;
        case 6: asm volatile("s_waitcnt vmcnt(6)\n\ts_barrier" ::: "memory"); break;
        case 8: asm volatile("s_waitcnt vmcnt(8)\n\ts_barrier" ::: "memory"); break;
        case 9: asm volatile("s_waitcnt vmcnt(9)\n\ts_barrier" ::: "memory"); break;
        default: asm volatile("s_waitcnt vmcnt(0)\n\ts_barrier" ::: "memory"); break;
    }
}
template <int kind>
__device__ __forceinline__ void attn_unit(const bf16_t* Q, bf16_t* Y, const int b, const int hq, const int qb, const bool ctxq, const float sinkl2, const float lf2, const float lb2,
                                          LAS unsigned char* lds, const int tid, const int lane, const int wave, const int tilecap) {
    constexpr int DQK = kind == 0 ? 96 : 64;
    constexpr int KS = DQK == 64 ? 128 : 256, NS = DQK / 16, SLOTK = 64 * KS, SLOT = SLOTK + 8192, NL = DQK == 64 ? 2 : 3, NSLOT = DQK == 64 ? 6 : 5;
    constexpr float THR = 8.0f;
    constexpr int KW = 2, KP = NS / KW;
    static_assert(NSLOT * SLOT <= AT_FAC && 8 * AT_SCRW <= AT_FAC && AT_FAC + 1024 <= LDS_MISC, "attention LDS map");
    int qcol, kcol, vcol, ycol, gcol = 0;
    if (kind == 0) { qcol = Q_MLAQ + hq * 96; kcol = Q_MLAK + hq * 96; vcol = Q_MLAV + hq * 64; ycol = 256 + hq * 64; }
    else if (kind == 1) { qcol = Q_GQAQ + hq * 64; kcol = Q_GQAK + (hq >> 1) * 64; vcol = Q_GQAV + (hq >> 1) * 64; ycol = 512 + hq * 64; }
    else if (kind == 2) { qcol = Q_RETQ + hq * 64; kcol = Q_RETK + hq * 64; vcol = Q_RETV + hq * 64; ycol = hq * 64; gcol = Q_RETG + hq * 64; }
    else { qcol = Q_WINQ + hq * 64; kcol = Q_WINK + (hq >> 1) * 64; vcol = Q_WINV + (hq >> 1) * 64; ycol = 768 + hq * 64; }
    const int r32 = lane & 31, hi = lane >> 5;
    const int qrow0 = (ctxq ? TL + b * 256 : b * 2048 + qb * 256) + 32 * wave;
    const int qpos = (ctxq ? 0 : qb * 256) + 32 * wave + r32;
    int lt0 = 0, nlat = 32;
    if (ctxq) nlat = 0;
    else if (kind == 3) { lt0 = 4 * qb - 2 < 0 ? 0 : 4 * qb - 2; const int lt1 = 4 * qb + 6 > 32 ? 32 : 4 * qb + 6; nlat = lt1 - lt0; }
    const int ntile = (4 + nlat) < tilecap ? (4 + nlat) : tilecap;
    bf16x8 qf[NS];
#pragma unroll
    for (int s = 0; s < NS; ++s) qf[s] = *(const GAS bf16x8*)(Q + (size_t)(qrow0 + r32) * QP + qcol + 16 * s + 8 * hi);
    f32x4 cfa = {}, cfq = {}, cba = {}, cbq = {}; float g32f = 0.f, g32b = 0.f;
    if constexpr (kind == 2) {
#pragma unroll
        for (int i = 0; i < 4; ++i) { cfa[i] = __builtin_bit_cast(float, __builtin_amdgcn_readfirstlane(__builtin_bit_cast(int, fast_exp2(lf2 * (float)(3 - i))))); cfq[i] = fast_exp2(lf2 * (float)(28 - 4 * hi - 8 * i));
            cba[i] = __builtin_bit_cast(float, __builtin_amdgcn_readfirstlane(__builtin_bit_cast(int, fast_exp2(lb2 * (float)i)))); cbq[i] = fast_exp2(lb2 * (float)(8 * i + 4 * hi)); }
        g32f = fast_exp2(32.f * lf2); g32b = fast_exp2(32.f * lb2);
    }
    int ksrc[DQK == 64 ? 1 : 2], vsrc;
    if constexpr (DQK == 64) { const int row = 8 * wave + (lane >> 3), ch = (lane & 7) ^ (row & 7); ksrc[0] = row * QP + kcol + 8 * ch; }
    else {
#pragma unroll
        for (int n = 0; n < 2; ++n) { const int row = 4 * (2 * wave + n) + (lane >> 4); int ch = (lane & 15) ^ (row & 7); if (ch >= 12) ch = 0; ksrc[n] = row * QP + kcol + 8 * ch; }
    }
    { const int row = 8 * wave + (lane >> 3); vsrc = row * QP + vcol + 8 * (lane & 7); }
#define AT_TILE_ROW0(t) ((t) < 4 ? TL + b * 256 + 64 * (t) : b * 2048 + 64 * (lt0 + (t) - 4))
#define AT_ISSUE(t) do { const bf16_t* tb_ = Q + (size_t)AT_TILE_ROW0(t) * QP; const unsigned sl_ = (unsigned)__builtin_amdgcn_readfirstlane((int)(ldsb + ((t) % NSLOT) * SLOT + wave * 1024 * (DQK == 64 ? 1 : 2))); \
        if constexpr (DQK == 64) { glds16(tb_ + ksrc[0], sl_); glds16(tb_ + vsrc, sl_ + SLOTK); } \
        else { glds16(tb_ + ksrc[0], sl_); glds16(tb_ + ksrc[DQK == 64 ? 0 : 1], sl_ + 1024); glds16(tb_ + vsrc, (unsigned)__builtin_amdgcn_readfirstlane((int)(ldsb + ((t) % NSLOT) * SLOT + SLOTK + wave * 1024))); } } while (0)
    const unsigned ldsb = (unsigned)(uintptr_t)lds;
    const unsigned krd = r32 * KS + 16 * (hi ^ (r32 & 1)) + 32 * ((r32 & 7) >> 1);
#define AT_KLOAD(KF, t, S0, S1) do { unsigned ka_ = (unsigned)(uintptr_t)(lds + ((t) % NSLOT) * SLOT) + krd; asm volatile("" : "+v"(ka_)); \
        _Pragma("unroll") for (int s = (S0); s < (S1); ++s) { const LAS unsigned char* kp_ = (const LAS unsigned char*)(uintptr_t)(ka_ ^ (unsigned)(32 * s)); \
            KF[2 * (s - (S0))] = *(const LAS bf16x8*)(kp_); KF[2 * (s - (S0)) + 1] = *(const LAS bf16x8*)(kp_ + 32 * KS); } } while (0)
#define AT_QKMR(P0, P1, KF, PART) do { _Pragma("unroll") for (int s = (PART) * KW; s < ((PART) + 1) * KW; ++s) { \
        if ((PART) == 0 && s == 0) { const f32x16 z_ = {}; P0 = __builtin_amdgcn_mfma_f32_32x32x16_bf16(KF[0], qf[0], z_, 0, 0, 0); P1 = __builtin_amdgcn_mfma_f32_32x32x16_bf16(KF[1], qf[0], z_, 0, 0, 0); } \
        else { P0 = __builtin_amdgcn_mfma_f32_32x32x16_bf16(KF[2 * (s - (PART) * KW)], qf[s], P0, 0, 0, 0); P1 = __builtin_amdgcn_mfma_f32_32x32x16_bf16(KF[2 * (s - (PART) * KW) + 1], qf[s], P1, 0, 0, 0); } } } while (0)
#define AT_KPART(KF, t, PART) AT_KLOAD(KF, t, (PART) * KW, ((PART) + 1) * KW)
#define AT_QK(P0, P1, t) do { bf16x8 kf_[2 * KW]; _Pragma("unroll") for (int p_ = 0; p_ < KP; ++p_) { AT_KPART(kf_, t, p_); AT_QKMR(P0, P1, kf_, p_); } } while (0)
    const int qw0_ = qb * 256 + 32 * wave;
#define AT_SKIP(t) ((kind == 3 && (t) >= 4) && ((64 * (lt0 + (t) - 4) + 63 < qw0_ - 128) || (64 * (lt0 + (t) - 4) > qw0_ + 31 + 128)))
#pragma unroll
    for (int t = 0; t < NSLOT - 1; ++t) if (t < ntile) AT_ISSUE(t);
    { const int infl = (ntile - 1 < NSLOT - 2 ? ntile - 1 : NSLOT - 2); at_wait_bar(infl * NL); }
    float mref = 0.f, lsum = 0.f;
    bool shifted = false;
    f32x16 o0 = {}, o1 = {}, pa0, pa1, pb0 = {}, pb1 = {};
    AT_QK(pa0, pa1, 0);
    LAS float* stage = (LAS float*)(lds + wave * AT_SCRW); LAS float* fac = (LAS float*)(lds + AT_FAC) + wave * 32;
    const int i16 = lane & 15, q4 = i16 >> 2, p4 = i16 & 3, g1 = (lane >> 4) & 1;
    const unsigned vrd = SLOTK + (4 * hi + q4) * 128 + (16 * g1 + 4 * p4) * 2;
#define CR(r) (((r) & 3) + 8 * ((r) >> 2))
#define AT_VLOAD(VF, t, u) do { unsigned vb_ = (unsigned)(uintptr_t)(lds + ((t) % NSLOT) * SLOT) + vrd + (32 * (u)) * 128; asm volatile("" : "+v"(vb_)); const LAS unsigned char* vb = (const LAS unsigned char*)(uintptr_t)vb_; \
        _Pragma("unroll") for (int s2 = 0; s2 < 2; ++s2) _Pragma("unroll") for (int d0 = 0; d0 < 2; ++d0) { const LAS unsigned char* vp = vb + (16 * s2) * 128 + 64 * d0; \
            const s16x4 lo = tr_read(vp), h2 = tr_read(vp + 8 * 128); VF[2 * s2 + d0] = (bf16x8){lo[0], lo[1], lo[2], lo[3], h2[0], h2[1], h2[2], h2[3]}; } } while (0)
#define AT_PVM(PU, VF) do { _Pragma("unroll") for (int s = 0; s < 2; ++s) { \
        u32x4 pw; pw.x = pk2(PU[8 * s], PU[8 * s + 1]); pw.y = pk2(PU[8 * s + 2], PU[8 * s + 3]); pw.z = pk2(PU[8 * s + 4], PU[8 * s + 5]); pw.w = pk2(PU[8 * s + 6], PU[8 * s + 7]); \
        const bf16x8 pa = __builtin_bit_cast(bf16x8, pw); \
        o0 = __builtin_amdgcn_mfma_f32_32x32x16_bf16(pa, VF[2 * s], o0, 0, 0, 0); o1 = __builtin_amdgcn_mfma_f32_32x32x16_bf16(pa, VF[2 * s + 1], o1, 0, 0, 0); } } while (0)
#define SB0() __builtin_amdgcn_sched_barrier(0)
#define AT_STEP(PC0, PC1, PN0, PN1, t) do { \
        const bool more = (t) + 1 < ntile; \
        if (more) { const int last_infl = ((t) + NSLOT - 2 < ntile - 1) ? ((t) + NSLOT - 2) : (ntile - 1); \
            at_wait_bar((last_infl - ((t) + 1)) * NL); \
            if ((t) + NSLOT - 1 < ntile) AT_ISSUE((t) + NSLOT - 1); } \
        const bool isctx = (t) < 4; const int kpos0 = isctx ? 64 * (t) : 64 * (lt0 + (t) - 4); \
        int dbase = kpos0 + 4 * hi - qpos; asm volatile("" : "+v"(dbase)); \
        const bool skip = AT_SKIP(t), skipn = more ? AT_SKIP((t) + 1) : true; \
        bf16x8 kf[2 * KW]; bf16x8 vf[4]; \
        if (!skipn) { AT_KPART(kf, (t) + 1, 0); SB0(); } \
        if (kind == 2) { \
            if (!skipn) { AT_QKMR(PN0, PN1, kf, 0); SB0(); AT_KPART(kf, (t) + 1, 1); } \
            AT_VLOAD(vf, t, 0); SB0(); \
              \
            const int qw0r = (ctxq ? 0 : qb * 256) + 32 * wave; \
            const int tcls = (isctx && !ctxq) ? 3 : ((kpos0 + 63 <= qw0r) ? 0 : ((kpos0 >= qw0r + 32) ? 1 : 2)); \
            float mf0 = 0.f, mf1 = 0.f, mb0 = 0.f, mb1 = 0.f; \
            if (tcls == 0) { mf1 = fast_exp2(lf2 * (float)(qpos - kpos0 - 63)); mf0 = mf1 * g32f; } \
            else if (tcls == 1) { mb0 = fast_exp2(lb2 * (float)(kpos0 - qpos)); mb1 = mb0 * g32b; } \
            else if (tcls == 3) { mf1 = fast_exp2(lf2 * (float)(256 + qpos - kpos0 - 63)); mf0 = mf1 * g32f; mb0 = fast_exp2(lb2 * (float)(2048 - qpos + kpos0)); mb1 = mb0 * g32b; } \
            if (tcls == 2) {        \
                _Pragma("unroll") for (int r = 0; r < 16; ++r) { const int d0 = -(dbase + CR(r)); PC0[r] *= fast_exp2((d0 >= 0 ? lf2 : -lb2) * (float)d0); } \
            } else { \
                const f32x4 fq_ = cfq * mf0, bq_ = cbq * mb0; \
                _Pragma("unroll") for (int r = 0; r < 16; ++r) PC0[r] *= cfa[r & 3] * fq_[r >> 2] + cba[r & 3] * bq_[r >> 2]; \
            } \
            SB0(); if (!skipn) { AT_QKMR(PN0, PN1, kf, 1); if (KP == 3) { SB0(); AT_KPART(kf, (t) + 1, 2); } } AT_PVM(PC0, vf); SB0(); AT_VLOAD(vf, t, 1); SB0(); \
            if (tcls == 2) { \
                _Pragma("unroll") for (int r = 0; r < 16; ++r) { const int d1 = -(dbase + CR(r)) - 32; PC1[r] *= fast_exp2((d1 >= 0 ? lf2 : -lb2) * (float)d1); } \
            } else { \
                const f32x4 fq_ = cfq * mf1, bq_ = cbq * mb1; \
                _Pragma("unroll") for (int r = 0; r < 16; ++r) PC1[r] *= cfa[r & 3] * fq_[r >> 2] + cba[r & 3] * bq_[r >> 2]; \
            } \
            SB0(); if (KP == 3 && !skipn) { AT_QKMR(PN0, PN1, kf, 2); } AT_PVM(PC1, vf); \
        } else if (!skip) { \
            if (kind == 3 && !isctx) { \
                _Pragma("unroll") for (int r = 0; r < 16; ++r) { const int d0 = dbase + CR(r), d1 = d0 + 32; \
                    if (d0 > 128 || d0 < -128) PC0[r] = -INFINITY; if (d1 > 128 || d1 < -128) PC1[r] = -INFINITY; } \
            } \
            float tm = fmaxf(PC0[0], PC1[0]); \
            _Pragma("unroll") for (int r = 1; r < 16; ++r) tm = fmaxf(tm, fmaxf(PC0[r], PC1[r])); \
            tm = xmax32(tm) - mref; \
            if (__any(tm > THR)) { \
                const float dl = (tm > THR) ? tm : 0.f; \
                mref += dl; shifted = true; \
                const float f = fast_exp2(-dl); lsum *= f; \
                if (hi == 0) fac[r32] = f; \
                LDS_WAIT(); asm volatile("" ::: "memory"); \
                _Pragma("unroll") for (int r = 0; r < 16; ++r) { const float fr_ = fac[crow(r, hi)]; o0[r] *= fr_; o1[r] *= fr_; } \
            } \
            if (shifted) { _Pragma("unroll") for (int r = 0; r < 16; ++r) { PC0[r] -= mref; PC1[r] -= mref; } } \
            SB0(); \
            if (!skipn) { AT_QKMR(PN0, PN1, kf, 0); SB0(); AT_KPART(kf, (t) + 1, 1); } \
            AT_VLOAD(vf, t, 0); SB0(); \
            float ps = 0.f; \
            _Pragma("unroll") for (int r = 0; r < 16; ++r) { PC0[r] = fast_exp2(PC0[r]); ps += PC0[r]; } \
            SB0(); if (!skipn) { AT_QKMR(PN0, PN1, kf, 1); if (KP == 3) { SB0(); AT_KPART(kf, (t) + 1, 2); } } AT_PVM(PC0, vf); SB0(); AT_VLOAD(vf, t, 1); SB0(); \
            _Pragma("unroll") for (int r = 0; r < 16; ++r) { PC1[r] = fast_exp2(PC1[r]); ps += PC1[r]; } \
            lsum += ps; \
            SB0(); if (KP == 3 && !skipn) { AT_QKMR(PN0, PN1, kf, 2); } AT_PVM(PC1, vf); \
        } else if (!skipn) { AT_QKMR(PN0, PN1, kf, 0); _Pragma("unroll") for (int p_ = 1; p_ < KP; ++p_) { AT_KPART(kf, (t) + 1, p_); AT_QKMR(PN0, PN1, kf, p_); } } \
        } while (0)
    for (int t = 0; t < ntile; t += 2) {
        AT_STEP(pa0, pa1, pb0, pb1, t);
        if (t + 1 < ntile) AT_STEP(pb0, pb1, pa0, pa1, t + 1);
    }
#undef AT_STEP
#undef AT_PVM
#undef AT_VLOAD
#undef AT_KLOAD
#undef AT_QKMR
#undef AT_KPART
#undef SB0
#undef AT_ISSUE
#undef AT_TILE_ROW0
#undef AT_QK
#undef AT_SKIP
#undef CR
    asm volatile("s_waitcnt lgkmcnt(0)\n\ts_barrier" ::: "memory");
#pragma unroll
    for (int r = 0; r < 16; ++r) { stage[crow(r, hi) * 65 + r32] = o0[r]; stage[crow(r, hi) * 65 + 32 + r32] = o1[r]; }
    LDS_WAIT(); asm volatile("" ::: "memory");
    float x[32];
#pragma unroll
    for (int j = 0; j < 32; ++j) x[j] = stage[r32 * 65 + 32 * hi + j];
    int orow_i = qrow0 + r32; asm volatile("" : "+v"(orow_i));
    const size_t orow = (size_t)orow_i;
    if (kind == 2) {
        float s = 0.f;
#pragma unroll
        for (int j = 0; j < 32; ++j) s += x[j];
        s = xadd<32>(s); const float mean = s * (1.f / 64.f); float v = 0.f;
#pragma unroll
        for (int j = 0; j < 32; ++j) { x[j] -= mean; v += x[j] * x[j]; }
        v = xadd<32>(v); const float rstd = 1.0f / sqrtf(v * (1.f / 64.f) + EPS);
        const bf16_t* gp = Q + orow * QP + gcol + 32 * hi;
#pragma unroll
        for (int c = 0; c < 4; ++c) { const u32x4 gw = *(const GAS u32x4*)(gp + 8 * c);
#pragma unroll
            for (int j = 0; j < 4; ++j) { const float ga = bflo(gw[j]), gb = bfhi(gw[j]); x[8 * c + 2 * j] *= rstd * ga * sigmoidf_(ga); x[8 * c + 2 * j + 1] *= rstd * gb * sigmoidf_(gb); } }
    } else {
        float lt = xadd<32>(lsum);
        if (kind == 3) lt += fast_exp2(sinkl2 - mref);
        const float inv = 1.0f / fmaxf(lt, 1e-30f);
#pragma unroll
        for (int j = 0; j < 32; ++j) x[j] *= inv;
    }
    bf16_t* yp = Y + orow * 1024 + ycol + 32 * hi;
#pragma unroll
    for (int c = 0; c < 4; ++c) { u32x4 w; w.x = pk2(x[8 * c], x[8 * c + 1]); w.y = pk2(x[8 * c + 2], x[8 * c + 3]); w.z = pk2(x[8 * c + 4], x[8 * c + 5]); w.w = pk2(x[8 * c + 6], x[8 * c + 7]); *(GAS u32x4*)(yp + 8 * c) = w; }
    asm volatile("s_waitcnt vmcnt(0) lgkmcnt(0)\n\ts_barrier" ::: "memory");
}
#ifndef PROBE_KMASK
#define PROBE_KMASK 0x1f
#endif
#ifndef PROBE_TILECAP
#define PROBE_TILECAP 1000
#endif
__device__ __forceinline__ void phase_mix(KArgs a, int lq, LAS unsigned char* lds, int tid, int lane, int wave, int G, int c) {
    const int l = lq & 1; const int kmask = (lq >= 2) ? PROBE_KMASK : 0x1f; const int tilecap = (lq >= 2) ? PROBE_TILECAP : 1000;
    unsigned char* ws = a->ws;
    const bf16_t* Q = (const bf16_t*)(ws + WS_QKV); bf16_t* Y = (bf16_t*)(ws + (lq >= 2 ? WS_MRG : WS_Y));
    const int nunits = l == 0 ? 1152 : 1024;
    const int vc = (G == 256) ? ((c & 7) * 32 + (c >> 3)) : c;
    for (int j = 0; ; ++j) {
        const int u = j * G + vc;
        if (u >= nunits) break;
        int kind, b, hq, qb; bool ctxq;
        if (u < 1024) { kind = u >> 8; const int r = u & 255; b = r >> 5; hq = (r >> 3) & 3; qb = r & 7; ctxq = false; }
        else { const int r = u - 1024; kind = r >> 5; b = (r >> 2) & 7; hq = r & 3; qb = 0; ctxq = true; }
        if (!((kmask >> (ctxq ? 4 : kind)) & 1)) continue;
        const float lf2 = -__expf(a->in[I_DECAY][l * 8 + hq]) * LOG2E, lb2 = -__expf(a->in[I_DECAY][l * 8 + 4 + hq]) * LOG2E;
        const float sk = a->in[I_SINK][l * 4 + hq] * LOG2E;
        int tid2 = tid; asm volatile("" : "+v"(tid2));
        const int lane2 = tid2 & 63;
        if (kind == 0) attn_unit<0>(Q, Y, b, hq, qb, ctxq, sk, lf2, lb2, lds, tid2, lane2, wave, tilecap);
        else if (kind == 1) attn_unit<1>(Q, Y, b, hq, qb, ctxq, sk, lf2, lb2, lds, tid2, lane2, wave, tilecap);
        else if (kind == 2) attn_unit<2>(Q, Y, b, hq, qb, ctxq, sk, lf2, lb2, lds, tid2, lane2, wave, tilecap);
        else attn_unit<3>(Q, Y, b, hq, qb, ctxq, sk, lf2, lb2, lds, tid2, lane2, wave, tilecap);
    }
}

#ifndef MK_BAR_XCD
#define MK_BAR_XCD 1
#endif
constexpr int NPHASE = 20;
#ifndef PH_MASK
#define PH_MASK 0x3ff
#endif
#define PH_ON(b) ((PH_MASK >> (b)) & 1)
#ifndef PROBE_REPEAT
#define PROBE_REPEAT 0
#endif
__global__ void __launch_bounds__(NTHREADS, 2) fwd_kernel(Args a_byval) {
    extern __shared__ __attribute__((aligned(16))) unsigned char lds_raw[];
    LAS unsigned char* lds0 = (LAS unsigned char*)lds_raw;
    const int wave0 = __builtin_amdgcn_readfirstlane((int)threadIdx.x >> 6);
    { LAS unsigned char* lds = lds0; const int t0 = wave0 * 64 + lane_id(); for (int u = t0; u < (LDS_BYTES - LDS_MISC) / 4; u += NTHREADS) ((LAS unsigned*)(lds + LDS_MISC))[u] = 0u; }
    __syncthreads();
    const int ph_lo = a_byval.ph_lo, ph_hi = a_byval.ph_hi;
#if MK_ONE_LAUNCH && MK_BAR_XCD
    XcdBarrier bar = xcd_barrier_post((unsigned*)(a_byval.ws + WS_CTL) + CW_BAR, (volatile LAS unsigned*)(lds0 + LDS_MISC), wave0);
#endif
    for (int ph = ph_lo; ph < ph_hi; ++ph) {
#if PROBE_REPEAT
      const int nrep = 1 + ((PROBE_REPEAT >> ph) & 1);
      for (int rep = 0; rep < nrep; ++rep) {
#else
      constexpr int nrep = 1, rep = 0; {
#endif
#define PHASE_IDS \
        KArgs a = (KArgs)__builtin_amdgcn_kernarg_segment_ptr(); asm volatile("" : "+s"(a)); \
        int wave = wave0; asm volatile("" : "+s"(wave)); unsigned z_ = 0u; asm volatile("" : "+v"(z_)); \
        const int lane = (int)__builtin_amdgcn_mbcnt_hi(~0u, __builtin_amdgcn_mbcnt_lo(~0u, z_)); const int tid = wave * 64 + lane; \
        unsigned ldso = 0; asm volatile("" : "+s"(ldso)); LAS unsigned char* lds = lds0 + ldso; \
        int G = gridDim.x, c = blockIdx.x; asm volatile("" : "+s"(G), "+s"(c)); \
        unsigned char* ws = a->ws; unsigned* ctl = (unsigned*)(ws + WS_CTL); const float* ada = (const float*)(ws + WS_ADA); (void)ctl; (void)ada; (void)tid; (void)lane; (void)lds; (void)G; (void)c;
        if (ph == 0) { if (PH_ON(0)) { PHASE_IDS p0_prologue(a, lds, tid, lane, wave, G, c); } }
        else if (ph == NPHASE - 1) { if (PH_ON(1)) { PHASE_IDS moe_tables(ctl, 1, lds, tid); phase_rownorm(a, 2, lds, lane, wave, G, c); } }
        else {
            const int l = (ph - 1) / 9, k = (ph - 1) % 9;
            if (k == 0) { if (PH_ON(1)) { PHASE_IDS if (l == 1) moe_tables(ctl, 0, lds, tid); phase_rownorm(a, l, lds, lane, wave, G, c); } }
            else if (k == 1) { if (PH_ON(2)) { PHASE_IDS
                SchedB S{l, G, c, (const char*)(ws + WS_H), (const char*)(ws + WS_WIN) + (size_t)l * NBG * 1024};
                const float* rope_ = (const float*)(ws + WS_ROPE);
                EpiB E{(bf16_t*)(ws + WS_P), (bf16_t*)(ws + WS_G), (bf16_t*)(ws + WS_QKV), rope_, rope_ + 2048 * 32, a->in[I_GQN] + l * 64, a->in[I_GKN] + l * 64};
                pg8::gemm_phase<EpiB, SchedB, false, true, 0x7a7a7a7a, 0x7f7f7f7f>(lds, tid, 1024, 1024, 1024, S, E); }
            } else if (k == 2) { if (PH_ON(3)) { PHASE_IDS phase_post(a, l, lds, lane, wave, G, c); } }
            else if (k == 3) { if (PH_ON(4)) { PHASE_IDS phase_mix(a, l + 2 * rep, lds, tid, lane, wave, G, c); } }
            else if (k == 4) { if (PH_ON(5)) { PHASE_IDS
                SchedE S{G, c, l == 0 ? 72 : 64, (const char*)(ws + WS_Y), (const char*)(ws + WS_WBR) + (size_t)l * 1048576 * 2};
                EpiE E{(const bf16_t*)(ws + WS_G), (bf16_t*)(ws + WS_MRG)};
                pg8::gemm_phase<EpiE, SchedE, false>(lds, tid, 2048, 2048, 2048, S, E); }
            } else if (k == 5) { if (PH_ON(6)) { PHASE_IDS
                SchedF S{G, c, l == 0 ? 72 : 64, (const char*)(ws + WS_MRG), (const char*)(ws + WS_WOUT) + (size_t)l * 1048576 * 2};
                EpiF E{a->in[I_X], a->in[I_CTX], (const float*)(ws + WS_X), (float*)(ws + WS_X), ada + (size_t)l * 9 * 6144, l};
                pg8::gemm_phase<EpiF, SchedF, false>(lds, tid, 2048, 2048, 2048, S, E); }
            } else if (k == 6) { if (PH_ON(7)) { PHASE_IDS phase_router(a, l, l == 0 ? TT : TL, lds, tid, lane, wave, G, c); } }
            else if (k == 7) { if (PH_ON(8)) { PHASE_IDS
                moe_tables(ctl, l, lds, tid);
                SchedMoe S{G, c, 8, 1, (const LAS int*)(lds + LDS_MISC + 1024), (const LAS int*)(lds + LDS_MISC + 2304), (const int*)(ws + WS_TOKINV), (const char*)(ws + WS_H), (const char*)(ws + WS_W13) + (size_t)l * 32 * 2 * MiB, 2 * MiB};
                EpiH E{(unsigned char*)(ws + WS_HID)};
                pg8::gemm_phase<EpiH, SchedMoe, true, true, 0x7a7a7a7a, 0x7f7f7f7f>(lds, tid, 1024, 1024, 1024, S, E); }
            } else if (PH_ON(9)) { PHASE_IDS
                moe_tables(ctl, l, lds, tid);
                SchedMoe S{G, c, 4, 0, (const LAS int*)(lds + LDS_MISC + 1024), (const LAS int*)(lds + LDS_MISC + 2304), (const int*)(ws + WS_TOKINV), (const char*)(ws + WS_HID), (const char*)(ws + WS_W2) + (size_t)l * 32 * 1 * MiB, 1 * MiB};
                EpiI E{(bf16_t*)(ws + WS_Y2)};
                pg8::gemm_phase<EpiI, SchedMoe, false, true, 0x7a7a7a7a, 0x7d7d7d7d>(lds, tid, 1024, 1024, 1024, S, E);
            }
        }
#if MK_ONE_LAUNCH
        if (ph + 1 < ph_hi || rep + 1 < nrep) {
#if MK_BAR_XCD
            if (ph == ph_lo) cg::this_grid().sync(); else xcd_barrier(bar);
#else
            cg::this_grid().sync();
#endif
        }
#endif
      }
    }
}

extern "C" void kernel_launch(void* const* d_in, const int* in_sizes, int n_in, void* d_out, int out_size, void* d_ws, size_t ws_size, hipStream_t stream) {
    static int grid = 0;
    if (grid == 0) {
        if (n_in != 26 || out_size != TL * DM || ws_size < WS_END) { fprintf(stderr, "kernel_launch: unexpected problem (n_in %d, out %d, ws %zu)\n", n_in, out_size, ws_size); grid = -1; return; }
        int dev = 0, cus = 0, per_cu = 0;
        (void)hipGetDevice(&dev); (void)hipDeviceGetAttribute(&cus, hipDeviceAttributeMultiprocessorCount, dev);
        if (hipFuncSetAttribute((const void*)fwd_kernel, hipFuncAttributeMaxDynamicSharedMemorySize, LDS_BYTES) != hipSuccess) { fprintf(stderr, "kernel_launch: hipFuncSetAttribute failed\n"); grid = -1; return; }
        if (hipOccupancyMaxActiveBlocksPerMultiprocessor(&per_cu, (const void*)fwd_kernel, NTHREADS, LDS_BYTES) != hipSuccess || per_cu < 1) { fprintf(stderr, "kernel_launch: occupancy query says %d blocks per CU\n", per_cu); (void)hipGetLastError(); per_cu = 1; }
        grid = cus;
        if (grid < 1) grid = 256;
    }
    if (grid < 0) return;
    (void)hipMemsetAsync((char*)d_ws + WS_CTL, 0, CTL_ZERO_BYTES, stream);
    Args a{};
    for (int i = 0; i < 26; ++i) a.in[i] = (const float*)d_in[i];
    a.out = (float*)d_out; a.ws = (unsigned char*)d_ws;
#if MK_ONE_LAUNCH
    a.ph_lo = 0; a.ph_hi = NPHASE;
    void* args[] = {&a};
    hipError_t e = hipLaunchCooperativeKernel((const void*)fwd_kernel, dim3(grid), dim3(NTHREADS), args, LDS_BYTES, stream);
    if (e != hipSuccess) fprintf(stderr, "kernel_launch: cooperative launch failed: %s (grid %d)\n", hipGetErrorString(e), grid);
#else
    for (int ph = 0; ph < NPHASE; ++ph) { a.ph_lo = ph; a.ph_hi = ph + 1; hipLaunchKernelGGL(fwd_kernel, dim3(grid), dim3(NTHREADS), LDS_BYTES, stream, a); }
#endif
}
```

```cpp
#include <hip/hip_runtime.h>
#include <hip/hip_cooperative_groups.h>
#include <cstdio>
#include <cstdint>
namespace cg = cooperative_groups;

#define LAS __attribute__((address_space(3)))
#define GAS __attribute__((address_space(1)))
typedef unsigned short bf16_t;
typedef short bf16x8 __attribute__((ext_vector_type(8)));
typedef short s16x4 __attribute__((ext_vector_type(4)));
typedef float f32x4 __attribute__((ext_vector_type(4)));
typedef float f32x2 __attribute__((ext_vector_type(2)));
typedef float f32x16 __attribute__((ext_vector_type(16)));
typedef unsigned u32x4 __attribute__((ext_vector_type(4)));
typedef unsigned u32x2 __attribute__((ext_vector_type(2)));

#ifndef MK_ONE_LAUNCH
#define MK_ONE_LAUNCH 1
#endif

constexpr int DM = 1024, NBATCH = 8, SEQ = 2048, CTXL = 256;
constexpr int TL = NBATCH * SEQ, TC = NBATCH * CTXL, TT = TL + TC;
constexpr int NIN = 2464, NINP = 2560, NGATE = 4096, NBG = NINP + NGATE;
constexpr int QP = 3072;
constexpr int NEXP = 32, MAXTILES = 176;
constexpr float EPS = 1e-6f, LOG2E = 1.4426950408889634f;
constexpr int P_RET = 0, P_MLA = 1024, P_GQA = 1440, P_WIN = 1952;
constexpr int Q_RETQ = 0, Q_RETK = 256, Q_RETV = 512, Q_RETG = 768;
constexpr int Q_MLAQ = 1024, Q_MLAK = 1408, Q_MLAV = 1792;
constexpr int Q_GQAQ = 2048, Q_GQAK = 2304, Q_GQAV = 2432;
constexpr int Q_WINQ = 2560, Q_WINK = 2816, Q_WINV = 2944;

constexpr size_t MiB = 1u << 20;
constexpr size_t WS_CTL = 0, CTL_ZERO_BYTES = 1 * MiB;
constexpr size_t WS_ADA = 1 * MiB;
constexpr size_t WS_ROPE = WS_ADA + 512 * 1024;
constexpr size_t WS_WRP = WS_ROPE + 768 * 1024;
constexpr size_t WS_TOKINV = 3 * MiB;
constexpr size_t WS_TOKE = WS_TOKINV + (size_t)NEXP * TT * 4;
constexpr size_t WS_TOKW = WS_TOKE + (size_t)TT * 2 * 4;
constexpr size_t WS_WSM = 6 * MiB;
constexpr size_t WS_WIN = 8 * MiB;
constexpr size_t WS_WBR = 34 * MiB;
constexpr size_t WS_WOUT = 38 * MiB;
constexpr size_t WS_W13 = 42 * MiB;
constexpr size_t WS_W2 = 298 * MiB;
constexpr size_t WS_X = 426 * MiB;
constexpr size_t WS_H = 498 * MiB;
constexpr size_t WS_QKV = 534 * MiB;
constexpr size_t WS_Y = 642 * MiB;
constexpr size_t WS_MRG = 678 * MiB;
constexpr size_t WS_P = 714 * MiB;
constexpr size_t WS_G = 804 * MiB;
constexpr size_t WS_HID = 714 * MiB;
constexpr size_t WS_Y2 = 804 * MiB;
constexpr size_t WS_END = 948 * MiB;
static_assert(WS_TOKW + (size_t)TT * 8 <= WS_WSM && WS_HID + (size_t)MAXTILES * 256 * 2048 <= WS_Y2 && WS_Y2 + (size_t)MAXTILES * 256 * 2048 <= WS_END, "ws map");
static_assert(WS_P + (size_t)TT * NINP * 2 <= WS_G && WS_G + (size_t)TT * NGATE * 2 <= WS_END && WS_END <= 1024 * MiB, "ws map");
constexpr int CW_BAR = 4096;
constexpr int CW_CNT = 16384;
constexpr int CW_WQ = 16640;

constexpr int LDS_MISC = 131072, LDS_BYTES = 147456;

__device__ __forceinline__ unsigned f2bf(float f) { unsigned u = __builtin_bit_cast(unsigned, f); return (u + 0x7fffu + ((u >> 16) & 1u)) >> 16; }
__device__ __forceinline__ unsigned pk2(float lo, float hi) { typedef __bf16 bf2 __attribute__((ext_vector_type(2))); f32x2 v = {lo, hi}; bf2 b = __builtin_convertvector(v, bf2); return __builtin_bit_cast(unsigned, b); }
__device__ __forceinline__ unsigned pk4_fp8(float a, float b, float c, float d) { int p = __builtin_amdgcn_cvt_pk_fp8_f32(a, b, 0, false); p = __builtin_amdgcn_cvt_pk_fp8_f32(c, d, p, true); return (unsigned)p; }
__device__ __forceinline__ float bf2f(unsigned short b) { return __builtin_bit_cast(float, (unsigned)b << 16); }
__device__ __forceinline__ float bflo(unsigned w) { return __builtin_bit_cast(float, w << 16); }
__device__ __forceinline__ float bfhi(unsigned w) { return __builtin_bit_cast(float, w & 0xffff0000u); }
template <int M> __device__ __forceinline__ float xadd(float v) {
    if constexpr (M == 32) { unsigned a = __builtin_bit_cast(unsigned, v), b = a; asm volatile("" : "+v"(b));
        auto r = __builtin_amdgcn_permlane32_swap(a, b, false, false); const unsigned r0 = r[0], r1 = r[1];
        return __uint_as_float(r0) + __uint_as_float(r1); }
    else return v + __builtin_bit_cast(float, __builtin_amdgcn_ds_swizzle(__builtin_bit_cast(int, v), (M << 10) | 0x1f));
}
__device__ __forceinline__ float xmax32(float v) { unsigned a = __builtin_bit_cast(unsigned, v), b = a; asm volatile("" : "+v"(b));
    auto r = __builtin_amdgcn_permlane32_swap(a, b, false, false); const unsigned r0 = r[0], r1 = r[1]; return fmaxf(__uint_as_float(r0), __uint_as_float(r1)); }
__device__ __forceinline__ float wave_sum(float v) { v = xadd<1>(v); v = xadd<2>(v); v = xadd<4>(v); v = xadd<8>(v); v = xadd<16>(v); return xadd<32>(v); }
__device__ __forceinline__ float fast_exp2(float x) { return __builtin_amdgcn_exp2f(x); }
__device__ __forceinline__ float fast_rcp(float x) { return __builtin_amdgcn_rcpf(x); }
__device__ __forceinline__ float sigmoidf_(float x) { return fast_rcp(1.f + fast_exp2(-x * LOG2E)); }
__device__ __forceinline__ int lane_id() { return (int)__builtin_amdgcn_mbcnt_hi(~0u, __builtin_amdgcn_mbcnt_lo(~0u, 0u)); }
__device__ __forceinline__ void glds16(const void* gsrc, unsigned lds_dst) { unsigned keep;
    asm volatile("s_mov_b32 %0, m0\n\ts_mov_b32 m0, %2\n\ts_nop 0\n\tglobal_load_lds_dwordx4 %1, off\n\ts_mov_b32 m0, %0" : "=&s"(keep) : "v"(gsrc), "s"(lds_dst) : "memory"); }
__device__ __forceinline__ const char* uniform_ptr(const char* p) { const unsigned long long v = (unsigned long long)(uintptr_t)p; const unsigned lo = (unsigned)__builtin_amdgcn_readfirstlane((int)(unsigned)v), hi = (unsigned)__builtin_amdgcn_readfirstlane((int)(unsigned)(v >> 32)); return (const char*)(uintptr_t)(((unsigned long long)hi << 32) | lo); }
__device__ __forceinline__ void glds16_sv(const void* sbase, unsigned voff, unsigned lds_dst) { unsigned keep;
    asm volatile("s_mov_b32 %0, m0\n\ts_mov_b32 m0, %3\n\ts_nop 0\n\tglobal_load_lds_dwordx4 %1, %2\n\ts_mov_b32 m0, %0" : "=&s"(keep) : "v"(voff), "s"(sbase), "s"(lds_dst) : "memory"); }
#define LDS_WAIT() asm volatile("s_waitcnt lgkmcnt(0)" ::: "memory")
#define VM_WAIT() asm volatile("s_waitcnt vmcnt(0)" ::: "memory")

#define XB_TMO      128
#define XB_XCNT(j)  (256  + 64 * (j))
#define XB_XSUB(j)  (1280 + 64 * (j))
#define XB_XGEN(j)  (2304 + 64 * (j))
#define XB_TOP      3328
#define XB_TOPGEN   3392
#define XCD_BAR_WORDS 3456
#define XB_SPIN_CAP (1u << 18)
__device__ __forceinline__ unsigned xb_ld(unsigned* p)              { return __hip_atomic_load(p, __ATOMIC_RELAXED, __HIP_MEMORY_SCOPE_AGENT); }
__device__ __forceinline__ unsigned xb_add(unsigned* p, unsigned v) { return __hip_atomic_fetch_add(p, v, __ATOMIC_RELAXED, __HIP_MEMORY_SCOPE_AGENT); }
__device__ __forceinline__ unsigned xb_xcc_id() { return (unsigned)__builtin_amdgcn_s_getreg((3 << 11) | 20) & 0xFu; }
#define XB_SPIN(cond, bar) do { unsigned _sp = 0; while (cond) { __builtin_amdgcn_s_sleep(1); \
    if ((++_sp & 255u) == 0u) { if (xb_ld(&(bar)[XB_TMO])) break; if (_sp > XB_SPIN_CAP) { atomicAdd(&(bar)[XB_TMO], 1u); break; } } } } while (0)
struct XcdBarrier { unsigned* bar; unsigned x; volatile LAS unsigned* st; int wave; };
__device__ __forceinline__ XcdBarrier xcd_barrier_post(unsigned* bar, volatile LAS unsigned* st, int wave) {
    XcdBarrier b; b.bar = bar; b.x = xb_xcc_id(); b.st = st; b.wave = wave;
    if (wave == 0 && lane_id() == 0) (void)xb_add(&bar[XB_XCNT(b.x)], 1u);
    return b;
}
__device__ __forceinline__ void xcd_barrier_complete(unsigned* bar, unsigned x, unsigned& nloc, unsigned& nx) {
    const unsigned G = gridDim.x * gridDim.y * gridDim.z;
    unsigned sum, cnt, mine, sp = 0u;
    for (;;) {
        sum = 0u; cnt = 0u; mine = 0u;
#pragma unroll
        for (unsigned j = 0; j < 16; ++j) { const unsigned c = xb_ld(&bar[XB_XCNT(j)]); sum += c; cnt += (c > 0u) ? 1u : 0u; }
        mine = xb_ld(&bar[XB_XCNT(x)]);
        if (sum == G) break;
        __builtin_amdgcn_s_sleep(1);
        if ((++sp & 255u) == 0u) { if (xb_ld(&bar[XB_TMO])) break; if (sp > XB_SPIN_CAP) { atomicAdd(&bar[XB_TMO], 1u); break; } }
    }
    nloc = mine > 0u ? mine : 1u; nx = cnt > 0u ? cnt : 1u;
}
__device__ __forceinline__ void xcd_barrier(const XcdBarrier& b) {
    asm volatile("s_waitcnt vmcnt(0)" ::: "memory");
    __syncthreads();
    if (b.wave == 0 && lane_id() == 0) {
        unsigned* bar = b.bar; asm volatile("" : "+s"(bar));
        __builtin_amdgcn_s_waitcnt(0);
        unsigned nloc = b.st[0], nx = b.st[1];
        if (nloc == 0u) { xcd_barrier_complete(bar, b.x, nloc, nx); b.st[0] = nloc; b.st[1] = nx; }
        const unsigned old = xb_add(&bar[XB_XSUB(b.x)], 1u);
        const unsigned gen = old / nloc;
        if (old + 1u == (gen + 1u) * nloc) {
            __builtin_amdgcn_fence(__ATOMIC_RELEASE, "agent");
            asm volatile("s_waitcnt vmcnt(0)" ::: "memory");
            const unsigned og = xb_add(&bar[XB_TOP], 1u);
            const unsigned tg = og / nx;
            if (og + 1u == (tg + 1u) * nx) xb_add(&bar[XB_TOPGEN], 1u);
            else XB_SPIN(xb_ld(&bar[XB_TOPGEN]) == tg, bar);
            __builtin_amdgcn_fence(__ATOMIC_ACQUIRE, "agent");
            xb_add(&bar[XB_XGEN(b.x)], 1u);
            asm volatile("s_waitcnt vmcnt(0)" ::: "memory");
        } else {
            XB_SPIN(xb_ld(&bar[XB_XGEN(b.x)]) == gen, bar);
            __builtin_amdgcn_fence(__ATOMIC_ACQUIRE, "agent");
            asm volatile("s_waitcnt vmcnt(0)" ::: "memory");
        }
    }
    __syncthreads();
}

namespace pg8 {
constexpr int BM = 256, BK = 64, HALF = 128, HTB = HALF * BK * 2, STAGE_BYTES = 8 * HTB;
__host__ __device__ __forceinline__ int lds_byte(int r, int c) { const int st = (r >> 4) * 2 + (c >> 5), rr = r & 15, cc = c & 31, ob = rr * 64 + cc * 2; return st * 1024 + (ob ^ (((ob >> 9) & 1) << 5)); }
__host__ __device__ __forceinline__ void stage_rc(int b, int& R, int& C) { const int st = b / 1024, sb = b % 1024, swz = sb ^ (((sb >> 9) & 1) << 5); R = (st >> 1) * 16 + swz / 64; C = (st & 1) * 32 + (swz % 64) / 2; }
__host__ __device__ __forceinline__ int perm32(int rho) { const int n = rho >> 4, i = rho & 15; return 8 * (i >> 2) + 4 * n + (i & 3); }
struct Unit { int pm, pn, aux; };
__device__ __forceinline__ void tile_order(int L, int nM, int nN, int& pm, int& pn) {
    const int nwg = nM * nN; int wgid = L; { const int q = nwg / 8, r = nwg % 8, xcd = wgid % 8, off = wgid / 8; wgid = (xcd < r ? xcd * (q + 1) : r * (q + 1) + (xcd - r) * q) + off; }
    const int nig = 8 * nN, gid = wgid / nig, fm = gid * 8, gsz = (nM - fm) < 8 ? (nM - fm) : 8;
    pm = fm + ((wgid % nig) % gsz); pn = (wgid % nig) / gsz;
}
typedef int i32x8 __attribute__((ext_vector_type(8)));
typedef int i32x4 __attribute__((ext_vector_type(4)));
struct Frag2 { bf16x8 k[2]; };
template <bool F8> struct FragT { typedef Frag2 type; };
template <> struct FragT<true> { typedef i32x8 type; };
__device__ __forceinline__ void frag_set(Frag2& f, int k, i32x4 v) { f.k[k] = __builtin_bit_cast(bf16x8, v); }
__device__ __forceinline__ void frag_set(i32x8& f, int k, i32x4 v) { if (k == 0) { f[0] = v[0]; f[1] = v[1]; f[2] = v[2]; f[3] = v[3]; } else { f[4] = v[0]; f[5] = v[1]; f[6] = v[2]; f[7] = v[3]; } }
__device__ __forceinline__ f32x4 mma1(const Frag2& w, const Frag2& x, f32x4 c, int, int) { c = __builtin_amdgcn_mfma_f32_16x16x32_bf16(w.k[0], x.k[0], c, 0, 0, 0); return __builtin_amdgcn_mfma_f32_16x16x32_bf16(w.k[1], x.k[1], c, 0, 0, 0); }
#ifndef FP8_ASM_MMA
#define FP8_ASM_MMA 1
#endif
__device__ __forceinline__ f32x4 mma1(const i32x8& w, const i32x8& x, f32x4 c, int sw, int sx) {
#if FP8_ASM_MMA
    asm volatile("v_mfma_scale_f32_16x16x128_f8f6f4 %0, %1, %2, %0, %3, %4 op_sel_hi:[0,0,0]" : "+v"(c) : "v"(w), "v"(x), "v"(sw), "v"(sx));
    return c;
#else
    return __builtin_amdgcn_mfma_scale_f32_16x16x128_f8f6f4(w, x, c, 0, 0, 0, sw, 0, sx);
#endif
}
template <class Epi, class Sched, bool GATHER, bool FP8 = false, int SW = 0x7f7f7f7f, int SX = 0x7f7f7f7f>
__device__ __forceinline__ void gemm_phase(LAS unsigned char* lds, const int tid, const int kb, const int lda, const int ldb, const Sched& S, const Epi& E) {
    const int wid = __builtin_amdgcn_readfirstlane(tid >> 6), lane = tid & 63, wr = wid >> 2, wc = wid & 3, fr = lane & 15, fq = lane >> 4;
    const int nt = kb / 128;
    int sR[2], sC[2]; unsigned voffB[2];
#pragma unroll
    for (int i = 0; i < 2; ++i) { int R, C; stage_rc(tid * 16 + i * 8192, R, C); sR[i] = R; sC[i] = C; const int Rb = Epi::PERM ? ((R & ~31) + perm32(R & 31)) : R; voffB[i] = (unsigned)(Rb * ldb + C * 2); }
    const size_t kstep = (size_t)(BK * 2);
    const size_t hstepB = (size_t)HALF * ldb;
    const unsigned ldsw = (unsigned)wid * 1024u; const unsigned ldsb_ = (unsigned)(uintptr_t)lds;
    const int aoff = lds_byte(wr * 64 + fr, fq * 8), boff = lds_byte(wc * 32 + fr, fq * 8);
#define PG8_SA(b, h) (((b) * 2 + (h)) * HTB)
#define PG8_SB(b, h) ((4 + (b) * 2 + (h)) * HTB)
#define PG8_STAGE_B(bufoff, gbase) do { _Pragma("unroll") for (int _i = 0; _i < 2; ++_i) \
        glds16_sv((const void*)(gbase), voffB[_i], (unsigned)__builtin_amdgcn_readfirstlane((int)(ldsb_ + (bufoff) + ldsw + _i * 8192))); } while (0)
#define PG8_STAGE_A(bufoff, gbase, off) do { _Pragma("unroll") for (int _i = 0; _i < 2; ++_i) \
        glds16_sv((const void*)(gbase), (off)[_i], (unsigned)__builtin_amdgcn_readfirstlane((int)(ldsb_ + (bufoff) + ldsw + _i * 8192))); } while (0)
#define PG8_LDA(dst, b, h) do { _Pragma("unroll") for (int m = 0; m < 4; ++m) _Pragma("unroll") for (int k = 0; k < 2; ++k) frag_set(dst[m], k, *(const LAS i32x4*)(lds + PG8_SA(b, h) + aoff + m * 2048 + k * 1024)); } while (0)
#define PG8_LDB(dst, b, h) do { _Pragma("unroll") for (int n = 0; n < 2; ++n) _Pragma("unroll") for (int k = 0; k < 2; ++k) frag_set(dst[n], k, *(const LAS i32x4*)(lds + PG8_SB(b, h) + boff + n * 2048 + k * 1024)); } while (0)
#define PG8_MMA(ai, bj, At, Bt) do { __builtin_amdgcn_s_setprio(1); _Pragma("unroll") for (int m = 0; m < 4; ++m) _Pragma("unroll") for (int n = 0; n < 2; ++n) { \
        acc[ai][bj][m][n] = mma1(Bt[n], At[m], acc[ai][bj][m][n], SW, SX); } \
        __builtin_amdgcn_s_setprio(0); } while (0)
#define PG8_WAIT_V(n) asm volatile("s_waitcnt vmcnt(" #n ")" ::: "memory")
#define PG8_WAIT_L(n) asm volatile("s_waitcnt lgkmcnt(" #n ")" ::: "memory")
#define PG8_BAR __builtin_amdgcn_s_barrier()
#define PG8_SCHED __builtin_amdgcn_sched_barrier(0)
#define PG8_OFFS(dst, u) do { _Pragma("unroll") for (int _h = 0; _h < 2; ++_h) _Pragma("unroll") for (int _i = 0; _i < 2; ++_i) { \
        const int _r = sR[_i] + _h * HALF; const int _row = GATHER ? S.arow(u, _r) : _r; dst[_h][_i] = (unsigned)(_row * lda + sC[_i] * 2); } } while (0)
    Unit cur, nxt; int ui = 0;
    if (!S.next(0, cur)) return;
    f32x4 acc[2][2][4][2];
#pragma unroll
    for (int a = 0; a < 2; ++a)
#pragma unroll
        for (int b = 0; b < 2; ++b)
#pragma unroll
            for (int m = 0; m < 4; ++m)
#pragma unroll
                for (int n = 0; n < 2; ++n) acc[a][b][m][n] = (f32x4){0.f, 0.f, 0.f, 0.f};
    typedef typename FragT<FP8>::type frag_t;
    frag_t At[4], B0[2], B1[2];
    const char* cA; const char* cB; S.ptrs(cur, cA, cB); cA = uniform_ptr(cA); cB = uniform_ptr(cB);
    asm volatile("s_nop 4" ::: "memory");
    unsigned offC[2][2], offN[2][2];
    PG8_OFFS(offC, cur);
    PG8_STAGE_B(PG8_SB(0, 0), cB); PG8_STAGE_B(PG8_SB(0, 1), cB + hstepB); PG8_STAGE_A(PG8_SA(0, 0), cA, offC[0]); PG8_STAGE_A(PG8_SA(0, 1), cA, offC[1]);
    if (wr == 1) PG8_BAR;
    PG8_WAIT_V(2); PG8_BAR;
    PG8_STAGE_B(PG8_SB(1, 0), cB + kstep); PG8_STAGE_A(PG8_SA(1, 0), cA + kstep, offC[0]); PG8_STAGE_B(PG8_SB(1, 1), cB + hstepB + kstep);
    PG8_WAIT_V(6); PG8_BAR;
    for (;;) {
        const bool has_next = S.next(ui + 1, nxt);
        const char* nA = cA; const char* nB = cB;
        if (has_next) { S.ptrs(nxt, nA, nB); nA = uniform_ptr(nA); nB = uniform_ptr(nB); asm volatile("s_nop 4" ::: "memory"); PG8_OFFS(offN, nxt); }
        else {
#pragma unroll
            for (int h = 0; h < 2; ++h)
#pragma unroll
                for (int i = 0; i < 2; ++i) offN[h][i] = offC[h][i];
        }
#pragma unroll 1
        for (int tsec = 0; tsec < nt; tsec += (Epi::MID ? 4 : nt)) {
        if constexpr (Epi::MID) { if (tsec != 0) { unsigned z_ = 0u; asm volatile("" : "+v"(z_)); const int l2_ = (int)__builtin_amdgcn_mbcnt_hi(~0u, __builtin_amdgcn_mbcnt_lo(~0u, z_)); E.mid(acc, cur, tsec >> 2, wr, wc, l2_ & 15, l2_ >> 4); } }
#pragma unroll 1
        for (int t = tsec; t < tsec + (Epi::MID ? 4 : nt); t += 2) {
            const bool last = (t == nt - 2);
            const char* a1 = cA + (size_t)(t + 1) * kstep;
            const char* a2 = last ? nA : cA + (size_t)(t + 2) * kstep; const char* b2 = last ? nB : cB + (size_t)(t + 2) * kstep;
            const char* a3 = a2 + kstep; const char* b3 = b2 + kstep;
            unsigned o2[2][2];
#pragma unroll
            for (int h = 0; h < 2; ++h)
#pragma unroll
                for (int i = 0; i < 2; ++i) o2[h][i] = last ? offN[h][i] : offC[h][i];
            PG8_LDB(B0, 0, 0); PG8_LDB(B1, 0, 1); PG8_SCHED; PG8_LDA(At, 0, 0); PG8_STAGE_A(PG8_SA(1, 1), a1, offC[1]);
            PG8_WAIT_V(8); PG8_WAIT_L(0); PG8_BAR; PG8_MMA(0, 0, At, B0); PG8_MMA(0, 1, At, B1); PG8_BAR; PG8_SCHED;
            PG8_LDA(At, 0, 1); PG8_STAGE_B(PG8_SB(0, 0), b2); PG8_STAGE_B(PG8_SB(0, 1), b2 + hstepB); PG8_STAGE_A(PG8_SA(0, 0), a2, o2[0]);
            PG8_WAIT_V(8); PG8_WAIT_L(0); PG8_BAR; PG8_MMA(1, 0, At, B0); PG8_MMA(1, 1, At, B1); PG8_BAR; PG8_SCHED;
            PG8_LDB(B0, 1, 0); PG8_LDB(B1, 1, 1); PG8_SCHED; PG8_LDA(At, 1, 0); PG8_STAGE_A(PG8_SA(0, 1), a2, o2[1]);
            PG8_WAIT_V(8); PG8_WAIT_L(0); PG8_BAR; PG8_MMA(0, 0, At, B0); PG8_MMA(0, 1, At, B1); PG8_BAR; PG8_SCHED;
            PG8_LDA(At, 1, 1); PG8_STAGE_B(PG8_SB(1, 0), b3); PG8_STAGE_B(PG8_SB(1, 1), b3 + hstepB); PG8_STAGE_A(PG8_SA(1, 0), a3, o2[0]);
            PG8_WAIT_V(8); PG8_WAIT_L(0); PG8_BAR; PG8_MMA(1, 0, At, B0); PG8_MMA(1, 1, At, B1); PG8_BAR; PG8_SCHED;
        }
        }
        if (wr == 0) PG8_BAR;
        if constexpr (FP8) asm volatile("s_nop 15\n\ts_nop 7" ::: "memory");
        { unsigned z_ = 0u; asm volatile("" : "+v"(z_)); const int l2_ = (int)__builtin_amdgcn_mbcnt_hi(~0u, __builtin_amdgcn_mbcnt_lo(~0u, z_)); E(acc, cur, wr, wc, l2_ & 15, l2_ >> 4); }
        if (!has_next) break;
        if (S.fresh(nxt)) {
#pragma unroll
            for (int a = 0; a < 2; ++a)
#pragma unroll
                for (int b = 0; b < 2; ++b)
#pragma unroll
                    for (int m = 0; m < 4; ++m)
#pragma unroll
                        for (int n = 0; n < 2; ++n) acc[a][b][m][n] = (f32x4){0.f, 0.f, 0.f, 0.f};
        }
        cur = nxt; cA = nA; cB = nB; ++ui;
#pragma unroll
        for (int h = 0; h < 2; ++h)
#pragma unroll
            for (int i = 0; i < 2; ++i) offC[h][i] = offN[h][i];
        if (wr == 1) PG8_BAR;
    }
    PG8_WAIT_V(0);
    PG8_BAR;
#undef PG8_SA
#undef PG8_SB
#undef PG8_STAGE_A
#undef PG8_STAGE_B
#undef PG8_LDA
#undef PG8_LDB
#undef PG8_MMA
#undef PG8_WAIT_V
#undef PG8_WAIT_L
#undef PG8_BAR
#undef PG8_SCHED
#undef PG8_OFFS
}
}

struct Args { const float* in[26]; float* out; unsigned char* ws; int ph_lo, ph_hi; };
typedef const __attribute__((address_space(4))) Args* KArgs;
enum { I_X = 0, I_C, I_CTX, I_CCTX, I_WADA, I_BADA, I_N1G, I_N2G, I_WIN, I_WGATE, I_WBR, I_WOUT, I_DECAY, I_QNG, I_WUQ, I_KVNG, I_WUKV, I_GQN, I_GKN, I_SINK, I_WR, I_BR, I_W1, I_W3, I_W2, I_FNG };
constexpr int NWAVES = 8, NTHREADS = 512;

struct CvtDesc { const float* src; const float* kscale; bf16_t* dst; int N, k0, n0, Kd, nvalid, rmap, fp8; };
__device__ __forceinline__ void cvt_load(const CvtDesc& d, int lane, f32x4 (&v)[16]) {
    const int kk = lane >> 4, n4 = lane & 15, ncol = d.n0 + 4 * n4;
#pragma unroll
    for (int j = 0; j < 16; ++j) {
        const int k = d.k0 + 16 * kk + j;
        v[j] = (4 * n4 < d.nvalid) ? __builtin_nontemporal_load((const GAS f32x4*)(d.src + (size_t)k * d.N + ncol)) : (f32x4){0.f, 0.f, 0.f, 0.f};
    }
}
__device__ __forceinline__ void cvt_store(const CvtDesc& d, f32x4 (&v)[16], LAS unsigned char* scr, int lane) {
    const int kk = lane >> 4, n4 = lane & 15;
    if (d.kscale) {
#pragma unroll
        for (int j = 0; j < 16; ++j) v[j] = v[j] * d.kscale[d.k0 + 16 * kk + j];
    }
    if (d.fp8) {
#pragma unroll
        for (int i = 0; i < 4; ++i) { u32x4 w;
            w.x = pk4_fp8(32.f * v[0][i], 32.f * v[1][i], 32.f * v[2][i], 32.f * v[3][i]); w.y = pk4_fp8(32.f * v[4][i], 32.f * v[5][i], 32.f * v[6][i], 32.f * v[7][i]);
            w.z = pk4_fp8(32.f * v[8][i], 32.f * v[9][i], 32.f * v[10][i], 32.f * v[11][i]); w.w = pk4_fp8(32.f * v[12][i], 32.f * v[13][i], 32.f * v[14][i], 32.f * v[15][i]);
            *(LAS u32x4*)(scr + (4 * n4 + i) * 80 + 16 * kk) = w; }
        LDS_WAIT(); asm volatile("" ::: "memory");
        const int c = lane & 3;
#pragma unroll
        for (int jj = 0; jj < 4; ++jj) {
            const int n = (lane >> 2) + 16 * jj;
            const u32x4 o = *(const LAS u32x4*)(scr + n * 80 + 16 * c);
            const int prow = d.rmap == 0 ? n : (d.rmap == 1 ? (n & 31) + 128 * (n >> 5) : 32 * (n >> 4) + 8 * ((n >> 2) & 3) + (n & 3));
            *(GAS u32x4*)((unsigned char*)d.dst + (size_t)prow * d.Kd + d.k0 + 16 * c) = o;
        }
        LDS_WAIT(); asm volatile("" ::: "memory");
        return;
    }
#pragma unroll
    for (int i = 0; i < 4; ++i) { u32x4 w0, w1;
        w0.x = pk2(v[0][i], v[1][i]); w0.y = pk2(v[2][i], v[3][i]); w0.z = pk2(v[4][i], v[5][i]); w0.w = pk2(v[6][i], v[7][i]);
        w1.x = pk2(v[8][i], v[9][i]); w1.y = pk2(v[10][i], v[11][i]); w1.z = pk2(v[12][i], v[13][i]); w1.w = pk2(v[14][i], v[15][i]);
        *(LAS u32x4*)(scr + (4 * n4 + i) * 144 + 32 * kk) = w0; *(LAS u32x4*)(scr + (4 * n4 + i) * 144 + 32 * kk + 16) = w1; }
    LDS_WAIT(); asm volatile("" ::: "memory");
    const int c = lane & 7;
#pragma unroll
    for (int jj = 0; jj < 8; ++jj) {
        const int n = (lane >> 3) + 8 * jj;
        const u32x4 o = *(const LAS u32x4*)(scr + n * 144 + 16 * c);
        const int prow = d.rmap == 0 ? n : (d.rmap == 1 ? (n & 31) + 128 * (n >> 5) : 32 * (n >> 4) + 8 * ((n >> 2) & 3) + (n & 3));
        *(GAS u32x4*)(d.dst + (size_t)prow * d.Kd + d.k0 + 8 * c) = o;
    }
    LDS_WAIT(); asm volatile("" ::: "memory");
}
constexpr int CV_EXP_ITEMS = 2 * 32 * 3 * 256;
constexpr int CV_IN = 16 * 40, CV_GT = 16 * 64, CV_BRN = 4 * 16, CV_OUT = 16 * 16, CV_UQ = 4 * 6, CV_UKV = 2 * 8;
constexpr int CV_PER_L = CV_IN + CV_GT + 4 * CV_BRN + CV_OUT + CV_UQ + CV_UKV;
constexpr int CV_NITEMS = CV_EXP_ITEMS + 2 * CV_PER_L;
constexpr int CV_E0_SHARE = 14592;
__device__ __forceinline__ void cvt_decode(KArgs a, unsigned char* ws, int it, CvtDesc& d) {
    d.kscale = nullptr; d.N = 1024; d.Kd = 1024; d.nvalid = 64; d.rmap = 0; d.fp8 = 0;
    if (it < CV_EXP_ITEMS) {
        d.fp8 = 1;
        const int j = it >> 8, r = it & 255, l = j / 96, jj = j % 96, e = jj / 3, kind = jj % 3, kb = r >> 4, nb = r & 15;
        const size_t eo = ((size_t)l * 32 + e) * 1048576;
        d.k0 = kb * 64; d.n0 = nb * 64;
        if (kind < 2) { d.src = (kind == 0 ? a->in[I_W1] : a->in[I_W3]) + eo;
            d.dst = (bf16_t*)(ws + WS_W13 + ((size_t)l * 32 + e) * 2097152 + (size_t)(256 * (nb >> 1) + 128 * kind + 64 * (nb & 1)) * 1024); }
        else { d.src = a->in[I_W2] + eo; d.dst = (bf16_t*)(ws + WS_W2 + eo + (size_t)(nb * 64) * 1024); }
        return;
    }
    int r = it - CV_EXP_ITEMS; const int l = r / CV_PER_L; r -= l * CV_PER_L;
    if (r < CV_IN) {
        const int kb = r / 40, hb = r % 40, t = hb >> 2, wc = hb & 3; int src0 = -1, nv = 64;
        if (t < 5) src0 = 256 * t + 64 * wc;
        else if (t == 5) { if (wc < 2) src0 = 1280 + 64 * wc; else if (wc == 2) { src0 = 1408; nv = 32; } }
        else if (t == 6) src0 = P_GQA + 64 * wc;
        else if (t == 7) src0 = wc < 2 ? P_GQA + 256 + 64 * wc : P_GQA + 384 + 64 * (wc - 2);
        else if (t == 8) src0 = P_WIN + 64 * wc;
        else src0 = wc < 2 ? P_WIN + 256 + 64 * wc : P_WIN + 384 + 64 * (wc - 2);
        d.src = a->in[I_WIN] + (size_t)l * 1024 * NIN; d.N = NIN; d.k0 = kb * 64; d.n0 = src0 < 0 ? 0 : src0; d.nvalid = src0 < 0 ? 0 : nv; d.rmap = 1;
        d.fp8 = 1; d.dst = (bf16_t*)(ws + WS_WIN + ((size_t)l * NBG + 256 * t + 32 * wc) * 1024); return; } r -= CV_IN;
    if (r < CV_GT) {
        const int kb = r >> 6, nb = r & 63, i = nb >> 4, tg = nb & 15;
        d.src = a->in[I_WGATE] + (size_t)l * 1024 * 4096; d.N = 4096; d.k0 = kb * 64; d.n0 = i * 1024 + 64 * tg; d.rmap = 2;
        d.fp8 = 1; d.dst = (bf16_t*)(ws + WS_WIN + ((size_t)l * NBG + NINP + 256 * tg + 128 * (i >> 1) + 4 * (i & 1)) * 1024); return; } r -= CV_GT;
    if (r < 4 * CV_BRN) { const int i = r / CV_BRN, rr = r % CV_BRN, kb = rr >> 4, nb = rr & 15; d.src = a->in[I_WBR] + ((size_t)l * 4 + i) * 256 * 1024; d.k0 = kb * 64; d.n0 = nb * 64;
        d.dst = (bf16_t*)(ws + WS_WBR) + ((size_t)l * 1024 + nb * 64) * 1024 + 256 * i; return; } r -= 4 * CV_BRN;
    if (r < CV_OUT) { const int kb = r >> 4, nb = r & 15; d.src = a->in[I_WOUT] + (size_t)l * 1048576; d.k0 = kb * 64; d.n0 = nb * 64; d.dst = (bf16_t*)(ws + WS_WOUT) + (size_t)l * 1048576 + (size_t)(nb * 64) * 1024; return; } r -= CV_OUT;
    if (r < CV_UQ) { const int kb = r / 6, nb = r % 6; d.src = a->in[I_WUQ] + (size_t)l * 256 * 384; d.N = 384; d.k0 = kb * 64; d.n0 = nb * 64; d.kscale = a->in[I_QNG] + l * 256; d.dst = (bf16_t*)(ws + WS_WSM) + ((size_t)l * 384 + nb * 64) * 256; d.Kd = 256; return; } r -= CV_UQ;
    { const int kb = r >> 3, nb = r & 7; d.src = a->in[I_WUKV] + (size_t)l * 128 * 512; d.N = 512; d.k0 = kb * 64; d.n0 = nb * 64; d.kscale = a->in[I_KVNG] + l * 128; d.dst = (bf16_t*)(ws + WS_WSM) + 2 * 384 * 256 + ((size_t)l * 512 + nb * 64) * 128; d.Kd = 128; }
}

__device__ __forceinline__ void cvt_run(KArgs a, unsigned char* ws, LAS unsigned char* lds, int lane, int wave, int first, int last, int start, int stride) {
    LAS unsigned char* scr = lds + 57344 + wave * 9216;
    int it = first + start;
    if (it < last) {
        CvtDesc dA, dB; f32x4 va[16], vb[16];
        cvt_decode(a, ws, it, dA); cvt_load(dA, lane, va);
        for (;;) {
            const int itB = it + stride; const bool hasB = itB < last;
            if (hasB) { cvt_decode(a, ws, itB, dB); cvt_load(dB, lane, vb); }
            cvt_store(dA, va, scr, lane);
            if (!hasB) break;
            const int itA = itB + stride; const bool hasA = itA < last;
            if (hasA) { cvt_decode(a, ws, itA, dA); cvt_load(dA, lane, va); }
            cvt_store(dB, vb, scr, lane);
            if (!hasA) break;
            it = itA;
        }
    }
}
__device__ __forceinline__ void p0_prologue(KArgs a, LAS unsigned char* lds, int tid, int lane, int wave, int G, int c) {
    unsigned char* ws = a->ws;
    if (c < 192) {
        LAS float* st = (LAS float*)lds;
        LAS float* red = (LAS float*)(lds + 36864);
        for (int idx = tid; idx < 9 * 1024; idx += NTHREADS) { const int r = idx >> 10, k = idx & 1023; const float v = r < 8 ? a->in[I_C][r * 1024 + k] : a->in[I_CCTX][k]; st[idx] = v / (1.f + __expf(-v)); }
        __syncthreads();
        const int l = c / 96, n0 = (c % 96) * 64;
        float acc[9];
#pragma unroll
        for (int r = 0; r < 9; ++r) acc[r] = 0.f;
        const float* wp = a->in[I_WADA] + ((size_t)l * 1024 + wave * 128) * 6144 + n0 + lane;
#pragma unroll 4
        for (int k = 0; k < 128; ++k) { const float wv = wp[(size_t)k * 6144];
#pragma unroll
            for (int r = 0; r < 9; ++r) acc[r] += st[r * 1024 + wave * 128 + k] * wv; }
#pragma unroll
        for (int r = 0; r < 9; ++r) red[(wave * 9 + r) * 64 + lane] = acc[r];
        __syncthreads();
        for (int idx = tid; idx < 9 * 64; idx += NTHREADS) { const int r = idx >> 6, n = idx & 63; float s = 0.f;
#pragma unroll
            for (int w = 0; w < 8; ++w) s += red[(w * 9 + r) * 64 + n];
            ((float*)(ws + WS_ADA))[((size_t)l * 9 + r) * 6144 + n0 + n] = s + a->in[I_BADA][l * 6144 + n0 + n]; }
        __syncthreads();
    }
    const int gw = c * NWAVES + wave, NGW = G * NWAVES;
    {
        float* rope = (float*)(ws + WS_ROPE);
        for (int idx = gw * 64 + lane; idx < 2048 * 48; idx += NGW * 64) {
            const int pos = idx / 48, j = idx % 48, row = pos >> 6, col = pos & 63;
            if (j < 32) { const int i = j, f = i & 15; const float inv = powf(10000.f, -(float)f / 16.f); const float ang = (float)(i < 16 ? row : col) * inv;
                rope[pos * 32 + i] = cosf(ang); rope[2048 * 32 + pos * 32 + i] = sinf(ang); }
            else { const int i = j - 32, f = i & 7; const float inv = powf(10000.f, -(float)f / 8.f); const float ang = (float)(i < 8 ? row : col) * inv;
                rope[2 * 2048 * 32 + pos * 16 + i] = cosf(ang); rope[2 * 2048 * 32 + 2048 * 16 + pos * 16 + i] = sinf(ang); }
        }
        float* wrp = (float*)(ws + WS_WRP);
        for (int idx = gw * 64 + lane; idx < 32768; idx += NGW * 64) { const int half = idx >> 14, w = (idx >> 11) & 7, q = (idx >> 9) & 3, e = (idx >> 5) & 15, s = idx & 31;
            wrp[idx] = a->in[I_WR][(128 * w + 32 * q + s) * 32 + 16 * half + e]; }
    }
    cvt_run(a, ws, lds, lane, wave, 0, CV_EXP_ITEMS / 2, gw, NGW);
    cvt_run(a, ws, lds, lane, wave, CV_EXP_ITEMS, CV_NITEMS, gw, NGW);
}

__device__ __forceinline__ void moe_tables(const unsigned* ctl, int l, LAS unsigned char* lds, int tid) {
    LAS int* tb = (LAS int*)(lds + LDS_MISC + 1024); LAS int* cn = (LAS int*)(lds + LDS_MISC + 2304);
    __syncthreads();
    if (tid < 32) cn[tid] = (int)__hip_atomic_load(ctl + CW_CNT + l * 32 + tid, __ATOMIC_RELAXED, __HIP_MEMORY_SCOPE_AGENT);
    __syncthreads();
    if (tid == 0) { int s = 0; for (int e = 0; e < 32; ++e) { tb[e] = s; s += (cn[e] + 255) >> 8; } tb[32] = s; }
    __syncthreads();
    if (tid < MAXTILES) { LAS int* te = (LAS int*)(lds + LDS_MISC + 1024 + 48 * 4); int e = 0; for (int k = 1; k < 32; ++k) e += (tid >= tb[k]) ? 1 : 0; te[tid] = e | ((tid - tb[e]) << 8); }
    __syncthreads();
}

__device__ __forceinline__ void phase_rownorm(KArgs a, int mode, LAS unsigned char* lds, int lane, int wave, int G, int c) {
    unsigned char* ws = a->ws;
    const int gw = c * NWAVES + wave, NGW = G * NWAVES;
    const float* ada = (const float*)(ws + WS_ADA);
    float* X = (float*)(ws + WS_X);
    const LAS int* tb = (const LAS int*)(lds + LDS_MISC + 1024);
    const int nrows = (mode == 2) ? TL : TT;
    const int lprev = mode - 1, lcur = (mode == 2) ? 0 : mode;
    constexpr int R = 3;
    for (int base = gw; base < nrows; base += R * NGW) {
        f32x4 v[R][4]; int rows[R]; bool ok[R];
#pragma unroll
        for (int r = 0; r < R; ++r) { rows[r] = base + r * NGW; ok[r] = rows[r] < nrows; if (!ok[r]) rows[r] = base; }
#pragma unroll
        for (int r = 0; r < R; ++r) {
            const int row = rows[r];
            const float* src = (mode == 0) ? (row < TL ? a->in[I_X] + (size_t)row * 1024 : a->in[I_CTX] + (size_t)(row - TL) * 1024) : X + (size_t)row * 1024;
#pragma unroll
            for (int j = 0; j < 4; ++j) v[r][j] = *(const GAS f32x4*)(src + 4 * lane + 256 * j);
        }
        if (mode != 0) {
            const int* te = (const int*)(ws + WS_TOKE); const float* tw = (const float*)(ws + WS_TOKW);
            const bf16_t* Y2 = (const bf16_t*)(ws + WS_Y2);
            u32x2 y0[R][4], y1[R][4]; float w0[R], w1[R];
#pragma unroll
            for (int r = 0; r < R; ++r) {
                const int row = rows[r];
                const int e0 = te[row * 2], e1 = te[row * 2 + 1]; w0[r] = tw[row * 2]; w1[r] = tw[row * 2 + 1];
                const size_t s0 = (size_t)(tb[e0 >> 20] * 256 + (e0 & 0xfffff)), s1 = (size_t)(tb[e1 >> 20] * 256 + (e1 & 0xfffff));
#pragma unroll
                for (int j = 0; j < 4; ++j) { y0[r][j] = *(const GAS u32x2*)(Y2 + s0 * 1024 + 4 * lane + 256 * j); y1[r][j] = *(const GAS u32x2*)(Y2 + s1 * 1024 + 4 * lane + 256 * j); }
            }
#pragma unroll
            for (int r = 0; r < R; ++r) {
                const int row = rows[r]; const int b = row < TL ? (row >> 11) : 8;
                const float* g2 = ada + ((size_t)lprev * 9 + b) * 6144 + 5120;
#pragma unroll
                for (int j = 0; j < 4; ++j) {
                    const f32x4 gg = *(const GAS f32x4*)(g2 + 4 * lane + 256 * j);
                    f32x4 f; f.x = w0[r] * bflo(y0[r][j].x) + w1[r] * bflo(y1[r][j].x); f.y = w0[r] * bfhi(y0[r][j].x) + w1[r] * bfhi(y1[r][j].x);
                    f.z = w0[r] * bflo(y0[r][j].y) + w1[r] * bflo(y1[r][j].y); f.w = w0[r] * bfhi(y0[r][j].y) + w1[r] * bfhi(y1[r][j].y);
                    v[r][j] = v[r][j] + gg * f;
                }
                if (mode == 1 && ok[r]) {
#pragma unroll
                    for (int j = 0; j < 4; ++j) *(GAS f32x4*)(X + (size_t)row * 1024 + 4 * lane + 256 * j) = v[r][j];
                }
            }
        }
#pragma unroll
        for (int r = 0; r < R; ++r) {
            const int row = rows[r]; const int b = row < TL ? (row >> 11) : 8;
            float ss = 0.f;
#pragma unroll
            for (int j = 0; j < 4; ++j) ss += (v[r][j].x * v[r][j].x + v[r][j].y * v[r][j].y) + (v[r][j].z * v[r][j].z + v[r][j].w * v[r][j].w);
            const float rstd = 1.0f / sqrtf(wave_sum(ss) * (1.f / 1024.f) + EPS);
            if (ok[r]) {
                if (mode == 2) {
#pragma unroll
                    for (int j = 0; j < 4; ++j) { const f32x4 g = *(const GAS f32x4*)(a->in[I_FNG] + 4 * lane + 256 * j); *(GAS f32x4*)(a->out + (size_t)row * 1024 + 4 * lane + 256 * j) = v[r][j] * rstd * g; }
                } else {
                    const float* gn = a->in[I_N1G] + lcur * 1024; const float* sh = ada + ((size_t)lcur * 9 + b) * 6144; const float* sc = sh + 1024;
                    unsigned char* H = (unsigned char*)(ws + WS_H) + (size_t)row * 1024;
#pragma unroll
                    for (int j = 0; j < 4; ++j) { const int cc = 4 * lane + 256 * j; const f32x4 g = *(const GAS f32x4*)(gn + cc), s1 = *(const GAS f32x4*)(sc + cc), s0 = *(const GAS f32x4*)(sh + cc);
                        const f32x4 h = v[r][j] * rstd * g * (s1 + 1.0f) + s0; *(GAS unsigned*)(H + cc) = pk4_fp8(h.x, h.y, h.z, h.w); }
                }
            }
        }
    }
}

using pg8::Unit;
struct SchedB {
    int layer, G, c; const char* H; const char* W;
    __device__ __forceinline__ bool next(int i, Unit& u) const {
        const int L = i * G + c; u.aux = 0;
        if (layer == 0) { if (L >= 72 * 26) return false; pg8::tile_order(L, 72, 26, u.pm, u.pn); return true; }
        if (L < 64 * 16) { pg8::tile_order(L, 64, 16, u.pm, u.pn); u.pn += 10; return true; }
        const int L2 = L - 64 * 16; if (L2 >= 72 * 10) return false; pg8::tile_order(L2, 72, 10, u.pm, u.pn); return true;
    }
    __device__ __forceinline__ void ptrs(const Unit& u, const char*& A, const char*& B) const { A = H + (size_t)u.pm * 256 * 1024; B = W + (size_t)u.pn * 256 * 1024; }
    __device__ __forceinline__ int arow(const Unit&, int r) const { return r; }
    __device__ __forceinline__ bool fresh(const Unit&) const { return true; }
};
struct EpiB {
    static constexpr bool PERM = true, MID = false;
    bf16_t* P; bf16_t* Gt; bf16_t* Q; const float* cos64; const float* sin64; const float* qng; const float* kng;
    __device__ __forceinline__ void operator()(f32x4 (&acc)[2][2][4][2], const Unit& u, int wr, int wc, int fr, int fq) const {
        const int row0 = u.pm * 256 + wr * 64 + fr;
        if (u.pn >= 10) {
            const int d0 = (u.pn - 10) * 64 + 16 * wc + 4 * fq;
#pragma unroll
            for (int ai = 0; ai < 2; ++ai)
#pragma unroll
                for (int m = 0; m < 4; ++m) { bf16_t* gp = Gt + (size_t)(row0 + ai * 128 + m * 16) * NGATE + d0;
                    f32x4 g[4];
#pragma unroll
                    for (int i = 0; i < 4; ++i)
#pragma unroll
                        for (int j = 0; j < 4; ++j) g[i][j] = fmaxf(sigmoidf_(acc[ai][i >> 1][m][i & 1][j]), 1e-6f);
#pragma unroll
                    for (int i = 0; i < 4; ++i) { f32x4 r = g[i];
                        if (i < 3) {
#pragma unroll
                            for (int j = 0; j < 4; ++j) r[j] *= fast_rcp(g[i + 1][j]); }
                        u32x2 w; w.x = pk2(r[0], r[1]); w.y = pk2(r[2], r[3]); *(GAS u32x2*)(gp + i * 1024) = w; } }
            return;
        }
        const int t = u.pn;
        bf16_t* dst; size_t ld; int col; int mode = 0;
        float scale = 1.f; const float* gain = nullptr;
        if (t == 4) { dst = P; ld = NINP; col = P_MLA + 64 * wc; }
        else if (t == 5) { dst = P; ld = NINP; col = 1280 + 64 * wc; mode = wc < 3 ? 0 : 3; }
        else { dst = Q; ld = QP;
            if (t == 0) { col = Q_RETQ + 64 * wc; mode = 1; scale = 0.125f; }
            else if (t == 1) { col = Q_RETK + 64 * wc; mode = 1; }
            else if (t == 2) col = Q_RETV + 64 * wc;
            else if (t == 3) col = Q_RETG + 64 * wc;
            else if (t == 6) { col = Q_GQAQ + 64 * wc; mode = 2; scale = 0.125f * LOG2E; gain = qng; }
            else if (t == 7) { if (wc < 2) { col = Q_GQAK + 64 * wc; mode = 2; gain = kng; } else col = Q_GQAV + 64 * (wc - 2); }
            else if (t == 8) { col = Q_WINQ + 64 * wc; mode = 1; scale = 0.125f * LOG2E; }
            else { if (wc < 2) { col = Q_WINK + 64 * wc; mode = 1; } else col = Q_WINV + 64 * (wc - 2); } }
        if (mode == 3) return;
        f32x4 ga0 = {1.f, 1.f, 1.f, 1.f}, ga1 = ga0, gb0 = ga0, gb1 = ga0;
        if (mode == 2) { ga0 = *(const GAS f32x4*)(gain + 8 * fq); ga1 = *(const GAS f32x4*)(gain + 8 * fq + 4); gb0 = *(const GAS f32x4*)(gain + 32 + 8 * fq); gb1 = *(const GAS f32x4*)(gain + 32 + 8 * fq + 4); }
        const bool half_only = (t == 5 && wc == 2);
#pragma unroll
        for (int ai = 0; ai < 2; ++ai)
#pragma unroll
            for (int m = 0; m < 4; ++m) {
                const int row = row0 + ai * 128 + m * 16;
                f32x4 a0 = acc[ai][0][m][0], a1 = acc[ai][0][m][1], b0 = acc[ai][1][m][0], b1 = acc[ai][1][m][1];
                if (mode == 2) {
                    float ss = 0.f;
#pragma unroll
                    for (int j = 0; j < 4; ++j) ss += a0[j] * a0[j] + a1[j] * a1[j] + b0[j] * b0[j] + b1[j] * b1[j];
                    ss = xadd<16>(ss); ss = xadd<32>(ss);
                    const float rstd = __builtin_amdgcn_rsqf(ss * (1.f / 64.f) + EPS);
                    a0 = a0 * rstd * ga0; a1 = a1 * rstd * ga1; b0 = b0 * rstd * gb0; b1 = b1 * rstd * gb1;
                }
                if (mode >= 1) {
                    if (row < TL) { const int pos = row & 2047;
                        const f32x4 c0 = *(const GAS f32x4*)(cos64 + pos * 32 + 8 * fq), c1 = *(const GAS f32x4*)(cos64 + pos * 32 + 8 * fq + 4);
                        const f32x4 s0 = *(const GAS f32x4*)(sin64 + pos * 32 + 8 * fq), s1 = *(const GAS f32x4*)(sin64 + pos * 32 + 8 * fq + 4);
                        const f32x4 o0 = a0 * c0 - b0 * s0, o1 = a1 * c1 - b1 * s1, p0 = b0 * c0 + a0 * s0, p1 = b1 * c1 + a1 * s1;
                        a0 = o0; a1 = o1; b0 = p0; b1 = p1; }
                    a0 = a0 * scale; a1 = a1 * scale; b0 = b0 * scale; b1 = b1 * scale;
                }
                bf16_t* rp = dst + (size_t)row * ld + col + 8 * fq;
                u32x4 w; w.x = pk2(a0[0], a0[1]); w.y = pk2(a0[2], a0[3]); w.z = pk2(a1[0], a1[1]); w.w = pk2(a1[2], a1[3]);
                *(GAS u32x4*)rp = w;
                if (!half_only) { u32x4 w2; w2.x = pk2(b0[0], b0[1]); w2.y = pk2(b0[2], b0[3]); w2.z = pk2(b1[0], b1[1]); w2.w = pk2(b1[2], b1[3]); *(GAS u32x4*)(rp + 32) = w2; }
                asm volatile("" ::: "memory");
            }
    }
};
struct SchedE {
    int G, c, nM; const char* Y; const char* W;
    __device__ __forceinline__ bool next(int i, Unit& u) const { const int L = i * G + c; u.aux = 0; if (L >= nM * 4) return false; pg8::tile_order(L, nM, 4, u.pm, u.pn); return true; }
    __device__ __forceinline__ void ptrs(const Unit& u, const char*& A, const char*& B) const { A = Y + (size_t)u.pm * 256 * 1024 * 2; B = W + (size_t)u.pn * 256 * 1024 * 2; }
    __device__ __forceinline__ int arow(const Unit&, int r) const { return r; }
    __device__ __forceinline__ bool fresh(const Unit&) const { return true; }
};
struct EpiE {
    static constexpr bool PERM = true, MID = true;
    const bf16_t* Gt; bf16_t* M;
    __device__ __forceinline__ void mid(f32x4 (&acc)[2][2][4][2], const Unit& u, int i, int wr, int wc, int fr, int fq) const {
        const int row0 = u.pm * 256 + wr * 64 + fr;
        const int col0 = u.pn * 256 + wc * 32 + 8 * fq;
#pragma unroll
        for (int ai = 0; ai < 2; ++ai)
#pragma unroll
            for (int m = 0; m < 4; ++m) { const bf16_t* gp = Gt + (size_t)(row0 + ai * 128 + m * 16) * NGATE + (i - 1) * 1024 + col0;
#pragma unroll
                for (int bj = 0; bj < 2; ++bj) {
                    const u32x4 g = *(const GAS u32x4*)(gp + bj * 128);
                    const f32x4 s0 = {bflo(g.x), bfhi(g.x), bflo(g.y), bfhi(g.y)}, s1 = {bflo(g.z), bfhi(g.z), bflo(g.w), bfhi(g.w)};
                    acc[ai][bj][m][0] = acc[ai][bj][m][0] * s0; acc[ai][bj][m][1] = acc[ai][bj][m][1] * s1;
                    asm volatile("" ::: "memory");
                } }
    }
    __device__ __forceinline__ void operator()(f32x4 (&acc)[2][2][4][2], const Unit& u, int wr, int wc, int fr, int fq) const {
        const int row0 = u.pm * 256 + wr * 64 + fr, col0 = u.pn * 256 + wc * 32 + 8 * fq;
#pragma unroll
        for (int ai = 0; ai < 2; ++ai)
#pragma unroll
            for (int m = 0; m < 4; ++m) { const size_t row = (size_t)(row0 + ai * 128 + m * 16);
#pragma unroll
                for (int bj = 0; bj < 2; ++bj) {
                    const u32x4 g = *(const GAS u32x4*)(Gt + row * NGATE + 3 * 1024 + col0 + bj * 128);
                    const f32x4 s0 = {bflo(g.x), bfhi(g.x), bflo(g.y), bfhi(g.y)}, s1 = {bflo(g.z), bfhi(g.z), bflo(g.w), bfhi(g.w)};
                    const f32x4 v0 = acc[ai][bj][m][0] * s0, v1 = acc[ai][bj][m][1] * s1;
                    u32x4 w; w.x = pk2(v0[0], v0[1]); w.y = pk2(v0[2], v0[3]); w.z = pk2(v1[0], v1[1]); w.w = pk2(v1[2], v1[3]);
                    *(GAS u32x4*)(M + row * 1024 + col0 + bj * 128) = w;
                } }
    }
};
struct SchedF {
    int G, c, nM; const char* A0; const char* W;
    __device__ __forceinline__ bool next(int i, Unit& u) const { const int L = i * G + c; u.aux = 0; if (L >= nM * 4) return false; pg8::tile_order(L, nM, 4, u.pm, u.pn); return true; }
    __device__ __forceinline__ void ptrs(const Unit& u, const char*& A, const char*& B) const { A = A0 + (size_t)u.pm * 256 * 1024 * 2; B = W + (size_t)u.pn * 256 * 1024 * 2; }
    __device__ __forceinline__ int arow(const Unit&, int r) const { return r; }
    __device__ __forceinline__ bool fresh(const Unit&) const { return true; }
};
struct EpiF {
    static constexpr bool PERM = false, MID = false;
    const float* xin; const float* cin; const float* Xs; float* X; const float* ada_l; int layer;
    __device__ __forceinline__ void operator()(f32x4 (&acc)[2][2][4][2], const Unit& u, int wr, int wc, int fr, int fq) const {
        const int row0 = u.pm * 256 + wr * 64 + fr, col0 = u.pn * 256 + wc * 32 + 4 * fq;
#pragma unroll
        for (int ai = 0; ai < 2; ++ai)
#pragma unroll
            for (int m = 0; m < 4; ++m) { const int row = row0 + ai * 128 + m * 16; const int b = row < TL ? (row >> 11) : 8;
                const float* src = (layer == 0) ? (row < TL ? xin + (size_t)row * 1024 : cin + (size_t)(row - TL) * 1024) : Xs + (size_t)row * 1024;
                const float* g1 = ada_l + (size_t)b * 6144 + 2048;
#pragma unroll
                for (int bj = 0; bj < 2; ++bj)
#pragma unroll
                    for (int n = 0; n < 2; ++n) { const int c = col0 + bj * 128 + n * 16;
                        const f32x4 xs = *(const GAS f32x4*)(src + c), gg = *(const GAS f32x4*)(g1 + c);
                        *(GAS f32x4*)(X + (size_t)row * 1024 + c) = xs + gg * acc[ai][bj][m][n]; } }
    }
};
struct SchedMoe {
    int G, c, npn, gather; const LAS int* tb; const LAS int* cn; const int* tokinv; const char* A0; const char* W; size_t wstride;
    __device__ __forceinline__ bool next(int i, Unit& u) const {
        const int L = i * G + c; if (L >= __builtin_amdgcn_readfirstlane(tb[32]) * npn) return false;
        const int rt = L / npn; u.pm = rt; u.pn = L - rt * npn; u.aux = __builtin_amdgcn_readfirstlane(tb[48 + rt]); return true;
    }
    __device__ __forceinline__ void ptrs(const Unit& u, const char*& A, const char*& B) const {
        A = gather ? A0 : A0 + (size_t)u.pm * 256 * 1024; B = W + (size_t)(u.aux & 255) * wstride + (size_t)u.pn * 256 * 1024; }
    __device__ __forceinline__ int arow(const Unit& u, int r) const { const int e = u.aux & 255, idx = (u.aux >> 8) * 256 + r; return idx < cn[e] ? tokinv[(size_t)e * TT + idx] : 0; }
    __device__ __forceinline__ bool fresh(const Unit&) const { return true; }
};
struct EpiH {
    static constexpr bool PERM = true, MID = false;
    unsigned char* HID;
    __device__ __forceinline__ void operator()(f32x4 (&acc)[2][2][4][2], const Unit& u, int wr, int wc, int fr, int fq) const {
        const int row0 = u.pm * 256 + wr * 64 + fr, col0 = u.pn * 128 + wc * 32 + 8 * fq;
#pragma unroll
        for (int ai = 0; ai < 2; ++ai)
#pragma unroll
            for (int m = 0; m < 4; ++m) { f32x4 h0, h1;
#pragma unroll
                for (int j = 0; j < 4; ++j) { const float a0 = acc[ai][0][m][0][j], a1 = acc[ai][0][m][1][j];
                    h0[j] = a0 * sigmoidf_(a0) * acc[ai][1][m][0][j]; h1[j] = a1 * sigmoidf_(a1) * acc[ai][1][m][1][j]; }
                u32x2 w; w.x = pk4_fp8(4.f * h0[0], 4.f * h0[1], 4.f * h0[2], 4.f * h0[3]); w.y = pk4_fp8(4.f * h1[0], 4.f * h1[1], 4.f * h1[2], 4.f * h1[3]);
                *(GAS u32x2*)(HID + (size_t)(row0 + ai * 128 + m * 16) * 1024 + col0) = w; }
    }
};
struct EpiI {
    static constexpr bool PERM = true, MID = false;
    bf16_t* Y2;
    __device__ __forceinline__ void operator()(f32x4 (&acc)[2][2][4][2], const Unit& u, int wr, int wc, int fr, int fq) const {
        const int row0 = u.pm * 256 + wr * 64 + fr, col0 = u.pn * 256 + wc * 32 + 8 * fq;
#pragma unroll
        for (int ai = 0; ai < 2; ++ai)
#pragma unroll
            for (int m = 0; m < 4; ++m)
#pragma unroll
                for (int bj = 0; bj < 2; ++bj) { const f32x4 v0 = acc[ai][bj][m][0], v1 = acc[ai][bj][m][1];
                    u32x4 w; w.x = pk2(v0[0], v0[1]); w.y = pk2(v0[2], v0[3]); w.z = pk2(v1[0], v1[1]); w.w = pk2(v1[2], v1[3]);
                    *(GAS u32x4*)(Y2 + (size_t)(row0 + ai * 128 + m * 16) * 1024 + col0 + bj * 128) = w; }
    }
};

__device__ __forceinline__ void rope_item_desc(int item, int& src, int& dst, float& scale, int& normsel) {
    normsel = 0; scale = 1.f;
    if (item < 4) { src = P_RET + item * 64; dst = Q_RETQ + item * 64; scale = 0.125f; }
    else if (item < 8) { src = P_RET + 256 + (item - 4) * 64; dst = Q_RETK + (item - 4) * 64; }
    else if (item < 12) { src = P_GQA + (item - 8) * 64; dst = Q_GQAQ + (item - 8) * 64; scale = 0.125f * LOG2E; normsel = 1; }
    else if (item < 14) { src = P_GQA + 256 + (item - 12) * 64; dst = Q_GQAK + (item - 12) * 64; normsel = 2; }
    else if (item < 16) { src = P_WIN + 256 + (item - 14) * 64; dst = Q_WINK + (item - 14) * 64; }
    else { src = P_WIN + (item - 16) * 64; dst = Q_WINQ + (item - 16) * 64; scale = 0.125f * LOG2E; }
}
__device__ __forceinline__ void phase_post(KArgs a, int l, LAS unsigned char* lds, int lane, int wave, int G, int c) {
    unsigned char* ws = a->ws;
    const bf16_t* P = (const bf16_t*)(ws + WS_P); bf16_t* Q = (bf16_t*)(ws + WS_QKV);
    const float* cos32 = (const float*)(ws + WS_ROPE) + 2 * 2048 * 32; const float* sin32 = cos32 + 2048 * 16;
    const bf16_t* Wuq = (const bf16_t*)(ws + WS_WSM) + (size_t)l * 384 * 256; const bf16_t* Wukv = (const bf16_t*)(ws + WS_WSM) + 2 * 384 * 256 + (size_t)l * 512 * 128;
    const float qscale = 0.10206207261596577f * LOG2E;
    const unsigned ldsb = (unsigned)(uintptr_t)lds;
    constexpr int LQ = 0, LKV = 49152;
    for (int u = c; u < (TT / 128) * 4; u += G) {
        const int h = u & 3, rb = u >> 2;
        for (int p = wave; p < 80; p += NWAVES) {
            if (p < 48) { const int row = 2 * p + (lane >> 5), ch = (lane & 31) ^ (row & 7);
                glds16(Wuq + (size_t)(96 * h + row) * 256 + 8 * ch, (unsigned)__builtin_amdgcn_readfirstlane((int)(ldsb + LQ + p * 1024))); }
            else { const int p2 = p - 48, row = 4 * p2 + (lane >> 4), ch = (lane & 15) ^ (row & 7);
                glds16(Wukv + (size_t)(128 * h + row) * 128 + 8 * ch, (unsigned)__builtin_amdgcn_readfirstlane((int)(ldsb + LKV + p2 * 1024))); }
        }
        const int tk = lane & 15, kq = lane >> 4, row = rb * 128 + wave * 16 + tk; const bool islat = row < TL; const int pos = row & 2047;
        const bf16_t* prow = P + (size_t)row * NINP + P_MLA; bf16_t* qrow = Q + (size_t)row * QP;
        bf16x8 zq[8], zkv[4]; float sq = 0.f, skv = 0.f;
#pragma unroll
        for (int s2 = 0; s2 < 8; ++s2) zq[s2] = *(const GAS bf16x8*)(prow + 32 * s2 + 8 * kq);
#pragma unroll
        for (int s2 = 0; s2 < 4; ++s2) zkv[s2] = *(const GAS bf16x8*)(prow + 256 + 32 * s2 + 8 * kq);
        const u32x2 kr1 = *(const GAS u32x2*)(prow + 384 + 4 * kq), kr2 = *(const GAS u32x2*)(prow + 400 + 4 * kq);
#pragma unroll
        for (int s2 = 0; s2 < 8; ++s2)
#pragma unroll
            for (int j = 0; j < 8; ++j) { const float f = bf2f((unsigned short)zq[s2][j]); sq += f * f; }
#pragma unroll
        for (int s2 = 0; s2 < 4; ++s2)
#pragma unroll
            for (int j = 0; j < 8; ++j) { const float f = bf2f((unsigned short)zkv[s2][j]); skv += f * f; }
        sq = xadd<16>(sq); sq = xadd<32>(sq); skv = xadd<16>(skv); skv = xadd<32>(skv);
        const float rq = (1.0f / sqrtf(sq * (1.f / 256.f) + EPS)) * qscale, rkv = 1.0f / sqrtf(skv * (1.f / 128.f) + EPS);
        f32x4 cr = {1.f, 1.f, 1.f, 1.f}, sr = {0.f, 0.f, 0.f, 0.f};
        if (islat) { cr = *(const GAS f32x4*)(cos32 + pos * 16 + 4 * kq); sr = *(const GAS f32x4*)(sin32 + pos * 16 + 4 * kq); }
        asm volatile("s_waitcnt vmcnt(0)\n\ts_barrier" ::: "memory");
        f32x4 acc[6];
#pragma unroll
        for (int p = 0; p < 6; ++p) {
            bf16x8 w[8];
#pragma unroll
            for (int s2 = 0; s2 < 8; ++s2) w[s2] = *(const LAS bf16x8*)(lds + LQ + (16 * p + tk) * 512 + (((4 * s2 + kq) ^ (tk & 7)) * 16));
            acc[p] = (f32x4){0.f, 0.f, 0.f, 0.f};
#pragma unroll
            for (int s2 = 0; s2 < 8; ++s2) acc[p] = __builtin_amdgcn_mfma_f32_16x16x32_bf16(w[s2], zq[s2], acc[p], 0, 0, 0);
        }
#pragma unroll
        for (int p = 0; p < 4; ++p) { const f32x4 v = acc[p] * rq; u32x2 o; o.x = pk2(v[0], v[1]); o.y = pk2(v[2], v[3]); *(GAS u32x2*)(qrow + Q_MLAQ + h * 96 + 16 * p + 4 * kq) = o; }
        { const f32x4 x1 = acc[4] * rq, x2 = acc[5] * rq; const f32x4 o1 = x1 * cr - x2 * sr, o2 = x2 * cr + x1 * sr;
          u32x2 w1; w1.x = pk2(o1[0], o1[1]); w1.y = pk2(o1[2], o1[3]); u32x2 w2; w2.x = pk2(o2[0], o2[1]); w2.y = pk2(o2[2], o2[3]);
          *(GAS u32x2*)(qrow + Q_MLAQ + h * 96 + 64 + 4 * kq) = w1; *(GAS u32x2*)(qrow + Q_MLAQ + h * 96 + 80 + 4 * kq) = w2; }
#pragma unroll
        for (int p = 0; p < 8; ++p) {
            bf16x8 w[4];
#pragma unroll
            for (int s2 = 0; s2 < 4; ++s2) w[s2] = *(const LAS bf16x8*)(lds + LKV + (16 * p + tk) * 256 + (((4 * s2 + kq) ^ (tk & 7)) * 16));
            f32x4 ac = {0.f, 0.f, 0.f, 0.f};
#pragma unroll
            for (int s2 = 0; s2 < 4; ++s2) ac = __builtin_amdgcn_mfma_f32_16x16x32_bf16(w[s2], zkv[s2], ac, 0, 0, 0);
            const f32x4 v = ac * rkv; u32x2 o; o.x = pk2(v[0], v[1]); o.y = pk2(v[2], v[3]);
            const int col = p < 4 ? Q_MLAK + h * 96 + 16 * p + 4 * kq : Q_MLAV + h * 64 + 16 * (p - 4) + 4 * kq;
            *(GAS u32x2*)(qrow + col) = o;
        }
        if (h == 0) {
            const f32x4 x1 = {bflo(kr1.x), bfhi(kr1.x), bflo(kr1.y), bfhi(kr1.y)}, x2 = {bflo(kr2.x), bfhi(kr2.x), bflo(kr2.y), bfhi(kr2.y)};
            const f32x4 o1 = x1 * cr - x2 * sr, o2 = x2 * cr + x1 * sr;
            u32x2 w1; w1.x = pk2(o1[0], o1[1]); w1.y = pk2(o1[2], o1[3]); u32x2 w2; w2.x = pk2(o2[0], o2[1]); w2.y = pk2(o2[2], o2[3]);
#pragma unroll
            for (int hh = 0; hh < 4; ++hh) { *(GAS u32x2*)(qrow + Q_MLAK + hh * 96 + 64 + 4 * kq) = w1; *(GAS u32x2*)(qrow + Q_MLAK + hh * 96 + 80 + 4 * kq) = w2; }
        }
        asm volatile("s_waitcnt lgkmcnt(0)\n\ts_barrier" ::: "memory");
    }
}

__device__ __forceinline__ void phase_router(KArgs a, int l, int nrows, LAS unsigned char* lds, int tid, int lane, int wave, int G, int c) {
    unsigned char* ws = a->ws;
    const float* X = (const float*)(ws + WS_X); unsigned char* H = (unsigned char*)(ws + WS_H);
    const float* ada = (const float*)(ws + WS_ADA); const float* wrp = (const float*)(ws + WS_WRP);
    const float* gn = a->in[I_N2G] + l * 1024; const float* brt = a->in[I_BR];
    unsigned* ctl = (unsigned*)(ws + WS_CTL);
    int* tokinv = (int*)(ws + WS_TOKINV); int* toke = (int*)(ws + WS_TOKE); float* tokw = (float*)(ws + WS_TOKW);
    const int tk = lane & 15, q = lane >> 4;
    f32x4 wr0[8], wr1[8];
    { const float* p0 = wrp + (((0 * 8 + wave) * 4 + q) * 16 + tk) * 32; const float* p1 = wrp + (((1 * 8 + wave) * 4 + q) * 16 + tk) * 32;
#pragma unroll
      for (int s = 0; s < 8; ++s) { wr0[s] = *(const GAS f32x4*)(p0 + 4 * s); wr1[s] = *(const GAS f32x4*)(p1 + 4 * s); } }
    LAS float* hb = (LAS float*)lds;
    LAS float* part = (LAS float*)(lds + 16 * 4112);
    LAS float* lgs = part + 8 * 16 * 32;
    for (int g = c; g < nrows / 16; g += G) {
        f32x4 v[2][4];
#pragma unroll
        for (int rr = 0; rr < 2; ++rr) { const float* xr = X + (size_t)(g * 16 + 2 * wave + rr) * 1024;
#pragma unroll
            for (int j = 0; j < 4; ++j) v[rr][j] = *(const GAS f32x4*)(xr + 4 * lane + 256 * j); }
#pragma unroll
        for (int rr = 0; rr < 2; ++rr) {
            const int row = g * 16 + 2 * wave + rr, b = row < TL ? (row >> 11) : 8;
            float ss = 0.f;
#pragma unroll
            for (int j = 0; j < 4; ++j) ss += (v[rr][j].x * v[rr][j].x + v[rr][j].y * v[rr][j].y) + (v[rr][j].z * v[rr][j].z + v[rr][j].w * v[rr][j].w);
            const float rstd = 1.0f / sqrtf(wave_sum(ss) * (1.f / 1024.f) + EPS);
            const float* sh = ada + ((size_t)l * 9 + b) * 6144 + 3072; const float* sc = sh + 1024;
#pragma unroll
            for (int j = 0; j < 4; ++j) { const int cc = 4 * lane + 256 * j; const f32x4 gg = *(const GAS f32x4*)(gn + cc), s1 = *(const GAS f32x4*)(sc + cc), s0 = *(const GAS f32x4*)(sh + cc);
                const f32x4 h = v[rr][j] * rstd * gg * (s1 + 1.0f) + s0;
                *(GAS unsigned*)(H + (size_t)row * 1024 + cc) = pk4_fp8(h.x, h.y, h.z, h.w);
                *(LAS f32x4*)(hb + (2 * wave + rr) * 1028 + cc) = h; }
        }
        __syncthreads();
        f32x4 acc0 = {0.f, 0.f, 0.f, 0.f}, acc1 = {0.f, 0.f, 0.f, 0.f};
#pragma unroll
        for (int s = 0; s < 8; ++s) { const f32x4 a4 = *(const LAS f32x4*)(hb + tk * 1028 + 128 * wave + 32 * q + 4 * s);
#pragma unroll
            for (int j = 0; j < 4; ++j) { acc0 = __builtin_amdgcn_mfma_f32_16x16x4f32(a4[j], wr0[s][j], acc0, 0, 0, 0); acc1 = __builtin_amdgcn_mfma_f32_16x16x4f32(a4[j], wr1[s][j], acc1, 0, 0, 0); } }
#pragma unroll
        for (int r = 0; r < 4; ++r) { part[(wave * 16 + 4 * q + r) * 32 + tk] = acc0[r]; part[(wave * 16 + 4 * q + r) * 32 + 16 + tk] = acc1[r]; }
        __syncthreads();
        LAS float* selv = lgs + 512;
        { float sum = 0.f;
#pragma unroll
          for (int w = 0; w < 8; ++w) sum += part[w * 512 + tid];
          const float sg = 1.0f / (1.0f + __expf(-sum)); lgs[tid] = sg; selv[tid] = sg + brt[tid & 31]; }
        __syncthreads();
        if (wave == 0 && lane < 16) {
            const LAS float* my = selv + lane * 32; const LAS float* mys = lgs + lane * 32;
            float gs[4];
#pragma unroll
            for (int g4 = 0; g4 < 4; ++g4) { float m1 = -1e30f, m2 = -1e30f;
#pragma unroll
                for (int j = 0; j < 8; ++j) { const float vv = my[g4 * 8 + j];
                    if (vv > m1) { m2 = m1; m1 = vv; } else if (vv > m2) m2 = vv; }
                gs[g4] = m1 + m2; }
            int gsel = 0; float gb = gs[0];
#pragma unroll
            for (int g4 = 1; g4 < 4; ++g4) if (gs[g4] > gb) { gb = gs[g4]; gsel = g4; }
            float v1 = -1e30f, v2 = -1e30f, s1v = 0.f, s2v = 0.f; int e1 = 0, e2 = 0;
#pragma unroll
            for (int j = 0; j < 8; ++j) { const int e = gsel * 8 + j; const float sg = mys[e]; const float vv = my[e];
                if (vv > v1) { v2 = v1; e2 = e1; s2v = s1v; v1 = vv; e1 = e; s1v = sg; } else if (vv > v2) { v2 = vv; e2 = e; s2v = sg; } }
            const float inv = 1.0f / (s1v + s2v);
            const int myrow = g * 16 + lane;
            const int p1 = (int)__hip_atomic_fetch_add(ctl + CW_CNT + l * 32 + e1, 1u, __ATOMIC_RELAXED, __HIP_MEMORY_SCOPE_AGENT);
            const int p2 = (int)__hip_atomic_fetch_add(ctl + CW_CNT + l * 32 + e2, 1u, __ATOMIC_RELAXED, __HIP_MEMORY_SCOPE_AGENT);
            tokinv[(size_t)e1 * TT + p1] = myrow; tokinv[(size_t)e2 * TT + p2] = myrow;
            toke[myrow * 2] = (e1 << 20) | p1; toke[myrow * 2 + 1] = (e2 << 20) | p2;
            tokw[myrow * 2] = s1v * inv; tokw[myrow * 2 + 1] = s2v * inv;
        }
    }
    __syncthreads();
}

__device__ __forceinline__ float max3f(float a, float b, float c) { float r; asm("v_max3_f32 %0, %1, %2, %3" : "=v"(r) : "v"(a), "v"(b), "v"(c)); return r; }
__device__ __forceinline__ int crow(int r, int hi) { return (r & 3) + 8 * (r >> 2) + 4 * hi; }
__device__ __forceinline__ s16x4 tr_read(const LAS unsigned char* p) { typedef short v4s __attribute__((ext_vector_type(4))); return __builtin_bit_cast(s16x4, __builtin_amdgcn_ds_read_tr16_b64_v4i16((LAS v4s*)p)); }
constexpr int AT_FAC = 124928, AT_SCRW = 8448;
__device__ __forceinline__ void at_wait_bar(int n) {
    switch (n) {
        case 0: asm volatile("s_waitcnt vmcnt(0)\n\ts_barrier" ::: "memory"); break;
        case 2: asm volatile("s_waitcnt vmcnt(2)\n\ts_barrier" ::: "memory"); break;
        case 3: asm volatile("s_waitcnt vmcnt(3)\n\ts_barrier" ::: "memory"); break;
        case 4: asm volatile("s_waitcnt vmcnt(4)\n\ts_barrier" ::: "memory"); break;
        case 6: asm volatile("s_waitcnt vmcnt(6)\n\ts_barrier" ::: "memory"); break;
        case 8: asm volatile("s_waitcnt vmcnt(8)\n\ts_barrier" ::: "memory"); break;
        case 9: asm volatile("s_waitcnt vmcnt(9)\n\ts_barrier" ::: "memory"); break;
        default: asm volatile("s_waitcnt vmcnt(0)\n\ts_barrier" ::: "memory"); break;
    }
}
template <int kind>
__device__ __forceinline__ void attn_unit(const bf16_t* Q, bf16_t* Y, const int b, const int hq, const int qb, const bool ctxq, const float sinkl2, const float lf2, const float lb2,
                                          LAS unsigned char* lds, const int tid, const int lane, const int wave, const int tilecap) {
    constexpr int DQK = kind == 0 ? 96 : 64;
    constexpr int KS = DQK == 64 ? 128 : 256, NS = DQK / 16, SLOTK = 64 * KS, SLOT = SLOTK + 8192, NL = DQK == 64 ? 2 : 3, NSLOT = DQK == 64 ? 6 : 5;
    constexpr float THR = 8.0f;
    constexpr int KW = 2, KP = NS / KW;
    static_assert(NSLOT * SLOT <= AT_FAC && 8 * AT_SCRW <= AT_FAC && AT_FAC + 1024 <= LDS_MISC, "attention LDS map");
    int qcol, kcol, vcol, ycol, gcol = 0;
    if (kind == 0) { qcol = Q_MLAQ + hq * 96; kcol = Q_MLAK + hq * 96; vcol = Q_MLAV + hq * 64; ycol = 256 + hq * 64; }
    else if (kind == 1) { qcol = Q_GQAQ + hq * 64; kcol = Q_GQAK + (hq >> 1) * 64; vcol = Q_GQAV + (hq >> 1) * 64; ycol = 512 + hq * 64; }
    else if (kind == 2) { qcol = Q_RETQ + hq * 64; kcol = Q_RETK + hq * 64; vcol = Q_RETV + hq * 64; ycol = hq * 64; gcol = Q_RETG + hq * 64; }
    else { qcol = Q_WINQ + hq * 64; kcol = Q_WINK + (hq >> 1) * 64; vcol = Q_WINV + (hq >> 1) * 64; ycol = 768 + hq * 64; }
    const int r32 = lane & 31, hi = lane >> 5;
    const int qrow0 = (ctxq ? TL + b * 256 : b * 2048 + qb * 256) + 32 * wave;
    const int qpos = (ctxq ? 0 : qb * 256) + 32 * wave + r32;
    int lt0 = 0, nlat = 32;
    if (ctxq) nlat = 0;
    else if (kind == 3) { lt0 = 4 * qb - 2 < 0 ? 0 : 4 * qb - 2; const int lt1 = 4 * qb + 6 > 32 ? 32 : 4 * qb + 6; nlat = lt1 - lt0; }
    const int ntile = (4 + nlat) < tilecap ? (4 + nlat) : tilecap;
    bf16x8 qf[NS];
#pragma unroll
    for (int s = 0; s < NS; ++s) qf[s] = *(const GAS bf16x8*)(Q + (size_t)(qrow0 + r32) * QP + qcol + 16 * s + 8 * hi);
    f32x4 cfa = {}, cfq = {}, cba = {}, cbq = {}; float g32f = 0.f, g32b = 0.f;
    if constexpr (kind == 2) {
#pragma unroll
        for (int i = 0; i < 4; ++i) { cfa[i] = __builtin_bit_cast(float, __builtin_amdgcn_readfirstlane(__builtin_bit_cast(int, fast_exp2(lf2 * (float)(3 - i))))); cfq[i] = fast_exp2(lf2 * (float)(28 - 4 * hi - 8 * i));
            cba[i] = __builtin_bit_cast(float, __builtin_amdgcn_readfirstlane(__builtin_bit_cast(int, fast_exp2(lb2 * (float)i)))); cbq[i] = fast_exp2(lb2 * (float)(8 * i + 4 * hi)); }
        g32f = fast_exp2(32.f * lf2); g32b = fast_exp2(32.f * lb2);
    }
    int ksrc[DQK == 64 ? 1 : 2], vsrc;
    if constexpr (DQK == 64) { const int row = 8 * wave + (lane >> 3), ch = (lane & 7) ^ (row & 7); ksrc[0] = row * QP + kcol + 8 * ch; }
    else {
#pragma unroll
        for (int n = 0; n < 2; ++n) { const int row = 4 * (2 * wave + n) + (lane >> 4); int ch = (lane & 15) ^ (row & 7); if (ch >= 12) ch = 0; ksrc[n] = row * QP + kcol + 8 * ch; }
    }
    { const int row = 8 * wave + (lane >> 3); vsrc = row * QP + vcol + 8 * (lane & 7); }
#define AT_TILE_ROW0(t) ((t) < 4 ? TL + b * 256 + 64 * (t) : b * 2048 + 64 * (lt0 + (t) - 4))
#define AT_ISSUE(t) do { const bf16_t* tb_ = Q + (size_t)AT_TILE_ROW0(t) * QP; const unsigned sl_ = (unsigned)__builtin_amdgcn_readfirstlane((int)(ldsb + ((t) % NSLOT) * SLOT + wave * 1024 * (DQK == 64 ? 1 : 2))); \
        if constexpr (DQK == 64) { glds16(tb_ + ksrc[0], sl_); glds16(tb_ + vsrc, sl_ + SLOTK); } \
        else { glds16(tb_ + ksrc[0], sl_); glds16(tb_ + ksrc[DQK == 64 ? 0 : 1], sl_ + 1024); glds16(tb_ + vsrc, (unsigned)__builtin_amdgcn_readfirstlane((int)(ldsb + ((t) % NSLOT) * SLOT + SLOTK + wave * 1024))); } } while (0)
    const unsigned ldsb = (unsigned)(uintptr_t)lds;
    const unsigned krd = r32 * KS + 16 * (hi ^ (r32 & 1)) + 32 * ((r32 & 7) >> 1);
#define AT_KLOAD(KF, t, S0, S1) do { unsigned ka_ = (unsigned)(uintptr_t)(lds + ((t) % NSLOT) * SLOT) + krd; asm volatile("" : "+v"(ka_)); \
        _Pragma("unroll") for (int s = (S0); s < (S1); ++s) { const LAS unsigned char* kp_ = (const LAS unsigned char*)(uintptr_t)(ka_ ^ (unsigned)(32 * s)); \
            KF[2 * (s - (S0))] = *(const LAS bf16x8*)(kp_); KF[2 * (s - (S0)) + 1] = *(const LAS bf16x8*)(kp_ + 32 * KS); } } while (0)
#define AT_QKMR(P0, P1, KF, PART) do { _Pragma("unroll") for (int s = (PART) * KW; s < ((PART) + 1) * KW; ++s) { \
        if ((PART) == 0 && s == 0) { const f32x16 z_ = {}; P0 = __builtin_amdgcn_mfma_f32_32x32x16_bf16(KF[0], qf[0], z_, 0, 0, 0); P1 = __builtin_amdgcn_mfma_f32_32x32x16_bf16(KF[1], qf[0], z_, 0, 0, 0); } \
        else { P0 = __builtin_amdgcn_mfma_f32_32x32x16_bf16(KF[2 * (s - (PART) * KW)], qf[s], P0, 0, 0, 0); P1 = __builtin_amdgcn_mfma_f32_32x32x16_bf16(KF[2 * (s - (PART) * KW) + 1], qf[s], P1, 0, 0, 0); } } } while (0)
#define AT_KPART(KF, t, PART) AT_KLOAD(KF, t, (PART) * KW, ((PART) + 1) * KW)
#define AT_QK(P0, P1, t) do { bf16x8 kf_[2 * KW]; _Pragma("unroll") for (int p_ = 0; p_ < KP; ++p_) { AT_KPART(kf_, t, p_); AT_QKMR(P0, P1, kf_, p_); } } while (0)
    const int qw0_ = qb * 256 + 32 * wave;
#define AT_SKIP(t) ((kind == 3 && (t) >= 4) && ((64 * (lt0 + (t) - 4) + 63 < qw0_ - 128) || (64 * (lt0 + (t) - 4) > qw0_ + 31 + 128)))
#pragma unroll
    for (int t = 0; t < NSLOT - 1; ++t) if (t < ntile) AT_ISSUE(t);
    { const int infl = (ntile - 1 < NSLOT - 2 ? ntile - 1 : NSLOT - 2); at_wait_bar(infl * NL); }
    float mref = 0.f, lsum = 0.f;
    bool shifted = false;
    f32x16 o0 = {}, o1 = {}, pa0, pa1, pb0 = {}, pb1 = {};
    AT_QK(pa0, pa1, 0);
    LAS float* stage = (LAS float*)(lds + wave * AT_SCRW); LAS float* fac = (LAS float*)(lds + AT_FAC) + wave * 32;
    const int i16 = lane & 15, q4 = i16 >> 2, p4 = i16 & 3, g1 = (lane >> 4) & 1;
    const unsigned vrd = SLOTK + (4 * hi + q4) * 128 + (16 * g1 + 4 * p4) * 2;
#define CR(r) (((r) & 3) + 8 * ((r) >> 2))
#define AT_VLOAD(VF, t, u) do { unsigned vb_ = (unsigned)(uintptr_t)(lds + ((t) % NSLOT) * SLOT) + vrd + (32 * (u)) * 128; asm volatile("" : "+v"(vb_)); const LAS unsigned char* vb = (const LAS unsigned char*)(uintptr_t)vb_; \
        _Pragma("unroll") for (int s2 = 0; s2 < 2; ++s2) _Pragma("unroll") for (int d0 = 0; d0 < 2; ++d0) { const LAS unsigned char* vp = vb + (16 * s2) * 128 + 64 * d0; \
            const s16x4 lo = tr_read(vp), h2 = tr_read(vp + 8 * 128); VF[2 * s2 + d0] = (bf16x8){lo[0], lo[1], lo[2], lo[3], h2[0], h2[1], h2[2], h2[3]}; } } while (0)
#define AT_PVM(PU, VF) do { _Pragma("unroll") for (int s = 0; s < 2; ++s) { \
        u32x4 pw; pw.x = pk2(PU[8 * s], PU[8 * s + 1]); pw.y = pk2(PU[8 * s + 2], PU[8 * s + 3]); pw.z = pk2(PU[8 * s + 4], PU[8 * s + 5]); pw.w = pk2(PU[8 * s + 6], PU[8 * s + 7]); \
        const bf16x8 pa = __builtin_bit_cast(bf16x8, pw); \
        o0 = __builtin_amdgcn_mfma_f32_32x32x16_bf16(pa, VF[2 * s], o0, 0, 0, 0); o1 = __builtin_amdgcn_mfma_f32_32x32x16_bf16(pa, VF[2 * s + 1], o1, 0, 0, 0); } } while (0)
#define SB0() __builtin_amdgcn_sched_barrier(0)
#define AT_STEP(PC0, PC1, PN0, PN1, t) do { \
        const bool more = (t) + 1 < ntile; \
        if (more) { const int last_infl = ((t) + NSLOT - 2 < ntile - 1) ? ((t) + NSLOT - 2) : (ntile - 1); \
            at_wait_bar((last_infl - ((t) + 1)) * NL); \
            if ((t) + NSLOT - 1 < ntile) AT_ISSUE((t) + NSLOT - 1); } \
        const bool isctx = (t) < 4; const int kpos0 = isctx ? 64 * (t) : 64 * (lt0 + (t) - 4); \
        int dbase = kpos0 + 4 * hi - qpos; asm volatile("" : "+v"(dbase)); \
        const bool skip = AT_SKIP(t), skipn = more ? AT_SKIP((t) + 1) : true; \
        bf16x8 kf[2 * KW]; bf16x8 vf[4]; \
        if (!skipn) { AT_KPART(kf, (t) + 1, 0); SB0(); } \
        if (kind == 2) { \
            if (!skipn) { AT_QKMR(PN0, PN1, kf, 0); SB0(); AT_KPART(kf, (t) + 1, 1); } \
            AT_VLOAD(vf, t, 0); SB0(); \
              \
            const int qw0r = (ctxq ? 0 : qb * 256) + 32 * wave; \
            const int tcls = (isctx && !ctxq) ? 3 : ((kpos0 + 63 <= qw0r) ? 0 : ((kpos0 >= qw0r + 32) ? 1 : 2)); \
            float mf0 = 0.f, mf1 = 0.f, mb0 = 0.f, mb1 = 0.f; \
            if (tcls == 0) { mf1 = fast_exp2(lf2 * (float)(qpos - kpos0 - 63)); mf0 = mf1 * g32f; } \
            else if (tcls == 1) { mb0 = fast_exp2(lb2 * (float)(kpos0 - qpos)); mb1 = mb0 * g32b; } \
            else if (tcls == 3) { mf1 = fast_exp2(lf2 * (float)(256 + qpos - kpos0 - 63)); mf0 = mf1 * g32f; mb0 = fast_exp2(lb2 * (float)(2048 - qpos + kpos0)); mb1 = mb0 * g32b; } \
            if (tcls == 2) {        \
                _Pragma("unroll") for (int r = 0; r < 16; ++r) { const int d0 = -(dbase + CR(r)); PC0[r] *= fast_exp2((d0 >= 0 ? lf2 : -lb2) * (float)d0); } \
            } else { \
                const f32x4 fq_ = cfq * mf0, bq_ = cbq * mb0; \
                _Pragma("unroll") for (int r = 0; r < 16; ++r) PC0[r] *= cfa[r & 3] * fq_[r >> 2] + cba[r & 3] * bq_[r >> 2]; \
            } \
            SB0(); if (!skipn) { AT_QKMR(PN0, PN1, kf, 1); if (KP == 3) { SB0(); AT_KPART(kf, (t) + 1, 2); } } AT_PVM(PC0, vf); SB0(); AT_VLOAD(vf, t, 1); SB0(); \
            if (tcls == 2) { \
                _Pragma("unroll") for (int r = 0; r < 16; ++r) { const int d1 = -(dbase + CR(r)) - 32; PC1[r] *= fast_exp2((d1 >= 0 ? lf2 : -lb2) * (float)d1); } \
            } else { \
                const f32x4 fq_ = cfq * mf1, bq_ = cbq * mb1; \
                _Pragma("unroll") for (int r = 0; r < 16; ++r) PC1[r] *= cfa[r & 3] * fq_[r >> 2] + cba[r & 3] * bq_[r >> 2]; \
            } \
            SB0(); if (KP == 3 && !skipn) { AT_QKMR(PN0, PN1, kf, 2); } AT_PVM(PC1, vf); \
        } else if (!skip) { \
            if (kind == 3 && !isctx) { \
                _Pragma("unroll") for (int r = 0; r < 16; ++r) { const int d0 = dbase + CR(r), d1 = d0 + 32; \
                    if (d0 > 128 || d0 < -128) PC0[r] = -INFINITY; if (d1 > 128 || d1 < -128) PC1[r] = -INFINITY; } \
            } \
            float tm = max3f(PC0[0], PC1[0], PC0[1]), tm2 = max3f(PC1[1], PC0[2], PC1[2]); \
            _Pragma("unroll") for (int r = 3; r < 15; r += 2) { tm = max3f(tm, PC0[r], PC1[r]); tm2 = max3f(tm2, PC0[r + 1], PC1[r + 1]); } \
            tm = max3f(tm, PC0[15], PC1[15]); tm = max3f(tm, tm2, tm2); \
            tm = xmax32(tm) - mref; \
            if (__any(tm > THR)) { \
                const float dl = (tm > THR) ? tm : 0.f; \
                mref += dl; shifted = true; \
                const float f = fast_exp2(-dl); lsum *= f; \
                if (hi == 0) fac[r32] = f; \
                LDS_WAIT(); asm volatile("" ::: "memory"); \
                _Pragma("unroll") for (int r = 0; r < 16; ++r) { const float fr_ = fac[crow(r, hi)]; o0[r] *= fr_; o1[r] *= fr_; } \
            } \
            if (shifted) { _Pragma("unroll") for (int r = 0; r < 16; ++r) { PC0[r] -= mref; PC1[r] -= mref; } } \
            SB0(); \
            if (!skipn) { AT_QKMR(PN0, PN1, kf, 0); SB0(); AT_KPART(kf, (t) + 1, 1); } \
            AT_VLOAD(vf, t, 0); SB0(); \
            float ps = 0.f; \
            _Pragma("unroll") for (int r = 0; r < 16; ++r) { PC0[r] = fast_exp2(PC0[r]); ps += PC0[r]; } \
            SB0(); if (!skipn) { AT_QKMR(PN0, PN1, kf, 1); if (KP == 3) { SB0(); AT_KPART(kf, (t) + 1, 2); } } AT_PVM(PC0, vf); SB0(); AT_VLOAD(vf, t, 1); SB0(); \
            _Pragma("unroll") for (int r = 0; r < 16; ++r) { PC1[r] = fast_exp2(PC1[r]); ps += PC1[r]; } \
            lsum += ps; \
            SB0(); if (KP == 3 && !skipn) { AT_QKMR(PN0, PN1, kf, 2); } AT_PVM(PC1, vf); \
        } else if (!skipn) { AT_QKMR(PN0, PN1, kf, 0); _Pragma("unroll") for (int p_ = 1; p_ < KP; ++p_) { AT_KPART(kf, (t) + 1, p_); AT_QKMR(PN0, PN1, kf, p_); } } \
        } while (0)
    for (int t = 0; t < ntile; t += 2) {
        AT_STEP(pa0, pa1, pb0, pb1, t);
        if (t + 1 < ntile) AT_STEP(pb0, pb1, pa0, pa1, t + 1);
    }
#undef AT_STEP
#undef AT_PVM
#undef AT_VLOAD
#undef AT_KLOAD
#undef AT_QKMR
#undef AT_KPART
#undef SB0
#undef AT_ISSUE
#undef AT_TILE_ROW0
#undef AT_QK
#undef AT_SKIP
#undef CR
    asm volatile("s_waitcnt lgkmcnt(0)\n\ts_barrier" ::: "memory");
#pragma unroll
    for (int r = 0; r < 16; ++r) { stage[crow(r, hi) * 65 + r32] = o0[r]; stage[crow(r, hi) * 65 + 32 + r32] = o1[r]; }
    LDS_WAIT(); asm volatile("" ::: "memory");
    float x[32];
#pragma unroll
    for (int j = 0; j < 32; ++j) x[j] = stage[r32 * 65 + 32 * hi + j];
    int orow_i = qrow0 + r32; asm volatile("" : "+v"(orow_i));
    const size_t orow = (size_t)orow_i;
    if (kind == 2) {
        float s = 0.f;
#pragma unroll
        for (int j = 0; j < 32; ++j) s += x[j];
        s = xadd<32>(s); const float mean = s * (1.f / 64.f); float v = 0.f;
#pragma unroll
        for (int j = 0; j < 32; ++j) { x[j] -= mean; v += x[j] * x[j]; }
        v = xadd<32>(v); const float rstd = 1.0f / sqrtf(v * (1.f / 64.f) + EPS);
        const bf16_t* gp = Q + orow * QP + gcol + 32 * hi;
#pragma unroll
        for (int c = 0; c < 4; ++c) { const u32x4 gw = *(const GAS u32x4*)(gp + 8 * c);
#pragma unroll
            for (int j = 0; j < 4; ++j) { const float ga = bflo(gw[j]), gb = bfhi(gw[j]); x[8 * c + 2 * j] *= rstd * ga * sigmoidf_(ga); x[8 * c + 2 * j + 1] *= rstd * gb * sigmoidf_(gb); } }
    } else {
        float lt = xadd<32>(lsum);
        if (kind == 3) lt += fast_exp2(sinkl2 - mref);
        const float inv = 1.0f / fmaxf(lt, 1e-30f);
#pragma unroll
        for (int j = 0; j < 32; ++j) x[j] *= inv;
    }
    bf16_t* yp = Y + orow * 1024 + ycol + 32 * hi;
#pragma unroll
    for (int c = 0; c < 4; ++c) { u32x4 w; w.x = pk2(x[8 * c], x[8 * c + 1]); w.y = pk2(x[8 * c + 2], x[8 * c + 3]); w.z = pk2(x[8 * c + 4], x[8 * c + 5]); w.w = pk2(x[8 * c + 6], x[8 * c + 7]); *(GAS u32x4*)(yp + 8 * c) = w; }
    asm volatile("s_waitcnt vmcnt(0) lgkmcnt(0)\n\ts_barrier" ::: "memory");
}
#ifndef PROBE_KMASK
#define PROBE_KMASK 0x1f
#endif
#ifndef PROBE_TILECAP
#define PROBE_TILECAP 1000
#endif
__device__ __forceinline__ void phase_mix(KArgs a, int lq, LAS unsigned char* lds, int tid, int lane, int wave, int G, int c) {
    const int l = lq & 1; const int kmask = (lq >= 2) ? PROBE_KMASK : 0x1f; const int tilecap = (lq >= 2) ? PROBE_TILECAP : 1000;
    unsigned char* ws = a->ws;
    const bf16_t* Q = (const bf16_t*)(ws + WS_QKV); bf16_t* Y = (bf16_t*)(ws + (lq >= 2 ? WS_MRG : WS_Y));
    const int nunits = l == 0 ? 1152 : 1024;
    const int vc = (G == 256) ? ((c & 7) * 32 + (c >> 3)) : c;
    for (int j = 0; ; ++j) {
        const int u = j * G + vc;
        if (u >= nunits) break;
        int kind, b, hq, qb; bool ctxq;
        if (u < 1024) { kind = u >> 8; const int r = u & 255; b = r >> 5; hq = (r >> 3) & 3; qb = r & 7; ctxq = false; }
        else { const int r = u - 1024; kind = r >> 5; b = (r >> 2) & 7; hq = r & 3; qb = 0; ctxq = true; }
        if (!((kmask >> (ctxq ? 4 : kind)) & 1)) continue;
        const float lf2 = -__expf(a->in[I_DECAY][l * 8 + hq]) * LOG2E, lb2 = -__expf(a->in[I_DECAY][l * 8 + 4 + hq]) * LOG2E;
        const float sk = a->in[I_SINK][l * 4 + hq] * LOG2E;
        int tid2 = tid; asm volatile("" : "+v"(tid2));
        const int lane2 = tid2 & 63;
        if (kind == 0) attn_unit<0>(Q, Y, b, hq, qb, ctxq, sk, lf2, lb2, lds, tid2, lane2, wave, tilecap);
        else if (kind == 1) attn_unit<1>(Q, Y, b, hq, qb, ctxq, sk, lf2, lb2, lds, tid2, lane2, wave, tilecap);
        else if (kind == 2) attn_unit<2>(Q, Y, b, hq, qb, ctxq, sk, lf2, lb2, lds, tid2, lane2, wave, tilecap);
        else attn_unit<3>(Q, Y, b, hq, qb, ctxq, sk, lf2, lb2, lds, tid2, lane2, wave, tilecap);
    }
}

#ifndef MK_BAR_XCD
#define MK_BAR_XCD 1
#endif
constexpr int NPHASE = 20;
#ifndef PH_MASK
#define PH_MASK 0x3ff
#endif
#define PH_ON(b) ((PH_MASK >> (b)) & 1)
#ifndef PROBE_REPEAT
#define PROBE_REPEAT 0
#endif
__global__ void __launch_bounds__(NTHREADS, 2) fwd_kernel(Args a_byval) {
    extern __shared__ __attribute__((aligned(16))) unsigned char lds_raw[];
    LAS unsigned char* lds0 = (LAS unsigned char*)lds_raw;
    const int wave0 = __builtin_amdgcn_readfirstlane((int)threadIdx.x >> 6);
    { LAS unsigned char* lds = lds0; const int t0 = wave0 * 64 + lane_id(); for (int u = t0; u < (LDS_BYTES - LDS_MISC) / 4; u += NTHREADS) ((LAS unsigned*)(lds + LDS_MISC))[u] = 0u; }
    __syncthreads();
    const int ph_lo = a_byval.ph_lo, ph_hi = a_byval.ph_hi;
#if MK_ONE_LAUNCH && MK_BAR_XCD
    XcdBarrier bar = xcd_barrier_post((unsigned*)(a_byval.ws + WS_CTL) + CW_BAR, (volatile LAS unsigned*)(lds0 + LDS_MISC), wave0);
#endif
    for (int ph = ph_lo; ph < ph_hi; ++ph) {
#if PROBE_REPEAT
      const int nrep = 1 + ((PROBE_REPEAT >> ph) & 1);
      for (int rep = 0; rep < nrep; ++rep) {
#else
      constexpr int nrep = 1, rep = 0; {
#endif
#define PHASE_IDS \
        KArgs a = (KArgs)__builtin_amdgcn_kernarg_segment_ptr(); asm volatile("" : "+s"(a)); \
        int wave = wave0; asm volatile("" : "+s"(wave)); unsigned z_ = 0u; asm volatile("" : "+v"(z_)); \
        const int lane = (int)__builtin_amdgcn_mbcnt_hi(~0u, __builtin_amdgcn_mbcnt_lo(~0u, z_)); const int tid = wave * 64 + lane; \
        unsigned ldso = 0; asm volatile("" : "+s"(ldso)); LAS unsigned char* lds = lds0 + ldso; \
        int G = gridDim.x, c = blockIdx.x; asm volatile("" : "+s"(G), "+s"(c)); \
        unsigned char* ws = a->ws; unsigned* ctl = (unsigned*)(ws + WS_CTL); const float* ada = (const float*)(ws + WS_ADA); (void)ctl; (void)ada; (void)tid; (void)lane; (void)lds; (void)G; (void)c;
        if (ph == 0) { if (PH_ON(0)) { PHASE_IDS p0_prologue(a, lds, tid, lane, wave, G, c); } }
        else if (ph == NPHASE - 1) { if (PH_ON(1)) { PHASE_IDS moe_tables(ctl, 1, lds, tid); phase_rownorm(a, 2, lds, lane, wave, G, c); } }
        else {
            const int l = (ph - 1) / 9, k = (ph - 1) % 9;
            if (k == 0) { if (PH_ON(1)) { PHASE_IDS if (l == 1) moe_tables(ctl, 0, lds, tid); phase_rownorm(a, l, lds, lane, wave, G, c); } }
            else if (k == 1) { if (PH_ON(2)) { PHASE_IDS
                SchedB S{l, G, c, (const char*)(ws + WS_H), (const char*)(ws + WS_WIN) + (size_t)l * NBG * 1024};
                const float* rope_ = (const float*)(ws + WS_ROPE);
                EpiB E{(bf16_t*)(ws + WS_P), (bf16_t*)(ws + WS_G), (bf16_t*)(ws + WS_QKV), rope_, rope_ + 2048 * 32, a->in[I_GQN] + l * 64, a->in[I_GKN] + l * 64};
                pg8::gemm_phase<EpiB, SchedB, false, true, 0x7a7a7a7a, 0x7f7f7f7f>(lds, tid, 1024, 1024, 1024, S, E); }
            } else if (k == 2) { if (PH_ON(3)) { PHASE_IDS phase_post(a, l, lds, lane, wave, G, c); } }
            else if (k == 3) { if (PH_ON(4)) { PHASE_IDS phase_mix(a, l + 2 * rep, lds, tid, lane, wave, G, c); } }
            else if (k == 4) { if (PH_ON(5)) { PHASE_IDS
                SchedE S{G, c, l == 0 ? 72 : 64, (const char*)(ws + WS_Y), (const char*)(ws + WS_WBR) + (size_t)l * 1048576 * 2};
                EpiE E{(const bf16_t*)(ws + WS_G), (bf16_t*)(ws + WS_MRG)};
                pg8::gemm_phase<EpiE, SchedE, false>(lds, tid, 2048, 2048, 2048, S, E);
                if (l == 0 && G == 256 && c >= 32) cvt_run(a, ws, lds, lane, wave, CV_EXP_ITEMS / 2, CV_EXP_ITEMS / 2 + CV_E0_SHARE, (c - 32) * NWAVES + wave, 224 * NWAVES); }
            } else if (k == 5) { if (PH_ON(6)) { PHASE_IDS
                SchedF S{G, c, l == 0 ? 72 : 64, (const char*)(ws + WS_MRG), (const char*)(ws + WS_WOUT) + (size_t)l * 1048576 * 2};
                EpiF E{a->in[I_X], a->in[I_CTX], (const float*)(ws + WS_X), (float*)(ws + WS_X), ada + (size_t)l * 9 * 6144, l};
                pg8::gemm_phase<EpiF, SchedF, false>(lds, tid, 2048, 2048, 2048, S, E);
                if (l == 0) { if (G == 256 && c >= 32) cvt_run(a, ws, lds, lane, wave, CV_EXP_ITEMS / 2 + CV_E0_SHARE, CV_EXP_ITEMS, (c - 32) * NWAVES + wave, 224 * NWAVES);
                              else if (G != 256) { cvt_run(a, ws, lds, lane, wave, CV_EXP_ITEMS / 2, CV_EXP_ITEMS, c * NWAVES + wave, G * NWAVES); } } }
            } else if (k == 6) { if (PH_ON(7)) { PHASE_IDS phase_router(a, l, l == 0 ? TT : TL, lds, tid, lane, wave, G, c); } }
            else if (k == 7) { if (PH_ON(8)) { PHASE_IDS
                moe_tables(ctl, l, lds, tid);
                SchedMoe S{G, c, 8, 1, (const LAS int*)(lds + LDS_MISC + 1024), (const LAS int*)(lds + LDS_MISC + 2304), (const int*)(ws + WS_TOKINV), (const char*)(ws + WS_H), (const char*)(ws + WS_W13) + (size_t)l * 32 * 2 * MiB, 2 * MiB};
                EpiH E{(unsigned char*)(ws + WS_HID)};
                pg8::gemm_phase<EpiH, SchedMoe, true, true, 0x7a7a7a7a, 0x7f7f7f7f>(lds, tid, 1024, 1024, 1024, S, E); }
            } else if (PH_ON(9)) { PHASE_IDS
                moe_tables(ctl, l, lds, tid);
                SchedMoe S{G, c, 4, 0, (const LAS int*)(lds + LDS_MISC + 1024), (const LAS int*)(lds + LDS_MISC + 2304), (const int*)(ws + WS_TOKINV), (const char*)(ws + WS_HID), (const char*)(ws + WS_W2) + (size_t)l * 32 * 1 * MiB, 1 * MiB};
                EpiI E{(bf16_t*)(ws + WS_Y2)};
                pg8::gemm_phase<EpiI, SchedMoe, false, true, 0x7a7a7a7a, 0x7d7d7d7d>(lds, tid, 1024, 1024, 1024, S, E);
            }
        }
#if MK_ONE_LAUNCH
        if (ph + 1 < ph_hi || rep + 1 < nrep) {
#if MK_BAR_XCD
            if (ph == ph_lo) cg::this_grid().sync(); else xcd_barrier(bar);
#else
            cg::this_grid().sync();
#endif
        }
#endif
      }
    }
}

extern "C" void kernel_launch(void* const* d_in, const int* in_sizes, int n_in, void* d_out, int out_size, void* d_ws, size_t ws_size, hipStream_t stream) {
    static int grid = 0;
    if (grid == 0) {
        if (n_in != 26 || out_size != TL * DM || ws_size < WS_END) { fprintf(stderr, "kernel_launch: unexpected problem (n_in %d, out %d, ws %zu)\n", n_in, out_size, ws_size); grid = -1; return; }
        int dev = 0, cus = 0, per_cu = 0;
        (void)hipGetDevice(&dev); (void)hipDeviceGetAttribute(&cus, hipDeviceAttributeMultiprocessorCount, dev);
        if (hipFuncSetAttribute((const void*)fwd_kernel, hipFuncAttributeMaxDynamicSharedMemorySize, LDS_BYTES) != hipSuccess) { fprintf(stderr, "kernel_launch: hipFuncSetAttribute failed\n"); grid = -1; return; }
        if (hipOccupancyMaxActiveBlocksPerMultiprocessor(&per_cu, (const void*)fwd_kernel, NTHREADS, LDS_BYTES) != hipSuccess || per_cu < 1) { fprintf(stderr, "kernel_launch: occupancy query says %d blocks per CU\n", per_cu); (void)hipGetLastError(); per_cu = 1; }
        grid = cus;
        if (grid < 1) grid = 256;
    }
    if (grid < 0) return;
    (void)hipMemsetAsync((char*)d_ws + WS_CTL, 0, CTL_ZERO_BYTES, stream);
    Args a{};
    for (int i = 0; i < 26; ++i) a.in[i] = (const float*)d_in[i];
    a.out = (float*)d_out; a.ws = (unsigned char*)d_ws;
#if MK_ONE_LAUNCH
    a.ph_lo = 0; a.ph_hi = NPHASE;
    void* args[] = {&a};
    hipError_t e = hipLaunchCooperativeKernel((const void*)fwd_kernel, dim3(grid), dim3(NTHREADS), args, LDS_BYTES, stream);
    if (e != hipSuccess) fprintf(stderr, "kernel_launch: cooperative launch failed: %s (grid %d)\n", hipGetErrorString(e), grid);
#else
    for (int ph = 0; ph < NPHASE; ++ph) { a.ph_lo = ph; a.ph_hi = ph + 1; hipLaunchKernelGGL(fwd_kernel, dim3(grid), dim3(NTHREADS), LDS_BYTES, stream, a); }
#endif
}
```

```cpp
#include <hip/hip_runtime.h>
#include <hip/hip_cooperative_groups.h>
#include <cstdio>
#include <cstdint>
namespace cg = cooperative_groups;

#define LAS __attribute__((address_space(3)))
#define GAS __attribute__((address_space(1)))
typedef unsigned short bf16_t;
typedef short bf16x8 __attribute__((ext_vector_type(8)));
typedef short s16x4 __attribute__((ext_vector_type(4)));
typedef float f32x4 __attribute__((ext_vector_type(4)));
typedef float f32x2 __attribute__((ext_vector_type(2)));
typedef float f32x16 __attribute__((ext_vector_type(16)));
typedef unsigned u32x4 __attribute__((ext_vector_type(4)));
typedef unsigned u32x2 __attribute__((ext_vector_type(2)));

#ifndef MK_ONE_LAUNCH
#define MK_ONE_LAUNCH 1
#endif

constexpr int DM = 1024, NBATCH = 8, SEQ = 2048, CTXL = 256;
constexpr int TL = NBATCH * SEQ, TC = NBATCH * CTXL, TT = TL + TC;
constexpr int NIN = 2464, NINP = 2560, NGATE = 4096, NBG = NINP + NGATE;
constexpr int QP = 3072;
constexpr int NEXP = 32, MAXTILES = 176;
constexpr float EPS = 1e-6f, LOG2E = 1.4426950408889634f;
constexpr int P_RET = 0, P_MLA = 1024, P_GQA = 1440, P_WIN = 1952;
constexpr int Q_RETQ = 0, Q_RETK = 256, Q_RETV = 512, Q_RETG = 768;
constexpr int Q_MLAQ = 1024, Q_MLAK = 1408, Q_MLAV = 1792;
constexpr int Q_GQAQ = 2048, Q_GQAK = 2304, Q_GQAV = 2432;
constexpr int Q_WINQ = 2560, Q_WINK = 2816, Q_WINV = 2944;

constexpr size_t MiB = 1u << 20;
constexpr size_t WS_CTL = 0, CTL_ZERO_BYTES = 1 * MiB;
constexpr size_t WS_ADA = 1 * MiB;
constexpr size_t WS_ROPE = WS_ADA + 512 * 1024;
constexpr size_t WS_WRP = WS_ROPE + 768 * 1024;
constexpr size_t WS_TOKINV = 3 * MiB;
constexpr size_t WS_TOKE = WS_TOKINV + (size_t)NEXP * TT * 4;
constexpr size_t WS_TOKW = WS_TOKE + (size_t)TT * 2 * 4;
constexpr size_t WS_WSM = 6 * MiB;
constexpr size_t WS_WIN = 8 * MiB;
constexpr size_t WS_WBR = 34 * MiB;
constexpr size_t WS_WOUT = 38 * MiB;
constexpr size_t WS_W13 = 42 * MiB;
constexpr size_t WS_W2 = 298 * MiB;
constexpr size_t WS_X = 426 * MiB;
constexpr size_t WS_H = 498 * MiB;
constexpr size_t WS_QKV = 534 * MiB;
constexpr size_t WS_Y = 642 * MiB;
constexpr size_t WS_MRG = 678 * MiB;
constexpr size_t WS_P = 714 * MiB;
constexpr size_t WS_G = 804 * MiB;
constexpr size_t WS_HID = 714 * MiB;
constexpr size_t WS_Y2 = 804 * MiB;
constexpr size_t WS_END = 948 * MiB;
static_assert(WS_TOKW + (size_t)TT * 8 <= WS_WSM && WS_HID + (size_t)MAXTILES * 256 * 2048 <= WS_Y2 && WS_Y2 + (size_t)MAXTILES * 256 * 2048 <= WS_END, "ws map");
static_assert(WS_P + (size_t)TT * NINP * 2 <= WS_G && WS_G + (size_t)TT * NGATE * 2 <= WS_END && WS_END <= 1024 * MiB, "ws map");
constexpr int CW_BAR = 4096;
constexpr int CW_CNT = 16384;
constexpr int CW_WQ = 16640;

constexpr int LDS_MISC = 131072, LDS_BYTES = 147456;

__device__ __forceinline__ unsigned f2bf(float f) { unsigned u = __builtin_bit_cast(unsigned, f); return (u + 0x7fffu + ((u >> 16) & 1u)) >> 16; }
__device__ __forceinline__ unsigned pk2(float lo, float hi) { typedef __bf16 bf2 __attribute__((ext_vector_type(2))); f32x2 v = {lo, hi}; bf2 b = __builtin_convertvector(v, bf2); return __builtin_bit_cast(unsigned, b); }
__device__ __forceinline__ unsigned pk4_fp8(float a, float b, float c, float d) { int p = __builtin_amdgcn_cvt_pk_fp8_f32(a, b, 0, false); p = __builtin_amdgcn_cvt_pk_fp8_f32(c, d, p, true); return (unsigned)p; }
__device__ __forceinline__ float bf2f(unsigned short b) { return __builtin_bit_cast(float, (unsigned)b << 16); }
__device__ __forceinline__ float bflo(unsigned w) { return __builtin_bit_cast(float, w << 16); }
__device__ __forceinline__ float bfhi(unsigned w) { return __builtin_bit_cast(float, w & 0xffff0000u); }
template <int M> __device__ __forceinline__ float xadd(float v) {
    if constexpr (M == 32) { unsigned a = __builtin_bit_cast(unsigned, v), b = a; asm volatile("" : "+v"(b));
        auto r = __builtin_amdgcn_permlane32_swap(a, b, false, false); const unsigned r0 = r[0], r1 = r[1];
        return __uint_as_float(r0) + __uint_as_float(r1); }
    else return v + __builtin_bit_cast(float, __builtin_amdgcn_ds_swizzle(__builtin_bit_cast(int, v), (M << 10) | 0x1f));
}
__device__ __forceinline__ float xmax32(float v) { unsigned a = __builtin_bit_cast(unsigned, v), b = a; asm volatile("" : "+v"(b));
    auto r = __builtin_amdgcn_permlane32_swap(a, b, false, false); const unsigned r0 = r[0], r1 = r[1]; return fmaxf(__uint_as_float(r0), __uint_as_float(r1)); }
__device__ __forceinline__ float wave_sum(float v) { v = xadd<1>(v); v = xadd<2>(v); v = xadd<4>(v); v = xadd<8>(v); v = xadd<16>(v); return xadd<32>(v); }
__device__ __forceinline__ float fast_exp2(float x) { return __builtin_amdgcn_exp2f(x); }
__device__ __forceinline__ float fast_rcp(float x) { return __builtin_amdgcn_rcpf(x); }
__device__ __forceinline__ float sigmoidf_(float x) { return fast_rcp(1.f + fast_exp2(-x * LOG2E)); }
__device__ __forceinline__ int lane_id() { return (int)__builtin_amdgcn_mbcnt_hi(~0u, __builtin_amdgcn_mbcnt_lo(~0u, 0u)); }
__device__ __forceinline__ void glds16(const void* gsrc, unsigned lds_dst) { unsigned keep;
    asm volatile("s_mov_b32 %0, m0\n\ts_mov_b32 m0, %2\n\ts_nop 0\n\tglobal_load_lds_dwordx4 %1, off\n\ts_mov_b32 m0, %0" : "=&s"(keep) : "v"(gsrc), "s"(lds_dst) : "memory"); }
__device__ __forceinline__ const char* uniform_ptr(const char* p) { const unsigned long long v = (unsigned long long)(uintptr_t)p; const unsigned lo = (unsigned)__builtin_amdgcn_readfirstlane((int)(unsigned)v), hi = (unsigned)__builtin_amdgcn_readfirstlane((int)(unsigned)(v >> 32)); return (const char*)(uintptr_t)(((unsigned long long)hi << 32) | lo); }
__device__ __forceinline__ void glds16_sv(const void* sbase, unsigned voff, unsigned lds_dst) { unsigned keep;
    asm volatile("s_mov_b32 %0, m0\n\ts_mov_b32 m0, %3\n\ts_nop 0\n\tglobal_load_lds_dwordx4 %1, %2\n\ts_mov_b32 m0, %0" : "=&s"(keep) : "v"(voff), "s"(sbase), "s"(lds_dst) : "memory"); }
#define LDS_WAIT() asm volatile("s_waitcnt lgkmcnt(0)" ::: "memory")
#define VM_WAIT() asm volatile("s_waitcnt vmcnt(0)" ::: "memory")

#define XB_TMO      128
#define XB_XCNT(j)  (256  + 64 * (j))
#define XB_XSUB(j)  (1280 + 64 * (j))
#define XB_XGEN(j)  (2304 + 64 * (j))
#define XB_TOP      3328
#define XB_TOPGEN   3392
#define XCD_BAR_WORDS 3456
#define XB_SPIN_CAP (1u << 18)
__device__ __forceinline__ unsigned xb_ld(unsigned* p)              { return __hip_atomic_load(p, __ATOMIC_RELAXED, __HIP_MEMORY_SCOPE_AGENT); }
__device__ __forceinline__ unsigned xb_add(unsigned* p, unsigned v) { return __hip_atomic_fetch_add(p, v, __ATOMIC_RELAXED, __HIP_MEMORY_SCOPE_AGENT); }
__device__ __forceinline__ unsigned xb_xcc_id() { return (unsigned)__builtin_amdgcn_s_getreg((3 << 11) | 20) & 0xFu; }
#define XB_SPIN(cond, bar) do { unsigned _sp = 0; while (cond) { __builtin_amdgcn_s_sleep(1); \
    if ((++_sp & 255u) == 0u) { if (xb_ld(&(bar)[XB_TMO])) break; if (_sp > XB_SPIN_CAP) { atomicAdd(&(bar)[XB_TMO], 1u); break; } } } } while (0)
struct XcdBarrier { unsigned* bar; unsigned x; volatile LAS unsigned* st; int wave; };
__device__ __forceinline__ XcdBarrier xcd_barrier_post(unsigned* bar, volatile LAS unsigned* st, int wave) {
    XcdBarrier b; b.bar = bar; b.x = xb_xcc_id(); b.st = st; b.wave = wave;
    if (wave == 0 && lane_id() == 0) (void)xb_add(&bar[XB_XCNT(b.x)], 1u);
    return b;
}
__device__ __forceinline__ void xcd_barrier_complete(unsigned* bar, unsigned x, unsigned& nloc, unsigned& nx) {
    const unsigned G = gridDim.x * gridDim.y * gridDim.z;
    unsigned sum, cnt, mine, sp = 0u;
    for (;;) {
        sum = 0u; cnt = 0u; mine = 0u;
#pragma unroll
        for (unsigned j = 0; j < 16; ++j) { const unsigned c = xb_ld(&bar[XB_XCNT(j)]); sum += c; cnt += (c > 0u) ? 1u : 0u; }
        mine = xb_ld(&bar[XB_XCNT(x)]);
        if (sum == G) break;
        __builtin_amdgcn_s_sleep(1);
        if ((++sp & 255u) == 0u) { if (xb_ld(&bar[XB_TMO])) break; if (sp > XB_SPIN_CAP) { atomicAdd(&bar[XB_TMO], 1u); break; } }
    }
    nloc = mine > 0u ? mine : 1u; nx = cnt > 0u ? cnt : 1u;
}
__device__ __forceinline__ void xcd_barrier(const XcdBarrier& b) {
    asm volatile("s_waitcnt vmcnt(0)" ::: "memory");
    __syncthreads();
    if (b.wave == 0 && lane_id() == 0) {
        unsigned* bar = b.bar; asm volatile("" : "+s"(bar));
        __builtin_amdgcn_s_waitcnt(0);
        unsigned nloc = b.st[0], nx = b.st[1];
        if (nloc == 0u) { xcd_barrier_complete(bar, b.x, nloc, nx); b.st[0] = nloc; b.st[1] = nx; }
        const unsigned old = xb_add(&bar[XB_XSUB(b.x)], 1u);
        const unsigned gen = old / nloc;
        if (old + 1u == (gen + 1u) * nloc) {
            __builtin_amdgcn_fence(__ATOMIC_RELEASE, "agent");
            asm volatile("s_waitcnt vmcnt(0)" ::: "memory");
            const unsigned og = xb_add(&bar[XB_TOP], 1u);
            const unsigned tg = og / nx;
            if (og + 1u == (tg + 1u) * nx) xb_add(&bar[XB_TOPGEN], 1u);
            else XB_SPIN(xb_ld(&bar[XB_TOPGEN]) == tg, bar);
            __builtin_amdgcn_fence(__ATOMIC_ACQUIRE, "agent");
            xb_add(&bar[XB_XGEN(b.x)], 1u);
            asm volatile("s_waitcnt vmcnt(0)" ::: "memory");
        } else {
            XB_SPIN(xb_ld(&bar[XB_XGEN(b.x)]) == gen, bar);
            __builtin_amdgcn_fence(__ATOMIC_ACQUIRE, "agent");
            asm volatile("s_waitcnt vmcnt(0)" ::: "memory");
        }
    }
    __syncthreads();
}

namespace pg8 {
constexpr int BM = 256, BK = 64, HALF = 128, HTB = HALF * BK * 2, STAGE_BYTES = 8 * HTB;
__host__ __device__ __forceinline__ int lds_byte(int r, int c) { const int st = (r >> 4) * 2 + (c >> 5), rr = r & 15, cc = c & 31, ob = rr * 64 + cc * 2; return st * 1024 + (ob ^ (((ob >> 9) & 1) << 5)); }
__host__ __device__ __forceinline__ void stage_rc(int b, int& R, int& C) { const int st = b / 1024, sb = b % 1024, swz = sb ^ (((sb >> 9) & 1) << 5); R = (st >> 1) * 16 + swz / 64; C = (st & 1) * 32 + (swz % 64) / 2; }
__host__ __device__ __forceinline__ int perm32(int rho) { const int n = rho >> 4, i = rho & 15; return 8 * (i >> 2) + 4 * n + (i & 3); }
struct Unit { int pm, pn, aux; };
__device__ __forceinline__ void tile_order(int L, int nM, int nN, int& pm, int& pn) {
    const int nwg = nM * nN; int wgid = L; { const int q = nwg / 8, r = nwg % 8, xcd = wgid % 8, off = wgid / 8; wgid = (xcd < r ? xcd * (q + 1) : r * (q + 1) + (xcd - r) * q) + off; }
    const int nig = 8 * nN, gid = wgid / nig, fm = gid * 8, gsz = (nM - fm) < 8 ? (nM - fm) : 8;
    pm = fm + ((wgid % nig) % gsz); pn = (wgid % nig) / gsz;
}
typedef int i32x8 __attribute__((ext_vector_type(8)));
typedef int i32x4 __attribute__((ext_vector_type(4)));
struct Frag2 { bf16x8 k[2]; };
template <bool F8> struct FragT { typedef Frag2 type; };
template <> struct FragT<true> { typedef i32x8 type; };
__device__ __forceinline__ void frag_set(Frag2& f, int k, i32x4 v) { f.k[k] = __builtin_bit_cast(bf16x8, v); }
__device__ __forceinline__ void frag_set(i32x8& f, int k, i32x4 v) { if (k == 0) { f[0] = v[0]; f[1] = v[1]; f[2] = v[2]; f[3] = v[3]; } else { f[4] = v[0]; f[5] = v[1]; f[6] = v[2]; f[7] = v[3]; } }
__device__ __forceinline__ f32x4 mma1(const Frag2& w, const Frag2& x, f32x4 c, int, int) { c = __builtin_amdgcn_mfma_f32_16x16x32_bf16(w.k[0], x.k[0], c, 0, 0, 0); return __builtin_amdgcn_mfma_f32_16x16x32_bf16(w.k[1], x.k[1], c, 0, 0, 0); }
#ifndef FP8_ASM_MMA
#define FP8_ASM_MMA 1
#endif
__device__ __forceinline__ f32x4 mma1(const i32x8& w, const i32x8& x, f32x4 c, int sw, int sx) {
#if FP8_ASM_MMA
    asm volatile("v_mfma_scale_f32_16x16x128_f8f6f4 %0, %1, %2, %0, %3, %4 op_sel_hi:[0,0,0]" : "+v"(c) : "v"(w), "v"(x), "v"(sw), "v"(sx));
    return c;
#else
    return __builtin_amdgcn_mfma_scale_f32_16x16x128_f8f6f4(w, x, c, 0, 0, 0, sw, 0, sx);
#endif
}
template <class Epi, class Sched, bool GATHER, bool FP8 = false, int SW = 0x7f7f7f7f, int SX = 0x7f7f7f7f>
__device__ __forceinline__ void gemm_phase(LAS unsigned char* lds, const int tid, const int kb, const int lda, const int ldb, const Sched& S, const Epi& E) {
    const int wid = __builtin_amdgcn_readfirstlane(tid >> 6), lane = tid & 63, wr = wid >> 2, wc = wid & 3, fr = lane & 15, fq = lane >> 4;
    const int nt = kb / 128;
    int sR[2], sC[2]; unsigned voffB[2];
#pragma unroll
    for (int i = 0; i < 2; ++i) { int R, C; stage_rc(tid * 16 + i * 8192, R, C); sR[i] = R; sC[i] = C; const int Rb = Epi::PERM ? ((R & ~31) + perm32(R & 31)) : R; voffB[i] = (unsigned)(Rb * ldb + C * 2); }
    const size_t kstep = (size_t)(BK * 2);
    const size_t hstepB = (size_t)HALF * ldb;
    const unsigned ldsw = (unsigned)wid * 1024u; const unsigned ldsb_ = (unsigned)(uintptr_t)lds;
    const int aoff = lds_byte(wr * 64 + fr, fq * 8), boff = lds_byte(wc * 32 + fr, fq * 8);
#define PG8_SA(b, h) (((b) * 2 + (h)) * HTB)
#define PG8_SB(b, h) ((4 + (b) * 2 + (h)) * HTB)
#define PG8_STAGE_B(bufoff, gbase) do { _Pragma("unroll") for (int _i = 0; _i < 2; ++_i) \
        glds16_sv((const void*)(gbase), voffB[_i], (unsigned)__builtin_amdgcn_readfirstlane((int)(ldsb_ + (bufoff) + ldsw + _i * 8192))); } while (0)
#define PG8_STAGE_A(bufoff, gbase, off) do { _Pragma("unroll") for (int _i = 0; _i < 2; ++_i) \
        glds16_sv((const void*)(gbase), (off)[_i], (unsigned)__builtin_amdgcn_readfirstlane((int)(ldsb_ + (bufoff) + ldsw + _i * 8192))); } while (0)
#define PG8_LDA(dst, b, h) do { _Pragma("unroll") for (int m = 0; m < 4; ++m) _Pragma("unroll") for (int k = 0; k < 2; ++k) frag_set(dst[m], k, *(const LAS i32x4*)(lds + PG8_SA(b, h) + aoff + m * 2048 + k * 1024)); } while (0)
#define PG8_LDB(dst, b, h) do { _Pragma("unroll") for (int n = 0; n < 2; ++n) _Pragma("unroll") for (int k = 0; k < 2; ++k) frag_set(dst[n], k, *(const LAS i32x4*)(lds + PG8_SB(b, h) + boff + n * 2048 + k * 1024)); } while (0)
#define PG8_MMA(ai, bj, At, Bt) do { __builtin_amdgcn_s_setprio(1); _Pragma("unroll") for (int m = 0; m < 4; ++m) _Pragma("unroll") for (int n = 0; n < 2; ++n) { \
        acc[ai][bj][m][n] = mma1(Bt[n], At[m], acc[ai][bj][m][n], SW, SX); } \
        __builtin_amdgcn_s_setprio(0); } while (0)
#define PG8_WAIT_V(n) asm volatile("s_waitcnt vmcnt(" #n ")" ::: "memory")
#define PG8_WAIT_L(n) asm volatile("s_waitcnt lgkmcnt(" #n ")" ::: "memory")
#define PG8_BAR __builtin_amdgcn_s_barrier()
#define PG8_SCHED __builtin_amdgcn_sched_barrier(0)
#define PG8_OFFS(dst, u) do { _Pragma("unroll") for (int _h = 0; _h < 2; ++_h) _Pragma("unroll") for (int _i = 0; _i < 2; ++_i) { \
        const int _r = sR[_i] + _h * HALF; const int _row = GATHER ? S.arow(u, _r) : _r; dst[_h][_i] = (unsigned)(_row * lda + sC[_i] * 2); } } while (0)
    Unit cur, nxt; int ui = 0;
    if (!S.next(0, cur)) return;
    f32x4 acc[2][2][4][2];
#pragma unroll
    for (int a = 0; a < 2; ++a)
#pragma unroll
        for (int b = 0; b < 2; ++b)
#pragma unroll
            for (int m = 0; m < 4; ++m)
#pragma unroll
                for (int n = 0; n < 2; ++n) acc[a][b][m][n] = (f32x4){0.f, 0.f, 0.f, 0.f};
    typedef typename FragT<FP8>::type frag_t;
    frag_t At[4], B0[2], B1[2];
    const char* cA; const char* cB; S.ptrs(cur, cA, cB); cA = uniform_ptr(cA); cB = uniform_ptr(cB);
    asm volatile("s_nop 4" ::: "memory");
    unsigned offC[2][2], offN[2][2];
    PG8_OFFS(offC, cur);
    PG8_STAGE_B(PG8_SB(0, 0), cB); PG8_STAGE_B(PG8_SB(0, 1), cB + hstepB); PG8_STAGE_A(PG8_SA(0, 0), cA, offC[0]); PG8_STAGE_A(PG8_SA(0, 1), cA, offC[1]);
    if (wr == 1) PG8_BAR;
    PG8_WAIT_V(2); PG8_BAR;
    PG8_STAGE_B(PG8_SB(1, 0), cB + kstep); PG8_STAGE_A(PG8_SA(1, 0), cA + kstep, offC[0]); PG8_STAGE_B(PG8_SB(1, 1), cB + hstepB + kstep);
    PG8_WAIT_V(6); PG8_BAR;
    for (;;) {
        const bool has_next = S.next(ui + 1, nxt);
        const char* nA = cA; const char* nB = cB;
        if (has_next) { S.ptrs(nxt, nA, nB); nA = uniform_ptr(nA); nB = uniform_ptr(nB); asm volatile("s_nop 4" ::: "memory"); PG8_OFFS(offN, nxt); }
        else {
#pragma unroll
            for (int h = 0; h < 2; ++h)
#pragma unroll
                for (int i = 0; i < 2; ++i) offN[h][i] = offC[h][i];
        }
#pragma unroll 1
        for (int tsec = 0; tsec < nt; tsec += (Epi::MID ? 4 : nt)) {
        if constexpr (Epi::MID) { if (tsec != 0) { unsigned z_ = 0u; asm volatile("" : "+v"(z_)); const int l2_ = (int)__builtin_amdgcn_mbcnt_hi(~0u, __builtin_amdgcn_mbcnt_lo(~0u, z_)); E.mid(acc, cur, tsec >> 2, wr, wc, l2_ & 15, l2_ >> 4); } }
#pragma unroll 1
        for (int t = tsec; t < tsec + (Epi::MID ? 4 : nt); t += 2) {
            const bool last = (t == nt - 2);
            const char* a1 = cA + (size_t)(t + 1) * kstep;
            const char* a2 = last ? nA : cA + (size_t)(t + 2) * kstep; const char* b2 = last ? nB : cB + (size_t)(t + 2) * kstep;
            const char* a3 = a2 + kstep; const char* b3 = b2 + kstep;
            unsigned o2[2][2];
#pragma unroll
            for (int h = 0; h < 2; ++h)
#pragma unroll
                for (int i = 0; i < 2; ++i) o2[h][i] = last ? offN[h][i] : offC[h][i];
            PG8_LDB(B0, 0, 0); PG8_LDB(B1, 0, 1); PG8_SCHED; PG8_LDA(At, 0, 0); PG8_STAGE_A(PG8_SA(1, 1), a1, offC[1]);
            PG8_WAIT_V(8); PG8_WAIT_L(0); PG8_BAR; PG8_MMA(0, 0, At, B0); PG8_MMA(0, 1, At, B1); PG8_BAR; PG8_SCHED;
            PG8_LDA(At, 0, 1); PG8_STAGE_B(PG8_SB(0, 0), b2); PG8_STAGE_B(PG8_SB(0, 1), b2 + hstepB); PG8_STAGE_A(PG8_SA(0, 0), a2, o2[0]);
            PG8_WAIT_V(8); PG8_WAIT_L(0); PG8_BAR; PG8_MMA(1, 0, At, B0); PG8_MMA(1, 1, At, B1); PG8_BAR; PG8_SCHED;
            PG8_LDB(B0, 1, 0); PG8_LDB(B1, 1, 1); PG8_SCHED; PG8_LDA(At, 1, 0); PG8_STAGE_A(PG8_SA(0, 1), a2, o2[1]);
            PG8_WAIT_V(8); PG8_WAIT_L(0); PG8_BAR; PG8_MMA(0, 0, At, B0); PG8_MMA(0, 1, At, B1); PG8_BAR; PG8_SCHED;
            PG8_LDA(At, 1, 1); PG8_STAGE_B(PG8_SB(1, 0), b3); PG8_STAGE_B(PG8_SB(1, 1), b3 + hstepB); PG8_STAGE_A(PG8_SA(1, 0), a3, o2[0]);
            PG8_WAIT_V(8); PG8_WAIT_L(0); PG8_BAR; PG8_MMA(1, 0, At, B0); PG8_MMA(1, 1, At, B1); PG8_BAR; PG8_SCHED;
        }
        }
        if (wr == 0) PG8_BAR;
        if constexpr (FP8) asm volatile("s_nop 15\n\ts_nop 7" ::: "memory");
        { unsigned z_ = 0u; asm volatile("" : "+v"(z_)); const int l2_ = (int)__builtin_amdgcn_mbcnt_hi(~0u, __builtin_amdgcn_mbcnt_lo(~0u, z_)); E(acc, cur, wr, wc, l2_ & 15, l2_ >> 4); }
        if (!has_next) break;
        if (S.fresh(nxt)) {
#pragma unroll
            for (int a = 0; a < 2; ++a)
#pragma unroll
                for (int b = 0; b < 2; ++b)
#pragma unroll
                    for (int m = 0; m < 4; ++m)
#pragma unroll
                        for (int n = 0; n < 2; ++n) acc[a][b][m][n] = (f32x4){0.f, 0.f, 0.f, 0.f};
        }
        cur = nxt; cA = nA; cB = nB; ++ui;
#pragma unroll
        for (int h = 0; h < 2; ++h)
#pragma unroll
            for (int i = 0; i < 2; ++i) offC[h][i] = offN[h][i];
        if (wr == 1) PG8_BAR;
    }
    PG8_WAIT_V(0);
    PG8_BAR;
#undef PG8_SA
#undef PG8_SB
#undef PG8_STAGE_A
#undef PG8_STAGE_B
#undef PG8_LDA
#undef PG8_LDB
#undef PG8_MMA
#undef PG8_WAIT_V
#undef PG8_WAIT_L
#undef PG8_BAR
#undef PG8_SCHED
#undef PG8_OFFS
}
}

struct Args { const float* in[26]; float* out; unsigned char* ws; int ph_lo, ph_hi; };
typedef const __attribute__((address_space(4))) Args* KArgs;
enum { I_X = 0, I_C, I_CTX, I_CCTX, I_WADA, I_BADA, I_N1G, I_N2G, I_WIN, I_WGATE, I_WBR, I_WOUT, I_DECAY, I_QNG, I_WUQ, I_KVNG, I_WUKV, I_GQN, I_GKN, I_SINK, I_WR, I_BR, I_W1, I_W3, I_W2, I_FNG };
constexpr int NWAVES = 8, NTHREADS = 512;

struct CvtDesc { const float* src; const float* kscale; bf16_t* dst; int N, k0, n0, Kd, nvalid, rmap, fp8; };
__device__ __forceinline__ void cvt_load(const CvtDesc& d, int lane, f32x4 (&v)[16]) {
    const int kk = lane >> 4, n4 = lane & 15, ncol = d.n0 + 4 * n4;
#pragma unroll
    for (int j = 0; j < 16; ++j) {
        const int k = d.k0 + 16 * kk + j;
        v[j] = (4 * n4 < d.nvalid) ? __builtin_nontemporal_load((const GAS f32x4*)(d.src + (size_t)k * d.N + ncol)) : (f32x4){0.f, 0.f, 0.f, 0.f};
    }
}
__device__ __forceinline__ void cvt_store(const CvtDesc& d, f32x4 (&v)[16], LAS unsigned char* scr, int lane) {
    const int kk = lane >> 4, n4 = lane & 15;
    if (d.kscale) {
#pragma unroll
        for (int j = 0; j < 16; ++j) v[j] = v[j] * d.kscale[d.k0 + 16 * kk + j];
    }
    if (d.fp8) {
#pragma unroll
        for (int i = 0; i < 4; ++i) { u32x4 w;
            w.x = pk4_fp8(32.f * v[0][i], 32.f * v[1][i], 32.f * v[2][i], 32.f * v[3][i]); w.y = pk4_fp8(32.f * v[4][i], 32.f * v[5][i], 32.f * v[6][i], 32.f * v[7][i]);
            w.z = pk4_fp8(32.f * v[8][i], 32.f * v[9][i], 32.f * v[10][i], 32.f * v[11][i]); w.w = pk4_fp8(32.f * v[12][i], 32.f * v[13][i], 32.f * v[14][i], 32.f * v[15][i]);
            *(LAS u32x4*)(scr + (4 * n4 + i) * 80 + 16 * kk) = w; }
        LDS_WAIT(); asm volatile("" ::: "memory");
        const int c = lane & 3;
#pragma unroll
        for (int jj = 0; jj < 4; ++jj) {
            const int n = (lane >> 2) + 16 * jj;
            const u32x4 o = *(const LAS u32x4*)(scr + n * 80 + 16 * c);
            const int prow = d.rmap == 0 ? n : (d.rmap == 1 ? (n & 31) + 128 * (n >> 5) : 32 * (n >> 4) + 8 * ((n >> 2) & 3) + (n & 3));
            *(GAS u32x4*)((unsigned char*)d.dst + (size_t)prow * d.Kd + d.k0 + 16 * c) = o;
        }
        LDS_WAIT(); asm volatile("" ::: "memory");
        return;
    }
#pragma unroll
    for (int i = 0; i < 4; ++i) { u32x4 w0, w1;
        w0.x = pk2(v[0][i], v[1][i]); w0.y = pk2(v[2][i], v[3][i]); w0.z = pk2(v[4][i], v[5][i]); w0.w = pk2(v[6][i], v[7][i]);
        w1.x = pk2(v[8][i], v[9][i]); w1.y = pk2(v[10][i], v[11][i]); w1.z = pk2(v[12][i], v[13][i]); w1.w = pk2(v[14][i], v[15][i]);
        *(LAS u32x4*)(scr + (4 * n4 + i) * 144 + 32 * kk) = w0; *(LAS u32x4*)(scr + (4 * n4 + i) * 144 + 32 * kk + 16) = w1; }
    LDS_WAIT(); asm volatile("" ::: "memory");
    const int c = lane & 7;
#pragma unroll
    for (int jj = 0; jj < 8; ++jj) {
        const int n = (lane >> 3) + 8 * jj;
        const u32x4 o = *(const LAS u32x4*)(scr + n * 144 + 16 * c);
        const int prow = d.rmap == 0 ? n : (d.rmap == 1 ? (n & 31) + 128 * (n >> 5) : 32 * (n >> 4) + 8 * ((n >> 2) & 3) + (n & 3));
        *(GAS u32x4*)(d.dst + (size_t)prow * d.Kd + d.k0 + 8 * c) = o;
    }
    LDS_WAIT(); asm volatile("" ::: "memory");
}
constexpr int CV_EXP_ITEMS = 2 * 32 * 3 * 256;
constexpr int CV_IN = 16 * 40, CV_GT = 16 * 64, CV_BRN = 4 * 16, CV_OUT = 16 * 16, CV_UQ = 4 * 6, CV_UKV = 2 * 8;
constexpr int CV_PER_L = CV_IN + CV_GT + 4 * CV_BRN + CV_OUT + CV_UQ + CV_UKV;
constexpr int CV_NITEMS = CV_EXP_ITEMS + 2 * CV_PER_L;
constexpr int CV_E0_SHARE = 14592;
__device__ __forceinline__ void cvt_decode(KArgs a, unsigned char* ws, int it, CvtDesc& d) {
    d.kscale = nullptr; d.N = 1024; d.Kd = 1024; d.nvalid = 64; d.rmap = 0; d.fp8 = 0;
    if (it < CV_EXP_ITEMS) {
        d.fp8 = 1;
        const int j = it >> 8, r = it & 255, l = j / 96, jj = j % 96, e = jj / 3, kind = jj % 3, kb = r >> 4, nb = r & 15;
        const size_t eo = ((size_t)l * 32 + e) * 1048576;
        d.k0 = kb * 64; d.n0 = nb * 64;
        if (kind < 2) { d.src = (kind == 0 ? a->in[I_W1] : a->in[I_W3]) + eo;
            d.dst = (bf16_t*)(ws + WS_W13 + ((size_t)l * 32 + e) * 2097152 + (size_t)(256 * (nb >> 1) + 128 * kind + 64 * (nb & 1)) * 1024); }
        else { d.src = a->in[I_W2] + eo; d.dst = (bf16_t*)(ws + WS_W2 + eo + (size_t)(nb * 64) * 1024); }
        return;
    }
    int r = it - CV_EXP_ITEMS; const int l = r / CV_PER_L; r -= l * CV_PER_L;
    if (r < CV_IN) {
        const int kb = r / 40, hb = r % 40, t = hb >> 2, wc = hb & 3; int src0 = -1, nv = 64;
        if (t < 5) src0 = 256 * t + 64 * wc;
        else if (t == 5) { if (wc < 2) src0 = 1280 + 64 * wc; else if (wc == 2) { src0 = 1408; nv = 32; } }
        else if (t == 6) src0 = P_GQA + 64 * wc;
        else if (t == 7) src0 = wc < 2 ? P_GQA + 256 + 64 * wc : P_GQA + 384 + 64 * (wc - 2);
        else if (t == 8) src0 = P_WIN + 64 * wc;
        else src0 = wc < 2 ? P_WIN + 256 + 64 * wc : P_WIN + 384 + 64 * (wc - 2);
        d.src = a->in[I_WIN] + (size_t)l * 1024 * NIN; d.N = NIN; d.k0 = kb * 64; d.n0 = src0 < 0 ? 0 : src0; d.nvalid = src0 < 0 ? 0 : nv; d.rmap = 1;
        d.fp8 = 1; d.dst = (bf16_t*)(ws + WS_WIN + ((size_t)l * NBG + 256 * t + 32 * wc) * 1024); return; } r -= CV_IN;
    if (r < CV_GT) {
        const int kb = r >> 6, nb = r & 63, i = nb >> 4, tg = nb & 15;
        d.src = a->in[I_WGATE] + (size_t)l * 1024 * 4096; d.N = 4096; d.k0 = kb * 64; d.n0 = i * 1024 + 64 * tg; d.rmap = 2;
        d.fp8 = 1; d.dst = (bf16_t*)(ws + WS_WIN + ((size_t)l * NBG + NINP + 256 * tg + 128 * (i >> 1) + 4 * (i & 1)) * 1024); return; } r -= CV_GT;
    if (r < 4 * CV_BRN) { const int i = r / CV_BRN, rr = r % CV_BRN, kb = rr >> 4, nb = rr & 15; d.src = a->in[I_WBR] + ((size_t)l * 4 + i) * 256 * 1024; d.k0 = kb * 64; d.n0 = nb * 64;
        d.dst = (bf16_t*)(ws + WS_WBR) + ((size_t)l * 1024 + nb * 64) * 1024 + 256 * i; return; } r -= 4 * CV_BRN;
    if (r < CV_OUT) { const int kb = r >> 4, nb = r & 15; d.src = a->in[I_WOUT] + (size_t)l * 1048576; d.k0 = kb * 64; d.n0 = nb * 64; d.dst = (bf16_t*)(ws + WS_WOUT) + (size_t)l * 1048576 + (size_t)(nb * 64) * 1024; return; } r -= CV_OUT;
    if (r < CV_UQ) { const int kb = r / 6, nb = r % 6; d.src = a->in[I_WUQ] + (size_t)l * 256 * 384; d.N = 384; d.k0 = kb * 64; d.n0 = nb * 64; d.kscale = a->in[I_QNG] + l * 256; d.dst = (bf16_t*)(ws + WS_WSM) + ((size_t)l * 384 + nb * 64) * 256; d.Kd = 256; return; } r -= CV_UQ;
    { const int kb = r >> 3, nb = r & 7; d.src = a->in[I_WUKV] + (size_t)l * 128 * 512; d.N = 512; d.k0 = kb * 64; d.n0 = nb * 64; d.kscale = a->in[I_KVNG] + l * 128; d.dst = (bf16_t*)(ws + WS_WSM) + 2 * 384 * 256 + ((size_t)l * 512 + nb * 64) * 128; d.Kd = 128; }
}

__device__ __forceinline__ void cvt_run(KArgs a, unsigned char* ws, LAS unsigned char* lds, int lane, int wave, int first, int last, int start, int stride) {
    LAS unsigned char* scr = lds + 57344 + wave * 9216;
    int it = first + start;
    if (it < last) {
        CvtDesc dA, dB; f32x4 va[16], vb[16];
        cvt_decode(a, ws, it, dA); cvt_load(dA, lane, va);
        for (;;) {
            const int itB = it + stride; const bool hasB = itB < last;
            if (hasB) { cvt_decode(a, ws, itB, dB); cvt_load(dB, lane, vb); }
            cvt_store(dA, va, scr, lane);
            if (!hasB) break;
            const int itA = itB + stride; const bool hasA = itA < last;
            if (hasA) { cvt_decode(a, ws, itA, dA); cvt_load(dA, lane, va); }
            cvt_store(dB, vb, scr, lane);
            if (!hasA) break;
            it = itA;
        }
    }
}
__device__ __forceinline__ void p0_prologue(KArgs a, LAS unsigned char* lds, int tid, int lane, int wave, int G, int c) {
    unsigned char* ws = a->ws;
    if (c < 192) {
        LAS float* st = (LAS float*)lds;
        LAS float* red = (LAS float*)(lds + 36864);
        for (int idx = tid; idx < 9 * 1024; idx += NTHREADS) { const int r = idx >> 10, k = idx & 1023; const float v = r < 8 ? a->in[I_C][r * 1024 + k] : a->in[I_CCTX][k]; st[idx] = v / (1.f + __expf(-v)); }
        __syncthreads();
        const int l = c / 96, n0 = (c % 96) * 64;
        float acc[9];
#pragma unroll
        for (int r = 0; r < 9; ++r) acc[r] = 0.f;
        const float* wp = a->in[I_WADA] + ((size_t)l * 1024 + wave * 128) * 6144 + n0 + lane;
#pragma unroll 4
        for (int k = 0; k < 128; ++k) { const float wv = wp[(size_t)k * 6144];
#pragma unroll
            for (int r = 0; r < 9; ++r) acc[r] += st[r * 1024 + wave * 128 + k] * wv; }
#pragma unroll
        for (int r = 0; r < 9; ++r) red[(wave * 9 + r) * 64 + lane] = acc[r];
        __syncthreads();
        for (int idx = tid; idx < 9 * 64; idx += NTHREADS) { const int r = idx >> 6, n = idx & 63; float s = 0.f;
#pragma unroll
            for (int w = 0; w < 8; ++w) s += red[(w * 9 + r) * 64 + n];
            ((float*)(ws + WS_ADA))[((size_t)l * 9 + r) * 6144 + n0 + n] = s + a->in[I_BADA][l * 6144 + n0 + n]; }
        __syncthreads();
    }
    const int gw = c * NWAVES + wave, NGW = G * NWAVES;
    {
        float* rope = (float*)(ws + WS_ROPE);
        for (int idx = gw * 64 + lane; idx < 2048 * 48; idx += NGW * 64) {
            const int pos = idx / 48, j = idx % 48, row = pos >> 6, col = pos & 63;
            if (j < 32) { const int i = j, f = i & 15; const float inv = powf(10000.f, -(float)f / 16.f); const float ang = (float)(i < 16 ? row : col) * inv;
                rope[pos * 32 + i] = cosf(ang); rope[2048 * 32 + pos * 32 + i] = sinf(ang); }
            else { const int i = j - 32, f = i & 7; const float inv = powf(10000.f, -(float)f / 8.f); const float ang = (float)(i < 8 ? row : col) * inv;
                rope[2 * 2048 * 32 + pos * 16 + i] = cosf(ang); rope[2 * 2048 * 32 + 2048 * 16 + pos * 16 + i] = sinf(ang); }
        }
        float* wrp = (float*)(ws + WS_WRP);
        for (int idx = gw * 64 + lane; idx < 32768; idx += NGW * 64) { const int half = idx >> 14, w = (idx >> 11) & 7, q = (idx >> 9) & 3, e = (idx >> 5) & 15, s = idx & 31;
            wrp[idx] = a->in[I_WR][(128 * w + 32 * q + s) * 32 + 16 * half + e]; }
    }
    cvt_run(a, ws, lds, lane, wave, 0, CV_EXP_ITEMS / 2, gw, NGW);
    cvt_run(a, ws, lds, lane, wave, CV_EXP_ITEMS, CV_NITEMS, gw, NGW);
}

__device__ __forceinline__ void moe_tables(const unsigned* ctl, int l, LAS unsigned char* lds, int tid) {
    LAS int* tb = (LAS int*)(lds + LDS_MISC + 1024); LAS int* cn = (LAS int*)(lds + LDS_MISC + 2304);
    __syncthreads();
    if (tid < 32) cn[tid] = (int)__hip_atomic_load(ctl + CW_CNT + l * 32 + tid, __ATOMIC_RELAXED, __HIP_MEMORY_SCOPE_AGENT);
    __syncthreads();
    if (tid == 0) { int s = 0; for (int e = 0; e < 32; ++e) { tb[e] = s; s += (cn[e] + 255) >> 8; } tb[32] = s; }
    __syncthreads();
    if (tid < MAXTILES) { LAS int* te = (LAS int*)(lds + LDS_MISC + 1024 + 48 * 4); int e = 0; for (int k = 1; k < 32; ++k) e += (tid >= tb[k]) ? 1 : 0; te[tid] = e | ((tid - tb[e]) << 8); }
    __syncthreads();
}

__device__ __forceinline__ void phase_rownorm(KArgs a, int mode, LAS unsigned char* lds, int lane, int wave, int G, int c) {
    unsigned char* ws = a->ws;
    const int gw = c * NWAVES + wave, NGW = G * NWAVES;
    const float* ada = (const float*)(ws + WS_ADA);
    float* X = (float*)(ws + WS_X);
    const LAS int* tb = (const LAS int*)(lds + LDS_MISC + 1024);
    const int nrows = (mode == 2) ? TL : TT;
    const int lprev = mode - 1, lcur = (mode == 2) ? 0 : mode;
    constexpr int R = 3;
    for (int base = gw; base < nrows; base += R * NGW) {
        f32x4 v[R][4]; int rows[R]; bool ok[R];
#pragma unroll
        for (int r = 0; r < R; ++r) { rows[r] = base + r * NGW; ok[r] = rows[r] < nrows; if (!ok[r]) rows[r] = base; }
#pragma unroll
        for (int r = 0; r < R; ++r) {
            const int row = rows[r];
            const float* src = (mode == 0) ? (row < TL ? a->in[I_X] + (size_t)row * 1024 : a->in[I_CTX] + (size_t)(row - TL) * 1024) : X + (size_t)row * 1024;
#pragma unroll
            for (int j = 0; j < 4; ++j) v[r][j] = *(const GAS f32x4*)(src + 4 * lane + 256 * j);
        }
        if (mode != 0) {
            const int* te = (const int*)(ws + WS_TOKE); const float* tw = (const float*)(ws + WS_TOKW);
            const bf16_t* Y2 = (const bf16_t*)(ws + WS_Y2);
            u32x2 y0[R][4], y1[R][4]; float w0[R], w1[R];
#pragma unroll
            for (int r = 0; r < R; ++r) {
                const int row = rows[r];
                const int e0 = te[row * 2], e1 = te[row * 2 + 1]; w0[r] = tw[row * 2]; w1[r] = tw[row * 2 + 1];
                const size_t s0 = (size_t)(tb[e0 >> 20] * 256 + (e0 & 0xfffff)), s1 = (size_t)(tb[e1 >> 20] * 256 + (e1 & 0xfffff));
#pragma unroll
                for (int j = 0; j < 4; ++j) { y0[r][j] = *(const GAS u32x2*)(Y2 + s0 * 1024 + 4 * lane + 256 * j); y1[r][j] = *(const GAS u32x2*)(Y2 + s1 * 1024 + 4 * lane + 256 * j); }
            }
#pragma unroll
            for (int r = 0; r < R; ++r) {
                const int row = rows[r]; const int b = row < TL ? (row >> 11) : 8;
                const float* g2 = ada + ((size_t)lprev * 9 + b) * 6144 + 5120;
#pragma unroll
                for (int j = 0; j < 4; ++j) {
                    const f32x4 gg = *(const GAS f32x4*)(g2 + 4 * lane + 256 * j);
                    f32x4 f; f.x = w0[r] * bflo(y0[r][j].x) + w1[r] * bflo(y1[r][j].x); f.y = w0[r] * bfhi(y0[r][j].x) + w1[r] * bfhi(y1[r][j].x);
                    f.z = w0[r] * bflo(y0[r][j].y) + w1[r] * bflo(y1[r][j].y); f.w = w0[r] * bfhi(y0[r][j].y) + w1[r] * bfhi(y1[r][j].y);
                    v[r][j] = v[r][j] + gg * f;
                }
                if (mode == 1 && ok[r]) {
#pragma unroll
                    for (int j = 0; j < 4; ++j) *(GAS f32x4*)(X + (size_t)row * 1024 + 4 * lane + 256 * j) = v[r][j];
                }
            }
        }
#pragma unroll
        for (int r = 0; r < R; ++r) {
            const int row = rows[r]; const int b = row < TL ? (row >> 11) : 8;
            float ss = 0.f;
#pragma unroll
            for (int j = 0; j < 4; ++j) ss += (v[r][j].x * v[r][j].x + v[r][j].y * v[r][j].y) + (v[r][j].z * v[r][j].z + v[r][j].w * v[r][j].w);
            const float rstd = 1.0f / sqrtf(wave_sum(ss) * (1.f / 1024.f) + EPS);
            if (ok[r]) {
                if (mode == 2) {
#pragma unroll
                    for (int j = 0; j < 4; ++j) { const f32x4 g = *(const GAS f32x4*)(a->in[I_FNG] + 4 * lane + 256 * j); *(GAS f32x4*)(a->out + (size_t)row * 1024 + 4 * lane + 256 * j) = v[r][j] * rstd * g; }
                } else {
                    const float* gn = a->in[I_N1G] + lcur * 1024; const float* sh = ada + ((size_t)lcur * 9 + b) * 6144; const float* sc = sh + 1024;
                    unsigned char* H = (unsigned char*)(ws + WS_H) + (size_t)row * 1024;
#pragma unroll
                    for (int j = 0; j < 4; ++j) { const int cc = 4 * lane + 256 * j; const f32x4 g = *(const GAS f32x4*)(gn + cc), s1 = *(const GAS f32x4*)(sc + cc), s0 = *(const GAS f32x4*)(sh + cc);
                        const f32x4 h = v[r][j] * rstd * g * (s1 + 1.0f) + s0; *(GAS unsigned*)(H + cc) = pk4_fp8(h.x, h.y, h.z, h.w); }
                }
            }
        }
    }
}

using pg8::Unit;
struct SchedB {
    int layer, G, c; const char* H; const char* W;
    __device__ __forceinline__ bool next(int i, Unit& u) const {
        const int L = i * G + c; u.aux = 0;
        if (layer == 0) { if (L >= 72 * 26) return false; pg8::tile_order(L, 72, 26, u.pm, u.pn); return true; }
        if (L < 64 * 16) { pg8::tile_order(L, 64, 16, u.pm, u.pn); u.pn += 10; return true; }
        const int L2 = L - 64 * 16; if (L2 >= 72 * 10) return false; pg8::tile_order(L2, 72, 10, u.pm, u.pn); return true;
    }
    __device__ __forceinline__ void ptrs(const Unit& u, const char*& A, const char*& B) const { A = H + (size_t)u.pm * 256 * 1024; B = W + (size_t)u.pn * 256 * 1024; }
    __device__ __forceinline__ int arow(const Unit&, int r) const { return r; }
    __device__ __forceinline__ bool fresh(const Unit&) const { return true; }
};
struct EpiB {
    static constexpr bool PERM = true, MID = false;
    bf16_t* P; bf16_t* Gt; bf16_t* Q; const float* cos64; const float* sin64; const float* qng; const float* kng;
    __device__ __forceinline__ void operator()(f32x4 (&acc)[2][2][4][2], const Unit& u, int wr, int wc, int fr, int fq) const {
        const int row0 = u.pm * 256 + wr * 64 + fr;
        if (u.pn >= 10) {
            const int d0 = (u.pn - 10) * 64 + 16 * wc + 4 * fq;
#pragma unroll
            for (int ai = 0; ai < 2; ++ai)
#pragma unroll
                for (int m = 0; m < 4; ++m) { bf16_t* gp = Gt + (size_t)(row0 + ai * 128 + m * 16) * NGATE + d0;
                    f32x4 g[4];
#pragma unroll
                    for (int i = 0; i < 4; ++i)
#pragma unroll
                        for (int j = 0; j < 4; ++j) g[i][j] = fmaxf(sigmoidf_(acc[ai][i >> 1][m][i & 1][j]), 1e-6f);
#pragma unroll
                    for (int i = 0; i < 4; ++i) { f32x4 r = g[i];
                        if (i < 3) {
#pragma unroll
                            for (int j = 0; j < 4; ++j) r[j] *= fast_rcp(g[i + 1][j]); }
                        u32x2 w; w.x = pk2(r[0], r[1]); w.y = pk2(r[2], r[3]); *(GAS u32x2*)(gp + i * 1024) = w; } }
            return;
        }
        const int t = u.pn;
        bf16_t* dst; size_t ld; int col; int mode = 0;
        float scale = 1.f; const float* gain = nullptr;
        if (t == 4) { dst = P; ld = NINP; col = P_MLA + 64 * wc; }
        else if (t == 5) { dst = P; ld = NINP; col = 1280 + 64 * wc; mode = wc < 3 ? 0 : 3; }
        else { dst = Q; ld = QP;
            if (t == 0) { col = Q_RETQ + 64 * wc; mode = 1; scale = 0.125f; }
            else if (t == 1) { col = Q_RETK + 64 * wc; mode = 1; }
            else if (t == 2) col = Q_RETV + 64 * wc;
            else if (t == 3) col = Q_RETG + 64 * wc;
            else if (t == 6) { col = Q_GQAQ + 64 * wc; mode = 2; scale = 0.125f * LOG2E; gain = qng; }
            else if (t == 7) { if (wc < 2) { col = Q_GQAK + 64 * wc; mode = 2; gain = kng; } else col = Q_GQAV + 64 * (wc - 2); }
            else if (t == 8) { col = Q_WINQ + 64 * wc; mode = 1; scale = 0.125f * LOG2E; }
            else { if (wc < 2) { col = Q_WINK + 64 * wc; mode = 1; } else col = Q_WINV + 64 * (wc - 2); } }
        if (mode == 3) return;
        f32x4 ga0 = {1.f, 1.f, 1.f, 1.f}, ga1 = ga0, gb0 = ga0, gb1 = ga0;
        if (mode == 2) { ga0 = *(const GAS f32x4*)(gain + 8 * fq); ga1 = *(const GAS f32x4*)(gain + 8 * fq + 4); gb0 = *(const GAS f32x4*)(gain + 32 + 8 * fq); gb1 = *(const GAS f32x4*)(gain + 32 + 8 * fq + 4); }
        const bool half_only = (t == 5 && wc == 2);
#pragma unroll
        for (int ai = 0; ai < 2; ++ai)
#pragma unroll
            for (int m = 0; m < 4; ++m) {
                const int row = row0 + ai * 128 + m * 16;
                f32x4 a0 = acc[ai][0][m][0], a1 = acc[ai][0][m][1], b0 = acc[ai][1][m][0], b1 = acc[ai][1][m][1];
                if (mode == 2) {
                    float ss = 0.f;
#pragma unroll
                    for (int j = 0; j < 4; ++j) ss += a0[j] * a0[j] + a1[j] * a1[j] + b0[j] * b0[j] + b1[j] * b1[j];
                    ss = xadd<16>(ss); ss = xadd<32>(ss);
                    const float rstd = __builtin_amdgcn_rsqf(ss * (1.f / 64.f) + EPS);
                    a0 = a0 * rstd * ga0; a1 = a1 * rstd * ga1; b0 = b0 * rstd * gb0; b1 = b1 * rstd * gb1;
                }
                if (mode >= 1) {
                    if (row < TL) { const int pos = row & 2047;
                        const f32x4 c0 = *(const GAS f32x4*)(cos64 + pos * 32 + 8 * fq), c1 = *(const GAS f32x4*)(cos64 + pos * 32 + 8 * fq + 4);
                        const f32x4 s0 = *(const GAS f32x4*)(sin64 + pos * 32 + 8 * fq), s1 = *(const GAS f32x4*)(sin64 + pos * 32 + 8 * fq + 4);
                        const f32x4 o0 = a0 * c0 - b0 * s0, o1 = a1 * c1 - b1 * s1, p0 = b0 * c0 + a0 * s0, p1 = b1 * c1 + a1 * s1;
                        a0 = o0; a1 = o1; b0 = p0; b1 = p1; }
                    a0 = a0 * scale; a1 = a1 * scale; b0 = b0 * scale; b1 = b1 * scale;
                }
                bf16_t* rp = dst + (size_t)row * ld + col + 8 * fq;
                u32x4 w; w.x = pk2(a0[0], a0[1]); w.y = pk2(a0[2], a0[3]); w.z = pk2(a1[0], a1[1]); w.w = pk2(a1[2], a1[3]);
                *(GAS u32x4*)rp = w;
                if (!half_only) { u32x4 w2; w2.x = pk2(b0[0], b0[1]); w2.y = pk2(b0[2], b0[3]); w2.z = pk2(b1[0], b1[1]); w2.w = pk2(b1[2], b1[3]); *(GAS u32x4*)(rp + 32) = w2; }
                asm volatile("" ::: "memory");
            }
    }
};
struct SchedE {
    int G, c, nM; const char* Y; const char* W;
    __device__ __forceinline__ bool next(int i, Unit& u) const { const int L = i * G + c; u.aux = 0; if (L >= nM * 4) return false; pg8::tile_order(L, nM, 4, u.pm, u.pn); return true; }
    __device__ __forceinline__ void ptrs(const Unit& u, const char*& A, const char*& B) const { A = Y + (size_t)u.pm * 256 * 1024 * 2; B = W + (size_t)u.pn * 256 * 1024 * 2; }
    __device__ __forceinline__ int arow(const Unit&, int r) const { return r; }
    __device__ __forceinline__ bool fresh(const Unit&) const { return true; }
};
struct EpiE {
    static constexpr bool PERM = true, MID = true;
    const bf16_t* Gt; bf16_t* M;
    __device__ __forceinline__ void mid(f32x4 (&acc)[2][2][4][2], const Unit& u, int i, int wr, int wc, int fr, int fq) const {
        const int row0 = u.pm * 256 + wr * 64 + fr;
        const int col0 = u.pn * 256 + wc * 32 + 8 * fq;
        const bf16_t* gp0 = Gt + (size_t)row0 * NGATE + (i - 1) * 1024 + col0;
        u32x4 g[2][4][2];
#pragma unroll
        for (int ai = 0; ai < 2; ++ai)
#pragma unroll
            for (int m = 0; m < 4; ++m)
#pragma unroll
                for (int bj = 0; bj < 2; ++bj) g[ai][m][bj] = *(const GAS u32x4*)(gp0 + (size_t)(ai * 128 + m * 16) * NGATE + bj * 128);
#pragma unroll
        for (int ai = 0; ai < 2; ++ai)
#pragma unroll
            for (int m = 0; m < 4; ++m)
#pragma unroll
                for (int bj = 0; bj < 2; ++bj) { const u32x4 gg = g[ai][m][bj];
                    const f32x4 s0 = {bflo(gg.x), bfhi(gg.x), bflo(gg.y), bfhi(gg.y)}, s1 = {bflo(gg.z), bfhi(gg.z), bflo(gg.w), bfhi(gg.w)};
                    acc[ai][bj][m][0] = acc[ai][bj][m][0] * s0; acc[ai][bj][m][1] = acc[ai][bj][m][1] * s1; }
    }
    __device__ __forceinline__ void operator()(f32x4 (&acc)[2][2][4][2], const Unit& u, int wr, int wc, int fr, int fq) const {
        const int row0 = u.pm * 256 + wr * 64 + fr, col0 = u.pn * 256 + wc * 32 + 8 * fq;
#pragma unroll
        for (int ai = 0; ai < 2; ++ai)
#pragma unroll
            for (int m = 0; m < 4; ++m) { const size_t row = (size_t)(row0 + ai * 128 + m * 16);
#pragma unroll
                for (int bj = 0; bj < 2; ++bj) {
                    const u32x4 g = *(const GAS u32x4*)(Gt + row * NGATE + 3 * 1024 + col0 + bj * 128);
                    const f32x4 s0 = {bflo(g.x), bfhi(g.x), bflo(g.y), bfhi(g.y)}, s1 = {bflo(g.z), bfhi(g.z), bflo(g.w), bfhi(g.w)};
                    const f32x4 v0 = acc[ai][bj][m][0] * s0, v1 = acc[ai][bj][m][1] * s1;
                    u32x4 w; w.x = pk2(v0[0], v0[1]); w.y = pk2(v0[2], v0[3]); w.z = pk2(v1[0], v1[1]); w.w = pk2(v1[2], v1[3]);
                    *(GAS u32x4*)(M + row * 1024 + col0 + bj * 128) = w;
                } }
    }
};
struct SchedF {
    int G, c, nM; const char* A0; const char* W;
    __device__ __forceinline__ bool next(int i, Unit& u) const { const int L = i * G + c; u.aux = 0; if (L >= nM * 4) return false; pg8::tile_order(L, nM, 4, u.pm, u.pn); return true; }
    __device__ __forceinline__ void ptrs(const Unit& u, const char*& A, const char*& B) const { A = A0 + (size_t)u.pm * 256 * 1024 * 2; B = W + (size_t)u.pn * 256 * 1024 * 2; }
    __device__ __forceinline__ int arow(const Unit&, int r) const { return r; }
    __device__ __forceinline__ bool fresh(const Unit&) const { return true; }
};
struct EpiF {
    static constexpr bool PERM = false, MID = false;
    const float* xin; const float* cin; const float* Xs; float* X; const float* ada_l; int layer;
    __device__ __forceinline__ void operator()(f32x4 (&acc)[2][2][4][2], const Unit& u, int wr, int wc, int fr, int fq) const {
        const int row0 = u.pm * 256 + wr * 64 + fr, col0 = u.pn * 256 + wc * 32 + 4 * fq;
#pragma unroll
        for (int ai = 0; ai < 2; ++ai)
#pragma unroll
            for (int m = 0; m < 4; ++m) { const int row = row0 + ai * 128 + m * 16; const int b = row < TL ? (row >> 11) : 8;
                const float* src = (layer == 0) ? (row < TL ? xin + (size_t)row * 1024 : cin + (size_t)(row - TL) * 1024) : Xs + (size_t)row * 1024;
                const float* g1 = ada_l + (size_t)b * 6144 + 2048;
#pragma unroll
                for (int bj = 0; bj < 2; ++bj)
#pragma unroll
                    for (int n = 0; n < 2; ++n) { const int c = col0 + bj * 128 + n * 16;
                        const f32x4 xs = *(const GAS f32x4*)(src + c), gg = *(const GAS f32x4*)(g1 + c);
                        *(GAS f32x4*)(X + (size_t)row * 1024 + c) = xs + gg * acc[ai][bj][m][n]; } }
    }
};
struct SchedMoe {
    int G, c, npn, gather; const LAS int* tb; const LAS int* cn; const int* tokinv; const char* A0; const char* W; size_t wstride;
    __device__ __forceinline__ bool next(int i, Unit& u) const {
        const int L = i * G + c; if (L >= __builtin_amdgcn_readfirstlane(tb[32]) * npn) return false;
        const int rt = L / npn; u.pm = rt; u.pn = L - rt * npn; u.aux = __builtin_amdgcn_readfirstlane(tb[48 + rt]); return true;
    }
    __device__ __forceinline__ void ptrs(const Unit& u, const char*& A, const char*& B) const {
        A = gather ? A0 : A0 + (size_t)u.pm * 256 * 1024; B = W + (size_t)(u.aux & 255) * wstride + (size_t)u.pn * 256 * 1024; }
    __device__ __forceinline__ int arow(const Unit& u, int r) const { const int e = u.aux & 255, idx = (u.aux >> 8) * 256 + r; return idx < cn[e] ? tokinv[(size_t)e * TT + idx] : 0; }
    __device__ __forceinline__ bool fresh(const Unit&) const { return true; }
};
struct EpiH {
    static constexpr bool PERM = true, MID = false;
    unsigned char* HID;
    __device__ __forceinline__ void operator()(f32x4 (&acc)[2][2][4][2], const Unit& u, int wr, int wc, int fr, int fq) const {
        const int row0 = u.pm * 256 + wr * 64 + fr, col0 = u.pn * 128 + wc * 32 + 8 * fq;
#pragma unroll
        for (int ai = 0; ai < 2; ++ai)
#pragma unroll
            for (int m = 0; m < 4; ++m) { f32x4 h0, h1;
#pragma unroll
                for (int j = 0; j < 4; ++j) { const float a0 = acc[ai][0][m][0][j], a1 = acc[ai][0][m][1][j];
                    h0[j] = a0 * sigmoidf_(a0) * acc[ai][1][m][0][j]; h1[j] = a1 * sigmoidf_(a1) * acc[ai][1][m][1][j]; }
                u32x2 w; w.x = pk4_fp8(4.f * h0[0], 4.f * h0[1], 4.f * h0[2], 4.f * h0[3]); w.y = pk4_fp8(4.f * h1[0], 4.f * h1[1], 4.f * h1[2], 4.f * h1[3]);
                *(GAS u32x2*)(HID + (size_t)(row0 + ai * 128 + m * 16) * 1024 + col0) = w; }
    }
};
struct EpiI {
    static constexpr bool PERM = true, MID = false;
    bf16_t* Y2;
    __device__ __forceinline__ void operator()(f32x4 (&acc)[2][2][4][2], const Unit& u, int wr, int wc, int fr, int fq) const {
        const int row0 = u.pm * 256 + wr * 64 + fr, col0 = u.pn * 256 + wc * 32 + 8 * fq;
#pragma unroll
        for (int ai = 0; ai < 2; ++ai)
#pragma unroll
            for (int m = 0; m < 4; ++m)
#pragma unroll
                for (int bj = 0; bj < 2; ++bj) { const f32x4 v0 = acc[ai][bj][m][0], v1 = acc[ai][bj][m][1];
                    u32x4 w; w.x = pk2(v0[0], v0[1]); w.y = pk2(v0[2], v0[3]); w.z = pk2(v1[0], v1[1]); w.w = pk2(v1[2], v1[3]);
                    *(GAS u32x4*)(Y2 + (size_t)(row0 + ai * 128 + m * 16) * 1024 + col0 + bj * 128) = w; }
    }
};

__device__ __forceinline__ void rope_item_desc(int item, int& src, int& dst, float& scale, int& normsel) {
    normsel = 0; scale = 1.f;
    if (item < 4) { src = P_RET + item * 64; dst = Q_RETQ + item * 64; scale = 0.125f; }
    else if (item < 8) { src = P_RET + 256 + (item - 4) * 64; dst = Q_RETK + (item - 4) * 64; }
    else if (item < 12) { src = P_GQA + (item - 8) * 64; dst = Q_GQAQ + (item - 8) * 64; scale = 0.125f * LOG2E; normsel = 1; }
    else if (item < 14) { src = P_GQA + 256 + (item - 12) * 64; dst = Q_GQAK + (item - 12) * 64; normsel = 2; }
    else if (item < 16) { src = P_WIN + 256 + (item - 14) * 64; dst = Q_WINK + (item - 14) * 64; }
    else { src = P_WIN + (item - 16) * 64; dst = Q_WINQ + (item - 16) * 64; scale = 0.125f * LOG2E; }
}
__device__ __forceinline__ void phase_post(KArgs a, int l, LAS unsigned char* lds, int lane, int wave, int G, int c) {
    unsigned char* ws = a->ws;
    const bf16_t* P = (const bf16_t*)(ws + WS_P); bf16_t* Q = (bf16_t*)(ws + WS_QKV);
    const float* cos32 = (const float*)(ws + WS_ROPE) + 2 * 2048 * 32; const float* sin32 = cos32 + 2048 * 16;
    const bf16_t* Wuq = (const bf16_t*)(ws + WS_WSM) + (size_t)l * 384 * 256; const bf16_t* Wukv = (const bf16_t*)(ws + WS_WSM) + 2 * 384 * 256 + (size_t)l * 512 * 128;
    const float qscale = 0.10206207261596577f * LOG2E;
    const unsigned ldsb = (unsigned)(uintptr_t)lds;
    constexpr int LQ = 0, LKV = 49152;
    for (int u = c; u < (TT / 128) * 4; u += G) {
        const int h = u & 3, rb = u >> 2;
        for (int p = wave; p < 80; p += NWAVES) {
            if (p < 48) { const int row = 2 * p + (lane >> 5), ch = (lane & 31) ^ (row & 7);
                glds16(Wuq + (size_t)(96 * h + row) * 256 + 8 * ch, (unsigned)__builtin_amdgcn_readfirstlane((int)(ldsb + LQ + p * 1024))); }
            else { const int p2 = p - 48, row = 4 * p2 + (lane >> 4), ch = (lane & 15) ^ (row & 7);
                glds16(Wukv + (size_t)(128 * h + row) * 128 + 8 * ch, (unsigned)__builtin_amdgcn_readfirstlane((int)(ldsb + LKV + p2 * 1024))); }
        }
        const int tk = lane & 15, kq = lane >> 4, row = rb * 128 + wave * 16 + tk; const bool islat = row < TL; const int pos = row & 2047;
        const bf16_t* prow = P + (size_t)row * NINP + P_MLA; bf16_t* qrow = Q + (size_t)row * QP;
        bf16x8 zq[8], zkv[4]; float sq = 0.f, skv = 0.f;
#pragma unroll
        for (int s2 = 0; s2 < 8; ++s2) zq[s2] = *(const GAS bf16x8*)(prow + 32 * s2 + 8 * kq);
#pragma unroll
        for (int s2 = 0; s2 < 4; ++s2) zkv[s2] = *(const GAS bf16x8*)(prow + 256 + 32 * s2 + 8 * kq);
        const u32x2 kr1 = *(const GAS u32x2*)(prow + 384 + 4 * kq), kr2 = *(const GAS u32x2*)(prow + 400 + 4 * kq);
#pragma unroll
        for (int s2 = 0; s2 < 8; ++s2)
#pragma unroll
            for (int j = 0; j < 8; ++j) { const float f = bf2f((unsigned short)zq[s2][j]); sq += f * f; }
#pragma unroll
        for (int s2 = 0; s2 < 4; ++s2)
#pragma unroll
            for (int j = 0; j < 8; ++j) { const float f = bf2f((unsigned short)zkv[s2][j]); skv += f * f; }
        sq = xadd<16>(sq); sq = xadd<32>(sq); skv = xadd<16>(skv); skv = xadd<32>(skv);
        const float rq = (1.0f / sqrtf(sq * (1.f / 256.f) + EPS)) * qscale, rkv = 1.0f / sqrtf(skv * (1.f / 128.f) + EPS);
        f32x4 cr = {1.f, 1.f, 1.f, 1.f}, sr = {0.f, 0.f, 0.f, 0.f};
        if (islat) { cr = *(const GAS f32x4*)(cos32 + pos * 16 + 4 * kq); sr = *(const GAS f32x4*)(sin32 + pos * 16 + 4 * kq); }
        asm volatile("s_waitcnt vmcnt(0)\n\ts_barrier" ::: "memory");
        f32x4 acc[6];
#pragma unroll
        for (int p = 0; p < 6; ++p) {
            bf16x8 w[8];
#pragma unroll
            for (int s2 = 0; s2 < 8; ++s2) w[s2] = *(const LAS bf16x8*)(lds + LQ + (16 * p + tk) * 512 + (((4 * s2 + kq) ^ (tk & 7)) * 16));
            acc[p] = (f32x4){0.f, 0.f, 0.f, 0.f};
#pragma unroll
            for (int s2 = 0; s2 < 8; ++s2) acc[p] = __builtin_amdgcn_mfma_f32_16x16x32_bf16(w[s2], zq[s2], acc[p], 0, 0, 0);
        }
#pragma unroll
        for (int p = 0; p < 4; ++p) { const f32x4 v = acc[p] * rq; u32x2 o; o.x = pk2(v[0], v[1]); o.y = pk2(v[2], v[3]); *(GAS u32x2*)(qrow + Q_MLAQ + h * 96 + 16 * p + 4 * kq) = o; }
        { const f32x4 x1 = acc[4] * rq, x2 = acc[5] * rq; const f32x4 o1 = x1 * cr - x2 * sr, o2 = x2 * cr + x1 * sr;
          u32x2 w1; w1.x = pk2(o1[0], o1[1]); w1.y = pk2(o1[2], o1[3]); u32x2 w2; w2.x = pk2(o2[0], o2[1]); w2.y = pk2(o2[2], o2[3]);
          *(GAS u32x2*)(qrow + Q_MLAQ + h * 96 + 64 + 4 * kq) = w1; *(GAS u32x2*)(qrow + Q_MLAQ + h * 96 + 80 + 4 * kq) = w2; }
#pragma unroll
        for (int p = 0; p < 8; ++p) {
            bf16x8 w[4];
#pragma unroll
            for (int s2 = 0; s2 < 4; ++s2) w[s2] = *(const LAS bf16x8*)(lds + LKV + (16 * p + tk) * 256 + (((4 * s2 + kq) ^ (tk & 7)) * 16));
            f32x4 ac = {0.f, 0.f, 0.f, 0.f};
#pragma unroll
            for (int s2 = 0; s2 < 4; ++s2) ac = __builtin_amdgcn_mfma_f32_16x16x32_bf16(w[s2], zkv[s2], ac, 0, 0, 0);
            const f32x4 v = ac * rkv; u32x2 o; o.x = pk2(v[0], v[1]); o.y = pk2(v[2], v[3]);
            const int col = p < 4 ? Q_MLAK + h * 96 + 16 * p + 4 * kq : Q_MLAV + h * 64 + 16 * (p - 4) + 4 * kq;
            *(GAS u32x2*)(qrow + col) = o;
        }
        if (h == 0) {
            const f32x4 x1 = {bflo(kr1.x), bfhi(kr1.x), bflo(kr1.y), bfhi(kr1.y)}, x2 = {bflo(kr2.x), bfhi(kr2.x), bflo(kr2.y), bfhi(kr2.y)};
            const f32x4 o1 = x1 * cr - x2 * sr, o2 = x2 * cr + x1 * sr;
            u32x2 w1; w1.x = pk2(o1[0], o1[1]); w1.y = pk2(o1[2], o1[3]); u32x2 w2; w2.x = pk2(o2[0], o2[1]); w2.y = pk2(o2[2], o2[3]);
#pragma unroll
            for (int hh = 0; hh < 4; ++hh) { *(GAS u32x2*)(qrow + Q_MLAK + hh * 96 + 64 + 4 * kq) = w1; *(GAS u32x2*)(qrow + Q_MLAK + hh * 96 + 80 + 4 * kq) = w2; }
        }
        asm volatile("s_waitcnt lgkmcnt(0)\n\ts_barrier" ::: "memory");
    }
}

__device__ __forceinline__ void phase_router(KArgs a, int l, int nrows, LAS unsigned char* lds, int tid, int lane, int wave, int G, int c) {
    unsigned char* ws = a->ws;
    const float* X = (const float*)(ws + WS_X); unsigned char* H = (unsigned char*)(ws + WS_H);
    const float* ada = (const float*)(ws + WS_ADA); const float* wrp = (const float*)(ws + WS_WRP);
    const float* gn = a->in[I_N2G] + l * 1024; const float* brt = a->in[I_BR];
    unsigned* ctl = (unsigned*)(ws + WS_CTL);
    int* tokinv = (int*)(ws + WS_TOKINV); int* toke = (int*)(ws + WS_TOKE); float* tokw = (float*)(ws + WS_TOKW);
    const int tk = lane & 15, q = lane >> 4;
    f32x4 wr0[8], wr1[8];
    { const float* p0 = wrp + (((0 * 8 + wave) * 4 + q) * 16 + tk) * 32; const float* p1 = wrp + (((1 * 8 + wave) * 4 + q) * 16 + tk) * 32;
#pragma unroll
      for (int s = 0; s < 8; ++s) { wr0[s] = *(const GAS f32x4*)(p0 + 4 * s); wr1[s] = *(const GAS f32x4*)(p1 + 4 * s); } }
    LAS float* hb = (LAS float*)lds;
    LAS float* part = (LAS float*)(lds + 16 * 4112);
    LAS float* lgs = part + 8 * 16 * 32;
    for (int g = c; g < nrows / 16; g += G) {
        f32x4 v[2][4];
#pragma unroll
        for (int rr = 0; rr < 2; ++rr) { const float* xr = X + (size_t)(g * 16 + 2 * wave + rr) * 1024;
#pragma unroll
            for (int j = 0; j < 4; ++j) v[rr][j] = *(const GAS f32x4*)(xr + 4 * lane + 256 * j); }
#pragma unroll
        for (int rr = 0; rr < 2; ++rr) {
            const int row = g * 16 + 2 * wave + rr, b = row < TL ? (row >> 11) : 8;
            float ss = 0.f;
#pragma unroll
            for (int j = 0; j < 4; ++j) ss += (v[rr][j].x * v[rr][j].x + v[rr][j].y * v[rr][j].y) + (v[rr][j].z * v[rr][j].z + v[rr][j].w * v[rr][j].w);
            const float rstd = 1.0f / sqrtf(wave_sum(ss) * (1.f / 1024.f) + EPS);
            const float* sh = ada + ((size_t)l * 9 + b) * 6144 + 3072; const float* sc = sh + 1024;
#pragma unroll
            for (int j = 0; j < 4; ++j) { const int cc = 4 * lane + 256 * j; const f32x4 gg = *(const GAS f32x4*)(gn + cc), s1 = *(const GAS f32x4*)(sc + cc), s0 = *(const GAS f32x4*)(sh + cc);
                const f32x4 h = v[rr][j] * rstd * gg * (s1 + 1.0f) + s0;
                *(GAS unsigned*)(H + (size_t)row * 1024 + cc) = pk4_fp8(h.x, h.y, h.z, h.w);
                *(LAS f32x4*)(hb + (2 * wave + rr) * 1028 + cc) = h; }
        }
        __syncthreads();
        f32x4 acc0 = {0.f, 0.f, 0.f, 0.f}, acc1 = {0.f, 0.f, 0.f, 0.f};
#pragma unroll
        for (int s = 0; s < 8; ++s) { const f32x4 a4 = *(const LAS f32x4*)(hb + tk * 1028 + 128 * wave + 32 * q + 4 * s);
#pragma unroll
            for (int j = 0; j < 4; ++j) { acc0 = __builtin_amdgcn_mfma_f32_16x16x4f32(a4[j], wr0[s][j], acc0, 0, 0, 0); acc1 = __builtin_amdgcn_mfma_f32_16x16x4f32(a4[j], wr1[s][j], acc1, 0, 0, 0); } }
#pragma unroll
        for (int r = 0; r < 4; ++r) { part[(wave * 16 + 4 * q + r) * 32 + tk] = acc0[r]; part[(wave * 16 + 4 * q + r) * 32 + 16 + tk] = acc1[r]; }
        __syncthreads();
        LAS float* selv = lgs + 512;
        { float sum = 0.f;
#pragma unroll
          for (int w = 0; w < 8; ++w) sum += part[w * 512 + tid];
          const float sg = 1.0f / (1.0f + __expf(-sum)); lgs[tid] = sg; selv[tid] = sg + brt[tid & 31]; }
        __syncthreads();
        if (wave == 0 && lane < 16) {
            const LAS float* my = selv + lane * 32; const LAS float* mys = lgs + lane * 32;
            float gs[4];
#pragma unroll
            for (int g4 = 0; g4 < 4; ++g4) { float m1 = -1e30f, m2 = -1e30f;
#pragma unroll
                for (int j = 0; j < 8; ++j) { const float vv = my[g4 * 8 + j];
                    if (vv > m1) { m2 = m1; m1 = vv; } else if (vv > m2) m2 = vv; }
                gs[g4] = m1 + m2; }
            int gsel = 0; float gb = gs[0];
#pragma unroll
            for (int g4 = 1; g4 < 4; ++g4) if (gs[g4] > gb) { gb = gs[g4]; gsel = g4; }
            float v1 = -1e30f, v2 = -1e30f, s1v = 0.f, s2v = 0.f; int e1 = 0, e2 = 0;
#pragma unroll
            for (int j = 0; j < 8; ++j) { const int e = gsel * 8 + j; const float sg = mys[e]; const float vv = my[e];
                if (vv > v1) { v2 = v1; e2 = e1; s2v = s1v; v1 = vv; e1 = e; s1v = sg; } else if (vv > v2) { v2 = vv; e2 = e; s2v = sg; } }
            const float inv = 1.0f / (s1v + s2v);
            const int myrow = g * 16 + lane;
            const int p1 = (int)__hip_atomic_fetch_add(ctl + CW_CNT + l * 32 + e1, 1u, __ATOMIC_RELAXED, __HIP_MEMORY_SCOPE_AGENT);
            const int p2 = (int)__hip_atomic_fetch_add(ctl + CW_CNT + l * 32 + e2, 1u, __ATOMIC_RELAXED, __HIP_MEMORY_SCOPE_AGENT);
            tokinv[(size_t)e1 * TT + p1] = myrow; tokinv[(size_t)e2 * TT + p2] = myrow;
            toke[myrow * 2] = (e1 << 20) | p1; toke[myrow * 2 + 1] = (e2 << 20) | p2;
            tokw[myrow * 2] = s1v * inv; tokw[myrow * 2 + 1] = s2v * inv;
        }
    }
    __syncthreads();
}

__device__ __forceinline__ float max3f(float a, float b, float c) { float r; asm("v_max3_f32 %0, %1, %2, %3" : "=v"(r) : "v"(a), "v"(b), "v"(c)); return r; }
__device__ __forceinline__ int crow(int r, int hi) { return (r & 3) + 8 * (r >> 2) + 4 * hi; }
__device__ __forceinline__ s16x4 tr_read(const LAS unsigned char* p) { typedef short v4s __attribute__((ext_vector_type(4))); return __builtin_bit_cast(s16x4, __builtin_amdgcn_ds_read_tr16_b64_v4i16((LAS v4s*)p)); }
constexpr int AT_FAC = 124928, AT_SCRW = 8448;
__device__ __forceinline__ void at_wait_bar(int n) {
    switch (n) {
        case 0: asm volatile("s_waitcnt vmcnt(0)\n\ts_barrier" ::: "memory"); break;
        case 2: asm volatile("s_waitcnt vmcnt(2)\n\ts_barrier" ::: "memory"); break;
        case 3: asm volatile("s_waitcnt vmcnt(3)\n\ts_barrier" ::: "memory"); break;
        case 4: asm volatile("s_waitcnt vmcnt(4)\n\ts_barrier" ::: "memory"); break;
        case 6: asm volatile("s_waitcnt vmcnt(6)\n\ts_barrier" ::: "memory"); break;
        case 8: asm volatile("s_waitcnt vmcnt(8)\n\ts_barrier" ::: "memory"); break;
        case 9: asm volatile("s_waitcnt vmcnt(9)\n\ts_barrier" ::: "memory"); break;
        default: asm volatile("s_waitcnt vmcnt(0)\n\ts_barrier" ::: "memory"); break;
    }
}
template <int kind>
__device__ __forceinline__ void attn_unit(const bf16_t* Q, bf16_t* Y, const int b, const int hq, const int qb, const bool ctxq, const float sinkl2, const float lf2, const float lb2,
                                          LAS unsigned char* lds, const int tid, const int lane, const int wave, const int tilecap) {
    constexpr int DQK = kind == 0 ? 96 : 64;
    constexpr int KS = DQK == 64 ? 128 : 256, NS = DQK / 16, SLOTK = 64 * KS, SLOT = SLOTK + 8192, NL = DQK == 64 ? 2 : 3, NSLOT = DQK == 64 ? 6 : 5;
    constexpr float THR = 8.0f;
    constexpr int KW = 2, KP = NS / KW;
    static_assert(NSLOT * SLOT <= AT_FAC && 8 * AT_SCRW <= AT_FAC && AT_FAC + 1024 <= LDS_MISC, "attention LDS map");
    int qcol, kcol, vcol, ycol, gcol = 0;
    if (kind == 0) { qcol = Q_MLAQ + hq * 96; kcol = Q_MLAK + hq * 96; vcol = Q_MLAV + hq * 64; ycol = 256 + hq * 64; }
    else if (kind == 1) { qcol = Q_GQAQ + hq * 64; kcol = Q_GQAK + (hq >> 1) * 64; vcol = Q_GQAV + (hq >> 1) * 64; ycol = 512 + hq * 64; }
    else if (kind == 2) { qcol = Q_RETQ + hq * 64; kcol = Q_RETK + hq * 64; vcol = Q_RETV + hq * 64; ycol = hq * 64; gcol = Q_RETG + hq * 64; }
    else { qcol = Q_WINQ + hq * 64; kcol = Q_WINK + (hq >> 1) * 64; vcol = Q_WINV + (hq >> 1) * 64; ycol = 768 + hq * 64; }
    const int r32 = lane & 31, hi = lane >> 5;
    const int qrow0 = (ctxq ? TL + b * 256 : b * 2048 + qb * 256) + 32 * wave;
    const int qpos = (ctxq ? 0 : qb * 256) + 32 * wave + r32;
    int lt0 = 0, nlat = 32;
    if (ctxq) nlat = 0;
    else if (kind == 3) { lt0 = 4 * qb - 2 < 0 ? 0 : 4 * qb - 2; const int lt1 = 4 * qb + 6 > 32 ? 32 : 4 * qb + 6; nlat = lt1 - lt0; }
    const int ntile = (4 + nlat) < tilecap ? (4 + nlat) : tilecap;
    bf16x8 qf[NS];
#pragma unroll
    for (int s = 0; s < NS; ++s) qf[s] = *(const GAS bf16x8*)(Q + (size_t)(qrow0 + r32) * QP + qcol + 16 * s + 8 * hi);
    f32x4 cfa = {}, cfq = {}, cba = {}, cbq = {}; float g32f = 0.f, g32b = 0.f;
    if constexpr (kind == 2) {
#pragma unroll
        for (int i = 0; i < 4; ++i) { cfa[i] = __builtin_bit_cast(float, __builtin_amdgcn_readfirstlane(__builtin_bit_cast(int, fast_exp2(lf2 * (float)(3 - i))))); cfq[i] = fast_exp2(lf2 * (float)(28 - 4 * hi - 8 * i));
            cba[i] = __builtin_bit_cast(float, __builtin_amdgcn_readfirstlane(__builtin_bit_cast(int, fast_exp2(lb2 * (float)i)))); cbq[i] = fast_exp2(lb2 * (float)(8 * i + 4 * hi)); }
        g32f = fast_exp2(32.f * lf2); g32b = fast_exp2(32.f * lb2);
    }
    int ksrc[DQK == 64 ? 1 : 2], vsrc;
    if constexpr (DQK == 64) { const int row = 8 * wave + (lane >> 3), ch = (lane & 7) ^ ((row >> 1) & 7); ksrc[0] = row * QP + kcol + 8 * ch; }
    else {
#pragma unroll
        for (int n = 0; n < 2; ++n) { const int row = 4 * (2 * wave + n) + (lane >> 4); int ch = (lane & 15) ^ (row & 15); if (ch >= 12) ch = 0; ksrc[n] = row * QP + kcol + 8 * ch; }
    }
    { const int row = 8 * wave + (lane >> 3); vsrc = row * QP + vcol + 8 * ((lane & 7) ^ (((row >> 1) & 1) << 2)); }
#define AT_TILE_ROW0(t) ((t) < 4 ? TL + b * 256 + 64 * (t) : b * 2048 + 64 * (lt0 + (t) - 4))
#define AT_ISSUE(t) do { const bf16_t* tb_ = Q + (size_t)AT_TILE_ROW0(t) * QP; const unsigned sl_ = (unsigned)__builtin_amdgcn_readfirstlane((int)(ldsb + ((t) % NSLOT) * SLOT + wave * 1024 * (DQK == 64 ? 1 : 2))); \
        if constexpr (DQK == 64) { glds16(tb_ + ksrc[0], sl_); glds16(tb_ + vsrc, sl_ + SLOTK); } \
        else { glds16(tb_ + ksrc[0], sl_); glds16(tb_ + ksrc[DQK == 64 ? 0 : 1], sl_ + 1024); glds16(tb_ + vsrc, (unsigned)__builtin_amdgcn_readfirstlane((int)(ldsb + ((t) % NSLOT) * SLOT + SLOTK + wave * 1024))); } } while (0)
    const unsigned ldsb = (unsigned)(uintptr_t)lds;
    const int kkey = DQK == 64 ? ((r32 >> 1) & 7) : (r32 & 15);
    const unsigned krd = r32 * KS + 16 * (hi ^ (kkey & 1)) + 32 * (kkey >> 1);
#define AT_KLOAD(KF, t, S0, S1) do { unsigned ka_ = (unsigned)(uintptr_t)(lds + ((t) % NSLOT) * SLOT) + krd; asm volatile("" : "+v"(ka_)); \
        _Pragma("unroll") for (int s = (S0); s < (S1); ++s) { const LAS unsigned char* kp_ = (const LAS unsigned char*)(uintptr_t)(ka_ ^ (unsigned)(32 * s)); \
            KF[2 * (s - (S0))] = *(const LAS bf16x8*)(kp_); KF[2 * (s - (S0)) + 1] = *(const LAS bf16x8*)(kp_ + 32 * KS); } } while (0)
#define AT_QKMR(P0, P1, KF, PART) do { _Pragma("unroll") for (int s = (PART) * KW; s < ((PART) + 1) * KW; ++s) { \
        if ((PART) == 0 && s == 0) { const f32x16 z_ = {}; P0 = __builtin_amdgcn_mfma_f32_32x32x16_bf16(KF[0], qf[0], z_, 0, 0, 0); P1 = __builtin_amdgcn_mfma_f32_32x32x16_bf16(KF[1], qf[0], z_, 0, 0, 0); } \
        else { P0 = __builtin_amdgcn_mfma_f32_32x32x16_bf16(KF[2 * (s - (PART) * KW)], qf[s], P0, 0, 0, 0); P1 = __builtin_amdgcn_mfma_f32_32x32x16_bf16(KF[2 * (s - (PART) * KW) + 1], qf[s], P1, 0, 0, 0); } } } while (0)
#define AT_KPART(KF, t, PART) AT_KLOAD(KF, t, (PART) * KW, ((PART) + 1) * KW)
#define AT_QK(P0, P1, t) do { bf16x8 kf_[2 * KW]; _Pragma("unroll") for (int p_ = 0; p_ < KP; ++p_) { AT_KPART(kf_, t, p_); AT_QKMR(P0, P1, kf_, p_); } } while (0)
    const int qw0_ = qb * 256 + 32 * wave;
#define AT_SKIP(t) ((kind == 3 && (t) >= 4) && ((64 * (lt0 + (t) - 4) + 63 < qw0_ - 128) || (64 * (lt0 + (t) - 4) > qw0_ + 31 + 128)))
#pragma unroll
    for (int t = 0; t < NSLOT - 1; ++t) if (t < ntile) AT_ISSUE(t);
    { const int infl = (ntile - 1 < NSLOT - 2 ? ntile - 1 : NSLOT - 2); at_wait_bar(infl * NL); }
    float mref = 0.f, lsum = 0.f;
    bool shifted = false;
    f32x16 o0 = {}, o1 = {}, pa0, pa1, pb0 = {}, pb1 = {};
    AT_QK(pa0, pa1, 0);
    LAS float* stage = (LAS float*)(lds + wave * AT_SCRW); LAS float* fac = (LAS float*)(lds + AT_FAC) + wave * 32;
    const int i16 = lane & 15, q4 = i16 >> 2, p4 = i16 & 3, g1 = (lane >> 4) & 1;
    const unsigned vrd = SLOTK + (4 * hi + q4) * 128 + (16 * g1 + 4 * p4) * 2 + 64 * ((q4 >> 1) & 1);
#define CR(r) (((r) & 3) + 8 * ((r) >> 2))
#define AT_VLOAD(VF, t, u) do { unsigned vb_ = (unsigned)(uintptr_t)(lds + ((t) % NSLOT) * SLOT) + vrd + (32 * (u)) * 128; asm volatile("" : "+v"(vb_)); const LAS unsigned char* vb = (const LAS unsigned char*)(uintptr_t)vb_; \
        unsigned vx_ = vb_ ^ 64u; asm volatile("" : "+v"(vx_)); const LAS unsigned char* vbx = (const LAS unsigned char*)(uintptr_t)vx_; \
        _Pragma("unroll") for (int s2 = 0; s2 < 2; ++s2) _Pragma("unroll") for (int d0 = 0; d0 < 2; ++d0) { const LAS unsigned char* vp = (d0 ? vbx : vb) + (16 * s2) * 128; \
            const s16x4 lo = tr_read(vp), h2 = tr_read(vp + 8 * 128); VF[2 * s2 + d0] = (bf16x8){lo[0], lo[1], lo[2], lo[3], h2[0], h2[1], h2[2], h2[3]}; } } while (0)
#define AT_PVM(PU, VF) do { _Pragma("unroll") for (int s = 0; s < 2; ++s) { \
        u32x4 pw; pw.x = pk2(PU[8 * s], PU[8 * s + 1]); pw.y = pk2(PU[8 * s + 2], PU[8 * s + 3]); pw.z = pk2(PU[8 * s + 4], PU[8 * s + 5]); pw.w = pk2(PU[8 * s + 6], PU[8 * s + 7]); \
        const bf16x8 pa = __builtin_bit_cast(bf16x8, pw); \
        o0 = __builtin_amdgcn_mfma_f32_32x32x16_bf16(pa, VF[2 * s], o0, 0, 0, 0); o1 = __builtin_amdgcn_mfma_f32_32x32x16_bf16(pa, VF[2 * s + 1], o1, 0, 0, 0); } } while (0)
#define SB0() __builtin_amdgcn_sched_barrier(0)
#define AT_STEP(PC0, PC1, PN0, PN1, t) do { \
        const bool more = (t) + 1 < ntile; \
        if (more) { const int last_infl = ((t) + NSLOT - 2 < ntile - 1) ? ((t) + NSLOT - 2) : (ntile - 1); \
            at_wait_bar((last_infl - ((t) + 1)) * NL); \
            if ((t) + NSLOT - 1 < ntile) AT_ISSUE((t) + NSLOT - 1); } \
        const bool isctx = (t) < 4; const int kpos0 = isctx ? 64 * (t) : 64 * (lt0 + (t) - 4); \
        int dbase = kpos0 + 4 * hi - qpos; asm volatile("" : "+v"(dbase)); \
        const bool skip = AT_SKIP(t), skipn = more ? AT_SKIP((t) + 1) : true; \
        bf16x8 kf[2 * KW]; bf16x8 vf[4]; \
        if (!skipn) { AT_KPART(kf, (t) + 1, 0); SB0(); } \
        if (kind == 2) { \
            if (!skipn) { AT_QKMR(PN0, PN1, kf, 0); SB0(); AT_KPART(kf, (t) + 1, 1); } \
            AT_VLOAD(vf, t, 0); SB0(); \
              \
            const int qw0r = (ctxq ? 0 : qb * 256) + 32 * wave; \
            const int tcls = (isctx && !ctxq) ? 3 : ((kpos0 + 63 <= qw0r) ? 0 : ((kpos0 >= qw0r + 32) ? 1 : 2)); \
            float mf0 = 0.f, mf1 = 0.f, mb0 = 0.f, mb1 = 0.f; \
            if (tcls == 0) { mf1 = fast_exp2(lf2 * (float)(qpos - kpos0 - 63)); mf0 = mf1 * g32f; } \
            else if (tcls == 1) { mb0 = fast_exp2(lb2 * (float)(kpos0 - qpos)); mb1 = mb0 * g32b; } \
            else if (tcls == 3) { mf1 = fast_exp2(lf2 * (float)(256 + qpos - kpos0 - 63)); mf0 = mf1 * g32f; mb0 = fast_exp2(lb2 * (float)(2048 - qpos + kpos0)); mb1 = mb0 * g32b; } \
            if (tcls == 2) {        \
                _Pragma("unroll") for (int r = 0; r < 16; ++r) { const int d0 = -(dbase + CR(r)); PC0[r] *= fast_exp2((d0 >= 0 ? lf2 : -lb2) * (float)d0); } \
            } else { \
                const f32x4 fq_ = cfq * mf0, bq_ = cbq * mb0; \
                _Pragma("unroll") for (int r = 0; r < 16; ++r) PC0[r] *= cfa[r & 3] * fq_[r >> 2] + cba[r & 3] * bq_[r >> 2]; \
            } \
            SB0(); if (!skipn) { AT_QKMR(PN0, PN1, kf, 1); if (KP == 3) { SB0(); AT_KPART(kf, (t) + 1, 2); } } AT_PVM(PC0, vf); SB0(); AT_VLOAD(vf, t, 1); SB0(); \
            if (tcls == 2) { \
                _Pragma("unroll") for (int r = 0; r < 16; ++r) { const int d1 = -(dbase + CR(r)) - 32; PC1[r] *= fast_exp2((d1 >= 0 ? lf2 : -lb2) * (float)d1); } \
            } else { \
                const f32x4 fq_ = cfq * mf1, bq_ = cbq * mb1; \
                _Pragma("unroll") for (int r = 0; r < 16; ++r) PC1[r] *= cfa[r & 3] * fq_[r >> 2] + cba[r & 3] * bq_[r >> 2]; \
            } \
            SB0(); if (KP == 3 && !skipn) { AT_QKMR(PN0, PN1, kf, 2); } AT_PVM(PC1, vf); \
        } else if (!skip) { \
            if (kind == 3 && !isctx) { \
                _Pragma("unroll") for (int r = 0; r < 16; ++r) { const int d0 = dbase + CR(r), d1 = d0 + 32; \
                    if (d0 > 128 || d0 < -128) PC0[r] = -INFINITY; if (d1 > 128 || d1 < -128) PC1[r] = -INFINITY; } \
            } \
            float tm = max3f(PC0[0], PC1[0], PC0[1]), tm2 = max3f(PC1[1], PC0[2], PC1[2]); \
            _Pragma("unroll") for (int r = 3; r < 15; r += 2) { tm = max3f(tm, PC0[r], PC1[r]); tm2 = max3f(tm2, PC0[r + 1], PC1[r + 1]); } \
            tm = max3f(tm, PC0[15], PC1[15]); tm = max3f(tm, tm2, tm2); \
            tm = xmax32(tm) - mref; \
            if (__any(tm > THR)) { \
                const float dl = (tm > THR) ? tm : 0.f; \
                mref += dl; shifted = true; \
                const float f = fast_exp2(-dl); lsum *= f; \
                if (hi == 0) fac[r32] = f; \
                LDS_WAIT(); asm volatile("" ::: "memory"); \
                _Pragma("unroll") for (int r = 0; r < 16; ++r) { const float fr_ = fac[crow(r, hi)]; o0[r] *= fr_; o1[r] *= fr_; } \
            } \
            if (shifted) { _Pragma("unroll") for (int r = 0; r < 16; ++r) { PC0[r] -= mref; PC1[r] -= mref; } } \
            SB0(); \
            if (!skipn) { AT_QKMR(PN0, PN1, kf, 0); SB0(); AT_KPART(kf, (t) + 1, 1); } \
            AT_VLOAD(vf, t, 0); SB0(); \
            float ps = 0.f; \
            _Pragma("unroll") for (int r = 0; r < 16; ++r) { PC0[r] = fast_exp2(PC0[r]); ps += PC0[r]; } \
            SB0(); if (!skipn) { AT_QKMR(PN0, PN1, kf, 1); if (KP == 3) { SB0(); AT_KPART(kf, (t) + 1, 2); } } AT_PVM(PC0, vf); SB0(); AT_VLOAD(vf, t, 1); SB0(); \
            _Pragma("unroll") for (int r = 0; r < 16; ++r) { PC1[r] = fast_exp2(PC1[r]); ps += PC1[r]; } \
            lsum += ps; \
            SB0(); if (KP == 3 && !skipn) { AT_QKMR(PN0, PN1, kf, 2); } AT_PVM(PC1, vf); \
        } else if (!skipn) { AT_QKMR(PN0, PN1, kf, 0); _Pragma("unroll") for (int p_ = 1; p_ < KP; ++p_) { AT_KPART(kf, (t) + 1, p_); AT_QKMR(PN0, PN1, kf, p_); } } \
        } while (0)
    for (int t = 0; t < ntile; t += 2) {
        AT_STEP(pa0, pa1, pb0, pb1, t);
        if (t + 1 < ntile) AT_STEP(pb0, pb1, pa0, pa1, t + 1);
    }
#undef AT_STEP
#undef AT_PVM
#undef AT_VLOAD
#undef AT_KLOAD
#undef AT_QKMR
#undef AT_KPART
#undef SB0
#undef AT_ISSUE
#undef AT_TILE_ROW0
#undef AT_QK
#undef AT_SKIP
#undef CR
    asm volatile("s_waitcnt lgkmcnt(0)\n\ts_barrier" ::: "memory");
#pragma unroll
    for (int r = 0; r < 16; ++r) { stage[crow(r, hi) * 65 + r32] = o0[r]; stage[crow(r, hi) * 65 + 32 + r32] = o1[r]; }
    LDS_WAIT(); asm volatile("" ::: "memory");
    float x[32];
#pragma unroll
    for (int j = 0; j < 32; ++j) x[j] = stage[r32 * 65 + 32 * hi + j];
    int orow_i = qrow0 + r32; asm volatile("" : "+v"(orow_i));
    const size_t orow = (size_t)orow_i;
    if (kind == 2) {
        float s = 0.f;
#pragma unroll
        for (int j = 0; j < 32; ++j) s += x[j];
        s = xadd<32>(s); const float mean = s * (1.f / 64.f); float v = 0.f;
#pragma unroll
        for (int j = 0; j < 32; ++j) { x[j] -= mean; v += x[j] * x[j]; }
        v = xadd<32>(v); const float rstd = 1.0f / sqrtf(v * (1.f / 64.f) + EPS);
        const bf16_t* gp = Q + orow * QP + gcol + 32 * hi;
#pragma unroll
        for (int c = 0; c < 4; ++c) { const u32x4 gw = *(const GAS u32x4*)(gp + 8 * c);
#pragma unroll
            for (int j = 0; j < 4; ++j) { const float ga = bflo(gw[j]), gb = bfhi(gw[j]); x[8 * c + 2 * j] *= rstd * ga * sigmoidf_(ga); x[8 * c + 2 * j + 1] *= rstd * gb * sigmoidf_(gb); } }
    } else {
        float lt = xadd<32>(lsum);
        if (kind == 3) lt += fast_exp2(sinkl2 - mref);
        const float inv = 1.0f / fmaxf(lt, 1e-30f);
#pragma unroll
        for (int j = 0; j < 32; ++j) x[j] *= inv;
    }
    bf16_t* yp = Y + orow * 1024 + ycol + 32 * hi;
#pragma unroll
    for (int c = 0; c < 4; ++c) { u32x4 w; w.x = pk2(x[8 * c], x[8 * c + 1]); w.y = pk2(x[8 * c + 2], x[8 * c + 3]); w.z = pk2(x[8 * c + 4], x[8 * c + 5]); w.w = pk2(x[8 * c + 6], x[8 * c + 7]); *(GAS u32x4*)(yp + 8 * c) = w; }
    asm volatile("s_waitcnt vmcnt(0) lgkmcnt(0)\n\ts_barrier" ::: "memory");
}
#ifndef PROBE_KMASK
#define PROBE_KMASK 0x1f
#endif
#ifndef PROBE_TILECAP
#define PROBE_TILECAP 1000
#endif
__device__ __forceinline__ void phase_mix(KArgs a, int lq, LAS unsigned char* lds, int tid, int lane, int wave, int G, int c) {
    const int l = lq & 1; const int kmask = (lq >= 2) ? PROBE_KMASK : 0x1f; const int tilecap = (lq >= 2) ? PROBE_TILECAP : 1000;
    unsigned char* ws = a->ws;
    const bf16_t* Q = (const bf16_t*)(ws + WS_QKV); bf16_t* Y = (bf16_t*)(ws + (lq >= 2 ? WS_MRG : WS_Y));
    const int nunits = l == 0 ? 1152 : 1024;
    const int vc = (G == 256) ? ((c & 7) * 32 + (c >> 3)) : c;
    for (int j = 0; ; ++j) {
        const int u = j * G + vc;
        if (u >= nunits) break;
        int kind, b, hq, qb; bool ctxq;
        if (u < 1024) { kind = u >> 8; const int r = u & 255; b = r >> 5; hq = (r >> 3) & 3; qb = r & 7; ctxq = false; }
        else { const int r = u - 1024; kind = r >> 5; b = (r >> 2) & 7; hq = r & 3; qb = 0; ctxq = true; }
        if (!((kmask >> (ctxq ? 4 : kind)) & 1)) continue;
        const float lf2 = -__expf(a->in[I_DECAY][l * 8 + hq]) * LOG2E, lb2 = -__expf(a->in[I_DECAY][l * 8 + 4 + hq]) * LOG2E;
        const float sk = a->in[I_SINK][l * 4 + hq] * LOG2E;
        int tid2 = tid; asm volatile("" : "+v"(tid2));
        const int lane2 = tid2 & 63;
        if (kind == 0) attn_unit<0>(Q, Y, b, hq, qb, ctxq, sk, lf2, lb2, lds, tid2, lane2, wave, tilecap);
        else if (kind == 1) attn_unit<1>(Q, Y, b, hq, qb, ctxq, sk, lf2, lb2, lds, tid2, lane2, wave, tilecap);
        else if (kind == 2) attn_unit<2>(Q, Y, b, hq, qb, ctxq, sk, lf2, lb2, lds, tid2, lane2, wave, tilecap);
        else attn_unit<3>(Q, Y, b, hq, qb, ctxq, sk, lf2, lb2, lds, tid2, lane2, wave, tilecap);
    }
}

#ifndef MK_BAR_XCD
#define MK_BAR_XCD 1
#endif
constexpr int NPHASE = 20;
#ifndef PH_MASK
#define PH_MASK 0x3ff
#endif
#define PH_ON(b) ((PH_MASK >> (b)) & 1)
#ifndef PROBE_REPEAT
#define PROBE_REPEAT 0
#endif
__global__ void __launch_bounds__(NTHREADS, 2) fwd_kernel(Args a_byval) {
    extern __shared__ __attribute__((aligned(16))) unsigned char lds_raw[];
    LAS unsigned char* lds0 = (LAS unsigned char*)lds_raw;
    const int wave0 = __builtin_amdgcn_readfirstlane((int)threadIdx.x >> 6);
    { LAS unsigned char* lds = lds0; const int t0 = wave0 * 64 + lane_id(); for (int u = t0; u < (LDS_BYTES - LDS_MISC) / 4; u += NTHREADS) ((LAS unsigned*)(lds + LDS_MISC))[u] = 0u; }
    __syncthreads();
    const int ph_lo = a_byval.ph_lo, ph_hi = a_byval.ph_hi;
#if MK_ONE_LAUNCH && MK_BAR_XCD
    XcdBarrier bar = xcd_barrier_post((unsigned*)(a_byval.ws + WS_CTL) + CW_BAR, (volatile LAS unsigned*)(lds0 + LDS_MISC), wave0);
#endif
    for (int ph = ph_lo; ph < ph_hi; ++ph) {
#if PROBE_REPEAT
      const int nrep = 1 + ((PROBE_REPEAT >> ph) & 1);
      for (int rep = 0; rep < nrep; ++rep) {
#else
      constexpr int nrep = 1, rep = 0; {
#endif
#define PHASE_IDS \
        KArgs a = (KArgs)__builtin_amdgcn_kernarg_segment_ptr(); asm volatile("" : "+s"(a)); \
        int wave = wave0; asm volatile("" : "+s"(wave)); unsigned z_ = 0u; asm volatile("" : "+v"(z_)); \
        const int lane = (int)__builtin_amdgcn_mbcnt_hi(~0u, __builtin_amdgcn_mbcnt_lo(~0u, z_)); const int tid = wave * 64 + lane; \
        unsigned ldso = 0; asm volatile("" : "+s"(ldso)); LAS unsigned char* lds = lds0 + ldso; \
        int G = gridDim.x, c = blockIdx.x; asm volatile("" : "+s"(G), "+s"(c)); \
        unsigned char* ws = a->ws; unsigned* ctl = (unsigned*)(ws + WS_CTL); const float* ada = (const float*)(ws + WS_ADA); (void)ctl; (void)ada; (void)tid; (void)lane; (void)lds; (void)G; (void)c;
        if (ph == 0) { if (PH_ON(0)) { PHASE_IDS p0_prologue(a, lds, tid, lane, wave, G, c); } }
        else if (ph == NPHASE - 1) { if (PH_ON(1)) { PHASE_IDS moe_tables(ctl, 1, lds, tid); phase_rownorm(a, 2, lds, lane, wave, G, c); } }
        else {
            const int l = (ph - 1) / 9, k = (ph - 1) % 9;
            if (k == 0) { if (PH_ON(1)) { PHASE_IDS if (l == 1) moe_tables(ctl, 0, lds, tid); phase_rownorm(a, l, lds, lane, wave, G, c); } }
            else if (k == 1) { if (PH_ON(2)) { PHASE_IDS
                SchedB S{l, G, c, (const char*)(ws + WS_H), (const char*)(ws + WS_WIN) + (size_t)l * NBG * 1024};
                const float* rope_ = (const float*)(ws + WS_ROPE);
                EpiB E{(bf16_t*)(ws + WS_P), (bf16_t*)(ws + WS_G), (bf16_t*)(ws + WS_QKV), rope_, rope_ + 2048 * 32, a->in[I_GQN] + l * 64, a->in[I_GKN] + l * 64};
                pg8::gemm_phase<EpiB, SchedB, false, true, 0x7a7a7a7a, 0x7f7f7f7f>(lds, tid, 1024, 1024, 1024, S, E); }
            } else if (k == 2) { if (PH_ON(3)) { PHASE_IDS phase_post(a, l, lds, lane, wave, G, c); } }
            else if (k == 3) { if (PH_ON(4)) { PHASE_IDS phase_mix(a, l + 2 * rep, lds, tid, lane, wave, G, c); } }
            else if (k == 4) { if (PH_ON(5)) { PHASE_IDS
                SchedE S{G, c, l == 0 ? 72 : 64, (const char*)(ws + WS_Y), (const char*)(ws + WS_WBR) + (size_t)l * 1048576 * 2};
                EpiE E{(const bf16_t*)(ws + WS_G), (bf16_t*)(ws + WS_MRG)};
                pg8::gemm_phase<EpiE, SchedE, false>(lds, tid, 2048, 2048, 2048, S, E);
                if (l == 0 && G == 256 && c >= 32) cvt_run(a, ws, lds, lane, wave, CV_EXP_ITEMS / 2, CV_EXP_ITEMS / 2 + CV_E0_SHARE, (c - 32) * NWAVES + wave, 224 * NWAVES); }
            } else if (k == 5) { if (PH_ON(6)) { PHASE_IDS
                SchedF S{G, c, l == 0 ? 72 : 64, (const char*)(ws + WS_MRG), (const char*)(ws + WS_WOUT) + (size_t)l * 1048576 * 2};
                EpiF E{a->in[I_X], a->in[I_CTX], (const float*)(ws + WS_X), (float*)(ws + WS_X), ada + (size_t)l * 9 * 6144, l};
                pg8::gemm_phase<EpiF, SchedF, false>(lds, tid, 2048, 2048, 2048, S, E);
                if (l == 0) { if (G == 256 && c >= 32) cvt_run(a, ws, lds, lane, wave, CV_EXP_ITEMS / 2 + CV_E0_SHARE, CV_EXP_ITEMS, (c - 32) * NWAVES + wave, 224 * NWAVES);
                              else if (G != 256) { cvt_run(a, ws, lds, lane, wave, CV_EXP_ITEMS / 2, CV_EXP_ITEMS, c * NWAVES + wave, G * NWAVES); } } }
            } else if (k == 6) { if (PH_ON(7)) { PHASE_IDS phase_router(a, l, l == 0 ? TT : TL, lds, tid, lane, wave, G, c); } }
            else if (k == 7) { if (PH_ON(8)) { PHASE_IDS
                moe_tables(ctl, l, lds, tid);
                SchedMoe S{G, c, 8, 1, (const LAS int*)(lds + LDS_MISC + 1024), (const LAS int*)(lds + LDS_MISC + 2304), (const int*)(ws + WS_TOKINV), (const char*)(ws + WS_H), (const char*)(ws + WS_W13) + (size_t)l * 32 * 2 * MiB, 2 * MiB};
                EpiH E{(unsigned char*)(ws + WS_HID)};
                pg8::gemm_phase<EpiH, SchedMoe, true, true, 0x7a7a7a7a, 0x7f7f7f7f>(lds, tid, 1024, 1024, 1024, S, E); }
            } else if (PH_ON(9)) { PHASE_IDS
                moe_tables(ctl, l, lds, tid);
                SchedMoe S{G, c, 4, 0, (const LAS int*)(lds + LDS_MISC + 1024), (const LAS int*)(lds + LDS_MISC + 2304), (const int*)(ws + WS_TOKINV), (const char*)(ws + WS_HID), (const char*)(ws + WS_W2) + (size_t)l * 32 * 1 * MiB, 1 * MiB};
                EpiI E{(bf16_t*)(ws + WS_Y2)};
                pg8::gemm_phase<EpiI, SchedMoe, false, true, 0x7a7a7a7a, 0x7d7d7d7d>(lds, tid, 1024, 1024, 1024, S, E);
            }
        }
#if MK_ONE_LAUNCH
        if (ph + 1 < ph_hi || rep + 1 < nrep) {
#if MK_BAR_XCD
            if (ph == ph_lo) cg::this_grid().sync(); else xcd_barrier(bar);
#else
            cg::this_grid().sync();
#endif
        }
#endif
      }
    }
}

extern "C" void kernel_launch(void* const* d_in, const int* in_sizes, int n_in, void* d_out, int out_size, void* d_ws, size_t ws_size, hipStream_t stream) {
    static int grid = 0;
    if (grid == 0) {
        if (n_in != 26 || out_size != TL * DM || ws_size < WS_END) { fprintf(stderr, "kernel_launch: unexpected problem (n_in %d, out %d, ws %zu)\n", n_in, out_size, ws_size); grid = -1; return; }
        int dev = 0, cus = 0, per_cu = 0;
        (void)hipGetDevice(&dev); (void)hipDeviceGetAttribute(&cus, hipDeviceAttributeMultiprocessorCount, dev);
        if (hipFuncSetAttribute((const void*)fwd_kernel, hipFuncAttributeMaxDynamicSharedMemorySize, LDS_BYTES) != hipSuccess) { fprintf(stderr, "kernel_launch: hipFuncSetAttribute failed\n"); grid = -1; return; }
        if (hipOccupancyMaxActiveBlocksPerMultiprocessor(&per_cu, (const void*)fwd_kernel, NTHREADS, LDS_BYTES) != hipSuccess || per_cu < 1) { fprintf(stderr, "kernel_launch: occupancy query says %d blocks per CU\n", per_cu); (void)hipGetLastError(); per_cu = 1; }
        grid = cus;
        if (grid < 1) grid = 256;
    }
    if (grid < 0) return;
    (void)hipMemsetAsync((char*)d_ws + WS_CTL, 0, CTL_ZERO_BYTES, stream);
    Args a{};
    for (int i = 0; i < 26; ++i) a.in[i] = (const float*)d_in[i];
    a.out = (float*)d_out; a.ws = (unsigned char*)d_ws;
#if MK_ONE_LAUNCH
    a.ph_lo = 0; a.ph_hi = NPHASE;
    void* args[] = {&a};
    hipError_t e = hipLaunchCooperativeKernel((const void*)fwd_kernel, dim3(grid), dim3(NTHREADS), args, LDS_BYTES, stream);
    if (e != hipSuccess) fprintf(stderr, "kernel_launch: cooperative launch failed: %s (grid %d)\n", hipGetErrorString(e), grid);
#else
    for (int ph = 0; ph < NPHASE; ++ph) { a.ph_lo = ph; a.ph_hi = ph + 1; hipLaunchKernelGGL(fwd_kernel, dim3(grid), dim3(NTHREADS), LDS_BYTES, stream, a); }
#endif
}
```

```cpp
#include <hip/hip_runtime.h>
#include <hip/hip_cooperative_groups.h>
#include <cstdio>
#include <cstdint>
namespace cg = cooperative_groups;

#define LAS __attribute__((address_space(3)))
#define GAS __attribute__((address_space(1)))
typedef unsigned short bf16_t;
typedef short bf16x8 __attribute__((ext_vector_type(8)));
typedef short s16x4 __attribute__((ext_vector_type(4)));
typedef float f32x4 __attribute__((ext_vector_type(4)));
typedef float f32x2 __attribute__((ext_vector_type(2)));
typedef float f32x16 __attribute__((ext_vector_type(16)));
typedef unsigned u32x4 __attribute__((ext_vector_type(4)));
typedef unsigned u32x2 __attribute__((ext_vector_type(2)));

#ifndef MK_ONE_LAUNCH
#define MK_ONE_LAUNCH 1
#endif

constexpr int DM = 1024, NBATCH = 8, SEQ = 2048, CTXL = 256;
constexpr int TL = NBATCH * SEQ, TC = NBATCH * CTXL, TT = TL + TC;
constexpr int NIN = 2464, NINP = 2560, NGATE = 4096, NBG = NINP + NGATE;
constexpr int QP = 3072;
constexpr int NEXP = 32, MAXTILES = 176;
constexpr float EPS = 1e-6f, LOG2E = 1.4426950408889634f;
constexpr int P_RET = 0, P_MLA = 1024, P_GQA = 1440, P_WIN = 1952;
constexpr int Q_RETQ = 0, Q_RETK = 256, Q_RETV = 512, Q_RETG = 768;
constexpr int Q_MLAQ = 1024, Q_MLAK = 1408, Q_MLAV = 1792;
constexpr int Q_GQAQ = 2048, Q_GQAK = 2304, Q_GQAV = 2432;
constexpr int Q_WINQ = 2560, Q_WINK = 2816, Q_WINV = 2944;

constexpr size_t MiB = 1u << 20;
constexpr size_t WS_CTL = 0, CTL_ZERO_BYTES = 1 * MiB;
constexpr size_t WS_ADA = 1 * MiB;
constexpr size_t WS_ROPE = WS_ADA + 512 * 1024;
constexpr size_t WS_WRP = WS_ROPE + 768 * 1024;
constexpr size_t WS_TOKINV = 3 * MiB;
constexpr size_t WS_TOKE = WS_TOKINV + (size_t)NEXP * TT * 4;
constexpr size_t WS_TOKW = WS_TOKE + (size_t)TT * 2 * 4;
constexpr size_t WS_WSM = 6 * MiB;
constexpr size_t WS_WIN = 8 * MiB;
constexpr size_t WS_WBR = 34 * MiB;
constexpr size_t WS_WOUT = 38 * MiB;
constexpr size_t WS_W13 = 42 * MiB;
constexpr size_t WS_W2 = 298 * MiB;
constexpr size_t WS_X = 426 * MiB;
constexpr size_t WS_H = 498 * MiB;
constexpr size_t WS_QKV = 534 * MiB;
constexpr size_t WS_Y = 642 * MiB;
constexpr size_t WS_MRG = 678 * MiB;
constexpr size_t WS_P = 714 * MiB;
constexpr size_t WS_G = 804 * MiB;
constexpr size_t WS_HID = 714 * MiB;
constexpr size_t WS_Y2 = 804 * MiB;
constexpr size_t WS_END = 948 * MiB;
static_assert(WS_TOKW + (size_t)TT * 8 <= WS_WSM && WS_HID + (size_t)MAXTILES * 256 * 2048 <= WS_Y2 && WS_Y2 + (size_t)MAXTILES * 256 * 2048 <= WS_END, "ws map");
static_assert(WS_P + (size_t)TT * NINP * 2 <= WS_G && WS_G + (size_t)TT * NGATE * 2 <= WS_END && WS_END <= 1024 * MiB, "ws map");
constexpr int CW_BAR = 4096;
constexpr int CW_CNT = 16384;
constexpr int CW_WQ = 16640;

constexpr int LDS_MISC = 131072, LDS_BYTES = 147456;

__device__ __forceinline__ unsigned f2bf(float f) { unsigned u = __builtin_bit_cast(unsigned, f); return (u + 0x7fffu + ((u >> 16) & 1u)) >> 16; }
__device__ __forceinline__ unsigned pk2(float lo, float hi) { typedef __bf16 bf2 __attribute__((ext_vector_type(2))); f32x2 v = {lo, hi}; bf2 b = __builtin_convertvector(v, bf2); return __builtin_bit_cast(unsigned, b); }
__device__ __forceinline__ unsigned pk4_fp8(float a, float b, float c, float d) { int p = __builtin_amdgcn_cvt_pk_fp8_f32(a, b, 0, false); p = __builtin_amdgcn_cvt_pk_fp8_f32(c, d, p, true); return (unsigned)p; }
__device__ __forceinline__ float bf2f(unsigned short b) { return __builtin_bit_cast(float, (unsigned)b << 16); }
__device__ __forceinline__ float bflo(unsigned w) { return __builtin_bit_cast(float, w << 16); }
__device__ __forceinline__ float bfhi(unsigned w) { return __builtin_bit_cast(float, w & 0xffff0000u); }
template <int M> __device__ __forceinline__ float xadd(float v) {
    if constexpr (M == 32) { unsigned a = __builtin_bit_cast(unsigned, v), b = a; asm volatile("" : "+v"(b));
        auto r = __builtin_amdgcn_permlane32_swap(a, b, false, false); const unsigned r0 = r[0], r1 = r[1];
        return __uint_as_float(r0) + __uint_as_float(r1); }
    else return v + __builtin_bit_cast(float, __builtin_amdgcn_ds_swizzle(__builtin_bit_cast(int, v), (M << 10) | 0x1f));
}
__device__ __forceinline__ float xmax32(float v) { unsigned a = __builtin_bit_cast(unsigned, v), b = a; asm volatile("" : "+v"(b));
    auto r = __builtin_amdgcn_permlane32_swap(a, b, false, false); const unsigned r0 = r[0], r1 = r[1]; return fmaxf(__uint_as_float(r0), __uint_as_float(r1)); }
__device__ __forceinline__ float wave_sum(float v) { v = xadd<1>(v); v = xadd<2>(v); v = xadd<4>(v); v = xadd<8>(v); v = xadd<16>(v); return xadd<32>(v); }
__device__ __forceinline__ float fast_exp2(float x) { return __builtin_amdgcn_exp2f(x); }
__device__ __forceinline__ float fast_rcp(float x) { return __builtin_amdgcn_rcpf(x); }
__device__ __forceinline__ float sigmoidf_(float x) { return fast_rcp(1.f + fast_exp2(-x * LOG2E)); }
__device__ __forceinline__ int lane_id() { return (int)__builtin_amdgcn_mbcnt_hi(~0u, __builtin_amdgcn_mbcnt_lo(~0u, 0u)); }
__device__ __forceinline__ void glds16(const void* gsrc, unsigned lds_dst) { unsigned keep;
    asm volatile("s_mov_b32 %0, m0\n\ts_mov_b32 m0, %2\n\ts_nop 0\n\tglobal_load_lds_dwordx4 %1, off\n\ts_mov_b32 m0, %0" : "=&s"(keep) : "v"(gsrc), "s"(lds_dst) : "memory"); }
__device__ __forceinline__ const char* uniform_ptr(const char* p) { const unsigned long long v = (unsigned long long)(uintptr_t)p; const unsigned lo = (unsigned)__builtin_amdgcn_readfirstlane((int)(unsigned)v), hi = (unsigned)__builtin_amdgcn_readfirstlane((int)(unsigned)(v >> 32)); return (const char*)(uintptr_t)(((unsigned long long)hi << 32) | lo); }
__device__ __forceinline__ void glds16_sv(const void* sbase, unsigned voff, unsigned lds_dst) { unsigned keep;
    asm volatile("s_mov_b32 %0, m0\n\ts_mov_b32 m0, %3\n\ts_nop 0\n\tglobal_load_lds_dwordx4 %1, %2\n\ts_mov_b32 m0, %0" : "=&s"(keep) : "v"(voff), "s"(sbase), "s"(lds_dst) : "memory"); }
#define LDS_WAIT() asm volatile("s_waitcnt lgkmcnt(0)" ::: "memory")
#define VM_WAIT() asm volatile("s_waitcnt vmcnt(0)" ::: "memory")

#define XB_TMO      128
#define XB_XCNT(j)  (256  + 64 * (j))
#define XB_XSUB(j)  (1280 + 64 * (j))
#define XB_XGEN(j)  (2304 + 64 * (j))
#define XB_TOP      3328
#define XB_TOPGEN   3392
#define XCD_BAR_WORDS 3456
#define XB_SPIN_CAP (1u << 18)
__device__ __forceinline__ unsigned xb_ld(unsigned* p)              { return __hip_atomic_load(p, __ATOMIC_RELAXED, __HIP_MEMORY_SCOPE_AGENT); }
__device__ __forceinline__ unsigned xb_add(unsigned* p, unsigned v) { return __hip_atomic_fetch_add(p, v, __ATOMIC_RELAXED, __HIP_MEMORY_SCOPE_AGENT); }
__device__ __forceinline__ unsigned xb_xcc_id() { return (unsigned)__builtin_amdgcn_s_getreg((3 << 11) | 20) & 0xFu; }
#define XB_SPIN(cond, bar) do { unsigned _sp = 0; while (cond) { __builtin_amdgcn_s_sleep(1); \
    if ((++_sp & 255u) == 0u) { if (xb_ld(&(bar)[XB_TMO])) break; if (_sp > XB_SPIN_CAP) { atomicAdd(&(bar)[XB_TMO], 1u); break; } } } } while (0)
struct XcdBarrier { unsigned* bar; unsigned x; volatile LAS unsigned* st; int wave; };
__device__ __forceinline__ XcdBarrier xcd_barrier_post(unsigned* bar, volatile LAS unsigned* st, int wave) {
    XcdBarrier b; b.bar = bar; b.x = xb_xcc_id(); b.st = st; b.wave = wave;
    if (wave == 0 && lane_id() == 0) (void)xb_add(&bar[XB_XCNT(b.x)], 1u);
    return b;
}
__device__ __forceinline__ void xcd_barrier_complete(unsigned* bar, unsigned x, unsigned& nloc, unsigned& nx) {
    const unsigned G = gridDim.x * gridDim.y * gridDim.z;
    unsigned sum, cnt, mine, sp = 0u;
    for (;;) {
        sum = 0u; cnt = 0u; mine = 0u;
#pragma unroll
        for (unsigned j = 0; j < 16; ++j) { const unsigned c = xb_ld(&bar[XB_XCNT(j)]); sum += c; cnt += (c > 0u) ? 1u : 0u; }
        mine = xb_ld(&bar[XB_XCNT(x)]);
        if (sum == G) break;
        __builtin_amdgcn_s_sleep(1);
        if ((++sp & 255u) == 0u) { if (xb_ld(&bar[XB_TMO])) break; if (sp > XB_SPIN_CAP) { atomicAdd(&bar[XB_TMO], 1u); break; } }
    }
    nloc = mine > 0u ? mine : 1u; nx = cnt > 0u ? cnt : 1u;
}
__device__ __forceinline__ void xcd_barrier(const XcdBarrier& b) {
    asm volatile("s_waitcnt vmcnt(0)" ::: "memory");
    __syncthreads();
    if (b.wave == 0 && lane_id() == 0) {
        unsigned* bar = b.bar; asm volatile("" : "+s"(bar));
        __builtin_amdgcn_s_waitcnt(0);
        unsigned nloc = b.st[0], nx = b.st[1];
        if (nloc == 0u) { xcd_barrier_complete(bar, b.x, nloc, nx); b.st[0] = nloc; b.st[1] = nx; }
        const unsigned old = xb_add(&bar[XB_XSUB(b.x)], 1u);
        const unsigned gen = old / nloc;
        if (old + 1u == (gen + 1u) * nloc) {
            __builtin_amdgcn_fence(__ATOMIC_RELEASE, "agent");
            asm volatile("s_waitcnt vmcnt(0)" ::: "memory");
            const unsigned og = xb_add(&bar[XB_TOP], 1u);
            const unsigned tg = og / nx;
            if (og + 1u == (tg + 1u) * nx) xb_add(&bar[XB_TOPGEN], 1u);
            else XB_SPIN(xb_ld(&bar[XB_TOPGEN]) == tg, bar);
            __builtin_amdgcn_fence(__ATOMIC_ACQUIRE, "agent");
            xb_add(&bar[XB_XGEN(b.x)], 1u);
            asm volatile("s_waitcnt vmcnt(0)" ::: "memory");
        } else {
            XB_SPIN(xb_ld(&bar[XB_XGEN(b.x)]) == gen, bar);
            __builtin_amdgcn_fence(__ATOMIC_ACQUIRE, "agent");
            asm volatile("s_waitcnt vmcnt(0)" ::: "memory");
        }
    }
    __syncthreads();
}

namespace pg8 {
constexpr int BM = 256, BK = 64, HALF = 128, HTB = HALF * BK * 2, STAGE_BYTES = 8 * HTB;
__host__ __device__ __forceinline__ int lds_byte(int r, int c) { const int st = (r >> 4) * 2 + (c >> 5), rr = r & 15, cc = c & 31, ob = rr * 64 + cc * 2; return st * 1024 + (ob ^ (((ob >> 9) & 1) << 5)); }
__host__ __device__ __forceinline__ void stage_rc(int b, int& R, int& C) { const int st = b / 1024, sb = b % 1024, swz = sb ^ (((sb >> 9) & 1) << 5); R = (st >> 1) * 16 + swz / 64; C = (st & 1) * 32 + (swz % 64) / 2; }
__host__ __device__ __forceinline__ int perm32(int rho) { const int n = rho >> 4, i = rho & 15; return 8 * (i >> 2) + 4 * n + (i & 3); }
struct Unit { int pm, pn, aux; };
__device__ __forceinline__ void tile_order(int L, int nM, int nN, int& pm, int& pn) {
    const int nwg = nM * nN; int wgid = L; { const int q = nwg / 8, r = nwg % 8, xcd = wgid % 8, off = wgid / 8; wgid = (xcd < r ? xcd * (q + 1) : r * (q + 1) + (xcd - r) * q) + off; }
    const int nig = 8 * nN, gid = wgid / nig, fm = gid * 8, gsz = (nM - fm) < 8 ? (nM - fm) : 8;
    pm = fm + ((wgid % nig) % gsz); pn = (wgid % nig) / gsz;
}
typedef int i32x8 __attribute__((ext_vector_type(8)));
typedef int i32x4 __attribute__((ext_vector_type(4)));
struct Frag2 { bf16x8 k[2]; };
template <bool F8> struct FragT { typedef Frag2 type; };
template <> struct FragT<true> { typedef i32x8 type; };
__device__ __forceinline__ void frag_set(Frag2& f, int k, i32x4 v) { f.k[k] = __builtin_bit_cast(bf16x8, v); }
__device__ __forceinline__ void frag_set(i32x8& f, int k, i32x4 v) { if (k == 0) { f[0] = v[0]; f[1] = v[1]; f[2] = v[2]; f[3] = v[3]; } else { f[4] = v[0]; f[5] = v[1]; f[6] = v[2]; f[7] = v[3]; } }
__device__ __forceinline__ f32x4 mma1(const Frag2& w, const Frag2& x, f32x4 c, int, int) { c = __builtin_amdgcn_mfma_f32_16x16x32_bf16(w.k[0], x.k[0], c, 0, 0, 0); return __builtin_amdgcn_mfma_f32_16x16x32_bf16(w.k[1], x.k[1], c, 0, 0, 0); }
#ifndef FP8_ASM_MMA
#define FP8_ASM_MMA 1
#endif
__device__ __forceinline__ f32x4 mma1(const i32x8& w, const i32x8& x, f32x4 c, int sw, int sx) {
#if FP8_ASM_MMA
    asm volatile("v_mfma_scale_f32_16x16x128_f8f6f4 %0, %1, %2, %0, %3, %4 op_sel_hi:[0,0,0]" : "+v"(c) : "v"(w), "v"(x), "v"(sw), "v"(sx));
    return c;
#else
    return __builtin_amdgcn_mfma_scale_f32_16x16x128_f8f6f4(w, x, c, 0, 0, 0, sw, 0, sx);
#endif
}
template <class Epi, class Sched, bool GATHER, bool FP8 = false, int SW = 0x7f7f7f7f, int SX = 0x7f7f7f7f>
__device__ __forceinline__ void gemm_phase(LAS unsigned char* lds, const int tid, const int kb, const int lda, const int ldb, const Sched& S, const Epi& E) {
    const int wid = __builtin_amdgcn_readfirstlane(tid >> 6), lane = tid & 63, wr = wid >> 2, wc = wid & 3, fr = lane & 15, fq = lane >> 4;
    const int nt = kb / 128;
    int sR[2], sC[2]; unsigned voffB[2];
#pragma unroll
    for (int i = 0; i < 2; ++i) { int R, C; stage_rc(tid * 16 + i * 8192, R, C); sR[i] = R; sC[i] = C; const int Rb = Epi::PERM ? ((R & ~31) + perm32(R & 31)) : R; voffB[i] = (unsigned)(Rb * ldb + C * 2); }
    const size_t kstep = (size_t)(BK * 2);
    const size_t hstepB = (size_t)HALF * ldb;
    const unsigned ldsw = (unsigned)wid * 1024u; const unsigned ldsb_ = (unsigned)(uintptr_t)lds;
    const int aoff = lds_byte(wr * 64 + fr, fq * 8), boff = lds_byte(wc * 32 + fr, fq * 8);
#define PG8_SA(b, h) (((b) * 2 + (h)) * HTB)
#define PG8_SB(b, h) ((4 + (b) * 2 + (h)) * HTB)
#define PG8_STAGE_B(bufoff, gbase) do { _Pragma("unroll") for (int _i = 0; _i < 2; ++_i) \
        glds16_sv((const void*)(gbase), voffB[_i], (unsigned)__builtin_amdgcn_readfirstlane((int)(ldsb_ + (bufoff) + ldsw + _i * 8192))); } while (0)
#define PG8_STAGE_A(bufoff, gbase, off) do { _Pragma("unroll") for (int _i = 0; _i < 2; ++_i) \
        glds16_sv((const void*)(gbase), (off)[_i], (unsigned)__builtin_amdgcn_readfirstlane((int)(ldsb_ + (bufoff) + ldsw + _i * 8192))); } while (0)
#define PG8_LDA(dst, b, h) do { _Pragma("unroll") for (int m = 0; m < 4; ++m) _Pragma("unroll") for (int k = 0; k < 2; ++k) frag_set(dst[m], k, *(const LAS i32x4*)(lds + PG8_SA(b, h) + aoff + m * 2048 + k * 1024)); } while (0)
#define PG8_LDB(dst, b, h) do { _Pragma("unroll") for (int n = 0; n < 2; ++n) _Pragma("unroll") for (int k = 0; k < 2; ++k) frag_set(dst[n], k, *(const LAS i32x4*)(lds + PG8_SB(b, h) + boff + n * 2048 + k * 1024)); } while (0)
#define PG8_MMA(ai, bj, At, Bt) do { __builtin_amdgcn_s_setprio(1); _Pragma("unroll") for (int m = 0; m < 4; ++m) _Pragma("unroll") for (int n = 0; n < 2; ++n) { \
        acc[ai][bj][m][n] = mma1(Bt[n], At[m], acc[ai][bj][m][n], SW, SX); } \
        __builtin_amdgcn_s_setprio(0); } while (0)
#define PG8_WAIT_V(n) asm volatile("s_waitcnt vmcnt(" #n ")" ::: "memory")
#define PG8_WAIT_L(n) asm volatile("s_waitcnt lgkmcnt(" #n ")" ::: "memory")
#define PG8_BAR __builtin_amdgcn_s_barrier()
#define PG8_SCHED __builtin_amdgcn_sched_barrier(0)
#define PG8_OFFS(dst, u) do { _Pragma("unroll") for (int _h = 0; _h < 2; ++_h) _Pragma("unroll") for (int _i = 0; _i < 2; ++_i) { \
        const int _r = sR[_i] + _h * HALF; const int _row = GATHER ? S.arow(u, _r) : _r; dst[_h][_i] = (unsigned)(_row * lda + sC[_i] * 2); } } while (0)
    Unit cur, nxt; int ui = 0;
    if (!S.next(0, cur)) return;
    f32x4 acc[2][2][4][2];
#pragma unroll
    for (int a = 0; a < 2; ++a)
#pragma unroll
        for (int b = 0; b < 2; ++b)
#pragma unroll
            for (int m = 0; m < 4; ++m)
#pragma unroll
                for (int n = 0; n < 2; ++n) acc[a][b][m][n] = (f32x4){0.f, 0.f, 0.f, 0.f};
    typedef typename FragT<FP8>::type frag_t;
    frag_t At[4], B0[2], B1[2];
    const char* cA; const char* cB; S.ptrs(cur, cA, cB); cA = uniform_ptr(cA); cB = uniform_ptr(cB);
    asm volatile("s_nop 4" ::: "memory");
    unsigned offC[2][2], offN[2][2];
    PG8_OFFS(offC, cur);
    PG8_STAGE_B(PG8_SB(0, 0), cB); PG8_STAGE_B(PG8_SB(0, 1), cB + hstepB); PG8_STAGE_A(PG8_SA(0, 0), cA, offC[0]); PG8_STAGE_A(PG8_SA(0, 1), cA, offC[1]);
    if (wr == 1) PG8_BAR;
    PG8_WAIT_V(2); PG8_BAR;
    PG8_STAGE_B(PG8_SB(1, 0), cB + kstep); PG8_STAGE_A(PG8_SA(1, 0), cA + kstep, offC[0]); PG8_STAGE_B(PG8_SB(1, 1), cB + hstepB + kstep);
    PG8_WAIT_V(6); PG8_BAR;
    for (;;) {
        const bool has_next = S.next(ui + 1, nxt);
        const char* nA = cA; const char* nB = cB;
        if (has_next) { S.ptrs(nxt, nA, nB); nA = uniform_ptr(nA); nB = uniform_ptr(nB); asm volatile("s_nop 4" ::: "memory"); PG8_OFFS(offN, nxt); }
        else {
#pragma unroll
            for (int h = 0; h < 2; ++h)
#pragma unroll
                for (int i = 0; i < 2; ++i) offN[h][i] = offC[h][i];
        }
#pragma unroll 1
        for (int tsec = 0; tsec < nt; tsec += (Epi::MID ? 4 : nt)) {
        if constexpr (Epi::MID) { if (tsec != 0) { unsigned z_ = 0u; asm volatile("" : "+v"(z_)); const int l2_ = (int)__builtin_amdgcn_mbcnt_hi(~0u, __builtin_amdgcn_mbcnt_lo(~0u, z_)); E.mid(acc, cur, tsec >> 2, wr, wc, l2_ & 15, l2_ >> 4); } }
#pragma unroll 1
        for (int t = tsec; t < tsec + (Epi::MID ? 4 : nt); t += 2) {
            const bool last = (t == nt - 2);
            const char* a1 = cA + (size_t)(t + 1) * kstep;
            const char* a2 = last ? nA : cA + (size_t)(t + 2) * kstep; const char* b2 = last ? nB : cB + (size_t)(t + 2) * kstep;
            const char* a3 = a2 + kstep; const char* b3 = b2 + kstep;
            unsigned o2[2][2];
#pragma unroll
            for (int h = 0; h < 2; ++h)
#pragma unroll
                for (int i = 0; i < 2; ++i) o2[h][i] = last ? offN[h][i] : offC[h][i];
            PG8_LDB(B0, 0, 0); PG8_LDB(B1, 0, 1); PG8_SCHED; PG8_LDA(At, 0, 0); PG8_STAGE_A(PG8_SA(1, 1), a1, offC[1]);
            PG8_WAIT_V(8); PG8_WAIT_L(0); PG8_BAR; PG8_MMA(0, 0, At, B0); PG8_MMA(0, 1, At, B1); PG8_BAR; PG8_SCHED;
            PG8_LDA(At, 0, 1); PG8_STAGE_B(PG8_SB(0, 0), b2); PG8_STAGE_B(PG8_SB(0, 1), b2 + hstepB); PG8_STAGE_A(PG8_SA(0, 0), a2, o2[0]);
            PG8_WAIT_V(8); PG8_WAIT_L(0); PG8_BAR; PG8_MMA(1, 0, At, B0); PG8_MMA(1, 1, At, B1); PG8_BAR; PG8_SCHED;
            PG8_LDB(B0, 1, 0); PG8_LDB(B1, 1, 1); PG8_SCHED; PG8_LDA(At, 1, 0); PG8_STAGE_A(PG8_SA(0, 1), a2, o2[1]);
            PG8_WAIT_V(8); PG8_WAIT_L(0); PG8_BAR; PG8_MMA(0, 0, At, B0); PG8_MMA(0, 1, At, B1); PG8_BAR; PG8_SCHED;
            PG8_LDA(At, 1, 1); PG8_STAGE_B(PG8_SB(1, 0), b3); PG8_STAGE_B(PG8_SB(1, 1), b3 + hstepB); PG8_STAGE_A(PG8_SA(1, 0), a3, o2[0]);
            PG8_WAIT_V(8); PG8_WAIT_L(0); PG8_BAR; PG8_MMA(1, 0, At, B0); PG8_MMA(1, 1, At, B1); PG8_BAR; PG8_SCHED;
        }
        }
        if (wr == 0) PG8_BAR;
        if constexpr (FP8) asm volatile("s_nop 15\n\ts_nop 7" ::: "memory");
        { unsigned z_ = 0u; asm volatile("" : "+v"(z_)); const int l2_ = (int)__builtin_amdgcn_mbcnt_hi(~0u, __builtin_amdgcn_mbcnt_lo(~0u, z_)); E(acc, cur, wr, wc, l2_ & 15, l2_ >> 4); }
        if (!has_next) break;
        if (S.fresh(nxt)) {
#pragma unroll
            for (int a = 0; a < 2; ++a)
#pragma unroll
                for (int b = 0; b < 2; ++b)
#pragma unroll
                    for (int m = 0; m < 4; ++m)
#pragma unroll
                        for (int n = 0; n < 2; ++n) acc[a][b][m][n] = (f32x4){0.f, 0.f, 0.f, 0.f};
        }
        cur = nxt; cA = nA; cB = nB; ++ui;
#pragma unroll
        for (int h = 0; h < 2; ++h)
#pragma unroll
            for (int i = 0; i < 2; ++i) offC[h][i] = offN[h][i];
        if (wr == 1) PG8_BAR;
    }
    PG8_WAIT_V(0);
    PG8_BAR;
#undef PG8_SA
#undef PG8_SB
#undef PG8_STAGE_A
#undef PG8_STAGE_B
#undef PG8_LDA
#undef PG8_LDB
#undef PG8_MMA
#undef PG8_WAIT_V
#undef PG8_WAIT_L
#undef PG8_BAR
#undef PG8_SCHED
#undef PG8_OFFS
}
}

struct Args { const float* in[26]; float* out; unsigned char* ws; int ph_lo, ph_hi; };
typedef const __attribute__((address_space(4))) Args* KArgs;
enum { I_X = 0, I_C, I_CTX, I_CCTX, I_WADA, I_BADA, I_N1G, I_N2G, I_WIN, I_WGATE, I_WBR, I_WOUT, I_DECAY, I_QNG, I_WUQ, I_KVNG, I_WUKV, I_GQN, I_GKN, I_SINK, I_WR, I_BR, I_W1, I_W3, I_W2, I_FNG };
constexpr int NWAVES = 8, NTHREADS = 512;

struct CvtDesc { const float* src; const float* kscale; bf16_t* dst; int N, k0, n0, Kd, nvalid, rmap, fp8; };
__device__ __forceinline__ void cvt_load(const CvtDesc& d, int lane, f32x4 (&v)[16]) {
    const int kk = lane >> 4, n4 = lane & 15, ncol = d.n0 + 4 * n4;
#pragma unroll
    for (int j = 0; j < 16; ++j) {
        const int k = d.k0 + 16 * kk + j;
        v[j] = (4 * n4 < d.nvalid) ? __builtin_nontemporal_load((const GAS f32x4*)(d.src + (size_t)k * d.N + ncol)) : (f32x4){0.f, 0.f, 0.f, 0.f};
    }
}
__device__ __forceinline__ void cvt_store(const CvtDesc& d, f32x4 (&v)[16], LAS unsigned char* scr, int lane) {
    const int kk = lane >> 4, n4 = lane & 15;
    if (d.kscale) {
#pragma unroll
        for (int j = 0; j < 16; ++j) v[j] = v[j] * d.kscale[d.k0 + 16 * kk + j];
    }
    if (d.fp8) {
#pragma unroll
        for (int i = 0; i < 4; ++i) { u32x4 w;
            w.x = pk4_fp8(32.f * v[0][i], 32.f * v[1][i], 32.f * v[2][i], 32.f * v[3][i]); w.y = pk4_fp8(32.f * v[4][i], 32.f * v[5][i], 32.f * v[6][i], 32.f * v[7][i]);
            w.z = pk4_fp8(32.f * v[8][i], 32.f * v[9][i], 32.f * v[10][i], 32.f * v[11][i]); w.w = pk4_fp8(32.f * v[12][i], 32.f * v[13][i], 32.f * v[14][i], 32.f * v[15][i]);
            *(LAS u32x4*)(scr + (4 * n4 + i) * 80 + 16 * kk) = w; }
        LDS_WAIT(); asm volatile("" ::: "memory");
        const int c = lane & 3;
#pragma unroll
        for (int jj = 0; jj < 4; ++jj) {
            const int n = (lane >> 2) + 16 * jj;
            const u32x4 o = *(const LAS u32x4*)(scr + n * 80 + 16 * c);
            const int prow = d.rmap == 0 ? n : (d.rmap == 1 ? (n & 31) + 128 * (n >> 5) : 32 * (n >> 4) + 8 * ((n >> 2) & 3) + (n & 3));
            *(GAS u32x4*)((unsigned char*)d.dst + (size_t)prow * d.Kd + d.k0 + 16 * c) = o;
        }
        LDS_WAIT(); asm volatile("" ::: "memory");
        return;
    }
#pragma unroll
    for (int i = 0; i < 4; ++i) { u32x4 w0, w1;
        w0.x = pk2(v[0][i], v[1][i]); w0.y = pk2(v[2][i], v[3][i]); w0.z = pk2(v[4][i], v[5][i]); w0.w = pk2(v[6][i], v[7][i]);
        w1.x = pk2(v[8][i], v[9][i]); w1.y = pk2(v[10][i], v[11][i]); w1.z = pk2(v[12][i], v[13][i]); w1.w = pk2(v[14][i], v[15][i]);
        *(LAS u32x4*)(scr + (4 * n4 + i) * 144 + 32 * kk) = w0; *(LAS u32x4*)(scr + (4 * n4 + i) * 144 + 32 * kk + 16) = w1; }
    LDS_WAIT(); asm volatile("" ::: "memory");
    const int c = lane & 7;
#pragma unroll
    for (int jj = 0; jj < 8; ++jj) {
        const int n = (lane >> 3) + 8 * jj;
        const u32x4 o = *(const LAS u32x4*)(scr + n * 144 + 16 * c);
        const int prow = d.rmap == 0 ? n : (d.rmap == 1 ? (n & 31) + 128 * (n >> 5) : 32 * (n >> 4) + 8 * ((n >> 2) & 3) + (n & 3));
        *(GAS u32x4*)(d.dst + (size_t)prow * d.Kd + d.k0 + 8 * c) = o;
    }
    LDS_WAIT(); asm volatile("" ::: "memory");
}
constexpr int CV_EXP_ITEMS = 2 * 32 * 3 * 256;
constexpr int CV_IN = 16 * 40, CV_GT = 16 * 64, CV_BRN = 4 * 16, CV_OUT = 16 * 16, CV_UQ = 4 * 6, CV_UKV = 2 * 8;
constexpr int CV_PER_L = CV_IN + CV_GT + 4 * CV_BRN + CV_OUT + CV_UQ + CV_UKV;
constexpr int CV_NITEMS = CV_EXP_ITEMS + 2 * CV_PER_L;
constexpr int CV_E0_SHARE = 12288;
__device__ __forceinline__ void cvt_decode(KArgs a, unsigned char* ws, int it, CvtDesc& d) {
    d.kscale = nullptr; d.N = 1024; d.Kd = 1024; d.nvalid = 64; d.rmap = 0; d.fp8 = 0;
    if (it < CV_EXP_ITEMS) {
        d.fp8 = 1;
        const int j = it >> 8, r = it & 255, l = j / 96, jj = j % 96, e = jj / 3, kind = jj % 3, kb = r >> 4, nb = r & 15;
        const size_t eo = ((size_t)l * 32 + e) * 1048576;
        d.k0 = kb * 64; d.n0 = nb * 64;
        if (kind < 2) { d.src = (kind == 0 ? a->in[I_W1] : a->in[I_W3]) + eo;
            d.dst = (bf16_t*)(ws + WS_W13 + ((size_t)l * 32 + e) * 2097152 + (size_t)(256 * (nb >> 1) + 128 * kind + 64 * (nb & 1)) * 1024); }
        else { d.src = a->in[I_W2] + eo; d.dst = (bf16_t*)(ws + WS_W2 + eo + (size_t)(nb * 64) * 1024); }
        return;
    }
    int r = it - CV_EXP_ITEMS; const int l = r / CV_PER_L; r -= l * CV_PER_L;
    if (r < CV_IN) {
        const int kb = r / 40, hb = r % 40, t = hb >> 2, wc = hb & 3; int src0 = -1, nv = 64;
        if (t < 5) src0 = 256 * t + 64 * wc;
        else if (t == 5) { if (wc < 2) src0 = 1280 + 64 * wc; else if (wc == 2) { src0 = 1408; nv = 32; } }
        else if (t == 6) src0 = P_GQA + 64 * wc;
        else if (t == 7) src0 = wc < 2 ? P_GQA + 256 + 64 * wc : P_GQA + 384 + 64 * (wc - 2);
        else if (t == 8) src0 = P_WIN + 64 * wc;
        else src0 = wc < 2 ? P_WIN + 256 + 64 * wc : P_WIN + 384 + 64 * (wc - 2);
        d.src = a->in[I_WIN] + (size_t)l * 1024 * NIN; d.N = NIN; d.k0 = kb * 64; d.n0 = src0 < 0 ? 0 : src0; d.nvalid = src0 < 0 ? 0 : nv; d.rmap = 1;
        d.fp8 = 1; d.dst = (bf16_t*)(ws + WS_WIN + ((size_t)l * NBG + 256 * t + 32 * wc) * 1024); return; } r -= CV_IN;
    if (r < CV_GT) {
        const int kb = r >> 6, nb = r & 63, i = nb >> 4, tg = nb & 15;
        d.src = a->in[I_WGATE] + (size_t)l * 1024 * 4096; d.N = 4096; d.k0 = kb * 64; d.n0 = i * 1024 + 64 * tg; d.rmap = 2;
        d.fp8 = 1; d.dst = (bf16_t*)(ws + WS_WIN + ((size_t)l * NBG + NINP + 256 * tg + 128 * (i >> 1) + 4 * (i & 1)) * 1024); return; } r -= CV_GT;
    if (r < 4 * CV_BRN) { const int i = r / CV_BRN, rr = r % CV_BRN, kb = rr >> 4, nb = rr & 15; d.src = a->in[I_WBR] + ((size_t)l * 4 + i) * 256 * 1024; d.k0 = kb * 64; d.n0 = nb * 64;
        d.dst = (bf16_t*)(ws + WS_WBR) + ((size_t)l * 1024 + nb * 64) * 1024 + 256 * i; return; } r -= 4 * CV_BRN;
    if (r < CV_OUT) { const int kb = r >> 4, nb = r & 15; d.src = a->in[I_WOUT] + (size_t)l * 1048576; d.k0 = kb * 64; d.n0 = nb * 64; d.dst = (bf16_t*)(ws + WS_WOUT) + (size_t)l * 1048576 + (size_t)(nb * 64) * 1024; return; } r -= CV_OUT;
    if (r < CV_UQ) { const int kb = r / 6, nb = r % 6; d.src = a->in[I_WUQ] + (size_t)l * 256 * 384; d.N = 384; d.k0 = kb * 64; d.n0 = nb * 64; d.kscale = a->in[I_QNG] + l * 256; d.dst = (bf16_t*)(ws + WS_WSM) + ((size_t)l * 384 + nb * 64) * 256; d.Kd = 256; return; } r -= CV_UQ;
    { const int kb = r >> 3, nb = r & 7; d.src = a->in[I_WUKV] + (size_t)l * 128 * 512; d.N = 512; d.k0 = kb * 64; d.n0 = nb * 64; d.kscale = a->in[I_KVNG] + l * 128; d.dst = (bf16_t*)(ws + WS_WSM) + 2 * 384 * 256 + ((size_t)l * 512 + nb * 64) * 128; d.Kd = 128; }
}

__device__ __forceinline__ void cvt_run(KArgs a, unsigned char* ws, LAS unsigned char* lds, int lane, int wave, int first, int last, int start, int stride) {
    LAS unsigned char* scr = lds + 57344 + wave * 9216;
    int it = first + start;
    if (it < last) {
        CvtDesc dA, dB; f32x4 va[16], vb[16];
        cvt_decode(a, ws, it, dA); cvt_load(dA, lane, va);
        for (;;) {
            const int itB = it + stride; const bool hasB = itB < last;
            if (hasB) { cvt_decode(a, ws, itB, dB); cvt_load(dB, lane, vb); }
            cvt_store(dA, va, scr, lane);
            if (!hasB) break;
            const int itA = itB + stride; const bool hasA = itA < last;
            if (hasA) { cvt_decode(a, ws, itA, dA); cvt_load(dA, lane, va); }
            cvt_store(dB, vb, scr, lane);
            if (!hasA) break;
            it = itA;
        }
    }
}
__device__ __forceinline__ void p0_prologue(KArgs a, LAS unsigned char* lds, int tid, int lane, int wave, int G, int c) {
    unsigned char* ws = a->ws;
    if (c < 192) {
        LAS float* st = (LAS float*)lds;
        LAS float* red = (LAS float*)(lds + 36864);
        for (int idx = tid; idx < 9 * 1024; idx += NTHREADS) { const int r = idx >> 10, k = idx & 1023; const float v = r < 8 ? a->in[I_C][r * 1024 + k] : a->in[I_CCTX][k]; st[idx] = v / (1.f + __expf(-v)); }
        __syncthreads();
        const int l = c / 96, n0 = (c % 96) * 64;
        float acc[9];
#pragma unroll
        for (int r = 0; r < 9; ++r) acc[r] = 0.f;
        const float* wp = a->in[I_WADA] + ((size_t)l * 1024 + wave * 128) * 6144 + n0 + lane;
#pragma unroll 4
        for (int k = 0; k < 128; ++k) { const float wv = wp[(size_t)k * 6144];
#pragma unroll
            for (int r = 0; r < 9; ++r) acc[r] += st[r * 1024 + wave * 128 + k] * wv; }
#pragma unroll
        for (int r = 0; r < 9; ++r) red[(wave * 9 + r) * 64 + lane] = acc[r];
        __syncthreads();
        for (int idx = tid; idx < 9 * 64; idx += NTHREADS) { const int r = idx >> 6, n = idx & 63; float s = 0.f;
#pragma unroll
            for (int w = 0; w < 8; ++w) s += red[(w * 9 + r) * 64 + n];
            ((float*)(ws + WS_ADA))[((size_t)l * 9 + r) * 6144 + n0 + n] = s + a->in[I_BADA][l * 6144 + n0 + n]; }
        __syncthreads();
    }
    const int gw = c * NWAVES + wave, NGW = G * NWAVES;
    {
        float* rope = (float*)(ws + WS_ROPE);
        for (int idx = gw * 64 + lane; idx < 2048 * 48; idx += NGW * 64) {
            const int pos = idx / 48, j = idx % 48, row = pos >> 6, col = pos & 63;
            if (j < 32) { const int i = j, f = i & 15; const float inv = powf(10000.f, -(float)f / 16.f); const float ang = (float)(i < 16 ? row : col) * inv;
                rope[pos * 32 + i] = cosf(ang); rope[2048 * 32 + pos * 32 + i] = sinf(ang); }
            else { const int i = j - 32, f = i & 7; const float inv = powf(10000.f, -(float)f / 8.f); const float ang = (float)(i < 8 ? row : col) * inv;
                rope[2 * 2048 * 32 + pos * 16 + i] = cosf(ang); rope[2 * 2048 * 32 + 2048 * 16 + pos * 16 + i] = sinf(ang); }
        }
        float* wrp = (float*)(ws + WS_WRP);
        for (int idx = gw * 64 + lane; idx < 32768; idx += NGW * 64) { const int half = idx >> 14, w = (idx >> 11) & 7, q = (idx >> 9) & 3, e = (idx >> 5) & 15, s = idx & 31;
            wrp[idx] = a->in[I_WR][(128 * w + 32 * q + s) * 32 + 16 * half + e]; }
    }
    cvt_run(a, ws, lds, lane, wave, 0, CV_EXP_ITEMS / 2, gw, NGW);
    cvt_run(a, ws, lds, lane, wave, CV_EXP_ITEMS, CV_NITEMS, gw, NGW);
}

__device__ __forceinline__ void moe_tables(const unsigned* ctl, int l, LAS unsigned char* lds, int tid) {
    LAS int* tb = (LAS int*)(lds + LDS_MISC + 1024); LAS int* cn = (LAS int*)(lds + LDS_MISC + 2304);
    __syncthreads();
    if (tid < 32) cn[tid] = (int)__hip_atomic_load(ctl + CW_CNT + l * 32 + tid, __ATOMIC_RELAXED, __HIP_MEMORY_SCOPE_AGENT);
    __syncthreads();
    if (tid == 0) { int s = 0; for (int e = 0; e < 32; ++e) { tb[e] = s; s += (cn[e] + 255) >> 8; } tb[32] = s; }
    __syncthreads();
    if (tid < MAXTILES) { LAS int* te = (LAS int*)(lds + LDS_MISC + 1024 + 48 * 4); int e = 0; for (int k = 1; k < 32; ++k) e += (tid >= tb[k]) ? 1 : 0; te[tid] = e | ((tid - tb[e]) << 8); }
    __syncthreads();
}

__device__ __forceinline__ void phase_rownorm(KArgs a, int mode, LAS unsigned char* lds, int lane, int wave, int G, int c) {
    unsigned char* ws = a->ws;
    const int gw = c * NWAVES + wave, NGW = G * NWAVES;
    const float* ada = (const float*)(ws + WS_ADA);
    float* X = (float*)(ws + WS_X);
    const LAS int* tb = (const LAS int*)(lds + LDS_MISC + 1024);
    const int nrows = (mode == 2) ? TL : TT;
    const int lprev = mode - 1, lcur = (mode == 2) ? 0 : mode;
    constexpr int R = 3;
    for (int base = gw; base < nrows; base += R * NGW) {
        f32x4 v[R][4]; int rows[R]; bool ok[R];
#pragma unroll
        for (int r = 0; r < R; ++r) { rows[r] = base + r * NGW; ok[r] = rows[r] < nrows; if (!ok[r]) rows[r] = base; }
#pragma unroll
        for (int r = 0; r < R; ++r) {
            const int row = rows[r];
            const float* src = (mode == 0) ? (row < TL ? a->in[I_X] + (size_t)row * 1024 : a->in[I_CTX] + (size_t)(row - TL) * 1024) : X + (size_t)row * 1024;
#pragma unroll
            for (int j = 0; j < 4; ++j) v[r][j] = *(const GAS f32x4*)(src + 4 * lane + 256 * j);
        }
        if (mode != 0) {
            const int* te = (const int*)(ws + WS_TOKE); const float* tw = (const float*)(ws + WS_TOKW);
            const bf16_t* Y2 = (const bf16_t*)(ws + WS_Y2);
            u32x2 y0[R][4], y1[R][4]; float w0[R], w1[R];
#pragma unroll
            for (int r = 0; r < R; ++r) {
                const int row = rows[r];
                const int e0 = te[row * 2], e1 = te[row * 2 + 1]; w0[r] = tw[row * 2]; w1[r] = tw[row * 2 + 1];
                const size_t s0 = (size_t)(tb[e0 >> 20] * 256 + (e0 & 0xfffff)), s1 = (size_t)(tb[e1 >> 20] * 256 + (e1 & 0xfffff));
#pragma unroll
                for (int j = 0; j < 4; ++j) { y0[r][j] = *(const GAS u32x2*)(Y2 + s0 * 1024 + 4 * lane + 256 * j); y1[r][j] = *(const GAS u32x2*)(Y2 + s1 * 1024 + 4 * lane + 256 * j); }
            }
#pragma unroll
            for (int r = 0; r < R; ++r) {
                const int row = rows[r]; const int b = row < TL ? (row >> 11) : 8;
                const float* g2 = ada + ((size_t)lprev * 9 + b) * 6144 + 5120;
#pragma unroll
                for (int j = 0; j < 4; ++j) {
                    const f32x4 gg = *(const GAS f32x4*)(g2 + 4 * lane + 256 * j);
                    f32x4 f; f.x = w0[r] * bflo(y0[r][j].x) + w1[r] * bflo(y1[r][j].x); f.y = w0[r] * bfhi(y0[r][j].x) + w1[r] * bfhi(y1[r][j].x);
                    f.z = w0[r] * bflo(y0[r][j].y) + w1[r] * bflo(y1[r][j].y); f.w = w0[r] * bfhi(y0[r][j].y) + w1[r] * bfhi(y1[r][j].y);
                    v[r][j] = v[r][j] + gg * f;
                }
                if (mode == 1 && ok[r]) {
#pragma unroll
                    for (int j = 0; j < 4; ++j) *(GAS f32x4*)(X + (size_t)row * 1024 + 4 * lane + 256 * j) = v[r][j];
                }
            }
        }
#pragma unroll
        for (int r = 0; r < R; ++r) {
            const int row = rows[r]; const int b = row < TL ? (row >> 11) : 8;
            float ss = 0.f;
#pragma unroll
            for (int j = 0; j < 4; ++j) ss += (v[r][j].x * v[r][j].x + v[r][j].y * v[r][j].y) + (v[r][j].z * v[r][j].z + v[r][j].w * v[r][j].w);
            const float rstd = 1.0f / sqrtf(wave_sum(ss) * (1.f / 1024.f) + EPS);
            if (ok[r]) {
                if (mode == 2) {
#pragma unroll
                    for (int j = 0; j < 4; ++j) { const f32x4 g = *(const GAS f32x4*)(a->in[I_FNG] + 4 * lane + 256 * j); *(GAS f32x4*)(a->out + (size_t)row * 1024 + 4 * lane + 256 * j) = v[r][j] * rstd * g; }
                } else {
                    const float* gn = a->in[I_N1G] + lcur * 1024; const float* sh = ada + ((size_t)lcur * 9 + b) * 6144; const float* sc = sh + 1024;
                    unsigned char* H = (unsigned char*)(ws + WS_H) + (size_t)row * 1024;
#pragma unroll
                    for (int j = 0; j < 4; ++j) { const int cc = 4 * lane + 256 * j; const f32x4 g = *(const GAS f32x4*)(gn + cc), s1 = *(const GAS f32x4*)(sc + cc), s0 = *(const GAS f32x4*)(sh + cc);
                        const f32x4 h = v[r][j] * rstd * g * (s1 + 1.0f) + s0; *(GAS unsigned*)(H + cc) = pk4_fp8(h.x, h.y, h.z, h.w); }
                }
            }
        }
    }
}

using pg8::Unit;
struct SchedB {
    int layer, G, c; const char* H; const char* W;
    __device__ __forceinline__ bool next(int i, Unit& u) const {
        const int L = i * G + c; u.aux = 0;
        if (layer == 0) { if (L >= 72 * 26) return false; pg8::tile_order(L, 72, 26, u.pm, u.pn); return true; }
        if (L < 64 * 16) { pg8::tile_order(L, 64, 16, u.pm, u.pn); u.pn += 10; return true; }
        const int L2 = L - 64 * 16; if (L2 >= 72 * 10) return false; pg8::tile_order(L2, 72, 10, u.pm, u.pn); return true;
    }
    __device__ __forceinline__ void ptrs(const Unit& u, const char*& A, const char*& B) const { A = H + (size_t)u.pm * 256 * 1024; B = W + (size_t)u.pn * 256 * 1024; }
    __device__ __forceinline__ int arow(const Unit&, int r) const { return r; }
    __device__ __forceinline__ bool fresh(const Unit&) const { return true; }
};
struct EpiB {
    static constexpr bool PERM = true, MID = false;
    bf16_t* P; bf16_t* Gt; bf16_t* Q; const float* cos64; const float* sin64; const float* qng; const float* kng;
    __device__ __forceinline__ void operator()(f32x4 (&acc)[2][2][4][2], const Unit& u, int wr, int wc, int fr, int fq) const {
        const int row0 = u.pm * 256 + wr * 64 + fr;
        if (u.pn >= 10) {
            const int d0 = (u.pn - 10) * 64 + 16 * wc + 4 * fq;
#pragma unroll
            for (int ai = 0; ai < 2; ++ai)
#pragma unroll
                for (int m = 0; m < 4; ++m) { bf16_t* gp = Gt + (size_t)(row0 + ai * 128 + m * 16) * NGATE + d0;
                    f32x4 g[4];
#pragma unroll
                    for (int i = 0; i < 4; ++i)
#pragma unroll
                        for (int j = 0; j < 4; ++j) g[i][j] = fmaxf(sigmoidf_(acc[ai][i >> 1][m][i & 1][j]), 1e-6f);
#pragma unroll
                    for (int i = 0; i < 4; ++i) { f32x4 r = g[i];
                        if (i < 3) {
#pragma unroll
                            for (int j = 0; j < 4; ++j) r[j] *= fast_rcp(g[i + 1][j]); }
                        u32x2 w; w.x = pk2(r[0], r[1]); w.y = pk2(r[2], r[3]); *(GAS u32x2*)(gp + i * 1024) = w; } }
            return;
        }
        const int t = u.pn;
        bf16_t* dst; size_t ld; int col; int mode = 0;
        float scale = 1.f; const float* gain = nullptr;
        if (t == 4) { dst = P; ld = NINP; col = P_MLA + 64 * wc; }
        else if (t == 5) { dst = P; ld = NINP; col = 1280 + 64 * wc; mode = wc < 3 ? 0 : 3; }
        else { dst = Q; ld = QP;
            if (t == 0) { col = Q_RETQ + 64 * wc; mode = 1; scale = 0.125f; }
            else if (t == 1) { col = Q_RETK + 64 * wc; mode = 1; }
            else if (t == 2) col = Q_RETV + 64 * wc;
            else if (t == 3) col = Q_RETG + 64 * wc;
            else if (t == 6) { col = Q_GQAQ + 64 * wc; mode = 2; scale = 0.125f * LOG2E; gain = qng; }
            else if (t == 7) { if (wc < 2) { col = Q_GQAK + 64 * wc; mode = 2; gain = kng; } else col = Q_GQAV + 64 * (wc - 2); }
            else if (t == 8) { col = Q_WINQ + 64 * wc; mode = 1; scale = 0.125f * LOG2E; }
            else { if (wc < 2) { col = Q_WINK + 64 * wc; mode = 1; } else col = Q_WINV + 64 * (wc - 2); } }
        if (mode == 3) return;
        f32x4 ga0 = {1.f, 1.f, 1.f, 1.f}, ga1 = ga0, gb0 = ga0, gb1 = ga0;
        if (mode == 2) { ga0 = *(const GAS f32x4*)(gain + 8 * fq); ga1 = *(const GAS f32x4*)(gain + 8 * fq + 4); gb0 = *(const GAS f32x4*)(gain + 32 + 8 * fq); gb1 = *(const GAS f32x4*)(gain + 32 + 8 * fq + 4); }
        const bool half_only = (t == 5 && wc == 2);
#pragma unroll
        for (int ai = 0; ai < 2; ++ai)
#pragma unroll
            for (int m = 0; m < 4; ++m) {
                const int row = row0 + ai * 128 + m * 16;
                f32x4 a0 = acc[ai][0][m][0], a1 = acc[ai][0][m][1], b0 = acc[ai][1][m][0], b1 = acc[ai][1][m][1];
                if (mode == 2) {
                    float ss = 0.f;
#pragma unroll
                    for (int j = 0; j < 4; ++j) ss += a0[j] * a0[j] + a1[j] * a1[j] + b0[j] * b0[j] + b1[j] * b1[j];
                    ss = xadd<16>(ss); ss = xadd<32>(ss);
                    const float rstd = __builtin_amdgcn_rsqf(ss * (1.f / 64.f) + EPS);
                    a0 = a0 * rstd * ga0; a1 = a1 * rstd * ga1; b0 = b0 * rstd * gb0; b1 = b1 * rstd * gb1;
                }
                if (mode >= 1) {
                    if (row < TL) { const int pos = row & 2047;
                        const f32x4 c0 = *(const GAS f32x4*)(cos64 + pos * 32 + 8 * fq), c1 = *(const GAS f32x4*)(cos64 + pos * 32 + 8 * fq + 4);
                        const f32x4 s0 = *(const GAS f32x4*)(sin64 + pos * 32 + 8 * fq), s1 = *(const GAS f32x4*)(sin64 + pos * 32 + 8 * fq + 4);
                        const f32x4 o0 = a0 * c0 - b0 * s0, o1 = a1 * c1 - b1 * s1, p0 = b0 * c0 + a0 * s0, p1 = b1 * c1 + a1 * s1;
                        a0 = o0; a1 = o1; b0 = p0; b1 = p1; }
                    a0 = a0 * scale; a1 = a1 * scale; b0 = b0 * scale; b1 = b1 * scale;
                }
                bf16_t* rp = dst + (size_t)row * ld + col + 8 * fq;
                u32x4 w; w.x = pk2(a0[0], a0[1]); w.y = pk2(a0[2], a0[3]); w.z = pk2(a1[0], a1[1]); w.w = pk2(a1[2], a1[3]);
                *(GAS u32x4*)rp = w;
                if (!half_only) { u32x4 w2; w2.x = pk2(b0[0], b0[1]); w2.y = pk2(b0[2], b0[3]); w2.z = pk2(b1[0], b1[1]); w2.w = pk2(b1[2], b1[3]); *(GAS u32x4*)(rp + 32) = w2; }
                asm volatile("" ::: "memory");
            }
    }
};
struct SchedE {
    int G, c, nM; const char* Y; const char* W;
    __device__ __forceinline__ bool next(int i, Unit& u) const { const int L = i * G + c; u.aux = 0; if (L >= nM * 4) return false; pg8::tile_order(L, nM, 4, u.pm, u.pn); return true; }
    __device__ __forceinline__ void ptrs(const Unit& u, const char*& A, const char*& B) const { A = Y + (size_t)u.pm * 256 * 1024 * 2; B = W + (size_t)u.pn * 256 * 1024 * 2; }
    __device__ __forceinline__ int arow(const Unit&, int r) const { return r; }
    __device__ __forceinline__ bool fresh(const Unit&) const { return true; }
};
struct EpiE {
    static constexpr bool PERM = true, MID = true;
    const bf16_t* Gt; bf16_t* M;
    __device__ __forceinline__ void mid(f32x4 (&acc)[2][2][4][2], const Unit& u, int i, int wr, int wc, int fr, int fq) const {
        const int row0 = u.pm * 256 + wr * 64 + fr;
        const int col0 = u.pn * 256 + wc * 32 + 8 * fq;
        const bf16_t* gp0 = Gt + (size_t)row0 * NGATE + (i - 1) * 1024 + col0;
        u32x4 g[2][4][2];
#pragma unroll
        for (int ai = 0; ai < 2; ++ai)
#pragma unroll
            for (int m = 0; m < 4; ++m)
#pragma unroll
                for (int bj = 0; bj < 2; ++bj) g[ai][m][bj] = *(const GAS u32x4*)(gp0 + (size_t)(ai * 128 + m * 16) * NGATE + bj * 128);
#pragma unroll
        for (int ai = 0; ai < 2; ++ai)
#pragma unroll
            for (int m = 0; m < 4; ++m)
#pragma unroll
                for (int bj = 0; bj < 2; ++bj) { const u32x4 gg = g[ai][m][bj];
                    const f32x4 s0 = {bflo(gg.x), bfhi(gg.x), bflo(gg.y), bfhi(gg.y)}, s1 = {bflo(gg.z), bfhi(gg.z), bflo(gg.w), bfhi(gg.w)};
                    acc[ai][bj][m][0] = acc[ai][bj][m][0] * s0; acc[ai][bj][m][1] = acc[ai][bj][m][1] * s1; }
    }
    __device__ __forceinline__ void operator()(f32x4 (&acc)[2][2][4][2], const Unit& u, int wr, int wc, int fr, int fq) const {
        const int row0 = u.pm * 256 + wr * 64 + fr, col0 = u.pn * 256 + wc * 32 + 8 * fq;
#pragma unroll
        for (int ai = 0; ai < 2; ++ai)
#pragma unroll
            for (int m = 0; m < 4; ++m) { const size_t row = (size_t)(row0 + ai * 128 + m * 16);
#pragma unroll
                for (int bj = 0; bj < 2; ++bj) {
                    const u32x4 g = *(const GAS u32x4*)(Gt + row * NGATE + 3 * 1024 + col0 + bj * 128);
                    const f32x4 s0 = {bflo(g.x), bfhi(g.x), bflo(g.y), bfhi(g.y)}, s1 = {bflo(g.z), bfhi(g.z), bflo(g.w), bfhi(g.w)};
                    const f32x4 v0 = acc[ai][bj][m][0] * s0, v1 = acc[ai][bj][m][1] * s1;
                    u32x4 w; w.x = pk2(v0[0], v0[1]); w.y = pk2(v0[2], v0[3]); w.z = pk2(v1[0], v1[1]); w.w = pk2(v1[2], v1[3]);
                    *(GAS u32x4*)(M + row * 1024 + col0 + bj * 128) = w;
                } }
    }
};
struct SchedF {
    int G, c, nM; const char* A0; const char* W;
    __device__ __forceinline__ bool next(int i, Unit& u) const { const int L = i * G + c; u.aux = 0; if (L >= nM * 4) return false; pg8::tile_order(L, nM, 4, u.pm, u.pn); return true; }
    __device__ __forceinline__ void ptrs(const Unit& u, const char*& A, const char*& B) const { A = A0 + (size_t)u.pm * 256 * 1024 * 2; B = W + (size_t)u.pn * 256 * 1024 * 2; }
    __device__ __forceinline__ int arow(const Unit&, int r) const { return r; }
    __device__ __forceinline__ bool fresh(const Unit&) const { return true; }
};
struct EpiF {
    static constexpr bool PERM = false, MID = false;
    const float* xin; const float* cin; const float* Xs; float* X; const float* ada_l; int layer;
    __device__ __forceinline__ void operator()(f32x4 (&acc)[2][2][4][2], const Unit& u, int wr, int wc, int fr, int fq) const {
        const int row0 = u.pm * 256 + wr * 64 + fr, col0 = u.pn * 256 + wc * 32 + 4 * fq;
#pragma unroll
        for (int ai = 0; ai < 2; ++ai)
#pragma unroll
            for (int m = 0; m < 4; ++m) { const int row = row0 + ai * 128 + m * 16; const int b = row < TL ? (row >> 11) : 8;
                const float* src = (layer == 0) ? (row < TL ? xin + (size_t)row * 1024 : cin + (size_t)(row - TL) * 1024) : Xs + (size_t)row * 1024;
                const float* g1 = ada_l + (size_t)b * 6144 + 2048;
#pragma unroll
                for (int bj = 0; bj < 2; ++bj)
#pragma unroll
                    for (int n = 0; n < 2; ++n) { const int c = col0 + bj * 128 + n * 16;
                        const f32x4 xs = *(const GAS f32x4*)(src + c), gg = *(const GAS f32x4*)(g1 + c);
                        *(GAS f32x4*)(X + (size_t)row * 1024 + c) = xs + gg * acc[ai][bj][m][n]; } }
    }
};
struct SchedMoe {
    int G, c, npn, gather; const LAS int* tb; const LAS int* cn; const int* tokinv; const char* A0; const char* W; size_t wstride;
    __device__ __forceinline__ bool next(int i, Unit& u) const {
        const int L = i * G + c; if (L >= __builtin_amdgcn_readfirstlane(tb[32]) * npn) return false;
        const int rt = L / npn; u.pm = rt; u.pn = L - rt * npn; u.aux = __builtin_amdgcn_readfirstlane(tb[48 + rt]); return true;
    }
    __device__ __forceinline__ void ptrs(const Unit& u, const char*& A, const char*& B) const {
        A = gather ? A0 : A0 + (size_t)u.pm * 256 * 1024; B = W + (size_t)(u.aux & 255) * wstride + (size_t)u.pn * 256 * 1024; }
    __device__ __forceinline__ int arow(const Unit& u, int r) const { const int e = u.aux & 255, idx = (u.aux >> 8) * 256 + r; return idx < cn[e] ? tokinv[(size_t)e * TT + idx] : 0; }
    __device__ __forceinline__ bool fresh(const Unit&) const { return true; }
};
struct EpiH {
    static constexpr bool PERM = true, MID = false;
    unsigned char* HID;
    __device__ __forceinline__ void operator()(f32x4 (&acc)[2][2][4][2], const Unit& u, int wr, int wc, int fr, int fq) const {
        const int row0 = u.pm * 256 + wr * 64 + fr, col0 = u.pn * 128 + wc * 32 + 8 * fq;
#pragma unroll
        for (int ai = 0; ai < 2; ++ai)
#pragma unroll
            for (int m = 0; m < 4; ++m) { f32x4 h0, h1;
#pragma unroll
                for (int j = 0; j < 4; ++j) { const float a0 = acc[ai][0][m][0][j], a1 = acc[ai][0][m][1][j];
                    h0[j] = a0 * sigmoidf_(a0) * acc[ai][1][m][0][j]; h1[j] = a1 * sigmoidf_(a1) * acc[ai][1][m][1][j]; }
                u32x2 w; w.x = pk4_fp8(4.f * h0[0], 4.f * h0[1], 4.f * h0[2], 4.f * h0[3]); w.y = pk4_fp8(4.f * h1[0], 4.f * h1[1], 4.f * h1[2], 4.f * h1[3]);
                *(GAS u32x2*)(HID + (size_t)(row0 + ai * 128 + m * 16) * 1024 + col0) = w; }
    }
};
struct EpiI {
    static constexpr bool PERM = true, MID = false;
    bf16_t* Y2;
    __device__ __forceinline__ void operator()(f32x4 (&acc)[2][2][4][2], const Unit& u, int wr, int wc, int fr, int fq) const {
        const int row0 = u.pm * 256 + wr * 64 + fr, col0 = u.pn * 256 + wc * 32 + 8 * fq;
#pragma unroll
        for (int ai = 0; ai < 2; ++ai)
#pragma unroll
            for (int m = 0; m < 4; ++m)
#pragma unroll
                for (int bj = 0; bj < 2; ++bj) { const f32x4 v0 = acc[ai][bj][m][0], v1 = acc[ai][bj][m][1];
                    u32x4 w; w.x = pk2(v0[0], v0[1]); w.y = pk2(v0[2], v0[3]); w.z = pk2(v1[0], v1[1]); w.w = pk2(v1[2], v1[3]);
                    *(GAS u32x4*)(Y2 + (size_t)(row0 + ai * 128 + m * 16) * 1024 + col0 + bj * 128) = w; }
    }
};

__device__ __forceinline__ void rope_item_desc(int item, int& src, int& dst, float& scale, int& normsel) {
    normsel = 0; scale = 1.f;
    if (item < 4) { src = P_RET + item * 64; dst = Q_RETQ + item * 64; scale = 0.125f; }
    else if (item < 8) { src = P_RET + 256 + (item - 4) * 64; dst = Q_RETK + (item - 4) * 64; }
    else if (item < 12) { src = P_GQA + (item - 8) * 64; dst = Q_GQAQ + (item - 8) * 64; scale = 0.125f * LOG2E; normsel = 1; }
    else if (item < 14) { src = P_GQA + 256 + (item - 12) * 64; dst = Q_GQAK + (item - 12) * 64; normsel = 2; }
    else if (item < 16) { src = P_WIN + 256 + (item - 14) * 64; dst = Q_WINK + (item - 14) * 64; }
    else { src = P_WIN + (item - 16) * 64; dst = Q_WINQ + (item - 16) * 64; scale = 0.125f * LOG2E; }
}
__device__ __forceinline__ void phase_post(KArgs a, int l, LAS unsigned char* lds, int lane, int wave, int G, int c) {
    unsigned char* ws = a->ws;
    const bf16_t* P = (const bf16_t*)(ws + WS_P); bf16_t* Q = (bf16_t*)(ws + WS_QKV);
    const float* cos32 = (const float*)(ws + WS_ROPE) + 2 * 2048 * 32; const float* sin32 = cos32 + 2048 * 16;
    const bf16_t* Wuq = (const bf16_t*)(ws + WS_WSM) + (size_t)l * 384 * 256; const bf16_t* Wukv = (const bf16_t*)(ws + WS_WSM) + 2 * 384 * 256 + (size_t)l * 512 * 128;
    const float qscale = 0.10206207261596577f * LOG2E;
    const unsigned ldsb = (unsigned)(uintptr_t)lds;
    constexpr int LQ = 0, LKV = 49152;
    constexpr int NU = (TT / 128) * 4;
    const int tk = lane & 15, kq = lane >> 4;
    int hcur = -1;
    bf16x8 zqN[8], zkvN[4]; u32x2 kr1N, kr2N; f32x4 crN, srN;
#define PP_LOAD(u_) do { const int row_ = ((u_) >> 2) * 128 + wave * 16 + tk; const bf16_t* prow_ = P + (size_t)row_ * NINP + P_MLA; \
        _Pragma("unroll") for (int s2 = 0; s2 < 8; ++s2) zqN[s2] = *(const GAS bf16x8*)(prow_ + 32 * s2 + 8 * kq); \
        _Pragma("unroll") for (int s2 = 0; s2 < 4; ++s2) zkvN[s2] = *(const GAS bf16x8*)(prow_ + 256 + 32 * s2 + 8 * kq); \
        kr1N = *(const GAS u32x2*)(prow_ + 384 + 4 * kq); kr2N = *(const GAS u32x2*)(prow_ + 400 + 4 * kq); \
        crN = (f32x4){1.f, 1.f, 1.f, 1.f}; srN = (f32x4){0.f, 0.f, 0.f, 0.f}; \
        if (row_ < TL) { const int pos_ = row_ & 2047; crN = *(const GAS f32x4*)(cos32 + pos_ * 16 + 4 * kq); srN = *(const GAS f32x4*)(sin32 + pos_ * 16 + 4 * kq); } } while (0)
    if (c < NU) PP_LOAD(c);
    for (int u = c; u < NU; u += G) {
        const int h = u & 3, rb = u >> 2;
        if (h != hcur) {
            asm volatile("s_waitcnt lgkmcnt(0)\n\ts_barrier" ::: "memory");
            for (int p = wave; p < 80; p += NWAVES) {
                if (p < 48) { const int row = 2 * p + (lane >> 5), ch = (lane & 31) ^ (row & 15);
                    glds16(Wuq + (size_t)(96 * h + row) * 256 + 8 * ch, (unsigned)__builtin_amdgcn_readfirstlane((int)(ldsb + LQ + p * 1024))); }
                else { const int p2 = p - 48, row = 4 * p2 + (lane >> 4), ch = (lane & 15) ^ (row & 15);
                    glds16(Wukv + (size_t)(128 * h + row) * 128 + 8 * ch, (unsigned)__builtin_amdgcn_readfirstlane((int)(ldsb + LKV + p2 * 1024))); }
            }
            asm volatile("s_waitcnt vmcnt(0)\n\ts_barrier" ::: "memory");
            hcur = h;
        }
        const int row = rb * 128 + wave * 16 + tk;
        bf16_t* qrow = Q + (size_t)row * QP;
        bf16x8 zq[8], zkv[4];
#pragma unroll
        for (int s2 = 0; s2 < 8; ++s2) zq[s2] = zqN[s2];
#pragma unroll
        for (int s2 = 0; s2 < 4; ++s2) zkv[s2] = zkvN[s2];
        const u32x2 kr1 = kr1N, kr2 = kr2N; const f32x4 cr = crN, sr = srN;
        if (u + G < NU) PP_LOAD(u + G);
        float sq = 0.f, skv = 0.f;
#pragma unroll
        for (int s2 = 0; s2 < 8; ++s2)
#pragma unroll
            for (int j = 0; j < 8; ++j) { const float f = bf2f((unsigned short)zq[s2][j]); sq += f * f; }
#pragma unroll
        for (int s2 = 0; s2 < 4; ++s2)
#pragma unroll
            for (int j = 0; j < 8; ++j) { const float f = bf2f((unsigned short)zkv[s2][j]); skv += f * f; }
        sq = xadd<16>(sq); sq = xadd<32>(sq); skv = xadd<16>(skv); skv = xadd<32>(skv);
        const float rq = (1.0f / sqrtf(sq * (1.f / 256.f) + EPS)) * qscale, rkv = 1.0f / sqrtf(skv * (1.f / 128.f) + EPS);
        f32x4 acc[6];
#pragma unroll
        for (int p = 0; p < 6; p += 2) {
            bf16x8 w0[8], w1[8];
#pragma unroll
            for (int s2 = 0; s2 < 8; ++s2) { w0[s2] = *(const LAS bf16x8*)(lds + LQ + (16 * p + tk) * 512 + (((4 * s2 + kq) ^ tk) * 16)); w1[s2] = *(const LAS bf16x8*)(lds + LQ + (16 * (p + 1) + tk) * 512 + (((4 * s2 + kq) ^ tk) * 16)); }
            acc[p] = (f32x4){0.f, 0.f, 0.f, 0.f}; acc[p + 1] = (f32x4){0.f, 0.f, 0.f, 0.f};
#pragma unroll
            for (int s2 = 0; s2 < 8; ++s2) { acc[p] = __builtin_amdgcn_mfma_f32_16x16x32_bf16(w0[s2], zq[s2], acc[p], 0, 0, 0); acc[p + 1] = __builtin_amdgcn_mfma_f32_16x16x32_bf16(w1[s2], zq[s2], acc[p + 1], 0, 0, 0); }
        }
#pragma unroll
        for (int p = 0; p < 4; ++p) { const f32x4 v = acc[p] * rq; u32x2 o; o.x = pk2(v[0], v[1]); o.y = pk2(v[2], v[3]); *(GAS u32x2*)(qrow + Q_MLAQ + h * 96 + 16 * p + 4 * kq) = o; }
        { const f32x4 x1 = acc[4] * rq, x2 = acc[5] * rq; const f32x4 o1 = x1 * cr - x2 * sr, o2 = x2 * cr + x1 * sr;
          u32x2 w1; w1.x = pk2(o1[0], o1[1]); w1.y = pk2(o1[2], o1[3]); u32x2 w2; w2.x = pk2(o2[0], o2[1]); w2.y = pk2(o2[2], o2[3]);
          *(GAS u32x2*)(qrow + Q_MLAQ + h * 96 + 64 + 4 * kq) = w1; *(GAS u32x2*)(qrow + Q_MLAQ + h * 96 + 80 + 4 * kq) = w2; }
#pragma unroll
        for (int p = 0; p < 8; p += 2) {
            bf16x8 w0[4], w1[4];
#pragma unroll
            for (int s2 = 0; s2 < 4; ++s2) { w0[s2] = *(const LAS bf16x8*)(lds + LKV + (16 * p + tk) * 256 + (((4 * s2 + kq) ^ tk) * 16)); w1[s2] = *(const LAS bf16x8*)(lds + LKV + (16 * (p + 1) + tk) * 256 + (((4 * s2 + kq) ^ tk) * 16)); }
            f32x4 a0 = {0.f, 0.f, 0.f, 0.f}, a1 = a0;
#pragma unroll
            for (int s2 = 0; s2 < 4; ++s2) { a0 = __builtin_amdgcn_mfma_f32_16x16x32_bf16(w0[s2], zkv[s2], a0, 0, 0, 0); a1 = __builtin_amdgcn_mfma_f32_16x16x32_bf16(w1[s2], zkv[s2], a1, 0, 0, 0); }
#pragma unroll
            for (int e = 0; e < 2; ++e) { const int pp = p + e; const f32x4 v = (e ? a1 : a0) * rkv; u32x2 o; o.x = pk2(v[0], v[1]); o.y = pk2(v[2], v[3]);
                const int col = pp < 4 ? Q_MLAK + h * 96 + 16 * pp + 4 * kq : Q_MLAV + h * 64 + 16 * (pp - 4) + 4 * kq;
                *(GAS u32x2*)(qrow + col) = o; }
        }
        if (h == 0) {
            const f32x4 x1 = {bflo(kr1.x), bfhi(kr1.x), bflo(kr1.y), bfhi(kr1.y)}, x2 = {bflo(kr2.x), bfhi(kr2.x), bflo(kr2.y), bfhi(kr2.y)};
            const f32x4 o1 = x1 * cr - x2 * sr, o2 = x2 * cr + x1 * sr;
            u32x2 w1; w1.x = pk2(o1[0], o1[1]); w1.y = pk2(o1[2], o1[3]); u32x2 w2; w2.x = pk2(o2[0], o2[1]); w2.y = pk2(o2[2], o2[3]);
#pragma unroll
            for (int hh = 0; hh < 4; ++hh) { *(GAS u32x2*)(qrow + Q_MLAK + hh * 96 + 64 + 4 * kq) = w1; *(GAS u32x2*)(qrow + Q_MLAK + hh * 96 + 80 + 4 * kq) = w2; }
        }
    }
#undef PP_LOAD
    asm volatile("s_waitcnt lgkmcnt(0)\n\ts_barrier" ::: "memory");
}

__device__ __forceinline__ void phase_router(KArgs a, int l, int nrows, LAS unsigned char* lds, int tid, int lane, int wave, int G, int c) {
    unsigned char* ws = a->ws;
    const float* X = (const float*)(ws + WS_X); unsigned char* H = (unsigned char*)(ws + WS_H);
    const float* ada = (const float*)(ws + WS_ADA); const float* wrp = (const float*)(ws + WS_WRP);
    const float* gn = a->in[I_N2G] + l * 1024; const float* brt = a->in[I_BR];
    unsigned* ctl = (unsigned*)(ws + WS_CTL);
    int* tokinv = (int*)(ws + WS_TOKINV); int* toke = (int*)(ws + WS_TOKE); float* tokw = (float*)(ws + WS_TOKW);
    const int tk = lane & 15, q = lane >> 4;
    f32x4 wr0[8], wr1[8];
    { const float* p0 = wrp + (((0 * 8 + wave) * 4 + q) * 16 + tk) * 32; const float* p1 = wrp + (((1 * 8 + wave) * 4 + q) * 16 + tk) * 32;
#pragma unroll
      for (int s = 0; s < 8; ++s) { wr0[s] = *(const GAS f32x4*)(p0 + 4 * s); wr1[s] = *(const GAS f32x4*)(p1 + 4 * s); } }
    LAS float* hb = (LAS float*)lds;
    LAS float* part = (LAS float*)(lds + 16 * 4112);
    LAS float* lgs = part + 8 * 16 * 32;
    for (int g = c; g < nrows / 16; g += G) {
        f32x4 v[2][4];
#pragma unroll
        for (int rr = 0; rr < 2; ++rr) { const float* xr = X + (size_t)(g * 16 + 2 * wave + rr) * 1024;
#pragma unroll
            for (int j = 0; j < 4; ++j) v[rr][j] = *(const GAS f32x4*)(xr + 4 * lane + 256 * j); }
#pragma unroll
        for (int rr = 0; rr < 2; ++rr) {
            const int row = g * 16 + 2 * wave + rr, b = row < TL ? (row >> 11) : 8;
            float ss = 0.f;
#pragma unroll
            for (int j = 0; j < 4; ++j) ss += (v[rr][j].x * v[rr][j].x + v[rr][j].y * v[rr][j].y) + (v[rr][j].z * v[rr][j].z + v[rr][j].w * v[rr][j].w);
            const float rstd = 1.0f / sqrtf(wave_sum(ss) * (1.f / 1024.f) + EPS);
            const float* sh = ada + ((size_t)l * 9 + b) * 6144 + 3072; const float* sc = sh + 1024;
#pragma unroll
            for (int j = 0; j < 4; ++j) { const int cc = 4 * lane + 256 * j; const f32x4 gg = *(const GAS f32x4*)(gn + cc), s1 = *(const GAS f32x4*)(sc + cc), s0 = *(const GAS f32x4*)(sh + cc);
                const f32x4 h = v[rr][j] * rstd * gg * (s1 + 1.0f) + s0;
                *(GAS unsigned*)(H + (size_t)row * 1024 + cc) = pk4_fp8(h.x, h.y, h.z, h.w);
                *(LAS f32x4*)(hb + (2 * wave + rr) * 1028 + cc) = h; }
        }
        __syncthreads();
        f32x4 acc0 = {0.f, 0.f, 0.f, 0.f}, acc1 = {0.f, 0.f, 0.f, 0.f};
#pragma unroll
        for (int s = 0; s < 8; ++s) { const f32x4 a4 = *(const LAS f32x4*)(hb + tk * 1028 + 128 * wave + 32 * q + 4 * s);
#pragma unroll
            for (int j = 0; j < 4; ++j) { acc0 = __builtin_amdgcn_mfma_f32_16x16x4f32(a4[j], wr0[s][j], acc0, 0, 0, 0); acc1 = __builtin_amdgcn_mfma_f32_16x16x4f32(a4[j], wr1[s][j], acc1, 0, 0, 0); } }
#pragma unroll
        for (int r = 0; r < 4; ++r) { part[(wave * 16 + 4 * q + r) * 32 + tk] = acc0[r]; part[(wave * 16 + 4 * q + r) * 32 + 16 + tk] = acc1[r]; }
        __syncthreads();
        LAS float* selv = lgs + 512;
        { float sum = 0.f;
#pragma unroll
          for (int w = 0; w < 8; ++w) sum += part[w * 512 + tid];
          const float sg = 1.0f / (1.0f + __expf(-sum)); lgs[tid] = sg; selv[tid] = sg + brt[tid & 31]; }
        __syncthreads();
        if (wave == 0 && lane < 16) {
            const LAS float* my = selv + lane * 32; const LAS float* mys = lgs + lane * 32;
            float gs[4];
#pragma unroll
            for (int g4 = 0; g4 < 4; ++g4) { float m1 = -1e30f, m2 = -1e30f;
#pragma unroll
                for (int j = 0; j < 8; ++j) { const float vv = my[g4 * 8 + j];
                    if (vv > m1) { m2 = m1; m1 = vv; } else if (vv > m2) m2 = vv; }
                gs[g4] = m1 + m2; }
            int gsel = 0; float gb = gs[0];
#pragma unroll
            for (int g4 = 1; g4 < 4; ++g4) if (gs[g4] > gb) { gb = gs[g4]; gsel = g4; }
            float v1 = -1e30f, v2 = -1e30f, s1v = 0.f, s2v = 0.f; int e1 = 0, e2 = 0;
#pragma unroll
            for (int j = 0; j < 8; ++j) { const int e = gsel * 8 + j; const float sg = mys[e]; const float vv = my[e];
                if (vv > v1) { v2 = v1; e2 = e1; s2v = s1v; v1 = vv; e1 = e; s1v = sg; } else if (vv > v2) { v2 = vv; e2 = e; s2v = sg; } }
            const float inv = 1.0f / (s1v + s2v);
            const int myrow = g * 16 + lane;
            const int p1 = (int)__hip_atomic_fetch_add(ctl + CW_CNT + l * 32 + e1, 1u, __ATOMIC_RELAXED, __HIP_MEMORY_SCOPE_AGENT);
            const int p2 = (int)__hip_atomic_fetch_add(ctl + CW_CNT + l * 32 + e2, 1u, __ATOMIC_RELAXED, __HIP_MEMORY_SCOPE_AGENT);
            tokinv[(size_t)e1 * TT + p1] = myrow; tokinv[(size_t)e2 * TT + p2] = myrow;
            toke[myrow * 2] = (e1 << 20) | p1; toke[myrow * 2 + 1] = (e2 << 20) | p2;
            tokw[myrow * 2] = s1v * inv; tokw[myrow * 2 + 1] = s2v * inv;
        }
    }
    __syncthreads();
}

__device__ __forceinline__ float max3f(float a, float b, float c) { float r; asm("v_max3_f32 %0, %1, %2, %3" : "=v"(r) : "v"(a), "v"(b), "v"(c)); return r; }
__device__ __forceinline__ int crow(int r, int hi) { return (r & 3) + 8 * (r >> 2) + 4 * hi; }
__device__ __forceinline__ s16x4 tr_read(const LAS unsigned char* p) { typedef short v4s __attribute__((ext_vector_type(4))); return __builtin_bit_cast(s16x4, __builtin_amdgcn_ds_read_tr16_b64_v4i16((LAS v4s*)p)); }
constexpr int AT_FAC = 124928, AT_SCRW = 8448;
__device__ __forceinline__ void at_wait_bar(int n) {
    switch (n) {
        case 0: asm volatile("s_waitcnt vmcnt(0)\n\ts_barrier" ::: "memory"); break;
        case 2: asm volatile("s_waitcnt vmcnt(2)\n\ts_barrier" ::: "memory"); break;
        case 3: asm volatile("s_waitcnt vmcnt(3)\n\ts_barrier" ::: "memory"); break;
        case 4: asm volatile("s_waitcnt vmcnt(4)\n\ts_barrier" ::: "memory"); break;
        case 6: asm volatile("s_waitcnt vmcnt(6)\n\ts_barrier" ::: "memory"); break;
        case 8: asm volatile("s_waitcnt vmcnt(8)\n\ts_barrier" ::: "memory"); break;
        case 9: asm volatile("s_waitcnt vmcnt(9)\n\ts_barrier" ::: "memory"); break;
        default: asm volatile("s_waitcnt vmcnt(0)\n\ts_barrier" ::: "memory"); break;
    }
}
template <int kind>
__device__ __forceinline__ void attn_unit(const bf16_t* Q, bf16_t* Y, const int b, const int hq, const int qb, const bool ctxq, const float sinkl2, const float lf2, const float lb2,
                                          LAS unsigned char* lds, const int tid, const int lane, const int wave, const int tilecap) {
    constexpr int DQK = kind == 0 ? 96 : 64;
    constexpr int KS = DQK == 64 ? 128 : 256, NS = DQK / 16, SLOTK = 64 * KS, SLOT = SLOTK + 8192, NL = DQK == 64 ? 2 : 3, NSLOT = DQK == 64 ? 6 : 5;
    constexpr float THR = 8.0f;
    constexpr int KW = 2, KP = NS / KW;
    static_assert(NSLOT * SLOT <= AT_FAC && 8 * AT_SCRW <= AT_FAC && AT_FAC + 1024 <= LDS_MISC, "attention LDS map");
    int qcol, kcol, vcol, ycol, gcol = 0;
    if (kind == 0) { qcol = Q_MLAQ + hq * 96; kcol = Q_MLAK + hq * 96; vcol = Q_MLAV + hq * 64; ycol = 256 + hq * 64; }
    else if (kind == 1) { qcol = Q_GQAQ + hq * 64; kcol = Q_GQAK + (hq >> 1) * 64; vcol = Q_GQAV + (hq >> 1) * 64; ycol = 512 + hq * 64; }
    else if (kind == 2) { qcol = Q_RETQ + hq * 64; kcol = Q_RETK + hq * 64; vcol = Q_RETV + hq * 64; ycol = hq * 64; gcol = Q_RETG + hq * 64; }
    else { qcol = Q_WINQ + hq * 64; kcol = Q_WINK + (hq >> 1) * 64; vcol = Q_WINV + (hq >> 1) * 64; ycol = 768 + hq * 64; }
    const int r32 = lane & 31, hi = lane >> 5;
    const int qrow0 = (ctxq ? TL + b * 256 : b * 2048 + qb * 256) + 32 * wave;
    const int qpos = (ctxq ? 0 : qb * 256) + 32 * wave + r32;
    int lt0 = 0, nlat = 32;
    if (ctxq) nlat = 0;
    else if (kind == 3) { lt0 = 4 * qb - 2 < 0 ? 0 : 4 * qb - 2; const int lt1 = 4 * qb + 6 > 32 ? 32 : 4 * qb + 6; nlat = lt1 - lt0; }
    const int ntile = (4 + nlat) < tilecap ? (4 + nlat) : tilecap;
    bf16x8 qf[NS];
#pragma unroll
    for (int s = 0; s < NS; ++s) qf[s] = *(const GAS bf16x8*)(Q + (size_t)(qrow0 + r32) * QP + qcol + 16 * s + 8 * hi);
    f32x4 cfa = {}, cfq = {}, cba = {}, cbq = {}; float g32f = 0.f, g32b = 0.f;
    if constexpr (kind == 2) {
#pragma unroll
        for (int i = 0; i < 4; ++i) { cfa[i] = __builtin_bit_cast(float, __builtin_amdgcn_readfirstlane(__builtin_bit_cast(int, fast_exp2(lf2 * (float)(3 - i))))); cfq[i] = fast_exp2(lf2 * (float)(28 - 4 * hi - 8 * i));
            cba[i] = __builtin_bit_cast(float, __builtin_amdgcn_readfirstlane(__builtin_bit_cast(int, fast_exp2(lb2 * (float)i)))); cbq[i] = fast_exp2(lb2 * (float)(8 * i + 4 * hi)); }
        g32f = fast_exp2(32.f * lf2); g32b = fast_exp2(32.f * lb2);
    }
    int ksrc[DQK == 64 ? 1 : 2], vsrc;
    if constexpr (DQK == 64) { const int row = 8 * wave + (lane >> 3), ch = (lane & 7) ^ ((row >> 1) & 7); ksrc[0] = row * QP + kcol + 8 * ch; }
    else {
#pragma unroll
        for (int n = 0; n < 2; ++n) { const int row = 4 * (2 * wave + n) + (lane >> 4); int ch = (lane & 15) ^ (row & 15); if (ch >= 12) ch = 0; ksrc[n] = row * QP + kcol + 8 * ch; }
    }
    { const int row = 8 * wave + (lane >> 3); vsrc = row * QP + vcol + 8 * ((lane & 7) ^ (((row >> 1) & 1) << 2)); }
#define AT_TILE_ROW0(t) ((t) < 4 ? TL + b * 256 + 64 * (t) : b * 2048 + 64 * (lt0 + (t) - 4))
#define AT_ISSUE(t) do { const bf16_t* tb_ = Q + (size_t)AT_TILE_ROW0(t) * QP; const unsigned sl_ = (unsigned)__builtin_amdgcn_readfirstlane((int)(ldsb + ((t) % NSLOT) * SLOT + wave * 1024 * (DQK == 64 ? 1 : 2))); \
        if constexpr (DQK == 64) { glds16(tb_ + ksrc[0], sl_); glds16(tb_ + vsrc, sl_ + SLOTK); } \
        else { glds16(tb_ + ksrc[0], sl_); glds16(tb_ + ksrc[DQK == 64 ? 0 : 1], sl_ + 1024); glds16(tb_ + vsrc, (unsigned)__builtin_amdgcn_readfirstlane((int)(ldsb + ((t) % NSLOT) * SLOT + SLOTK + wave * 1024))); } } while (0)
    const unsigned ldsb = (unsigned)(uintptr_t)lds;
    const int kkey = DQK == 64 ? ((r32 >> 1) & 7) : (r32 & 15);
    const unsigned krd = r32 * KS + 16 * (hi ^ (kkey & 1)) + 32 * (kkey >> 1);
#define AT_KLOAD(KF, t, S0, S1) do { unsigned ka_ = (unsigned)(uintptr_t)(lds + ((t) % NSLOT) * SLOT) + krd; asm volatile("" : "+v"(ka_)); \
        _Pragma("unroll") for (int s = (S0); s < (S1); ++s) { const LAS unsigned char* kp_ = (const LAS unsigned char*)(uintptr_t)(ka_ ^ (unsigned)(32 * s)); \
            KF[2 * (s - (S0))] = *(const LAS bf16x8*)(kp_); KF[2 * (s - (S0)) + 1] = *(const LAS bf16x8*)(kp_ + 32 * KS); } } while (0)
#define AT_QKMR(P0, P1, KF, PART) do { _Pragma("unroll") for (int s = (PART) * KW; s < ((PART) + 1) * KW; ++s) { \
        if ((PART) == 0 && s == 0) { const f32x16 z_ = {}; P0 = __builtin_amdgcn_mfma_f32_32x32x16_bf16(KF[0], qf[0], z_, 0, 0, 0); P1 = __builtin_amdgcn_mfma_f32_32x32x16_bf16(KF[1], qf[0], z_, 0, 0, 0); } \
        else { P0 = __builtin_amdgcn_mfma_f32_32x32x16_bf16(KF[2 * (s - (PART) * KW)], qf[s], P0, 0, 0, 0); P1 = __builtin_amdgcn_mfma_f32_32x32x16_bf16(KF[2 * (s - (PART) * KW) + 1], qf[s], P1, 0, 0, 0); } } } while (0)
#define AT_KPART(KF, t, PART) AT_KLOAD(KF, t, (PART) * KW, ((PART) + 1) * KW)
#define AT_QK(P0, P1, t) do { bf16x8 kf_[2 * KW]; _Pragma("unroll") for (int p_ = 0; p_ < KP; ++p_) { AT_KPART(kf_, t, p_); AT_QKMR(P0, P1, kf_, p_); } } while (0)
    const int qw0_ = qb * 256 + 32 * wave;
#define AT_SKIP(t) ((kind == 3 && (t) >= 4) && ((64 * (lt0 + (t) - 4) + 63 < qw0_ - 128) || (64 * (lt0 + (t) - 4) > qw0_ + 31 + 128)))
#pragma unroll
    for (int t = 0; t < NSLOT - 1; ++t) if (t < ntile) AT_ISSUE(t);
    { const int infl = (ntile - 1 < NSLOT - 2 ? ntile - 1 : NSLOT - 2); at_wait_bar(infl * NL); }
    float mref = 0.f, lsum = 0.f;
    bool shifted = false;
    f32x16 o0 = {}, o1 = {}, pa0, pa1, pb0 = {}, pb1 = {};
    AT_QK(pa0, pa1, 0);
    LAS float* stage = (LAS float*)(lds + wave * AT_SCRW); LAS float* fac = (LAS float*)(lds + AT_FAC) + wave * 32;
    const int i16 = lane & 15, q4 = i16 >> 2, p4 = i16 & 3, g1 = (lane >> 4) & 1;
    const unsigned vrd = SLOTK + (4 * hi + q4) * 128 + (16 * g1 + 4 * p4) * 2 + 64 * ((q4 >> 1) & 1);
#define CR(r) (((r) & 3) + 8 * ((r) >> 2))
#define AT_VLOAD(VF, t, u) do { unsigned vb_ = (unsigned)(uintptr_t)(lds + ((t) % NSLOT) * SLOT) + vrd + (32 * (u)) * 128; asm volatile("" : "+v"(vb_)); const LAS unsigned char* vb = (const LAS unsigned char*)(uintptr_t)vb_; \
        unsigned vx_ = vb_ ^ 64u; asm volatile("" : "+v"(vx_)); const LAS unsigned char* vbx = (const LAS unsigned char*)(uintptr_t)vx_; \
        _Pragma("unroll") for (int s2 = 0; s2 < 2; ++s2) _Pragma("unroll") for (int d0 = 0; d0 < 2; ++d0) { const LAS unsigned char* vp = (d0 ? vbx : vb) + (16 * s2) * 128; \
            const s16x4 lo = tr_read(vp), h2 = tr_read(vp + 8 * 128); VF[2 * s2 + d0] = (bf16x8){lo[0], lo[1], lo[2], lo[3], h2[0], h2[1], h2[2], h2[3]}; } } while (0)
#define AT_PVM(PU, VF) do { _Pragma("unroll") for (int s = 0; s < 2; ++s) { \
        u32x4 pw; pw.x = pk2(PU[8 * s], PU[8 * s + 1]); pw.y = pk2(PU[8 * s + 2], PU[8 * s + 3]); pw.z = pk2(PU[8 * s + 4], PU[8 * s + 5]); pw.w = pk2(PU[8 * s + 6], PU[8 * s + 7]); \
        const bf16x8 pa = __builtin_bit_cast(bf16x8, pw); \
        o0 = __builtin_amdgcn_mfma_f32_32x32x16_bf16(pa, VF[2 * s], o0, 0, 0, 0); o1 = __builtin_amdgcn_mfma_f32_32x32x16_bf16(pa, VF[2 * s + 1], o1, 0, 0, 0); } } while (0)
#define SB0() __builtin_amdgcn_sched_barrier(0)
#define AT_STEP(PC0, PC1, PN0, PN1, t) do { \
        const bool more = (t) + 1 < ntile; \
        if (more) { const int last_infl = ((t) + NSLOT - 2 < ntile - 1) ? ((t) + NSLOT - 2) : (ntile - 1); \
            at_wait_bar((last_infl - ((t) + 1)) * NL); \
            if ((t) + NSLOT - 1 < ntile) AT_ISSUE((t) + NSLOT - 1); } \
        const bool isctx = (t) < 4; const int kpos0 = isctx ? 64 * (t) : 64 * (lt0 + (t) - 4); \
        int dbase = kpos0 + 4 * hi - qpos; asm volatile("" : "+v"(dbase)); \
        const bool skip = AT_SKIP(t), skipn = more ? AT_SKIP((t) + 1) : true; \
        bf16x8 kf[2 * KW]; bf16x8 vf[4]; \
        if (!skipn) { AT_KPART(kf, (t) + 1, 0); SB0(); } \
        if (kind == 2) { \
            if (!skipn) { AT_QKMR(PN0, PN1, kf, 0); SB0(); AT_KPART(kf, (t) + 1, 1); } \
            AT_VLOAD(vf, t, 0); SB0(); \
              \
            const int qw0r = (ctxq ? 0 : qb * 256) + 32 * wave; \
            const int tcls = (isctx && !ctxq) ? 3 : ((kpos0 + 63 <= qw0r) ? 0 : ((kpos0 >= qw0r + 32) ? 1 : 2)); \
            float mf0 = 0.f, mf1 = 0.f, mb0 = 0.f, mb1 = 0.f; \
            if (tcls == 0) { mf1 = fast_exp2(lf2 * (float)(qpos - kpos0 - 63)); mf0 = mf1 * g32f; } \
            else if (tcls == 1) { mb0 = fast_exp2(lb2 * (float)(kpos0 - qpos)); mb1 = mb0 * g32b; } \
            else if (tcls == 3) { mf1 = fast_exp2(lf2 * (float)(256 + qpos - kpos0 - 63)); mf0 = mf1 * g32f; mb0 = fast_exp2(lb2 * (float)(2048 - qpos + kpos0)); mb1 = mb0 * g32b; } \
            if (tcls == 2) {        \
                _Pragma("unroll") for (int r = 0; r < 16; ++r) { const int d0 = -(dbase + CR(r)); PC0[r] *= fast_exp2((d0 >= 0 ? lf2 : -lb2) * (float)d0); } \
            } else { \
                const f32x4 fq_ = cfq * mf0, bq_ = cbq * mb0; \
                _Pragma("unroll") for (int r = 0; r < 16; ++r) PC0[r] *= cfa[r & 3] * fq_[r >> 2] + cba[r & 3] * bq_[r >> 2]; \
            } \
            SB0(); if (!skipn) { AT_QKMR(PN0, PN1, kf, 1); if (KP == 3) { SB0(); AT_KPART(kf, (t) + 1, 2); } } AT_PVM(PC0, vf); SB0(); AT_VLOAD(vf, t, 1); SB0(); \
            if (tcls == 2) { \
                _Pragma("unroll") for (int r = 0; r < 16; ++r) { const int d1 = -(dbase + CR(r)) - 32; PC1[r] *= fast_exp2((d1 >= 0 ? lf2 : -lb2) * (float)d1); } \
            } else { \
                const f32x4 fq_ = cfq * mf1, bq_ = cbq * mb1; \
                _Pragma("unroll") for (int r = 0; r < 16; ++r) PC1[r] *= cfa[r & 3] * fq_[r >> 2] + cba[r & 3] * bq_[r >> 2]; \
            } \
            SB0(); if (KP == 3 && !skipn) { AT_QKMR(PN0, PN1, kf, 2); } AT_PVM(PC1, vf); \
        } else if (!skip) { \
            if (kind == 3 && !isctx) { \
                _Pragma("unroll") for (int r = 0; r < 16; ++r) { const int d0 = dbase + CR(r), d1 = d0 + 32; \
                    if (d0 > 128 || d0 < -128) PC0[r] = -INFINITY; if (d1 > 128 || d1 < -128) PC1[r] = -INFINITY; } \
            } \
            float tm = max3f(PC0[0], PC1[0], PC0[1]), tm2 = max3f(PC1[1], PC0[2], PC1[2]); \
            _Pragma("unroll") for (int r = 3; r < 15; r += 2) { tm = max3f(tm, PC0[r], PC1[r]); tm2 = max3f(tm2, PC0[r + 1], PC1[r + 1]); } \
            tm = max3f(tm, PC0[15], PC1[15]); tm = max3f(tm, tm2, tm2); \
            tm = xmax32(tm) - mref; \
            if (__any(tm > THR)) { \
                const float dl = (tm > THR) ? tm : 0.f; \
                mref += dl; shifted = true; \
                const float f = fast_exp2(-dl); lsum *= f; \
                if (hi == 0) fac[r32] = f; \
                LDS_WAIT(); asm volatile("" ::: "memory"); \
                _Pragma("unroll") for (int r = 0; r < 16; ++r) { const float fr_ = fac[crow(r, hi)]; o0[r] *= fr_; o1[r] *= fr_; } \
            } \
            if (shifted) { _Pragma("unroll") for (int r = 0; r < 16; ++r) { PC0[r] -= mref; PC1[r] -= mref; } } \
            SB0(); \
            if (!skipn) { AT_QKMR(PN0, PN1, kf, 0); SB0(); AT_KPART(kf, (t) + 1, 1); } \
            AT_VLOAD(vf, t, 0); SB0(); \
            float ps = 0.f; \
            _Pragma("unroll") for (int r = 0; r < 16; ++r) { PC0[r] = fast_exp2(PC0[r]); ps += PC0[r]; } \
            SB0(); if (!skipn) { AT_QKMR(PN0, PN1, kf, 1); if (KP == 3) { SB0(); AT_KPART(kf, (t) + 1, 2); } } AT_PVM(PC0, vf); SB0(); AT_VLOAD(vf, t, 1); SB0(); \
            _Pragma("unroll") for (int r = 0; r < 16; ++r) { PC1[r] = fast_exp2(PC1[r]); ps += PC1[r]; } \
            lsum += ps; \
            SB0(); if (KP == 3 && !skipn) { AT_QKMR(PN0, PN1, kf, 2); } AT_PVM(PC1, vf); \
        } else if (!skipn) { AT_QKMR(PN0, PN1, kf, 0); _Pragma("unroll") for (int p_ = 1; p_ < KP; ++p_) { AT_KPART(kf, (t) + 1, p_); AT_QKMR(PN0, PN1, kf, p_); } } \
        } while (0)
    for (int t = 0; t < ntile; t += 2) {
        AT_STEP(pa0, pa1, pb0, pb1, t);
        if (t + 1 < ntile) AT_STEP(pb0, pb1, pa0, pa1, t + 1);
    }
#undef AT_STEP
#undef AT_PVM
#undef AT_VLOAD
#undef AT_KLOAD
#undef AT_QKMR
#undef AT_KPART
#undef SB0
#undef AT_ISSUE
#undef AT_TILE_ROW0
#undef AT_QK
#undef AT_SKIP
#undef CR
    asm volatile("s_waitcnt lgkmcnt(0)\n\ts_barrier" ::: "memory");
#pragma unroll
    for (int r = 0; r < 16; ++r) { stage[crow(r, hi) * 65 + r32] = o0[r]; stage[crow(r, hi) * 65 + 32 + r32] = o1[r]; }
    LDS_WAIT(); asm volatile("" ::: "memory");
    float x[32];
#pragma unroll
    for (int j = 0; j < 32; ++j) x[j] = stage[r32 * 65 + 32 * hi + j];
    int orow_i = qrow0 + r32; asm volatile("" : "+v"(orow_i));
    const size_t orow = (size_t)orow_i;
    if (kind == 2) {
        float s = 0.f;
#pragma unroll
        for (int j = 0; j < 32; ++j) s += x[j];
        s = xadd<32>(s); const float mean = s * (1.f / 64.f); float v = 0.f;
#pragma unroll
        for (int j = 0; j < 32; ++j) { x[j] -= mean; v += x[j] * x[j]; }
        v = xadd<32>(v); const float rstd = 1.0f / sqrtf(v * (1.f / 64.f) + EPS);
        const bf16_t* gp = Q + orow * QP + gcol + 32 * hi;
#pragma unroll
        for (int c = 0; c < 4; ++c) { const u32x4 gw = *(const GAS u32x4*)(gp + 8 * c);
#pragma unroll
            for (int j = 0; j < 4; ++j) { const float ga = bflo(gw[j]), gb = bfhi(gw[j]); x[8 * c + 2 * j] *= rstd * ga * sigmoidf_(ga); x[8 * c + 2 * j + 1] *= rstd * gb * sigmoidf_(gb); } }
    } else {
        float lt = xadd<32>(lsum);
        if (kind == 3) lt += fast_exp2(sinkl2 - mref);
        const float inv = 1.0f / fmaxf(lt, 1e-30f);
#pragma unroll
        for (int j = 0; j < 32; ++j) x[j] *= inv;
    }
    bf16_t* yp = Y + orow * 1024 + ycol + 32 * hi;
#pragma unroll
    for (int c = 0; c < 4; ++c) { u32x4 w; w.x = pk2(x[8 * c], x[8 * c + 1]); w.y = pk2(x[8 * c + 2], x[8 * c + 3]); w.z = pk2(x[8 * c + 4], x[8 * c + 5]); w.w = pk2(x[8 * c + 6], x[8 * c + 7]); *(GAS u32x4*)(yp + 8 * c) = w; }
    asm volatile("s_waitcnt lgkmcnt(0)\n\ts_barrier" ::: "memory");
}
#ifndef PROBE_KMASK
#define PROBE_KMASK 0x1f
#endif
#ifndef PROBE_TILECAP
#define PROBE_TILECAP 1000
#endif
__device__ __forceinline__ void phase_mix(KArgs a, int lq, LAS unsigned char* lds, int tid, int lane, int wave, int G, int c) {
    const int l = lq & 1; const int kmask = (lq >= 2) ? PROBE_KMASK : 0x1f; const int tilecap = (lq >= 2) ? PROBE_TILECAP : 1000;
    unsigned char* ws = a->ws;
    const bf16_t* Q = (const bf16_t*)(ws + WS_QKV); bf16_t* Y = (bf16_t*)(ws + (lq >= 2 ? WS_MRG : WS_Y));
    const int nunits = l == 0 ? 1152 : 1024;
    const int vc = (G == 256) ? ((c & 7) * 32 + (c >> 3)) : c;
    for (int j = 0; ; ++j) {
        const int u = j * G + vc;
        if (u >= nunits) break;
        int kind, b, hq, qb; bool ctxq;
        if (u < 1024) { kind = u >> 8; const int r = u & 255; b = r >> 5; hq = (r >> 3) & 3; qb = r & 7; ctxq = false; }
        else { const int r = u - 1024; kind = r >> 5; b = (r >> 2) & 7; hq = r & 3; qb = 0; ctxq = true; }
        if (!((kmask >> (ctxq ? 4 : kind)) & 1)) continue;
        const float lf2 = -__expf(a->in[I_DECAY][l * 8 + hq]) * LOG2E, lb2 = -__expf(a->in[I_DECAY][l * 8 + 4 + hq]) * LOG2E;
        const float sk = a->in[I_SINK][l * 4 + hq] * LOG2E;
        int tid2 = tid; asm volatile("" : "+v"(tid2));
        const int lane2 = tid2 & 63;
        if (kind == 0) attn_unit<0>(Q, Y, b, hq, qb, ctxq, sk, lf2, lb2, lds, tid2, lane2, wave, tilecap);
        else if (kind == 1) attn_unit<1>(Q, Y, b, hq, qb, ctxq, sk, lf2, lb2, lds, tid2, lane2, wave, tilecap);
        else if (kind == 2) attn_unit<2>(Q, Y, b, hq, qb, ctxq, sk, lf2, lb2, lds, tid2, lane2, wave, tilecap);
        else attn_unit<3>(Q, Y, b, hq, qb, ctxq, sk, lf2, lb2, lds, tid2, lane2, wave, tilecap);
    }
}

#ifndef MK_BAR_XCD
#define MK_BAR_XCD 1
#endif
constexpr int NPHASE = 20;
#ifndef PH_MASK
#define PH_MASK 0x3ff
#endif
#define PH_ON(b) ((PH_MASK >> (b)) & 1)
#ifndef PROBE_REPEAT
#define PROBE_REPEAT 0
#endif
__global__ void __launch_bounds__(NTHREADS, 2) fwd_kernel(Args a_byval) {
    extern __shared__ __attribute__((aligned(16))) unsigned char lds_raw[];
    LAS unsigned char* lds0 = (LAS unsigned char*)lds_raw;
    const int wave0 = __builtin_amdgcn_readfirstlane((int)threadIdx.x >> 6);
    { LAS unsigned char* lds = lds0; const int t0 = wave0 * 64 + lane_id(); for (int u = t0; u < (LDS_BYTES - LDS_MISC) / 4; u += NTHREADS) ((LAS unsigned*)(lds + LDS_MISC))[u] = 0u; }
    __syncthreads();
    const int ph_lo = a_byval.ph_lo, ph_hi = a_byval.ph_hi;
#if MK_ONE_LAUNCH && MK_BAR_XCD
    XcdBarrier bar = xcd_barrier_post((unsigned*)(a_byval.ws + WS_CTL) + CW_BAR, (volatile LAS unsigned*)(lds0 + LDS_MISC), wave0);
#endif
    for (int ph = ph_lo; ph < ph_hi; ++ph) {
#if PROBE_REPEAT
      const int nrep = 1 + ((PROBE_REPEAT >> ph) & 1);
      for (int rep = 0; rep < nrep; ++rep) {
#else
      constexpr int nrep = 1, rep = 0; {
#endif
#define PHASE_IDS \
        KArgs a = (KArgs)__builtin_amdgcn_kernarg_segment_ptr(); asm volatile("" : "+s"(a)); \
        int wave = wave0; asm volatile("" : "+s"(wave)); unsigned z_ = 0u; asm volatile("" : "+v"(z_)); \
        const int lane = (int)__builtin_amdgcn_mbcnt_hi(~0u, __builtin_amdgcn_mbcnt_lo(~0u, z_)); const int tid = wave * 64 + lane; \
        unsigned ldso = 0; asm volatile("" : "+s"(ldso)); LAS unsigned char* lds = lds0 + ldso; \
        int G = gridDim.x, c = blockIdx.x; asm volatile("" : "+s"(G), "+s"(c)); \
        unsigned char* ws = a->ws; unsigned* ctl = (unsigned*)(ws + WS_CTL); const float* ada = (const float*)(ws + WS_ADA); (void)ctl; (void)ada; (void)tid; (void)lane; (void)lds; (void)G; (void)c;
        if (ph == 0) { if (PH_ON(0)) { PHASE_IDS p0_prologue(a, lds, tid, lane, wave, G, c); } }
        else if (ph == NPHASE - 1) { if (PH_ON(1)) { PHASE_IDS moe_tables(ctl, 1, lds, tid); phase_rownorm(a, 2, lds, lane, wave, G, c); } }
        else {
            const int l = (ph - 1) / 9, k = (ph - 1) % 9;
            if (k == 0) { if (PH_ON(1)) { PHASE_IDS if (l == 1) moe_tables(ctl, 0, lds, tid); phase_rownorm(a, l, lds, lane, wave, G, c); } }
            else if (k == 1) { if (PH_ON(2)) { PHASE_IDS
                SchedB S{l, G, c, (const char*)(ws + WS_H), (const char*)(ws + WS_WIN) + (size_t)l * NBG * 1024};
                const float* rope_ = (const float*)(ws + WS_ROPE);
                EpiB E{(bf16_t*)(ws + WS_P), (bf16_t*)(ws + WS_G), (bf16_t*)(ws + WS_QKV), rope_, rope_ + 2048 * 32, a->in[I_GQN] + l * 64, a->in[I_GKN] + l * 64};
                pg8::gemm_phase<EpiB, SchedB, false, true, 0x7a7a7a7a, 0x7f7f7f7f>(lds, tid, 1024, 1024, 1024, S, E); }
            } else if (k == 2) { if (PH_ON(3)) { PHASE_IDS phase_post(a, l, lds, lane, wave, G, c); } }
            else if (k == 3) { if (PH_ON(4)) { PHASE_IDS phase_mix(a, l + 2 * rep, lds, tid, lane, wave, G, c); } }
            else if (k == 4) { if (PH_ON(5)) { PHASE_IDS
                SchedE S{G, c, l == 0 ? 72 : 64, (const char*)(ws + WS_Y), (const char*)(ws + WS_WBR) + (size_t)l * 1048576 * 2};
                EpiE E{(const bf16_t*)(ws + WS_G), (bf16_t*)(ws + WS_MRG)};
                pg8::gemm_phase<EpiE, SchedE, false>(lds, tid, 2048, 2048, 2048, S, E);
                if (l == 0 && G == 256 && c >= 32) cvt_run(a, ws, lds, lane, wave, CV_EXP_ITEMS / 2, CV_EXP_ITEMS / 2 + CV_E0_SHARE, (c - 32) * NWAVES + wave, 224 * NWAVES); }
            } else if (k == 5) { if (PH_ON(6)) { PHASE_IDS
                SchedF S{G, c, l == 0 ? 72 : 64, (const char*)(ws + WS_MRG), (const char*)(ws + WS_WOUT) + (size_t)l * 1048576 * 2};
                EpiF E{a->in[I_X], a->in[I_CTX], (const float*)(ws + WS_X), (float*)(ws + WS_X), ada + (size_t)l * 9 * 6144, l};
                pg8::gemm_phase<EpiF, SchedF, false>(lds, tid, 2048, 2048, 2048, S, E);
                if (l == 0) { if (G == 256 && c >= 32) cvt_run(a, ws, lds, lane, wave, CV_EXP_ITEMS / 2 + CV_E0_SHARE, CV_EXP_ITEMS, (c - 32) * NWAVES + wave, 224 * NWAVES);
                              else if (G != 256) { cvt_run(a, ws, lds, lane, wave, CV_EXP_ITEMS / 2, CV_EXP_ITEMS, c * NWAVES + wave, G * NWAVES); } } }
            } else if (k == 6) { if (PH_ON(7)) { PHASE_IDS phase_router(a, l, l == 0 ? TT : TL, lds, tid, lane, wave, G, c); } }
            else if (k == 7) { if (PH_ON(8)) { PHASE_IDS
                moe_tables(ctl, l, lds, tid);
                SchedMoe S{G, c, 8, 1, (const LAS int*)(lds + LDS_MISC + 1024), (const LAS int*)(lds + LDS_MISC + 2304), (const int*)(ws + WS_TOKINV), (const char*)(ws + WS_H), (const char*)(ws + WS_W13) + (size_t)l * 32 * 2 * MiB, 2 * MiB};
                EpiH E{(unsigned char*)(ws + WS_HID)};
                pg8::gemm_phase<EpiH, SchedMoe, true, true, 0x7a7a7a7a, 0x7f7f7f7f>(lds, tid, 1024, 1024, 1024, S, E); }
            } else if (PH_ON(9)) { PHASE_IDS
                moe_tables(ctl, l, lds, tid);
                SchedMoe S{G, c, 4, 0, (const LAS int*)(lds + LDS_MISC + 1024), (const LAS int*)(lds + LDS_MISC + 2304), (const int*)(ws + WS_TOKINV), (const char*)(ws + WS_HID), (const char*)(ws + WS_W2) + (size_t)l * 32 * 1 * MiB, 1 * MiB};
                EpiI E{(bf16_t*)(ws + WS_Y2)};
                pg8::gemm_phase<EpiI, SchedMoe, false, true, 0x7a7a7a7a, 0x7d7d7d7d>(lds, tid, 1024, 1024, 1024, S, E);
            }
        }
#if MK_ONE_LAUNCH
        if (ph + 1 < ph_hi || rep + 1 < nrep) {
#if MK_BAR_XCD
            if (ph == ph_lo) cg::this_grid().sync(); else xcd_barrier(bar);
#else
            cg::this_grid().sync();
#endif
        }
#endif
      }
    }
}

extern "C" void kernel_launch(void* const* d_in, const int* in_sizes, int n_in, void* d_out, int out_size, void* d_ws, size_t ws_size, hipStream_t stream) {
    static int grid = 0;
    if (grid == 0) {
        if (n_in != 26 || out_size != TL * DM || ws_size < WS_END) { fprintf(stderr, "kernel_launch: unexpected problem (n_in %d, out %d, ws %zu)\n", n_in, out_size, ws_size); grid = -1; return; }
        int dev = 0, cus = 0, per_cu = 0;
        (void)hipGetDevice(&dev); (void)hipDeviceGetAttribute(&cus, hipDeviceAttributeMultiprocessorCount, dev);
        if (hipFuncSetAttribute((const void*)fwd_kernel, hipFuncAttributeMaxDynamicSharedMemorySize, LDS_BYTES) != hipSuccess) { fprintf(stderr, "kernel_launch: hipFuncSetAttribute failed\n"); grid = -1; return; }
        if (hipOccupancyMaxActiveBlocksPerMultiprocessor(&per_cu, (const void*)fwd_kernel, NTHREADS, LDS_BYTES) != hipSuccess || per_cu < 1) { fprintf(stderr, "kernel_launch: occupancy query says %d blocks per CU\n", per_cu); (void)hipGetLastError(); per_cu = 1; }
        grid = cus;
        if (grid < 1) grid = 256;
    }
    if (grid < 0) return;
    (void)hipMemsetAsync((char*)d_ws + WS_CTL, 0, CTL_ZERO_BYTES, stream);
    Args a{};
    for (int i = 0; i < 26; ++i) a.in[i] = (const float*)d_in[i];
    a.out = (float*)d_out; a.ws = (unsigned char*)d_ws;
#if MK_ONE_LAUNCH
    a.ph_lo = 0; a.ph_hi = NPHASE;
    void* args[] = {&a};
    hipError_t e = hipLaunchCooperativeKernel((const void*)fwd_kernel, dim3(grid), dim3(NTHREADS), args, LDS_BYTES, stream);
    if (e != hipSuccess) fprintf(stderr, "kernel_launch: cooperative launch failed: %s (grid %d)\n", hipGetErrorString(e), grid);
#else
    for (int ph = 0; ph < NPHASE; ++ph) { a.ph_lo = ph; a.ph_hi = ph + 1; hipLaunchKernelGGL(fwd_kernel, dim3(grid), dim3(NTHREADS), LDS_BYTES, stream, a); }
#endif
}
```

```cpp
#include <hip/hip_runtime.h>
#include <hip/hip_cooperative_groups.h>
#include <cstdio>
#include <cstdint>
namespace cg = cooperative_groups;

#define LAS __attribute__((address_space(3)))
#define GAS __attribute__((address_space(1)))
typedef unsigned short bf16_t;
typedef short bf16x8 __attribute__((ext_vector_type(8)));
typedef short s16x4 __attribute__((ext_vector_type(4)));
typedef float f32x4 __attribute__((ext_vector_type(4)));
typedef float f32x2 __attribute__((ext_vector_type(2)));
typedef float f32x16 __attribute__((ext_vector_type(16)));
typedef unsigned u32x4 __attribute__((ext_vector_type(4)));
typedef unsigned u32x2 __attribute__((ext_vector_type(2)));

#ifndef MK_ONE_LAUNCH
#define MK_ONE_LAUNCH 1
#endif

constexpr int DM = 1024, NBATCH = 8, SEQ = 2048, CTXL = 256;
constexpr int TL = NBATCH * SEQ, TC = NBATCH * CTXL, TT = TL + TC;
constexpr int NIN = 2464, NINP = 2560, NGATE = 4096, NBG = NINP + NGATE;
constexpr int QP = 3072;
constexpr int NEXP = 32, MAXTILES = 176;
constexpr float EPS = 1e-6f, LOG2E = 1.4426950408889634f;
constexpr int P_RET = 0, P_MLA = 1024, P_GQA = 1440, P_WIN = 1952;
constexpr int Q_RETQ = 0, Q_RETK = 256, Q_RETV = 512, Q_RETG = 768;
constexpr int Q_MLAQ = 1024, Q_MLAK = 1408, Q_MLAV = 1792;
constexpr int Q_GQAQ = 2048, Q_GQAK = 2304, Q_GQAV = 2432;
constexpr int Q_WINQ = 2560, Q_WINK = 2816, Q_WINV = 2944;

constexpr size_t MiB = 1u << 20;
constexpr size_t WS_CTL = 0, CTL_ZERO_BYTES = 1 * MiB;
constexpr size_t WS_ADA = 1 * MiB;
constexpr size_t WS_ROPE = WS_ADA + 512 * 1024;
constexpr size_t WS_WRP = WS_ROPE + 768 * 1024;
constexpr size_t WS_TOKINV = 3 * MiB;
constexpr size_t WS_TOKE = WS_TOKINV + (size_t)NEXP * TT * 4;
constexpr size_t WS_TOKW = WS_TOKE + (size_t)TT * 2 * 4;
constexpr size_t WS_WSM = 6 * MiB;
constexpr size_t WS_WIN = 8 * MiB;
constexpr size_t WS_WBR = 34 * MiB;
constexpr size_t WS_WOUT = 38 * MiB;
constexpr size_t WS_W13 = 42 * MiB;
constexpr size_t WS_W2 = 298 * MiB;
constexpr size_t WS_X = 426 * MiB;
constexpr size_t WS_H = 498 * MiB;
constexpr size_t WS_QKV = 534 * MiB;
constexpr size_t WS_Y = 642 * MiB;
constexpr size_t WS_MRG = 678 * MiB;
constexpr size_t WS_P = 714 * MiB;
constexpr size_t WS_G = 804 * MiB;
constexpr size_t WS_HID = 714 * MiB;
constexpr size_t WS_Y2 = 804 * MiB;
constexpr size_t WS_END = 948 * MiB;
static_assert(WS_TOKW + (size_t)TT * 8 <= WS_WSM && WS_HID + (size_t)MAXTILES * 256 * 2048 <= WS_Y2 && WS_Y2 + (size_t)MAXTILES * 256 * 2048 <= WS_END, "ws map");
static_assert(WS_P + (size_t)TT * NINP * 2 <= WS_G && WS_G + (size_t)TT * NGATE * 2 <= WS_END && WS_END <= 1024 * MiB, "ws map");
constexpr int CW_BAR = 4096;
constexpr int CW_CNT = 16384;
constexpr int CW_WQ = 16640;

constexpr int LDS_MISC = 131072, LDS_BYTES = 147456;

__device__ __forceinline__ unsigned f2bf(float f) { unsigned u = __builtin_bit_cast(unsigned, f); return (u + 0x7fffu + ((u >> 16) & 1u)) >> 16; }
__device__ __forceinline__ unsigned pk2(float lo, float hi) { typedef __bf16 bf2 __attribute__((ext_vector_type(2))); f32x2 v = {lo, hi}; bf2 b = __builtin_convertvector(v, bf2); return __builtin_bit_cast(unsigned, b); }
__device__ __forceinline__ f32x4 xres_ld(const bf16_t* p) { const u32x2 w = *(const GAS u32x2*)p; f32x4 v; v.x = __builtin_bit_cast(float, w.x << 16); v.y = __builtin_bit_cast(float, w.x & 0xffff0000u); v.z = __builtin_bit_cast(float, w.y << 16); v.w = __builtin_bit_cast(float, w.y & 0xffff0000u); return v; }
__device__ __forceinline__ void xres_st(bf16_t* p, f32x4 v) { u32x2 w; w.x = pk2(v.x, v.y); w.y = pk2(v.z, v.w); *(GAS u32x2*)p = w; }
__device__ __forceinline__ unsigned pk4_fp8(float a, float b, float c, float d) { int p = __builtin_amdgcn_cvt_pk_fp8_f32(a, b, 0, false); p = __builtin_amdgcn_cvt_pk_fp8_f32(c, d, p, true); return (unsigned)p; }
__device__ __forceinline__ float bf2f(unsigned short b) { return __builtin_bit_cast(float, (unsigned)b << 16); }
__device__ __forceinline__ float bflo(unsigned w) { return __builtin_bit_cast(float, w << 16); }
__device__ __forceinline__ float bfhi(unsigned w) { return __builtin_bit_cast(float, w & 0xffff0000u); }
template <int M> __device__ __forceinline__ float xadd(float v) {
    if constexpr (M == 32) { unsigned a = __builtin_bit_cast(unsigned, v), b = a; asm volatile("" : "+v"(b));
        auto r = __builtin_amdgcn_permlane32_swap(a, b, false, false); const unsigned r0 = r[0], r1 = r[1];
        return __uint_as_float(r0) + __uint_as_float(r1); }
    else return v + __builtin_bit_cast(float, __builtin_amdgcn_ds_swizzle(__builtin_bit_cast(int, v), (M << 10) | 0x1f));
}
__device__ __forceinline__ float xmax32(float v) { unsigned a = __builtin_bit_cast(unsigned, v), b = a; asm volatile("" : "+v"(b));
    auto r = __builtin_amdgcn_permlane32_swap(a, b, false, false); const unsigned r0 = r[0], r1 = r[1]; return fmaxf(__uint_as_float(r0), __uint_as_float(r1)); }
__device__ __forceinline__ float wave_sum(float v) { v = xadd<1>(v); v = xadd<2>(v); v = xadd<4>(v); v = xadd<8>(v); v = xadd<16>(v); return xadd<32>(v); }
__device__ __forceinline__ float fast_exp2(float x) { return __builtin_amdgcn_exp2f(x); }
__device__ __forceinline__ float fast_rcp(float x) { return __builtin_amdgcn_rcpf(x); }
__device__ __forceinline__ float sigmoidf_(float x) { return fast_rcp(1.f + fast_exp2(-x * LOG2E)); }
__device__ __forceinline__ int lane_id() { return (int)__builtin_amdgcn_mbcnt_hi(~0u, __builtin_amdgcn_mbcnt_lo(~0u, 0u)); }
__device__ __forceinline__ void glds16(const void* gsrc, unsigned lds_dst) { unsigned keep;
    asm volatile("s_mov_b32 %0, m0\n\ts_mov_b32 m0, %2\n\ts_nop 0\n\tglobal_load_lds_dwordx4 %1, off\n\ts_mov_b32 m0, %0" : "=&s"(keep) : "v"(gsrc), "s"(lds_dst) : "memory"); }
__device__ __forceinline__ const char* uniform_ptr(const char* p) { const unsigned long long v = (unsigned long long)(uintptr_t)p; const unsigned lo = (unsigned)__builtin_amdgcn_readfirstlane((int)(unsigned)v), hi = (unsigned)__builtin_amdgcn_readfirstlane((int)(unsigned)(v >> 32)); return (const char*)(uintptr_t)(((unsigned long long)hi << 32) | lo); }
__device__ __forceinline__ void glds16_sv(const void* sbase, unsigned voff, unsigned lds_dst) { unsigned keep;
    asm volatile("s_mov_b32 %0, m0\n\ts_mov_b32 m0, %3\n\ts_nop 0\n\tglobal_load_lds_dwordx4 %1, %2\n\ts_mov_b32 m0, %0" : "=&s"(keep) : "v"(voff), "s"(sbase), "s"(lds_dst) : "memory"); }
#define LDS_WAIT() asm volatile("s_waitcnt lgkmcnt(0)" ::: "memory")
#define VM_WAIT() asm volatile("s_waitcnt vmcnt(0)" ::: "memory")

#define XB_TMO      128
#define XB_XCNT(j)  (256  + 64 * (j))
#define XB_XSUB(j)  (1280 + 64 * (j))
#define XB_XGEN(j)  (2304 + 64 * (j))
#define XB_TOP      3328
#define XB_TOPGEN   3392
#define XCD_BAR_WORDS 3456
#define XB_SPIN_CAP (1u << 18)
__device__ __forceinline__ unsigned xb_ld(unsigned* p)              { return __hip_atomic_load(p, __ATOMIC_RELAXED, __HIP_MEMORY_SCOPE_AGENT); }
__device__ __forceinline__ unsigned xb_add(unsigned* p, unsigned v) { return __hip_atomic_fetch_add(p, v, __ATOMIC_RELAXED, __HIP_MEMORY_SCOPE_AGENT); }
__device__ __forceinline__ unsigned xb_xcc_id() { return (unsigned)__builtin_amdgcn_s_getreg((3 << 11) | 20) & 0xFu; }
#define XB_SPIN(cond, bar) do { unsigned _sp = 0; while (cond) { __builtin_amdgcn_s_sleep(1); \
    if ((++_sp & 255u) == 0u) { if (xb_ld(&(bar)[XB_TMO])) break; if (_sp > XB_SPIN_CAP) { atomicAdd(&(bar)[XB_TMO], 1u); break; } } } } while (0)
struct XcdBarrier { unsigned* bar; unsigned x; volatile LAS unsigned* st; int wave; };
__device__ __forceinline__ XcdBarrier xcd_barrier_post(unsigned* bar, volatile LAS unsigned* st, int wave) {
    XcdBarrier b; b.bar = bar; b.x = xb_xcc_id(); b.st = st; b.wave = wave;
    if (wave == 0 && lane_id() == 0) (void)xb_add(&bar[XB_XCNT(b.x)], 1u);
    return b;
}
__device__ __forceinline__ void xcd_barrier_complete(unsigned* bar, unsigned x, unsigned& nloc, unsigned& nx) {
    const unsigned G = gridDim.x * gridDim.y * gridDim.z;
    unsigned sum, cnt, mine, sp = 0u;
    for (;;) {
        sum = 0u; cnt = 0u; mine = 0u;
#pragma unroll
        for (unsigned j = 0; j < 16; ++j) { const unsigned c = xb_ld(&bar[XB_XCNT(j)]); sum += c; cnt += (c > 0u) ? 1u : 0u; }
        mine = xb_ld(&bar[XB_XCNT(x)]);
        if (sum == G) break;
        __builtin_amdgcn_s_sleep(1);
        if ((++sp & 255u) == 0u) { if (xb_ld(&bar[XB_TMO])) break; if (sp > XB_SPIN_CAP) { atomicAdd(&bar[XB_TMO], 1u); break; } }
    }
    nloc = mine > 0u ? mine : 1u; nx = cnt > 0u ? cnt : 1u;
}
__device__ __forceinline__ void xcd_barrier(const XcdBarrier& b) {
    asm volatile("s_waitcnt vmcnt(0)" ::: "memory");
    __syncthreads();
    if (b.wave == 0 && lane_id() == 0) {
        unsigned* bar = b.bar; asm volatile("" : "+s"(bar));
        __builtin_amdgcn_s_waitcnt(0);
        unsigned nloc = b.st[0], nx = b.st[1];
        if (nloc == 0u) { xcd_barrier_complete(bar, b.x, nloc, nx); b.st[0] = nloc; b.st[1] = nx; }
        const unsigned old = xb_add(&bar[XB_XSUB(b.x)], 1u);
        const unsigned gen = old / nloc;
        if (old + 1u == (gen + 1u) * nloc) {
            __builtin_amdgcn_fence(__ATOMIC_RELEASE, "agent");
            asm volatile("s_waitcnt vmcnt(0)" ::: "memory");
            const unsigned og = xb_add(&bar[XB_TOP], 1u);
            const unsigned tg = og / nx;
            if (og + 1u == (tg + 1u) * nx) xb_add(&bar[XB_TOPGEN], 1u);
            else XB_SPIN(xb_ld(&bar[XB_TOPGEN]) == tg, bar);
            __builtin_amdgcn_fence(__ATOMIC_ACQUIRE, "agent");
            xb_add(&bar[XB_XGEN(b.x)], 1u);
            asm volatile("s_waitcnt vmcnt(0)" ::: "memory");
        } else {
            XB_SPIN(xb_ld(&bar[XB_XGEN(b.x)]) == gen, bar);
            __builtin_amdgcn_fence(__ATOMIC_ACQUIRE, "agent");
            asm volatile("s_waitcnt vmcnt(0)" ::: "memory");
        }
    }
    __syncthreads();
}

namespace pg8 {
constexpr int BM = 256, BK = 64, HALF = 128, HTB = HALF * BK * 2, STAGE_BYTES = 8 * HTB;
__host__ __device__ __forceinline__ int lds_byte(int r, int c) { const int st = (r >> 4) * 2 + (c >> 5), rr = r & 15, cc = c & 31, ob = rr * 64 + cc * 2; return st * 1024 + (ob ^ (((ob >> 9) & 1) << 5)); }
__host__ __device__ __forceinline__ void stage_rc(int b, int& R, int& C) { const int st = b / 1024, sb = b % 1024, swz = sb ^ (((sb >> 9) & 1) << 5); R = (st >> 1) * 16 + swz / 64; C = (st & 1) * 32 + (swz % 64) / 2; }
__host__ __device__ __forceinline__ int perm32(int rho) { const int n = rho >> 4, i = rho & 15; return 8 * (i >> 2) + 4 * n + (i & 3); }
struct Unit { int pm, pn, aux; };
__device__ __forceinline__ void tile_order(int L, int nM, int nN, int& pm, int& pn) {
    const int nwg = nM * nN; int wgid = L; { const int q = nwg / 8, r = nwg % 8, xcd = wgid % 8, off = wgid / 8; wgid = (xcd < r ? xcd * (q + 1) : r * (q + 1) + (xcd - r) * q) + off; }
    const int nig = 8 * nN, gid = wgid / nig, fm = gid * 8, gsz = (nM - fm) < 8 ? (nM - fm) : 8;
    pm = fm + ((wgid % nig) % gsz); pn = (wgid % nig) / gsz;
}
typedef int i32x8 __attribute__((ext_vector_type(8)));
typedef int i32x4 __attribute__((ext_vector_type(4)));
struct Frag2 { bf16x8 k[2]; };
template <bool F8> struct FragT { typedef Frag2 type; };
template <> struct FragT<true> { typedef i32x8 type; };
__device__ __forceinline__ void frag_set(Frag2& f, int k, i32x4 v) { f.k[k] = __builtin_bit_cast(bf16x8, v); }
__device__ __forceinline__ void frag_set(i32x8& f, int k, i32x4 v) { if (k == 0) { f[0] = v[0]; f[1] = v[1]; f[2] = v[2]; f[3] = v[3]; } else { f[4] = v[0]; f[5] = v[1]; f[6] = v[2]; f[7] = v[3]; } }
__device__ __forceinline__ f32x4 mma1(const Frag2& w, const Frag2& x, f32x4 c, int, int) { c = __builtin_amdgcn_mfma_f32_16x16x32_bf16(w.k[0], x.k[0], c, 0, 0, 0); return __builtin_amdgcn_mfma_f32_16x16x32_bf16(w.k[1], x.k[1], c, 0, 0, 0); }
#ifndef FP8_ASM_MMA
#define FP8_ASM_MMA 1
#endif
__device__ __forceinline__ f32x4 mma1(const i32x8& w, const i32x8& x, f32x4 c, int sw, int sx) {
#if FP8_ASM_MMA
    asm volatile("v_mfma_scale_f32_16x16x128_f8f6f4 %0, %1, %2, %0, %3, %4 op_sel_hi:[0,0,0]" : "+v"(c) : "v"(w), "v"(x), "v"(sw), "v"(sx));
    return c;
#else
    return __builtin_amdgcn_mfma_scale_f32_16x16x128_f8f6f4(w, x, c, 0, 0, 0, sw, 0, sx);
#endif
}
template <class Epi, class Sched, bool GATHER, bool FP8 = false, int SW = 0x7f7f7f7f, int SX = 0x7f7f7f7f>
__device__ __forceinline__ void gemm_phase(LAS unsigned char* lds, const int tid, const int kb, const int lda, const int ldb, const Sched& S, const Epi& E) {
    const int wid = __builtin_amdgcn_readfirstlane(tid >> 6), lane = tid & 63, wr = wid >> 2, wc = wid & 3, fr = lane & 15, fq = lane >> 4;
    const int nt = kb / 128;
    int sR[2], sC[2]; unsigned voffB[2];
#pragma unroll
    for (int i = 0; i < 2; ++i) { int R, C; stage_rc(tid * 16 + i * 8192, R, C); sR[i] = R; sC[i] = C; const int Rb = Epi::PERM ? ((R & ~31) + perm32(R & 31)) : R; voffB[i] = (unsigned)(Rb * ldb + C * 2); }
    const size_t kstep = (size_t)(BK * 2);
    const size_t hstepB = (size_t)HALF * ldb;
    const unsigned ldsw = (unsigned)wid * 1024u; const unsigned ldsb_ = (unsigned)(uintptr_t)lds;
    const int aoff = lds_byte(wr * 64 + fr, fq * 8), boff = lds_byte(wc * 32 + fr, fq * 8);
#define PG8_SA(b, h) (((b) * 2 + (h)) * HTB)
#define PG8_SB(b, h) ((4 + (b) * 2 + (h)) * HTB)
#define PG8_STAGE_B(bufoff, gbase) do { _Pragma("unroll") for (int _i = 0; _i < 2; ++_i) \
        glds16_sv((const void*)(gbase), voffB[_i], (unsigned)__builtin_amdgcn_readfirstlane((int)(ldsb_ + (bufoff) + ldsw + _i * 8192))); } while (0)
#define PG8_STAGE_A(bufoff, gbase, off) do { _Pragma("unroll") for (int _i = 0; _i < 2; ++_i) \
        glds16_sv((const void*)(gbase), (off)[_i], (unsigned)__builtin_amdgcn_readfirstlane((int)(ldsb_ + (bufoff) + ldsw + _i * 8192))); } while (0)
#define PG8_LDA(dst, b, h) do { _Pragma("unroll") for (int m = 0; m < 4; ++m) _Pragma("unroll") for (int k = 0; k < 2; ++k) frag_set(dst[m], k, *(const LAS i32x4*)(lds + PG8_SA(b, h) + aoff + m * 2048 + k * 1024)); } while (0)
#define PG8_LDB(dst, b, h) do { _Pragma("unroll") for (int n = 0; n < 2; ++n) _Pragma("unroll") for (int k = 0; k < 2; ++k) frag_set(dst[n], k, *(const LAS i32x4*)(lds + PG8_SB(b, h) + boff + n * 2048 + k * 1024)); } while (0)
#define PG8_MMA(ai, bj, At, Bt) do { __builtin_amdgcn_s_setprio(1); _Pragma("unroll") for (int m = 0; m < 4; ++m) _Pragma("unroll") for (int n = 0; n < 2; ++n) { \
        acc[ai][bj][m][n] = mma1(Bt[n], At[m], acc[ai][bj][m][n], SW, SX); } \
        __builtin_amdgcn_s_setprio(0); } while (0)
#define PG8_WAIT_V(n) asm volatile("s_waitcnt vmcnt(" #n ")" ::: "memory")
#define PG8_WAIT_L(n) asm volatile("s_waitcnt lgkmcnt(" #n ")" ::: "memory")
#define PG8_BAR __builtin_amdgcn_s_barrier()
#define PG8_SCHED __builtin_amdgcn_sched_barrier(0)
#define PG8_OFFS(dst, u) do { _Pragma("unroll") for (int _h = 0; _h < 2; ++_h) _Pragma("unroll") for (int _i = 0; _i < 2; ++_i) { \
        const int _r = sR[_i] + _h * HALF; const int _row = GATHER ? S.arow(u, _r) : _r; dst[_h][_i] = (unsigned)(_row * lda + sC[_i] * 2); } } while (0)
    Unit cur, nxt; int ui = 0;
    if (!S.next(0, cur)) return;
    f32x4 acc[2][2][4][2];
#pragma unroll
    for (int a = 0; a < 2; ++a)
#pragma unroll
        for (int b = 0; b < 2; ++b)
#pragma unroll
            for (int m = 0; m < 4; ++m)
#pragma unroll
                for (int n = 0; n < 2; ++n) acc[a][b][m][n] = (f32x4){0.f, 0.f, 0.f, 0.f};
    typedef typename FragT<FP8>::type frag_t;
    frag_t At[4], B0[2], B1[2];
    const char* cA; const char* cB; S.ptrs(cur, cA, cB); cA = uniform_ptr(cA); cB = uniform_ptr(cB);
    asm volatile("s_nop 4" ::: "memory");
    unsigned offC[2][2], offN[2][2];
    PG8_OFFS(offC, cur);
    PG8_STAGE_B(PG8_SB(0, 0), cB); PG8_STAGE_B(PG8_SB(0, 1), cB + hstepB); PG8_STAGE_A(PG8_SA(0, 0), cA, offC[0]); PG8_STAGE_A(PG8_SA(0, 1), cA, offC[1]);
    if (wr == 1) PG8_BAR;
    PG8_WAIT_V(2); PG8_BAR;
    PG8_STAGE_B(PG8_SB(1, 0), cB + kstep); PG8_STAGE_A(PG8_SA(1, 0), cA + kstep, offC[0]); PG8_STAGE_B(PG8_SB(1, 1), cB + hstepB + kstep);
    PG8_WAIT_V(6); PG8_BAR;
    for (;;) {
        const bool has_next = S.next(ui + 1, nxt);
        const char* nA = cA; const char* nB = cB;
        if (has_next) { S.ptrs(nxt, nA, nB); nA = uniform_ptr(nA); nB = uniform_ptr(nB); asm volatile("s_nop 4" ::: "memory"); PG8_OFFS(offN, nxt); }
        else {
#pragma unroll
            for (int h = 0; h < 2; ++h)
#pragma unroll
                for (int i = 0; i < 2; ++i) offN[h][i] = offC[h][i];
        }
#pragma unroll 1
        for (int tsec = 0; tsec < nt; tsec += (Epi::MID ? 4 : nt)) {
        if constexpr (Epi::MID) { if (tsec != 0) { unsigned z_ = 0u; asm volatile("" : "+v"(z_)); const int l2_ = (int)__builtin_amdgcn_mbcnt_hi(~0u, __builtin_amdgcn_mbcnt_lo(~0u, z_)); E.mid(acc, cur, tsec >> 2, wr, wc, l2_ & 15, l2_ >> 4); } }
#pragma unroll 1
        for (int t = tsec; t < tsec + (Epi::MID ? 4 : nt); t += 2) {
            const bool last = (t == nt - 2);
            const char* a1 = cA + (size_t)(t + 1) * kstep;
            const char* a2 = last ? nA : cA + (size_t)(t + 2) * kstep; const char* b2 = last ? nB : cB + (size_t)(t + 2) * kstep;
            const char* a3 = a2 + kstep; const char* b3 = b2 + kstep;
            unsigned o2[2][2];
#pragma unroll
            for (int h = 0; h < 2; ++h)
#pragma unroll
                for (int i = 0; i < 2; ++i) o2[h][i] = last ? offN[h][i] : offC[h][i];
            PG8_LDB(B0, 0, 0); PG8_LDB(B1, 0, 1); PG8_SCHED; PG8_LDA(At, 0, 0); PG8_STAGE_A(PG8_SA(1, 1), a1, offC[1]);
            PG8_WAIT_V(8); PG8_WAIT_L(0); PG8_BAR; PG8_MMA(0, 0, At, B0); PG8_MMA(0, 1, At, B1); PG8_BAR; PG8_SCHED;
            PG8_LDA(At, 0, 1); PG8_STAGE_B(PG8_SB(0, 0), b2); PG8_STAGE_B(PG8_SB(0, 1), b2 + hstepB); PG8_STAGE_A(PG8_SA(0, 0), a2, o2[0]);
            PG8_WAIT_V(8); PG8_WAIT_L(0); PG8_BAR; PG8_MMA(1, 0, At, B0); PG8_MMA(1, 1, At, B1); PG8_BAR; PG8_SCHED;
            PG8_LDB(B0, 1, 0); PG8_LDB(B1, 1, 1); PG8_SCHED; PG8_LDA(At, 1, 0); PG8_STAGE_A(PG8_SA(0, 1), a2, o2[1]);
            PG8_WAIT_V(8); PG8_WAIT_L(0); PG8_BAR; PG8_MMA(0, 0, At, B0); PG8_MMA(0, 1, At, B1); PG8_BAR; PG8_SCHED;
            PG8_LDA(At, 1, 1); PG8_STAGE_B(PG8_SB(1, 0), b3); PG8_STAGE_B(PG8_SB(1, 1), b3 + hstepB); PG8_STAGE_A(PG8_SA(1, 0), a3, o2[0]);
            PG8_WAIT_V(8); PG8_WAIT_L(0); PG8_BAR; PG8_MMA(1, 0, At, B0); PG8_MMA(1, 1, At, B1); PG8_BAR; PG8_SCHED;
        }
        }
        if (wr == 0) PG8_BAR;
        if constexpr (FP8) asm volatile("s_nop 15\n\ts_nop 7" ::: "memory");
        { unsigned z_ = 0u; asm volatile("" : "+v"(z_)); const int l2_ = (int)__builtin_amdgcn_mbcnt_hi(~0u, __builtin_amdgcn_mbcnt_lo(~0u, z_)); E(acc, cur, wr, wc, l2_ & 15, l2_ >> 4); }
        if (!has_next) break;
        if (S.fresh(nxt)) {
#pragma unroll
            for (int a = 0; a < 2; ++a)
#pragma unroll
                for (int b = 0; b < 2; ++b)
#pragma unroll
                    for (int m = 0; m < 4; ++m)
#pragma unroll
                        for (int n = 0; n < 2; ++n) acc[a][b][m][n] = (f32x4){0.f, 0.f, 0.f, 0.f};
        }
        cur = nxt; cA = nA; cB = nB; ++ui;
#pragma unroll
        for (int h = 0; h < 2; ++h)
#pragma unroll
            for (int i = 0; i < 2; ++i) offC[h][i] = offN[h][i];
        if (wr == 1) PG8_BAR;
    }
    PG8_WAIT_V(0);
    PG8_BAR;
#undef PG8_SA
#undef PG8_SB
#undef PG8_STAGE_A
#undef PG8_STAGE_B
#undef PG8_LDA
#undef PG8_LDB
#undef PG8_MMA
#undef PG8_WAIT_V
#undef PG8_WAIT_L
#undef PG8_BAR
#undef PG8_SCHED
#undef PG8_OFFS
}
}

struct Args { const float* in[26]; float* out; unsigned char* ws; int ph_lo, ph_hi; };
typedef const __attribute__((address_space(4))) Args* KArgs;
enum { I_X = 0, I_C, I_CTX, I_CCTX, I_WADA, I_BADA, I_N1G, I_N2G, I_WIN, I_WGATE, I_WBR, I_WOUT, I_DECAY, I_QNG, I_WUQ, I_KVNG, I_WUKV, I_GQN, I_GKN, I_SINK, I_WR, I_BR, I_W1, I_W3, I_W2, I_FNG };
constexpr int NWAVES = 8, NTHREADS = 512;

struct CvtDesc { const float* src; const float* kscale; bf16_t* dst; int N, k0, n0, Kd, nvalid, rmap, fp8; };
__device__ __forceinline__ void cvt_load(const CvtDesc& d, int lane, f32x4 (&v)[16]) {
    const int kk = lane >> 4, n4 = lane & 15, ncol = d.n0 + 4 * n4;
#pragma unroll
    for (int j = 0; j < 16; ++j) {
        const int k = d.k0 + 16 * kk + j;
        v[j] = (4 * n4 < d.nvalid) ? __builtin_nontemporal_load((const GAS f32x4*)(d.src + (size_t)k * d.N + ncol)) : (f32x4){0.f, 0.f, 0.f, 0.f};
    }
}
__device__ __forceinline__ void cvt_store(const CvtDesc& d, f32x4 (&v)[16], LAS unsigned char* scr, int lane) {
    const int kk = lane >> 4, n4 = lane & 15;
    if (d.kscale) {
#pragma unroll
        for (int j = 0; j < 16; ++j) v[j] = v[j] * d.kscale[d.k0 + 16 * kk + j];
    }
    if (d.fp8) {
#pragma unroll
        for (int i = 0; i < 4; ++i) { u32x4 w;
            w.x = pk4_fp8(32.f * v[0][i], 32.f * v[1][i], 32.f * v[2][i], 32.f * v[3][i]); w.y = pk4_fp8(32.f * v[4][i], 32.f * v[5][i], 32.f * v[6][i], 32.f * v[7][i]);
            w.z = pk4_fp8(32.f * v[8][i], 32.f * v[9][i], 32.f * v[10][i], 32.f * v[11][i]); w.w = pk4_fp8(32.f * v[12][i], 32.f * v[13][i], 32.f * v[14][i], 32.f * v[15][i]);
            *(LAS u32x4*)(scr + (4 * n4 + i) * 80 + 16 * kk) = w; }
        LDS_WAIT(); asm volatile("" ::: "memory");
        const int c = lane & 3;
#pragma unroll
        for (int jj = 0; jj < 4; ++jj) {
            const int n = (lane >> 2) + 16 * jj;
            const u32x4 o = *(const LAS u32x4*)(scr + n * 80 + 16 * c);
            const int prow = d.rmap == 0 ? n : (d.rmap == 1 ? (n & 31) + 128 * (n >> 5) : 32 * (n >> 4) + 8 * ((n >> 2) & 3) + (n & 3));
            *(GAS u32x4*)((unsigned char*)d.dst + (size_t)prow * d.Kd + d.k0 + 16 * c) = o;
        }
        LDS_WAIT(); asm volatile("" ::: "memory");
        return;
    }
#pragma unroll
    for (int i = 0; i < 4; ++i) { u32x4 w0, w1;
        w0.x = pk2(v[0][i], v[1][i]); w0.y = pk2(v[2][i], v[3][i]); w0.z = pk2(v[4][i], v[5][i]); w0.w = pk2(v[6][i], v[7][i]);
        w1.x = pk2(v[8][i], v[9][i]); w1.y = pk2(v[10][i], v[11][i]); w1.z = pk2(v[12][i], v[13][i]); w1.w = pk2(v[14][i], v[15][i]);
        *(LAS u32x4*)(scr + (4 * n4 + i) * 144 + 32 * kk) = w0; *(LAS u32x4*)(scr + (4 * n4 + i) * 144 + 32 * kk + 16) = w1; }
    LDS_WAIT(); asm volatile("" ::: "memory");
    const int c = lane & 7;
#pragma unroll
    for (int jj = 0; jj < 8; ++jj) {
        const int n = (lane >> 3) + 8 * jj;
        const u32x4 o = *(const LAS u32x4*)(scr + n * 144 + 16 * c);
        const int prow = d.rmap == 0 ? n : (d.rmap == 1 ? (n & 31) + 128 * (n >> 5) : 32 * (n >> 4) + 8 * ((n >> 2) & 3) + (n & 3));
        *(GAS u32x4*)(d.dst + (size_t)prow * d.Kd + d.k0 + 8 * c) = o;
    }
    LDS_WAIT(); asm volatile("" ::: "memory");
}
constexpr int CV_EXP_ITEMS = 2 * 32 * 3 * 256;
constexpr int CV_IN = 16 * 40, CV_GT = 16 * 64, CV_BRN = 4 * 16, CV_OUT = 16 * 16, CV_UQ = 4 * 6, CV_UKV = 2 * 8;
constexpr int CV_PER_L = CV_IN + CV_GT + 4 * CV_BRN + CV_OUT + CV_UQ + CV_UKV;
constexpr int CV_NITEMS = CV_EXP_ITEMS + 2 * CV_PER_L;
constexpr int CV_E0_SHARE = 12288;
__device__ __forceinline__ void cvt_decode(KArgs a, unsigned char* ws, int it, CvtDesc& d) {
    d.kscale = nullptr; d.N = 1024; d.Kd = 1024; d.nvalid = 64; d.rmap = 0; d.fp8 = 0;
    if (it < CV_EXP_ITEMS) {
        d.fp8 = 1;
        const int j = it >> 8, r = it & 255, l = j / 96, jj = j % 96, e = jj / 3, kind = jj % 3, kb = r >> 4, nb = r & 15;
        const size_t eo = ((size_t)l * 32 + e) * 1048576;
        d.k0 = kb * 64; d.n0 = nb * 64;
        if (kind < 2) { d.src = (kind == 0 ? a->in[I_W1] : a->in[I_W3]) + eo;
            d.dst = (bf16_t*)(ws + WS_W13 + ((size_t)l * 32 + e) * 2097152 + (size_t)(256 * (nb >> 1) + 128 * kind + 64 * (nb & 1)) * 1024); }
        else { d.src = a->in[I_W2] + eo; d.dst = (bf16_t*)(ws + WS_W2 + eo + (size_t)(nb * 64) * 1024); }
        return;
    }
    int r = it - CV_EXP_ITEMS; const int l = r / CV_PER_L; r -= l * CV_PER_L;
    if (r < CV_IN) {
        const int kb = r / 40, hb = r % 40, t = hb >> 2, wc = hb & 3; int src0 = -1, nv = 64;
        if (t < 5) src0 = 256 * t + 64 * wc;
        else if (t == 5) { if (wc < 2) src0 = 1280 + 64 * wc; else if (wc == 2) { src0 = 1408; nv = 32; } }
        else if (t == 6) src0 = P_GQA + 64 * wc;
        else if (t == 7) src0 = wc < 2 ? P_GQA + 256 + 64 * wc : P_GQA + 384 + 64 * (wc - 2);
        else if (t == 8) src0 = P_WIN + 64 * wc;
        else src0 = wc < 2 ? P_WIN + 256 + 64 * wc : P_WIN + 384 + 64 * (wc - 2);
        d.src = a->in[I_WIN] + (size_t)l * 1024 * NIN; d.N = NIN; d.k0 = kb * 64; d.n0 = src0 < 0 ? 0 : src0; d.nvalid = src0 < 0 ? 0 : nv; d.rmap = 1;
        d.fp8 = 1; d.dst = (bf16_t*)(ws + WS_WIN + ((size_t)l * NBG + 256 * t + 32 * wc) * 1024); return; } r -= CV_IN;
    if (r < CV_GT) {
        const int kb = r >> 6, nb = r & 63, i = nb >> 4, tg = nb & 15;
        d.src = a->in[I_WGATE] + (size_t)l * 1024 * 4096; d.N = 4096; d.k0 = kb * 64; d.n0 = i * 1024 + 64 * tg; d.rmap = 2;
        d.fp8 = 1; d.dst = (bf16_t*)(ws + WS_WIN + ((size_t)l * NBG + NINP + 256 * tg + 128 * (i >> 1) + 4 * (i & 1)) * 1024); return; } r -= CV_GT;
    if (r < 4 * CV_BRN) { const int i = r / CV_BRN, rr = r % CV_BRN, kb = rr >> 4, nb = rr & 15; d.src = a->in[I_WBR] + ((size_t)l * 4 + i) * 256 * 1024; d.k0 = kb * 64; d.n0 = nb * 64;
        d.dst = (bf16_t*)(ws + WS_WBR) + ((size_t)l * 1024 + nb * 64) * 1024 + 256 * i; return; } r -= 4 * CV_BRN;
    if (r < CV_OUT) { const int kb = r >> 4, nb = r & 15; d.src = a->in[I_WOUT] + (size_t)l * 1048576; d.k0 = kb * 64; d.n0 = nb * 64; d.dst = (bf16_t*)(ws + WS_WOUT) + (size_t)l * 1048576 + (size_t)(nb * 64) * 1024; return; } r -= CV_OUT;
    if (r < CV_UQ) { const int kb = r / 6, nb = r % 6; d.src = a->in[I_WUQ] + (size_t)l * 256 * 384; d.N = 384; d.k0 = kb * 64; d.n0 = nb * 64; d.kscale = a->in[I_QNG] + l * 256; d.dst = (bf16_t*)(ws + WS_WSM) + ((size_t)l * 384 + nb * 64) * 256; d.Kd = 256; return; } r -= CV_UQ;
    { const int kb = r >> 3, nb = r & 7; d.src = a->in[I_WUKV] + (size_t)l * 128 * 512; d.N = 512; d.k0 = kb * 64; d.n0 = nb * 64; d.kscale = a->in[I_KVNG] + l * 128; d.dst = (bf16_t*)(ws + WS_WSM) + 2 * 384 * 256 + ((size_t)l * 512 + nb * 64) * 128; d.Kd = 128; }
}

__device__ __forceinline__ void cvt_run(KArgs a, unsigned char* ws, LAS unsigned char* lds, int lane, int wave, int first, int last, int start, int stride) {
    LAS unsigned char* scr = lds + 57344 + wave * 9216;
    int it = first + start;
    if (it < last) {
        CvtDesc dA, dB; f32x4 va[16], vb[16];
        cvt_decode(a, ws, it, dA); cvt_load(dA, lane, va);
        for (;;) {
            const int itB = it + stride; const bool hasB = itB < last;
            if (hasB) { cvt_decode(a, ws, itB, dB); cvt_load(dB, lane, vb); }
            cvt_store(dA, va, scr, lane);
            if (!hasB) break;
            const int itA = itB + stride; const bool hasA = itA < last;
            if (hasA) { cvt_decode(a, ws, itA, dA); cvt_load(dA, lane, va); }
            cvt_store(dB, vb, scr, lane);
            if (!hasA) break;
            it = itA;
        }
    }
}
__device__ __forceinline__ void p0_prologue(KArgs a, LAS unsigned char* lds, int tid, int lane, int wave, int G, int c) {
    unsigned char* ws = a->ws;
    if (c < 192) {
        LAS float* st = (LAS float*)lds;
        LAS float* red = (LAS float*)(lds + 36864);
        for (int idx = tid; idx < 9 * 1024; idx += NTHREADS) { const int r = idx >> 10, k = idx & 1023; const float v = r < 8 ? a->in[I_C][r * 1024 + k] : a->in[I_CCTX][k]; st[idx] = v / (1.f + __expf(-v)); }
        __syncthreads();
        const int l = c / 96, n0 = (c % 96) * 64;
        float acc[9];
#pragma unroll
        for (int r = 0; r < 9; ++r) acc[r] = 0.f;
        const float* wp = a->in[I_WADA] + ((size_t)l * 1024 + wave * 128) * 6144 + n0 + lane;
#pragma unroll 4
        for (int k = 0; k < 128; ++k) { const float wv = wp[(size_t)k * 6144];
#pragma unroll
            for (int r = 0; r < 9; ++r) acc[r] += st[r * 1024 + wave * 128 + k] * wv; }
#pragma unroll
        for (int r = 0; r < 9; ++r) red[(wave * 9 + r) * 64 + lane] = acc[r];
        __syncthreads();
        for (int idx = tid; idx < 9 * 64; idx += NTHREADS) { const int r = idx >> 6, n = idx & 63; float s = 0.f;
#pragma unroll
            for (int w = 0; w < 8; ++w) s += red[(w * 9 + r) * 64 + n];
            ((float*)(ws + WS_ADA))[((size_t)l * 9 + r) * 6144 + n0 + n] = s + a->in[I_BADA][l * 6144 + n0 + n]; }
        __syncthreads();
    }
    const int gw = c * NWAVES + wave, NGW = G * NWAVES;
    {
        float* rope = (float*)(ws + WS_ROPE);
        for (int idx = gw * 64 + lane; idx < 2048 * 48; idx += NGW * 64) {
            const int pos = idx / 48, j = idx % 48, row = pos >> 6, col = pos & 63;
            if (j < 32) { const int i = j, f = i & 15; const float inv = powf(10000.f, -(float)f / 16.f); const float ang = (float)(i < 16 ? row : col) * inv;
                rope[pos * 32 + i] = cosf(ang); rope[2048 * 32 + pos * 32 + i] = sinf(ang); }
            else { const int i = j - 32, f = i & 7; const float inv = powf(10000.f, -(float)f / 8.f); const float ang = (float)(i < 8 ? row : col) * inv;
                rope[2 * 2048 * 32 + pos * 16 + i] = cosf(ang); rope[2 * 2048 * 32 + 2048 * 16 + pos * 16 + i] = sinf(ang); }
        }
        float* wrp = (float*)(ws + WS_WRP);
        for (int idx = gw * 64 + lane; idx < 32768; idx += NGW * 64) { const int half = idx >> 14, w = (idx >> 11) & 7, q = (idx >> 9) & 3, e = (idx >> 5) & 15, s = idx & 31;
            wrp[idx] = a->in[I_WR][(128 * w + 32 * q + s) * 32 + 16 * half + e]; }
    }
    cvt_run(a, ws, lds, lane, wave, 0, CV_EXP_ITEMS / 2, gw, NGW);
    cvt_run(a, ws, lds, lane, wave, CV_EXP_ITEMS, CV_NITEMS, gw, NGW);
}

__device__ __forceinline__ void moe_tables(const unsigned* ctl, int l, LAS unsigned char* lds, int tid) {
    LAS int* tb = (LAS int*)(lds + LDS_MISC + 1024); LAS int* cn = (LAS int*)(lds + LDS_MISC + 2304);
    __syncthreads();
    if (tid < 32) cn[tid] = (int)__hip_atomic_load(ctl + CW_CNT + l * 32 + tid, __ATOMIC_RELAXED, __HIP_MEMORY_SCOPE_AGENT);
    __syncthreads();
    if (tid == 0) { int s = 0; for (int e = 0; e < 32; ++e) { tb[e] = s; s += (cn[e] + 255) >> 8; } tb[32] = s; }
    __syncthreads();
    if (tid < MAXTILES) { LAS int* te = (LAS int*)(lds + LDS_MISC + 1024 + 48 * 4); int e = 0; for (int k = 1; k < 32; ++k) e += (tid >= tb[k]) ? 1 : 0; te[tid] = e | ((tid - tb[e]) << 8); }
    __syncthreads();
}

__device__ __forceinline__ void phase_rownorm(KArgs a, int mode, LAS unsigned char* lds, int lane, int wave, int G, int c) {
    unsigned char* ws = a->ws;
    const int gw = c * NWAVES + wave, NGW = G * NWAVES;
    const float* ada = (const float*)(ws + WS_ADA);
    bf16_t* X = (bf16_t*)(ws + WS_X);
    const LAS int* tb = (const LAS int*)(lds + LDS_MISC + 1024);
    const int nrows = (mode == 2) ? TL : TT;
    const int lprev = mode - 1, lcur = (mode == 2) ? 0 : mode;
    constexpr int R = 3;
    for (int base = gw; base < nrows; base += R * NGW) {
        f32x4 v[R][4]; int rows[R]; bool ok[R];
#pragma unroll
        for (int r = 0; r < R; ++r) { rows[r] = base + r * NGW; ok[r] = rows[r] < nrows; if (!ok[r]) rows[r] = base; }
#pragma unroll
        for (int r = 0; r < R; ++r) {
            const int row = rows[r];
            if (mode == 0) { const float* src = row < TL ? a->in[I_X] + (size_t)row * 1024 : a->in[I_CTX] + (size_t)(row - TL) * 1024;
#pragma unroll
                for (int j = 0; j < 4; ++j) v[r][j] = *(const GAS f32x4*)(src + 4 * lane + 256 * j); }
            else {
#pragma unroll
                for (int j = 0; j < 4; ++j) v[r][j] = xres_ld(X + (size_t)row * 1024 + 4 * lane + 256 * j); }
        }
        if (mode != 0) {
            const int* te = (const int*)(ws + WS_TOKE); const float* tw = (const float*)(ws + WS_TOKW);
            const bf16_t* Y2 = (const bf16_t*)(ws + WS_Y2);
            u32x2 y0[R][4], y1[R][4]; float w0[R], w1[R];
#pragma unroll
            for (int r = 0; r < R; ++r) {
                const int row = rows[r];
                const int e0 = te[row * 2], e1 = te[row * 2 + 1]; w0[r] = tw[row * 2]; w1[r] = tw[row * 2 + 1];
                const size_t s0 = (size_t)(tb[e0 >> 20] * 256 + (e0 & 0xfffff)), s1 = (size_t)(tb[e1 >> 20] * 256 + (e1 & 0xfffff));
#pragma unroll
                for (int j = 0; j < 4; ++j) { y0[r][j] = *(const GAS u32x2*)(Y2 + s0 * 1024 + 4 * lane + 256 * j); y1[r][j] = *(const GAS u32x2*)(Y2 + s1 * 1024 + 4 * lane + 256 * j); }
            }
#pragma unroll
            for (int r = 0; r < R; ++r) {
                const int row = rows[r]; const int b = row < TL ? (row >> 11) : 8;
                const float* g2 = ada + ((size_t)lprev * 9 + b) * 6144 + 5120;
#pragma unroll
                for (int j = 0; j < 4; ++j) {
                    const f32x4 gg = *(const GAS f32x4*)(g2 + 4 * lane + 256 * j);
                    f32x4 f; f.x = w0[r] * bflo(y0[r][j].x) + w1[r] * bflo(y1[r][j].x); f.y = w0[r] * bfhi(y0[r][j].x) + w1[r] * bfhi(y1[r][j].x);
                    f.z = w0[r] * bflo(y0[r][j].y) + w1[r] * bflo(y1[r][j].y); f.w = w0[r] * bfhi(y0[r][j].y) + w1[r] * bfhi(y1[r][j].y);
                    v[r][j] = v[r][j] + gg * f;
                }
                if (mode == 1 && ok[r]) {
#pragma unroll
                    for (int j = 0; j < 4; ++j) xres_st(X + (size_t)row * 1024 + 4 * lane + 256 * j, v[r][j]);
                }
            }
        }
#pragma unroll
        for (int r = 0; r < R; ++r) {
            const int row = rows[r]; const int b = row < TL ? (row >> 11) : 8;
            float ss = 0.f;
#pragma unroll
            for (int j = 0; j < 4; ++j) ss += (v[r][j].x * v[r][j].x + v[r][j].y * v[r][j].y) + (v[r][j].z * v[r][j].z + v[r][j].w * v[r][j].w);
            const float rstd = 1.0f / sqrtf(wave_sum(ss) * (1.f / 1024.f) + EPS);
            if (ok[r]) {
                if (mode == 2) {
#pragma unroll
                    for (int j = 0; j < 4; ++j) { const f32x4 g = *(const GAS f32x4*)(a->in[I_FNG] + 4 * lane + 256 * j); *(GAS f32x4*)(a->out + (size_t)row * 1024 + 4 * lane + 256 * j) = v[r][j] * rstd * g; }
                } else {
                    const float* gn = a->in[I_N1G] + lcur * 1024; const float* sh = ada + ((size_t)lcur * 9 + b) * 6144; const float* sc = sh + 1024;
                    unsigned char* H = (unsigned char*)(ws + WS_H) + (size_t)row * 1024;
#pragma unroll
                    for (int j = 0; j < 4; ++j) { const int cc = 4 * lane + 256 * j; const f32x4 g = *(const GAS f32x4*)(gn + cc), s1 = *(const GAS f32x4*)(sc + cc), s0 = *(const GAS f32x4*)(sh + cc);
                        const f32x4 h = v[r][j] * rstd * g * (s1 + 1.0f) + s0; *(GAS unsigned*)(H + cc) = pk4_fp8(h.x, h.y, h.z, h.w); }
                }
            }
        }
    }
}

using pg8::Unit;
struct SchedB {
    int layer, G, c; const char* H; const char* W;
    __device__ __forceinline__ bool next(int i, Unit& u) const {
        const int L = i * G + c; u.aux = 0;
        if (layer == 0) { if (L >= 72 * 26) return false; pg8::tile_order(L, 72, 26, u.pm, u.pn); return true; }
        if (L < 64 * 16) { pg8::tile_order(L, 64, 16, u.pm, u.pn); u.pn += 10; return true; }
        const int L2 = L - 64 * 16; if (L2 >= 72 * 10) return false; pg8::tile_order(L2, 72, 10, u.pm, u.pn); return true;
    }
    __device__ __forceinline__ void ptrs(const Unit& u, const char*& A, const char*& B) const { A = H + (size_t)u.pm * 256 * 1024; B = W + (size_t)u.pn * 256 * 1024; }
    __device__ __forceinline__ int arow(const Unit&, int r) const { return r; }
    __device__ __forceinline__ bool fresh(const Unit&) const { return true; }
};
struct EpiB {
    static constexpr bool PERM = true, MID = false;
    bf16_t* P; bf16_t* Gt; bf16_t* Q; const float* cos64; const float* sin64; const float* qng; const float* kng;
    __device__ __forceinline__ void operator()(f32x4 (&acc)[2][2][4][2], const Unit& u, int wr, int wc, int fr, int fq) const {
        const int row0 = u.pm * 256 + wr * 64 + fr;
        if (u.pn >= 10) {
            const int d0 = (u.pn - 10) * 64 + 16 * wc + 4 * fq;
#pragma unroll
            for (int ai = 0; ai < 2; ++ai)
#pragma unroll
                for (int m = 0; m < 4; ++m) { bf16_t* gp = Gt + (size_t)(row0 + ai * 128 + m * 16) * NGATE + d0;
                    f32x4 g[4];
#pragma unroll
                    for (int i = 0; i < 4; ++i)
#pragma unroll
                        for (int j = 0; j < 4; ++j) g[i][j] = fmaxf(sigmoidf_(acc[ai][i >> 1][m][i & 1][j]), 1e-6f);
#pragma unroll
                    for (int i = 0; i < 4; ++i) { f32x4 r = g[i];
                        if (i < 3) {
#pragma unroll
                            for (int j = 0; j < 4; ++j) r[j] *= fast_rcp(g[i + 1][j]); }
                        u32x2 w; w.x = pk2(r[0], r[1]); w.y = pk2(r[2], r[3]); *(GAS u32x2*)(gp + i * 1024) = w; } }
            return;
        }
        const int t = u.pn;
        bf16_t* dst; size_t ld; int col; int mode = 0;
        float scale = 1.f; const float* gain = nullptr;
        if (t == 4) { dst = P; ld = NINP; col = P_MLA + 64 * wc; }
        else if (t == 5) { dst = P; ld = NINP; col = 1280 + 64 * wc; mode = wc < 3 ? 0 : 3; }
        else { dst = Q; ld = QP;
            if (t == 0) { col = Q_RETQ + 64 * wc; mode = 1; scale = 0.125f; }
            else if (t == 1) { col = Q_RETK + 64 * wc; mode = 1; }
            else if (t == 2) col = Q_RETV + 64 * wc;
            else if (t == 3) col = Q_RETG + 64 * wc;
            else if (t == 6) { col = Q_GQAQ + 64 * wc; mode = 2; scale = 0.125f * LOG2E; gain = qng; }
            else if (t == 7) { if (wc < 2) { col = Q_GQAK + 64 * wc; mode = 2; gain = kng; } else col = Q_GQAV + 64 * (wc - 2); }
            else if (t == 8) { col = Q_WINQ + 64 * wc; mode = 1; scale = 0.125f * LOG2E; }
            else { if (wc < 2) { col = Q_WINK + 64 * wc; mode = 1; } else col = Q_WINV + 64 * (wc - 2); } }
        if (mode == 3) return;
        f32x4 ga0 = {1.f, 1.f, 1.f, 1.f}, ga1 = ga0, gb0 = ga0, gb1 = ga0;
        if (mode == 2) { ga0 = *(const GAS f32x4*)(gain + 8 * fq); ga1 = *(const GAS f32x4*)(gain + 8 * fq + 4); gb0 = *(const GAS f32x4*)(gain + 32 + 8 * fq); gb1 = *(const GAS f32x4*)(gain + 32 + 8 * fq + 4); }
        const bool half_only = (t == 5 && wc == 2);
#pragma unroll
        for (int ai = 0; ai < 2; ++ai)
#pragma unroll
            for (int m = 0; m < 4; ++m) {
                const int row = row0 + ai * 128 + m * 16;
                f32x4 a0 = acc[ai][0][m][0], a1 = acc[ai][0][m][1], b0 = acc[ai][1][m][0], b1 = acc[ai][1][m][1];
                if (mode == 2) {
                    float ss = 0.f;
#pragma unroll
                    for (int j = 0; j < 4; ++j) ss += a0[j] * a0[j] + a1[j] * a1[j] + b0[j] * b0[j] + b1[j] * b1[j];
                    ss = xadd<16>(ss); ss = xadd<32>(ss);
                    const float rstd = __builtin_amdgcn_rsqf(ss * (1.f / 64.f) + EPS);
                    a0 = a0 * rstd * ga0; a1 = a1 * rstd * ga1; b0 = b0 * rstd * gb0; b1 = b1 * rstd * gb1;
                }
                if (mode >= 1) {
                    if (row < TL) { const int pos = row & 2047;
                        const f32x4 c0 = *(const GAS f32x4*)(cos64 + pos * 32 + 8 * fq), c1 = *(const GAS f32x4*)(cos64 + pos * 32 + 8 * fq + 4);
                        const f32x4 s0 = *(const GAS f32x4*)(sin64 + pos * 32 + 8 * fq), s1 = *(const GAS f32x4*)(sin64 + pos * 32 + 8 * fq + 4);
                        const f32x4 o0 = a0 * c0 - b0 * s0, o1 = a1 * c1 - b1 * s1, p0 = b0 * c0 + a0 * s0, p1 = b1 * c1 + a1 * s1;
                        a0 = o0; a1 = o1; b0 = p0; b1 = p1; }
                    a0 = a0 * scale; a1 = a1 * scale; b0 = b0 * scale; b1 = b1 * scale;
                }
                bf16_t* rp = dst + (size_t)row * ld + col + 8 * fq;
                u32x4 w; w.x = pk2(a0[0], a0[1]); w.y = pk2(a0[2], a0[3]); w.z = pk2(a1[0], a1[1]); w.w = pk2(a1[2], a1[3]);
                *(GAS u32x4*)rp = w;
                if (!half_only) { u32x4 w2; w2.x = pk2(b0[0], b0[1]); w2.y = pk2(b0[2], b0[3]); w2.z = pk2(b1[0], b1[1]); w2.w = pk2(b1[2], b1[3]); *(GAS u32x4*)(rp + 32) = w2; }
                asm volatile("" ::: "memory");
            }
    }
};
struct SchedE {
    int G, c, nM; const char* Y; const char* W;
    __device__ __forceinline__ bool next(int i, Unit& u) const { const int L = i * G + c; u.aux = 0; if (L >= nM * 4) return false; pg8::tile_order(L, nM, 4, u.pm, u.pn); return true; }
    __device__ __forceinline__ void ptrs(const Unit& u, const char*& A, const char*& B) const { A = Y + (size_t)u.pm * 256 * 1024 * 2; B = W + (size_t)u.pn * 256 * 1024 * 2; }
    __device__ __forceinline__ int arow(const Unit&, int r) const { return r; }
    __device__ __forceinline__ bool fresh(const Unit&) const { return true; }
};
struct EpiE {
    static constexpr bool PERM = true, MID = true;
    const bf16_t* Gt; bf16_t* M;
    __device__ __forceinline__ void mid(f32x4 (&acc)[2][2][4][2], const Unit& u, int i, int wr, int wc, int fr, int fq) const {
        const int row0 = u.pm * 256 + wr * 64 + fr;
        const int col0 = u.pn * 256 + wc * 32 + 8 * fq;
        const bf16_t* gp0 = Gt + (size_t)row0 * NGATE + (i - 1) * 1024 + col0;
        u32x4 g[2][4][2];
#pragma unroll
        for (int ai = 0; ai < 2; ++ai)
#pragma unroll
            for (int m = 0; m < 4; ++m)
#pragma unroll
                for (int bj = 0; bj < 2; ++bj) g[ai][m][bj] = *(const GAS u32x4*)(gp0 + (size_t)(ai * 128 + m * 16) * NGATE + bj * 128);
#pragma unroll
        for (int ai = 0; ai < 2; ++ai)
#pragma unroll
            for (int m = 0; m < 4; ++m)
#pragma unroll
                for (int bj = 0; bj < 2; ++bj) { const u32x4 gg = g[ai][m][bj];
                    const f32x4 s0 = {bflo(gg.x), bfhi(gg.x), bflo(gg.y), bfhi(gg.y)}, s1 = {bflo(gg.z), bfhi(gg.z), bflo(gg.w), bfhi(gg.w)};
                    acc[ai][bj][m][0] = acc[ai][bj][m][0] * s0; acc[ai][bj][m][1] = acc[ai][bj][m][1] * s1; }
    }
    __device__ __forceinline__ void operator()(f32x4 (&acc)[2][2][4][2], const Unit& u, int wr, int wc, int fr, int fq) const {
        const int row0 = u.pm * 256 + wr * 64 + fr, col0 = u.pn * 256 + wc * 32 + 8 * fq;
#pragma unroll
        for (int ai = 0; ai < 2; ++ai)
#pragma unroll
            for (int m = 0; m < 4; ++m) { const size_t row = (size_t)(row0 + ai * 128 + m * 16);
#pragma unroll
                for (int bj = 0; bj < 2; ++bj) {
                    const u32x4 g = *(const GAS u32x4*)(Gt + row * NGATE + 3 * 1024 + col0 + bj * 128);
                    const f32x4 s0 = {bflo(g.x), bfhi(g.x), bflo(g.y), bfhi(g.y)}, s1 = {bflo(g.z), bfhi(g.z), bflo(g.w), bfhi(g.w)};
                    const f32x4 v0 = acc[ai][bj][m][0] * s0, v1 = acc[ai][bj][m][1] * s1;
                    u32x4 w; w.x = pk2(v0[0], v0[1]); w.y = pk2(v0[2], v0[3]); w.z = pk2(v1[0], v1[1]); w.w = pk2(v1[2], v1[3]);
                    *(GAS u32x4*)(M + row * 1024 + col0 + bj * 128) = w;
                } }
    }
};
struct SchedF {
    int G, c, nM; const char* A0; const char* W;
    __device__ __forceinline__ bool next(int i, Unit& u) const { const int L = i * G + c; u.aux = 0; if (L >= nM * 4) return false; pg8::tile_order(L, nM, 4, u.pm, u.pn); return true; }
    __device__ __forceinline__ void ptrs(const Unit& u, const char*& A, const char*& B) const { A = A0 + (size_t)u.pm * 256 * 1024 * 2; B = W + (size_t)u.pn * 256 * 1024 * 2; }
    __device__ __forceinline__ int arow(const Unit&, int r) const { return r; }
    __device__ __forceinline__ bool fresh(const Unit&) const { return true; }
};
struct EpiF {
    static constexpr bool PERM = false, MID = false;
    const float* xin; const float* cin; const bf16_t* Xs; bf16_t* X; const float* ada_l; int layer;
    __device__ __forceinline__ void operator()(f32x4 (&acc)[2][2][4][2], const Unit& u, int wr, int wc, int fr, int fq) const {
        const int row0 = u.pm * 256 + wr * 64 + fr, col0 = u.pn * 256 + wc * 32 + 4 * fq;
#pragma unroll
        for (int ai = 0; ai < 2; ++ai)
#pragma unroll
            for (int m = 0; m < 4; ++m) { const int row = row0 + ai * 128 + m * 16; const int b = row < TL ? (row >> 11) : 8;
                const float* src = row < TL ? xin + (size_t)row * 1024 : cin + (size_t)(row - TL) * 1024;
                const float* g1 = ada_l + (size_t)b * 6144 + 2048;
#pragma unroll
                for (int bj = 0; bj < 2; ++bj)
#pragma unroll
                    for (int n = 0; n < 2; ++n) { const int c = col0 + bj * 128 + n * 16;
                        const f32x4 xs = (layer == 0) ? *(const GAS f32x4*)(src + c) : xres_ld(Xs + (size_t)row * 1024 + c); const f32x4 gg = *(const GAS f32x4*)(g1 + c);
                        xres_st(X + (size_t)row * 1024 + c, xs + gg * acc[ai][bj][m][n]); } }
    }
};
struct SchedMoe {
    int G, c, npn, gather; const LAS int* tb; const LAS int* cn; const int* tokinv; const char* A0; const char* W; size_t wstride;
    __device__ __forceinline__ bool next(int i, Unit& u) const {
        const int L = i * G + c; if (L >= __builtin_amdgcn_readfirstlane(tb[32]) * npn) return false;
        const int rt = L / npn; u.pm = rt; u.pn = L - rt * npn; u.aux = __builtin_amdgcn_readfirstlane(tb[48 + rt]); return true;
    }
    __device__ __forceinline__ void ptrs(const Unit& u, const char*& A, const char*& B) const {
        A = gather ? A0 : A0 + (size_t)u.pm * 256 * 1024; B = W + (size_t)(u.aux & 255) * wstride + (size_t)u.pn * 256 * 1024; }
    __device__ __forceinline__ int arow(const Unit& u, int r) const { const int e = u.aux & 255, idx = (u.aux >> 8) * 256 + r; return idx < cn[e] ? tokinv[(size_t)e * TT + idx] : 0; }
    __device__ __forceinline__ bool fresh(const Unit&) const { return true; }
};
struct EpiH {
    static constexpr bool PERM = true, MID = false;
    unsigned char* HID;
    __device__ __forceinline__ void operator()(f32x4 (&acc)[2][2][4][2], const Unit& u, int wr, int wc, int fr, int fq) const {
        const int row0 = u.pm * 256 + wr * 64 + fr, col0 = u.pn * 128 + wc * 32 + 8 * fq;
#pragma unroll
        for (int ai = 0; ai < 2; ++ai)
#pragma unroll
            for (int m = 0; m < 4; ++m) { f32x4 h0, h1;
#pragma unroll
                for (int j = 0; j < 4; ++j) { const float a0 = acc[ai][0][m][0][j], a1 = acc[ai][0][m][1][j];
                    h0[j] = a0 * sigmoidf_(a0) * acc[ai][1][m][0][j]; h1[j] = a1 * sigmoidf_(a1) * acc[ai][1][m][1][j]; }
                u32x2 w; w.x = pk4_fp8(4.f * h0[0], 4.f * h0[1], 4.f * h0[2], 4.f * h0[3]); w.y = pk4_fp8(4.f * h1[0], 4.f * h1[1], 4.f * h1[2], 4.f * h1[3]);
                *(GAS u32x2*)(HID + (size_t)(row0 + ai * 128 + m * 16) * 1024 + col0) = w; }
    }
};
struct EpiI {
    static constexpr bool PERM = true, MID = false;
    bf16_t* Y2;
    __device__ __forceinline__ void operator()(f32x4 (&acc)[2][2][4][2], const Unit& u, int wr, int wc, int fr, int fq) const {
        const int row0 = u.pm * 256 + wr * 64 + fr, col0 = u.pn * 256 + wc * 32 + 8 * fq;
#pragma unroll
        for (int ai = 0; ai < 2; ++ai)
#pragma unroll
            for (int m = 0; m < 4; ++m)
#pragma unroll
                for (int bj = 0; bj < 2; ++bj) { const f32x4 v0 = acc[ai][bj][m][0], v1 = acc[ai][bj][m][1];
                    u32x4 w; w.x = pk2(v0[0], v0[1]); w.y = pk2(v0[2], v0[3]); w.z = pk2(v1[0], v1[1]); w.w = pk2(v1[2], v1[3]);
                    *(GAS u32x4*)(Y2 + (size_t)(row0 + ai * 128 + m * 16) * 1024 + col0 + bj * 128) = w; }
    }
};

__device__ __forceinline__ void rope_item_desc(int item, int& src, int& dst, float& scale, int& normsel) {
    normsel = 0; scale = 1.f;
    if (item < 4) { src = P_RET + item * 64; dst = Q_RETQ + item * 64; scale = 0.125f; }
    else if (item < 8) { src = P_RET + 256 + (item - 4) * 64; dst = Q_RETK + (item - 4) * 64; }
    else if (item < 12) { src = P_GQA + (item - 8) * 64; dst = Q_GQAQ + (item - 8) * 64; scale = 0.125f * LOG2E; normsel = 1; }
    else if (item < 14) { src = P_GQA + 256 + (item - 12) * 64; dst = Q_GQAK + (item - 12) * 64; normsel = 2; }
    else if (item < 16) { src = P_WIN + 256 + (item - 14) * 64; dst = Q_WINK + (item - 14) * 64; }
    else { src = P_WIN + (item - 16) * 64; dst = Q_WINQ + (item - 16) * 64; scale = 0.125f * LOG2E; }
}
__device__ __forceinline__ void phase_post(KArgs a, int l, LAS unsigned char* lds, int lane, int wave, int G, int c) {
    unsigned char* ws = a->ws;
    const bf16_t* P = (const bf16_t*)(ws + WS_P); bf16_t* Q = (bf16_t*)(ws + WS_QKV);
    const float* cos32 = (const float*)(ws + WS_ROPE) + 2 * 2048 * 32; const float* sin32 = cos32 + 2048 * 16;
    const bf16_t* Wuq = (const bf16_t*)(ws + WS_WSM) + (size_t)l * 384 * 256; const bf16_t* Wukv = (const bf16_t*)(ws + WS_WSM) + 2 * 384 * 256 + (size_t)l * 512 * 128;
    const float qscale = 0.10206207261596577f * LOG2E;
    const unsigned ldsb = (unsigned)(uintptr_t)lds;
    constexpr int LQ = 0, LKV = 49152;
    constexpr int NU = (TT / 128) * 4;
    const int tk = lane & 15, kq = lane >> 4;
    int hcur = -1;
    bf16x8 zqN[8], zkvN[4]; u32x2 kr1N, kr2N; f32x4 crN, srN;
#define PP_LOAD(u_) do { const int row_ = ((u_) >> 2) * 128 + wave * 16 + tk; const bf16_t* prow_ = P + (size_t)row_ * NINP + P_MLA; \
        _Pragma("unroll") for (int s2 = 0; s2 < 8; ++s2) zqN[s2] = *(const GAS bf16x8*)(prow_ + 32 * s2 + 8 * kq); \
        _Pragma("unroll") for (int s2 = 0; s2 < 4; ++s2) zkvN[s2] = *(const GAS bf16x8*)(prow_ + 256 + 32 * s2 + 8 * kq); \
        kr1N = *(const GAS u32x2*)(prow_ + 384 + 4 * kq); kr2N = *(const GAS u32x2*)(prow_ + 400 + 4 * kq); \
        crN = (f32x4){1.f, 1.f, 1.f, 1.f}; srN = (f32x4){0.f, 0.f, 0.f, 0.f}; \
        if (row_ < TL) { const int pos_ = row_ & 2047; crN = *(const GAS f32x4*)(cos32 + pos_ * 16 + 4 * kq); srN = *(const GAS f32x4*)(sin32 + pos_ * 16 + 4 * kq); } } while (0)
    if (c < NU) PP_LOAD(c);
    for (int u = c; u < NU; u += G) {
        const int h = u & 3, rb = u >> 2;
        if (h != hcur) {
            asm volatile("s_waitcnt lgkmcnt(0)\n\ts_barrier" ::: "memory");
            for (int p = wave; p < 80; p += NWAVES) {
                if (p < 48) { const int row = 2 * p + (lane >> 5), ch = (lane & 31) ^ (row & 15);
                    glds16(Wuq + (size_t)(96 * h + row) * 256 + 8 * ch, (unsigned)__builtin_amdgcn_readfirstlane((int)(ldsb + LQ + p * 1024))); }
                else { const int p2 = p - 48, row = 4 * p2 + (lane >> 4), ch = (lane & 15) ^ (row & 15);
                    glds16(Wukv + (size_t)(128 * h + row) * 128 + 8 * ch, (unsigned)__builtin_amdgcn_readfirstlane((int)(ldsb + LKV + p2 * 1024))); }
            }
            asm volatile("s_waitcnt vmcnt(0)\n\ts_barrier" ::: "memory");
            hcur = h;
        }
        const int row = rb * 128 + wave * 16 + tk;
        bf16_t* qrow = Q + (size_t)row * QP;
        bf16x8 zq[8], zkv[4];
#pragma unroll
        for (int s2 = 0; s2 < 8; ++s2) zq[s2] = zqN[s2];
#pragma unroll
        for (int s2 = 0; s2 < 4; ++s2) zkv[s2] = zkvN[s2];
        const u32x2 kr1 = kr1N, kr2 = kr2N; const f32x4 cr = crN, sr = srN;
        if (u + G < NU) PP_LOAD(u + G);
        float sq = 0.f, skv = 0.f;
#pragma unroll
        for (int s2 = 0; s2 < 8; ++s2)
#pragma unroll
            for (int j = 0; j < 8; ++j) { const float f = bf2f((unsigned short)zq[s2][j]); sq += f * f; }
#pragma unroll
        for (int s2 = 0; s2 < 4; ++s2)
#pragma unroll
            for (int j = 0; j < 8; ++j) { const float f = bf2f((unsigned short)zkv[s2][j]); skv += f * f; }
        sq = xadd<16>(sq); sq = xadd<32>(sq); skv = xadd<16>(skv); skv = xadd<32>(skv);
        const float rq = (1.0f / sqrtf(sq * (1.f / 256.f) + EPS)) * qscale, rkv = 1.0f / sqrtf(skv * (1.f / 128.f) + EPS);
        f32x4 acc[6];
#pragma unroll
        for (int p = 0; p < 6; p += 2) {
            bf16x8 w0[8], w1[8];
#pragma unroll
            for (int s2 = 0; s2 < 8; ++s2) { w0[s2] = *(const LAS bf16x8*)(lds + LQ + (16 * p + tk) * 512 + (((4 * s2 + kq) ^ tk) * 16)); w1[s2] = *(const LAS bf16x8*)(lds + LQ + (16 * (p + 1) + tk) * 512 + (((4 * s2 + kq) ^ tk) * 16)); }
            acc[p] = (f32x4){0.f, 0.f, 0.f, 0.f}; acc[p + 1] = (f32x4){0.f, 0.f, 0.f, 0.f};
#pragma unroll
            for (int s2 = 0; s2 < 8; ++s2) { acc[p] = __builtin_amdgcn_mfma_f32_16x16x32_bf16(w0[s2], zq[s2], acc[p], 0, 0, 0); acc[p + 1] = __builtin_amdgcn_mfma_f32_16x16x32_bf16(w1[s2], zq[s2], acc[p + 1], 0, 0, 0); }
        }
#pragma unroll
        for (int p = 0; p < 4; ++p) { const f32x4 v = acc[p] * rq; u32x2 o; o.x = pk2(v[0], v[1]); o.y = pk2(v[2], v[3]); *(GAS u32x2*)(qrow + Q_MLAQ + h * 96 + 16 * p + 4 * kq) = o; }
        { const f32x4 x1 = acc[4] * rq, x2 = acc[5] * rq; const f32x4 o1 = x1 * cr - x2 * sr, o2 = x2 * cr + x1 * sr;
          u32x2 w1; w1.x = pk2(o1[0], o1[1]); w1.y = pk2(o1[2], o1[3]); u32x2 w2; w2.x = pk2(o2[0], o2[1]); w2.y = pk2(o2[2], o2[3]);
          *(GAS u32x2*)(qrow + Q_MLAQ + h * 96 + 64 + 4 * kq) = w1; *(GAS u32x2*)(qrow + Q_MLAQ + h * 96 + 80 + 4 * kq) = w2; }
#pragma unroll
        for (int p = 0; p < 8; p += 2) {
            bf16x8 w0[4], w1[4];
#pragma unroll
            for (int s2 = 0; s2 < 4; ++s2) { w0[s2] = *(const LAS bf16x8*)(lds + LKV + (16 * p + tk) * 256 + (((4 * s2 + kq) ^ tk) * 16)); w1[s2] = *(const LAS bf16x8*)(lds + LKV + (16 * (p + 1) + tk) * 256 + (((4 * s2 + kq) ^ tk) * 16)); }
            f32x4 a0 = {0.f, 0.f, 0.f, 0.f}, a1 = a0;
#pragma unroll
            for (int s2 = 0; s2 < 4; ++s2) { a0 = __builtin_amdgcn_mfma_f32_16x16x32_bf16(w0[s2], zkv[s2], a0, 0, 0, 0); a1 = __builtin_amdgcn_mfma_f32_16x16x32_bf16(w1[s2], zkv[s2], a1, 0, 0, 0); }
#pragma unroll
            for (int e = 0; e < 2; ++e) { const int pp = p + e; const f32x4 v = (e ? a1 : a0) * rkv; u32x2 o; o.x = pk2(v[0], v[1]); o.y = pk2(v[2], v[3]);
                const int col = pp < 4 ? Q_MLAK + h * 96 + 16 * pp + 4 * kq : Q_MLAV + h * 64 + 16 * (pp - 4) + 4 * kq;
                *(GAS u32x2*)(qrow + col) = o; }
        }
        if (h == 0) {
            const f32x4 x1 = {bflo(kr1.x), bfhi(kr1.x), bflo(kr1.y), bfhi(kr1.y)}, x2 = {bflo(kr2.x), bfhi(kr2.x), bflo(kr2.y), bfhi(kr2.y)};
            const f32x4 o1 = x1 * cr - x2 * sr, o2 = x2 * cr + x1 * sr;
            u32x2 w1; w1.x = pk2(o1[0], o1[1]); w1.y = pk2(o1[2], o1[3]); u32x2 w2; w2.x = pk2(o2[0], o2[1]); w2.y = pk2(o2[2], o2[3]);
#pragma unroll
            for (int hh = 0; hh < 4; ++hh) { *(GAS u32x2*)(qrow + Q_MLAK + hh * 96 + 64 + 4 * kq) = w1; *(GAS u32x2*)(qrow + Q_MLAK + hh * 96 + 80 + 4 * kq) = w2; }
        }
    }
#undef PP_LOAD
    asm volatile("s_waitcnt lgkmcnt(0)\n\ts_barrier" ::: "memory");
}

__device__ __forceinline__ void phase_router(KArgs a, int l, int nrows, LAS unsigned char* lds, int tid, int lane, int wave, int G, int c) {
    unsigned char* ws = a->ws;
    const bf16_t* X = (const bf16_t*)(ws + WS_X); unsigned char* H = (unsigned char*)(ws + WS_H);
    const float* ada = (const float*)(ws + WS_ADA); const float* wrp = (const float*)(ws + WS_WRP);
    const float* gn = a->in[I_N2G] + l * 1024; const float* brt = a->in[I_BR];
    unsigned* ctl = (unsigned*)(ws + WS_CTL);
    int* tokinv = (int*)(ws + WS_TOKINV); int* toke = (int*)(ws + WS_TOKE); float* tokw = (float*)(ws + WS_TOKW);
    const int tk = lane & 15, q = lane >> 4;
    f32x4 wr0[8], wr1[8];
    { const float* p0 = wrp + (((0 * 8 + wave) * 4 + q) * 16 + tk) * 32; const float* p1 = wrp + (((1 * 8 + wave) * 4 + q) * 16 + tk) * 32;
#pragma unroll
      for (int s = 0; s < 8; ++s) { wr0[s] = *(const GAS f32x4*)(p0 + 4 * s); wr1[s] = *(const GAS f32x4*)(p1 + 4 * s); } }
    LAS float* hb = (LAS float*)lds;
    LAS float* part = (LAS float*)(lds + 16 * 4112);
    LAS float* lgs = part + 8 * 16 * 32;
    for (int g = c; g < nrows / 16; g += G) {
        f32x4 v[2][4];
#pragma unroll
        for (int rr = 0; rr < 2; ++rr) { const bf16_t* xr = X + (size_t)(g * 16 + 2 * wave + rr) * 1024;
#pragma unroll
            for (int j = 0; j < 4; ++j) v[rr][j] = xres_ld(xr + 4 * lane + 256 * j); }
#pragma unroll
        for (int rr = 0; rr < 2; ++rr) {
            const int row = g * 16 + 2 * wave + rr, b = row < TL ? (row >> 11) : 8;
            float ss = 0.f;
#pragma unroll
            for (int j = 0; j < 4; ++j) ss += (v[rr][j].x * v[rr][j].x + v[rr][j].y * v[rr][j].y) + (v[rr][j].z * v[rr][j].z + v[rr][j].w * v[rr][j].w);
            const float rstd = 1.0f / sqrtf(wave_sum(ss) * (1.f / 1024.f) + EPS);
            const float* sh = ada + ((size_t)l * 9 + b) * 6144 + 3072; const float* sc = sh + 1024;
#pragma unroll
            for (int j = 0; j < 4; ++j) { const int cc = 4 * lane + 256 * j; const f32x4 gg = *(const GAS f32x4*)(gn + cc), s1 = *(const GAS f32x4*)(sc + cc), s0 = *(const GAS f32x4*)(sh + cc);
                const f32x4 h = v[rr][j] * rstd * gg * (s1 + 1.0f) + s0;
                *(GAS unsigned*)(H + (size_t)row * 1024 + cc) = pk4_fp8(h.x, h.y, h.z, h.w);
                *(LAS f32x4*)(hb + (2 * wave + rr) * 1028 + cc) = h; }
        }
        __syncthreads();
        f32x4 acc0 = {0.f, 0.f, 0.f, 0.f}, acc1 = {0.f, 0.f, 0.f, 0.f};
#pragma unroll
        for (int s = 0; s < 8; ++s) { const f32x4 a4 = *(const LAS f32x4*)(hb + tk * 1028 + 128 * wave + 32 * q + 4 * s);
#pragma unroll
            for (int j = 0; j < 4; ++j) { acc0 = __builtin_amdgcn_mfma_f32_16x16x4f32(a4[j], wr0[s][j], acc0, 0, 0, 0); acc1 = __builtin_amdgcn_mfma_f32_16x16x4f32(a4[j], wr1[s][j], acc1, 0, 0, 0); } }
#pragma unroll
        for (int r = 0; r < 4; ++r) { part[(wave * 16 + 4 * q + r) * 32 + tk] = acc0[r]; part[(wave * 16 + 4 * q + r) * 32 + 16 + tk] = acc1[r]; }
        __syncthreads();
        LAS float* selv = lgs + 512;
        { float sum = 0.f;
#pragma unroll
          for (int w = 0; w < 8; ++w) sum += part[w * 512 + tid];
          const float sg = 1.0f / (1.0f + __expf(-sum)); lgs[tid] = sg; selv[tid] = sg + brt[tid & 31]; }
        __syncthreads();
        if (wave == 0 && lane < 16) {
            const LAS float* my = selv + lane * 32; const LAS float* mys = lgs + lane * 32;
            float gs[4];
#pragma unroll
            for (int g4 = 0; g4 < 4; ++g4) { float m1 = -1e30f, m2 = -1e30f;
#pragma unroll
                for (int j = 0; j < 8; ++j) { const float vv = my[g4 * 8 + j];
                    if (vv > m1) { m2 = m1; m1 = vv; } else if (vv > m2) m2 = vv; }
                gs[g4] = m1 + m2; }
            int gsel = 0; float gb = gs[0];
#pragma unroll
            for (int g4 = 1; g4 < 4; ++g4) if (gs[g4] > gb) { gb = gs[g4]; gsel = g4; }
            float v1 = -1e30f, v2 = -1e30f, s1v = 0.f, s2v = 0.f; int e1 = 0, e2 = 0;
#pragma unroll
            for (int j = 0; j < 8; ++j) { const int e = gsel * 8 + j; const float sg = mys[e]; const float vv = my[e];
                if (vv > v1) { v2 = v1; e2 = e1; s2v = s1v; v1 = vv; e1 = e; s1v = sg; } else if (vv > v2) { v2 = vv; e2 = e; s2v = sg; } }
            const float inv = 1.0f / (s1v + s2v);
            const int myrow = g * 16 + lane;
            const int p1 = (int)__hip_atomic_fetch_add(ctl + CW_CNT + l * 32 + e1, 1u, __ATOMIC_RELAXED, __HIP_MEMORY_SCOPE_AGENT);
            const int p2 = (int)__hip_atomic_fetch_add(ctl + CW_CNT + l * 32 + e2, 1u, __ATOMIC_RELAXED, __HIP_MEMORY_SCOPE_AGENT);
            tokinv[(size_t)e1 * TT + p1] = myrow; tokinv[(size_t)e2 * TT + p2] = myrow;
            toke[myrow * 2] = (e1 << 20) | p1; toke[myrow * 2 + 1] = (e2 << 20) | p2;
            tokw[myrow * 2] = s1v * inv; tokw[myrow * 2 + 1] = s2v * inv;
        }
    }
    __syncthreads();
}

__device__ __forceinline__ float max3f(float a, float b, float c) { float r; asm("v_max3_f32 %0, %1, %2, %3" : "=v"(r) : "v"(a), "v"(b), "v"(c)); return r; }
__device__ __forceinline__ int crow(int r, int hi) { return (r & 3) + 8 * (r >> 2) + 4 * hi; }
__device__ __forceinline__ s16x4 tr_read(const LAS unsigned char* p) { typedef short v4s __attribute__((ext_vector_type(4))); return __builtin_bit_cast(s16x4, __builtin_amdgcn_ds_read_tr16_b64_v4i16((LAS v4s*)p)); }
constexpr int AT_FAC = 124928, AT_SCRW = 8448;
__device__ __forceinline__ void at_wait_bar(int n) {
    switch (n) {
        case 0: asm volatile("s_waitcnt vmcnt(0)\n\ts_barrier" ::: "memory"); break;
        case 2: asm volatile("s_waitcnt vmcnt(2)\n\ts_barrier" ::: "memory"); break;
        case 3: asm volatile("s_waitcnt vmcnt(3)\n\ts_barrier" ::: "memory"); break;
        case 4: asm volatile("s_waitcnt vmcnt(4)\n\ts_barrier" ::: "memory"); break;
        case 6: asm volatile("s_waitcnt vmcnt(6)\n\ts_barrier" ::: "memory"); break;
        case 8: asm volatile("s_waitcnt vmcnt(8)\n\ts_barrier" ::: "memory"); break;
        case 9: asm volatile("s_waitcnt vmcnt(9)\n\ts_barrier" ::: "memory"); break;
        default: asm volatile("s_waitcnt vmcnt(0)\n\ts_barrier" ::: "memory"); break;
    }
}
template <int kind>
__device__ __forceinline__ void attn_unit(const bf16_t* Q, bf16_t* Y, const int b, const int hq, const int qb, const bool ctxq, const float sinkl2, const float lf2, const float lb2,
                                          LAS unsigned char* lds, const int tid, const int lane, const int wave, const int tilecap) {
    constexpr int DQK = kind == 0 ? 96 : 64;
    constexpr int KS = DQK == 64 ? 128 : 256, NS = DQK / 16, SLOTK = 64 * KS, SLOT = SLOTK + 8192, NL = DQK == 64 ? 2 : 3, NSLOT = DQK == 64 ? 6 : 5;
    constexpr float THR = 8.0f;
    constexpr int KW = 2, KP = NS / KW;
    static_assert(NSLOT * SLOT <= AT_FAC && 8 * AT_SCRW <= AT_FAC && AT_FAC + 1024 <= LDS_MISC, "attention LDS map");
    int qcol, kcol, vcol, ycol, gcol = 0;
    if (kind == 0) { qcol = Q_MLAQ + hq * 96; kcol = Q_MLAK + hq * 96; vcol = Q_MLAV + hq * 64; ycol = 256 + hq * 64; }
    else if (kind == 1) { qcol = Q_GQAQ + hq * 64; kcol = Q_GQAK + (hq >> 1) * 64; vcol = Q_GQAV + (hq >> 1) * 64; ycol = 512 + hq * 64; }
    else if (kind == 2) { qcol = Q_RETQ + hq * 64; kcol = Q_RETK + hq * 64; vcol = Q_RETV + hq * 64; ycol = hq * 64; gcol = Q_RETG + hq * 64; }
    else { qcol = Q_WINQ + hq * 64; kcol = Q_WINK + (hq >> 1) * 64; vcol = Q_WINV + (hq >> 1) * 64; ycol = 768 + hq * 64; }
    const int r32 = lane & 31, hi = lane >> 5;
    const int qrow0 = (ctxq ? TL + b * 256 : b * 2048 + qb * 256) + 32 * wave;
    const int qpos = (ctxq ? 0 : qb * 256) + 32 * wave + r32;
    int lt0 = 0, nlat = 32;
    if (ctxq) nlat = 0;
    else if (kind == 3) { lt0 = 4 * qb - 2 < 0 ? 0 : 4 * qb - 2; const int lt1 = 4 * qb + 6 > 32 ? 32 : 4 * qb + 6; nlat = lt1 - lt0; }
    const int ntile = (4 + nlat) < tilecap ? (4 + nlat) : tilecap;
    bf16x8 qf[NS];
#pragma unroll
    for (int s = 0; s < NS; ++s) qf[s] = *(const GAS bf16x8*)(Q + (size_t)(qrow0 + r32) * QP + qcol + 16 * s + 8 * hi);
    f32x4 cfa = {}, cfq = {}, cba = {}, cbq = {}; float g32f = 0.f, g32b = 0.f;
    if constexpr (kind == 2) {
#pragma unroll
        for (int i = 0; i < 4; ++i) { cfa[i] = __builtin_bit_cast(float, __builtin_amdgcn_readfirstlane(__builtin_bit_cast(int, fast_exp2(lf2 * (float)(3 - i))))); cfq[i] = fast_exp2(lf2 * (float)(28 - 4 * hi - 8 * i));
            cba[i] = __builtin_bit_cast(float, __builtin_amdgcn_readfirstlane(__builtin_bit_cast(int, fast_exp2(lb2 * (float)i)))); cbq[i] = fast_exp2(lb2 * (float)(8 * i + 4 * hi)); }
        g32f = fast_exp2(32.f * lf2); g32b = fast_exp2(32.f * lb2);
    }
    int ksrc[DQK == 64 ? 1 : 2], vsrc;
    if constexpr (DQK == 64) { const int row = 8 * wave + (lane >> 3), ch = (lane & 7) ^ ((row >> 1) & 7); ksrc[0] = row * QP + kcol + 8 * ch; }
    else {
#pragma unroll
        for (int n = 0; n < 2; ++n) { const int row = 4 * (2 * wave + n) + (lane >> 4); int ch = (lane & 15) ^ (row & 15); if (ch >= 12) ch = 0; ksrc[n] = row * QP + kcol + 8 * ch; }
    }
    { const int row = 8 * wave + (lane >> 3); vsrc = row * QP + vcol + 8 * ((lane & 7) ^ (((row >> 1) & 1) << 2)); }
#define AT_TILE_ROW0(t) ((t) < 4 ? TL + b * 256 + 64 * (t) : b * 2048 + 64 * (lt0 + (t) - 4))
#define AT_ISSUE(t) do { const bf16_t* tb_ = Q + (size_t)AT_TILE_ROW0(t) * QP; const unsigned sl_ = (unsigned)__builtin_amdgcn_readfirstlane((int)(ldsb + ((t) % NSLOT) * SLOT + wave * 1024 * (DQK == 64 ? 1 : 2))); \
        if constexpr (DQK == 64) { glds16(tb_ + ksrc[0], sl_); glds16(tb_ + vsrc, sl_ + SLOTK); } \
        else { glds16(tb_ + ksrc[0], sl_); glds16(tb_ + ksrc[DQK == 64 ? 0 : 1], sl_ + 1024); glds16(tb_ + vsrc, (unsigned)__builtin_amdgcn_readfirstlane((int)(ldsb + ((t) % NSLOT) * SLOT + SLOTK + wave * 1024))); } } while (0)
    const unsigned ldsb = (unsigned)(uintptr_t)lds;
    const int kkey = DQK == 64 ? ((r32 >> 1) & 7) : (r32 & 15);
    const unsigned krd = r32 * KS + 16 * (hi ^ (kkey & 1)) + 32 * (kkey >> 1);
#define AT_KLOAD(KF, t, S0, S1) do { unsigned ka_ = (unsigned)(uintptr_t)(lds + ((t) % NSLOT) * SLOT) + krd; asm volatile("" : "+v"(ka_)); \
        _Pragma("unroll") for (int s = (S0); s < (S1); ++s) { const LAS unsigned char* kp_ = (const LAS unsigned char*)(uintptr_t)(ka_ ^ (unsigned)(32 * s)); \
            KF[2 * (s - (S0))] = *(const LAS bf16x8*)(kp_); KF[2 * (s - (S0)) + 1] = *(const LAS bf16x8*)(kp_ + 32 * KS); } } while (0)
#define AT_QKMR(P0, P1, KF, PART) do { _Pragma("unroll") for (int s = (PART) * KW; s < ((PART) + 1) * KW; ++s) { \
        if ((PART) == 0 && s == 0) { const f32x16 z_ = {}; P0 = __builtin_amdgcn_mfma_f32_32x32x16_bf16(KF[0], qf[0], z_, 0, 0, 0); P1 = __builtin_amdgcn_mfma_f32_32x32x16_bf16(KF[1], qf[0], z_, 0, 0, 0); } \
        else { P0 = __builtin_amdgcn_mfma_f32_32x32x16_bf16(KF[2 * (s - (PART) * KW)], qf[s], P0, 0, 0, 0); P1 = __builtin_amdgcn_mfma_f32_32x32x16_bf16(KF[2 * (s - (PART) * KW) + 1], qf[s], P1, 0, 0, 0); } } } while (0)
#define AT_KPART(KF, t, PART) AT_KLOAD(KF, t, (PART) * KW, ((PART) + 1) * KW)
#define AT_QK(P0, P1, t) do { bf16x8 kf_[2 * KW]; _Pragma("unroll") for (int p_ = 0; p_ < KP; ++p_) { AT_KPART(kf_, t, p_); AT_QKMR(P0, P1, kf_, p_); } } while (0)
    const int qw0_ = qb * 256 + 32 * wave;
#define AT_SKIP(t) ((kind == 3 && (t) >= 4) && ((64 * (lt0 + (t) - 4) + 63 < qw0_ - 128) || (64 * (lt0 + (t) - 4) > qw0_ + 31 + 128)))
#pragma unroll
    for (int t = 0; t < NSLOT - 1; ++t) if (t < ntile) AT_ISSUE(t);
    { const int infl = (ntile - 1 < NSLOT - 2 ? ntile - 1 : NSLOT - 2); at_wait_bar(infl * NL); }
    float mref = 0.f, lsum = 0.f;
    bool shifted = false;
    f32x16 o0 = {}, o1 = {}, pa0, pa1, pb0 = {}, pb1 = {};
    AT_QK(pa0, pa1, 0);
    LAS float* stage = (LAS float*)(lds + wave * AT_SCRW); LAS float* fac = (LAS float*)(lds + AT_FAC) + wave * 32;
    const int i16 = lane & 15, q4 = i16 >> 2, p4 = i16 & 3, g1 = (lane >> 4) & 1;
    const unsigned vrd = SLOTK + (4 * hi + q4) * 128 + (16 * g1 + 4 * p4) * 2 + 64 * ((q4 >> 1) & 1);
#define CR(r) (((r) & 3) + 8 * ((r) >> 2))
#define AT_VLOAD(VF, t, u) do { unsigned vb_ = (unsigned)(uintptr_t)(lds + ((t) % NSLOT) * SLOT) + vrd + (32 * (u)) * 128; asm volatile("" : "+v"(vb_)); const LAS unsigned char* vb = (const LAS unsigned char*)(uintptr_t)vb_; \
        unsigned vx_ = vb_ ^ 64u; asm volatile("" : "+v"(vx_)); const LAS unsigned char* vbx = (const LAS unsigned char*)(uintptr_t)vx_; \
        _Pragma("unroll") for (int s2 = 0; s2 < 2; ++s2) _Pragma("unroll") for (int d0 = 0; d0 < 2; ++d0) { const LAS unsigned char* vp = (d0 ? vbx : vb) + (16 * s2) * 128; \
            const s16x4 lo = tr_read(vp), h2 = tr_read(vp + 8 * 128); VF[2 * s2 + d0] = (bf16x8){lo[0], lo[1], lo[2], lo[3], h2[0], h2[1], h2[2], h2[3]}; } } while (0)
#define AT_PVM(PU, VF) do { _Pragma("unroll") for (int s = 0; s < 2; ++s) { \
        u32x4 pw; pw.x = pk2(PU[8 * s], PU[8 * s + 1]); pw.y = pk2(PU[8 * s + 2], PU[8 * s + 3]); pw.z = pk2(PU[8 * s + 4], PU[8 * s + 5]); pw.w = pk2(PU[8 * s + 6], PU[8 * s + 7]); \
        const bf16x8 pa = __builtin_bit_cast(bf16x8, pw); \
        o0 = __builtin_amdgcn_mfma_f32_32x32x16_bf16(pa, VF[2 * s], o0, 0, 0, 0); o1 = __builtin_amdgcn_mfma_f32_32x32x16_bf16(pa, VF[2 * s + 1], o1, 0, 0, 0); } } while (0)
#define SB0() __builtin_amdgcn_sched_barrier(0)
#define AT_STEP(PC0, PC1, PN0, PN1, t) do { \
        const bool more = (t) + 1 < ntile; \
        if (more) { const int last_infl = ((t) + NSLOT - 2 < ntile - 1) ? ((t) + NSLOT - 2) : (ntile - 1); \
            at_wait_bar((last_infl - ((t) + 1)) * NL); \
            if ((t) + NSLOT - 1 < ntile) AT_ISSUE((t) + NSLOT - 1); } \
        const bool isctx = (t) < 4; const int kpos0 = isctx ? 64 * (t) : 64 * (lt0 + (t) - 4); \
        int dbase = kpos0 + 4 * hi - qpos; asm volatile("" : "+v"(dbase)); \
        const bool skip = AT_SKIP(t), skipn = more ? AT_SKIP((t) + 1) : true; \
        bf16x8 kf[2 * KW]; bf16x8 vf[4]; \
        if (!skipn) { AT_KPART(kf, (t) + 1, 0); SB0(); } \
        if (kind == 2) { \
            if (!skipn) { AT_QKMR(PN0, PN1, kf, 0); SB0(); AT_KPART(kf, (t) + 1, 1); } \
            AT_VLOAD(vf, t, 0); SB0(); \
              \
            const int qw0r = (ctxq ? 0 : qb * 256) + 32 * wave; \
            const int tcls = (isctx && !ctxq) ? 3 : ((kpos0 + 63 <= qw0r) ? 0 : ((kpos0 >= qw0r + 32) ? 1 : 2)); \
            float mf0 = 0.f, mf1 = 0.f, mb0 = 0.f, mb1 = 0.f; \
            if (tcls == 0) { mf1 = fast_exp2(lf2 * (float)(qpos - kpos0 - 63)); mf0 = mf1 * g32f; } \
            else if (tcls == 1) { mb0 = fast_exp2(lb2 * (float)(kpos0 - qpos)); mb1 = mb0 * g32b; } \
            else if (tcls == 3) { mf1 = fast_exp2(lf2 * (float)(256 + qpos - kpos0 - 63)); mf0 = mf1 * g32f; mb0 = fast_exp2(lb2 * (float)(2048 - qpos + kpos0)); mb1 = mb0 * g32b; } \
            if (tcls == 2) {        \
                _Pragma("unroll") for (int r = 0; r < 16; ++r) { const int d0 = -(dbase + CR(r)); PC0[r] *= fast_exp2((d0 >= 0 ? lf2 : -lb2) * (float)d0); } \
            } else { \
                const f32x4 fq_ = cfq * mf0, bq_ = cbq * mb0; \
                _Pragma("unroll") for (int r = 0; r < 16; ++r) PC0[r] *= cfa[r & 3] * fq_[r >> 2] + cba[r & 3] * bq_[r >> 2]; \
            } \
            SB0(); if (!skipn) { AT_QKMR(PN0, PN1, kf, 1); if (KP == 3) { SB0(); AT_KPART(kf, (t) + 1, 2); } } AT_PVM(PC0, vf); SB0(); AT_VLOAD(vf, t, 1); SB0(); \
            if (tcls == 2) { \
                _Pragma("unroll") for (int r = 0; r < 16; ++r) { const int d1 = -(dbase + CR(r)) - 32; PC1[r] *= fast_exp2((d1 >= 0 ? lf2 : -lb2) * (float)d1); } \
            } else { \
                const f32x4 fq_ = cfq * mf1, bq_ = cbq * mb1; \
                _Pragma("unroll") for (int r = 0; r < 16; ++r) PC1[r] *= cfa[r & 3] * fq_[r >> 2] + cba[r & 3] * bq_[r >> 2]; \
            } \
            SB0(); if (KP == 3 && !skipn) { AT_QKMR(PN0, PN1, kf, 2); } AT_PVM(PC1, vf); \
        } else if (!skip) { \
            if (kind == 3 && !isctx) { \
                _Pragma("unroll") for (int r = 0; r < 16; ++r) { const int d0 = dbase + CR(r), d1 = d0 + 32; \
                    if (d0 > 128 || d0 < -128) PC0[r] = -INFINITY; if (d1 > 128 || d1 < -128) PC1[r] = -INFINITY; } \
            } \
            float tm = max3f(PC0[0], PC1[0], PC0[1]), tm2 = max3f(PC1[1], PC0[2], PC1[2]); \
            _Pragma("unroll") for (int r = 3; r < 15; r += 2) { tm = max3f(tm, PC0[r], PC1[r]); tm2 = max3f(tm2, PC0[r + 1], PC1[r + 1]); } \
            tm = max3f(tm, PC0[15], PC1[15]); tm = max3f(tm, tm2, tm2); \
            tm = xmax32(tm) - mref; \
            if (__any(tm > THR)) { \
                const float dl = (tm > THR) ? tm : 0.f; \
                mref += dl; shifted = true; \
                const float f = fast_exp2(-dl); lsum *= f; \
                if (hi == 0) fac[r32] = f; \
                LDS_WAIT(); asm volatile("" ::: "memory"); \
                _Pragma("unroll") for (int r = 0; r < 16; ++r) { const float fr_ = fac[crow(r, hi)]; o0[r] *= fr_; o1[r] *= fr_; } \
            } \
            if (shifted) { _Pragma("unroll") for (int r = 0; r < 16; ++r) { PC0[r] -= mref; PC1[r] -= mref; } } \
            SB0(); \
            if (!skipn) { AT_QKMR(PN0, PN1, kf, 0); SB0(); AT_KPART(kf, (t) + 1, 1); } \
            AT_VLOAD(vf, t, 0); SB0(); \
            float ps = 0.f; \
            _Pragma("unroll") for (int r = 0; r < 16; ++r) { PC0[r] = fast_exp2(PC0[r]); ps += PC0[r]; } \
            SB0(); if (!skipn) { AT_QKMR(PN0, PN1, kf, 1); if (KP == 3) { SB0(); AT_KPART(kf, (t) + 1, 2); } } AT_PVM(PC0, vf); SB0(); AT_VLOAD(vf, t, 1); SB0(); \
            _Pragma("unroll") for (int r = 0; r < 16; ++r) { PC1[r] = fast_exp2(PC1[r]); ps += PC1[r]; } \
            lsum += ps; \
            SB0(); if (KP == 3 && !skipn) { AT_QKMR(PN0, PN1, kf, 2); } AT_PVM(PC1, vf); \
        } else if (!skipn) { AT_QKMR(PN0, PN1, kf, 0); _Pragma("unroll") for (int p_ = 1; p_ < KP; ++p_) { AT_KPART(kf, (t) + 1, p_); AT_QKMR(PN0, PN1, kf, p_); } } \
        } while (0)
    for (int t = 0; t < ntile; t += 2) {
        AT_STEP(pa0, pa1, pb0, pb1, t);
        if (t + 1 < ntile) AT_STEP(pb0, pb1, pa0, pa1, t + 1);
    }
#undef AT_STEP
#undef AT_PVM
#undef AT_VLOAD
#undef AT_KLOAD
#undef AT_QKMR
#undef AT_KPART
#undef SB0
#undef AT_ISSUE
#undef AT_TILE_ROW0
#undef AT_QK
#undef AT_SKIP
#undef CR
    asm volatile("s_waitcnt lgkmcnt(0)\n\ts_barrier" ::: "memory");
#pragma unroll
    for (int r = 0; r < 16; ++r) { stage[crow(r, hi) * 65 + r32] = o0[r]; stage[crow(r, hi) * 65 + 32 + r32] = o1[r]; }
    LDS_WAIT(); asm volatile("" ::: "memory");
    float x[32];
#pragma unroll
    for (int j = 0; j < 32; ++j) x[j] = stage[r32 * 65 + 32 * hi + j];
    int orow_i = qrow0 + r32; asm volatile("" : "+v"(orow_i));
    const size_t orow = (size_t)orow_i;
    if (kind == 2) {
        float s = 0.f;
#pragma unroll
        for (int j = 0; j < 32; ++j) s += x[j];
        s = xadd<32>(s); const float mean = s * (1.f / 64.f); float v = 0.f;
#pragma unroll
        for (int j = 0; j < 32; ++j) { x[j] -= mean; v += x[j] * x[j]; }
        v = xadd<32>(v); const float rstd = 1.0f / sqrtf(v * (1.f / 64.f) + EPS);
        const bf16_t* gp = Q + orow * QP + gcol + 32 * hi;
#pragma unroll
        for (int c = 0; c < 4; ++c) { const u32x4 gw = *(const GAS u32x4*)(gp + 8 * c);
#pragma unroll
            for (int j = 0; j < 4; ++j) { const float ga = bflo(gw[j]), gb = bfhi(gw[j]); x[8 * c + 2 * j] *= rstd * ga * sigmoidf_(ga); x[8 * c + 2 * j + 1] *= rstd * gb * sigmoidf_(gb); } }
    } else {
        float lt = xadd<32>(lsum);
        if (kind == 3) lt += fast_exp2(sinkl2 - mref);
        const float inv = 1.0f / fmaxf(lt, 1e-30f);
#pragma unroll
        for (int j = 0; j < 32; ++j) x[j] *= inv;
    }
    bf16_t* yp = Y + orow * 1024 + ycol + 32 * hi;
#pragma unroll
    for (int c = 0; c < 4; ++c) { u32x4 w; w.x = pk2(x[8 * c], x[8 * c + 1]); w.y = pk2(x[8 * c + 2], x[8 * c + 3]); w.z = pk2(x[8 * c + 4], x[8 * c + 5]); w.w = pk2(x[8 * c + 6], x[8 * c + 7]); *(GAS u32x4*)(yp + 8 * c) = w; }
    asm volatile("s_waitcnt lgkmcnt(0)\n\ts_barrier" ::: "memory");
}
#ifndef PROBE_KMASK
#define PROBE_KMASK 0x1f
#endif
#ifndef PROBE_TILECAP
#define PROBE_TILECAP 1000
#endif
__device__ __forceinline__ void phase_mix(KArgs a, int lq, LAS unsigned char* lds, int tid, int lane, int wave, int G, int c) {
    const int l = lq & 1; const int kmask = (lq >= 2) ? PROBE_KMASK : 0x1f; const int tilecap = (lq >= 2) ? PROBE_TILECAP : 1000;
    unsigned char* ws = a->ws;
    const bf16_t* Q = (const bf16_t*)(ws + WS_QKV); bf16_t* Y = (bf16_t*)(ws + (lq >= 2 ? WS_MRG : WS_Y));
    const int nunits = l == 0 ? 1152 : 1024;
    const int vc = (G == 256) ? ((c & 7) * 32 + (c >> 3)) : c;
    for (int j = 0; ; ++j) {
        const int u = j * G + vc;
        if (u >= nunits) break;
        int kind, b, hq, qb; bool ctxq;
        if (u < 1024) { kind = u >> 8; const int r = u & 255; b = r >> 5; hq = (r >> 3) & 3; qb = r & 7; ctxq = false; }
        else { const int r = u - 1024; kind = r >> 5; b = (r >> 2) & 7; hq = r & 3; qb = 0; ctxq = true; }
        if (!((kmask >> (ctxq ? 4 : kind)) & 1)) continue;
        const float lf2 = -__expf(a->in[I_DECAY][l * 8 + hq]) * LOG2E, lb2 = -__expf(a->in[I_DECAY][l * 8 + 4 + hq]) * LOG2E;
        const float sk = a->in[I_SINK][l * 4 + hq] * LOG2E;
        int tid2 = tid; asm volatile("" : "+v"(tid2));
        const int lane2 = tid2 & 63;
        if (kind == 0) attn_unit<0>(Q, Y, b, hq, qb, ctxq, sk, lf2, lb2, lds, tid2, lane2, wave, tilecap);
        else if (kind == 1) attn_unit<1>(Q, Y, b, hq, qb, ctxq, sk, lf2, lb2, lds, tid2, lane2, wave, tilecap);
        else if (kind == 2) attn_unit<2>(Q, Y, b, hq, qb, ctxq, sk, lf2, lb2, lds, tid2, lane2, wave, tilecap);
        else attn_unit<3>(Q, Y, b, hq, qb, ctxq, sk, lf2, lb2, lds, tid2, lane2, wave, tilecap);
    }
}

#ifndef MK_BAR_XCD
#define MK_BAR_XCD 1
#endif
constexpr int NPHASE = 20;
#ifndef PH_MASK
#define PH_MASK 0x3ff
#endif
#define PH_ON(b) ((PH_MASK >> (b)) & 1)
#ifndef PROBE_REPEAT
#define PROBE_REPEAT 0
#endif
__global__ void __launch_bounds__(NTHREADS, 2) fwd_kernel(Args a_byval) {
    extern __shared__ __attribute__((aligned(16))) unsigned char lds_raw[];
    LAS unsigned char* lds0 = (LAS unsigned char*)lds_raw;
    const int wave0 = __builtin_amdgcn_readfirstlane((int)threadIdx.x >> 6);
    { LAS unsigned char* lds = lds0; const int t0 = wave0 * 64 + lane_id(); for (int u = t0; u < (LDS_BYTES - LDS_MISC) / 4; u += NTHREADS) ((LAS unsigned*)(lds + LDS_MISC))[u] = 0u; }
    __syncthreads();
    const int ph_lo = a_byval.ph_lo, ph_hi = a_byval.ph_hi;
#if MK_ONE_LAUNCH && MK_BAR_XCD
    XcdBarrier bar = xcd_barrier_post((unsigned*)(a_byval.ws + WS_CTL) + CW_BAR, (volatile LAS unsigned*)(lds0 + LDS_MISC), wave0);
#endif
    for (int ph = ph_lo; ph < ph_hi; ++ph) {
#if PROBE_REPEAT
      const int nrep = 1 + ((PROBE_REPEAT >> ph) & 1);
      for (int rep = 0; rep < nrep; ++rep) {
#else
      constexpr int nrep = 1, rep = 0; {
#endif
#define PHASE_IDS \
        KArgs a = (KArgs)__builtin_amdgcn_kernarg_segment_ptr(); asm volatile("" : "+s"(a)); \
        int wave = wave0; asm volatile("" : "+s"(wave)); unsigned z_ = 0u; asm volatile("" : "+v"(z_)); \
        const int lane = (int)__builtin_amdgcn_mbcnt_hi(~0u, __builtin_amdgcn_mbcnt_lo(~0u, z_)); const int tid = wave * 64 + lane; \
        unsigned ldso = 0; asm volatile("" : "+s"(ldso)); LAS unsigned char* lds = lds0 + ldso; \
        int G = gridDim.x, c = blockIdx.x; asm volatile("" : "+s"(G), "+s"(c)); \
        unsigned char* ws = a->ws; unsigned* ctl = (unsigned*)(ws + WS_CTL); const float* ada = (const float*)(ws + WS_ADA); (void)ctl; (void)ada; (void)tid; (void)lane; (void)lds; (void)G; (void)c;
        if (ph == 0) { if (PH_ON(0)) { PHASE_IDS p0_prologue(a, lds, tid, lane, wave, G, c); } }
        else if (ph == NPHASE - 1) { if (PH_ON(1)) { PHASE_IDS moe_tables(ctl, 1, lds, tid); phase_rownorm(a, 2, lds, lane, wave, G, c); } }
        else {
            const int l = (ph - 1) / 9, k = (ph - 1) % 9;
            if (k == 0) { if (PH_ON(1)) { PHASE_IDS if (l == 1) moe_tables(ctl, 0, lds, tid); phase_rownorm(a, l, lds, lane, wave, G, c); } }
            else if (k == 1) { if (PH_ON(2)) { PHASE_IDS
                SchedB S{l, G, c, (const char*)(ws + WS_H), (const char*)(ws + WS_WIN) + (size_t)l * NBG * 1024};
                const float* rope_ = (const float*)(ws + WS_ROPE);
                EpiB E{(bf16_t*)(ws + WS_P), (bf16_t*)(ws + WS_G), (bf16_t*)(ws + WS_QKV), rope_, rope_ + 2048 * 32, a->in[I_GQN] + l * 64, a->in[I_GKN] + l * 64};
                pg8::gemm_phase<EpiB, SchedB, false, true, 0x7a7a7a7a, 0x7f7f7f7f>(lds, tid, 1024, 1024, 1024, S, E); }
            } else if (k == 2) { if (PH_ON(3)) { PHASE_IDS phase_post(a, l, lds, lane, wave, G, c); } }
            else if (k == 3) { if (PH_ON(4)) { PHASE_IDS phase_mix(a, l + 2 * rep, lds, tid, lane, wave, G, c); } }
            else if (k == 4) { if (PH_ON(5)) { PHASE_IDS
                SchedE S{G, c, l == 0 ? 72 : 64, (const char*)(ws + WS_Y), (const char*)(ws + WS_WBR) + (size_t)l * 1048576 * 2};
                EpiE E{(const bf16_t*)(ws + WS_G), (bf16_t*)(ws + WS_MRG)};
                pg8::gemm_phase<EpiE, SchedE, false>(lds, tid, 2048, 2048, 2048, S, E);
                if (l == 0 && G == 256 && c >= 32) cvt_run(a, ws, lds, lane, wave, CV_EXP_ITEMS / 2, CV_EXP_ITEMS / 2 + CV_E0_SHARE, (c - 32) * NWAVES + wave, 224 * NWAVES); }
            } else if (k == 5) { if (PH_ON(6)) { PHASE_IDS
                SchedF S{G, c, l == 0 ? 72 : 64, (const char*)(ws + WS_MRG), (const char*)(ws + WS_WOUT) + (size_t)l * 1048576 * 2};
                EpiF E{a->in[I_X], a->in[I_CTX], (const bf16_t*)(ws + WS_X), (bf16_t*)(ws + WS_X), ada + (size_t)l * 9 * 6144, l};
                pg8::gemm_phase<EpiF, SchedF, false>(lds, tid, 2048, 2048, 2048, S, E);
                if (l == 0) { if (G == 256 && c >= 32) cvt_run(a, ws, lds, lane, wave, CV_EXP_ITEMS / 2 + CV_E0_SHARE, CV_EXP_ITEMS, (c - 32) * NWAVES + wave, 224 * NWAVES);
                              else if (G != 256) { cvt_run(a, ws, lds, lane, wave, CV_EXP_ITEMS / 2, CV_EXP_ITEMS, c * NWAVES + wave, G * NWAVES); } } }
            } else if (k == 6) { if (PH_ON(7)) { PHASE_IDS phase_router(a, l, l == 0 ? TT : TL, lds, tid, lane, wave, G, c); } }
            else if (k == 7) { if (PH_ON(8)) { PHASE_IDS
                moe_tables(ctl, l, lds, tid);
                SchedMoe S{G, c, 8, 1, (const LAS int*)(lds + LDS_MISC + 1024), (const LAS int*)(lds + LDS_MISC + 2304), (const int*)(ws + WS_TOKINV), (const char*)(ws + WS_H), (const char*)(ws + WS_W13) + (size_t)l * 32 * 2 * MiB, 2 * MiB};
                EpiH E{(unsigned char*)(ws + WS_HID)};
                pg8::gemm_phase<EpiH, SchedMoe, true, true, 0x7a7a7a7a, 0x7f7f7f7f>(lds, tid, 1024, 1024, 1024, S, E); }
            } else if (PH_ON(9)) { PHASE_IDS
                moe_tables(ctl, l, lds, tid);
                SchedMoe S{G, c, 4, 0, (const LAS int*)(lds + LDS_MISC + 1024), (const LAS int*)(lds + LDS_MISC + 2304), (const int*)(ws + WS_TOKINV), (const char*)(ws + WS_HID), (const char*)(ws + WS_W2) + (size_t)l * 32 * 1 * MiB, 1 * MiB};
                EpiI E{(bf16_t*)(ws + WS_Y2)};
                pg8::gemm_phase<EpiI, SchedMoe, false, true, 0x7a7a7a7a, 0x7d7d7d7d>(lds, tid, 1024, 1024, 1024, S, E);
            }
        }
#if MK_ONE_LAUNCH
        if (ph + 1 < ph_hi || rep + 1 < nrep) {
#if MK_BAR_XCD
            if (ph == ph_lo) cg::this_grid().sync(); else xcd_barrier(bar);
#else
            cg::this_grid().sync();
#endif
        }
#endif
      }
    }
}

extern "C" void kernel_launch(void* const* d_in, const int* in_sizes, int n_in, void* d_out, int out_size, void* d_ws, size_t ws_size, hipStream_t stream) {
    static int grid = 0;
    if (grid == 0) {
        if (n_in != 26 || out_size != TL * DM || ws_size < WS_END) { fprintf(stderr, "kernel_launch: unexpected problem (n_in %d, out %d, ws %zu)\n", n_in, out_size, ws_size); grid = -1; return; }
        int dev = 0, cus = 0, per_cu = 0;
        (void)hipGetDevice(&dev); (void)hipDeviceGetAttribute(&cus, hipDeviceAttributeMultiprocessorCount, dev);
        if (hipFuncSetAttribute((const void*)fwd_kernel, hipFuncAttributeMaxDynamicSharedMemorySize, LDS_BYTES) != hipSuccess) { fprintf(stderr, "kernel_launch: hipFuncSetAttribute failed\n"); grid = -1; return; }
        if (hipOccupancyMaxActiveBlocksPerMultiprocessor(&per_cu, (const void*)fwd_kernel, NTHREADS, LDS_BYTES) != hipSuccess || per_cu < 1) { fprintf(stderr, "kernel_launch: occupancy query says %d blocks per CU\n", per_cu); (void)hipGetLastError(); per_cu = 1; }
        grid = cus;
        if (grid < 1) grid = 256;
    }
    if (grid < 0) return;
    (void)hipMemsetAsync((char*)d_ws + WS_CTL, 0, CTL_ZERO_BYTES, stream);
    Args a{};
    for (int i = 0; i < 26; ++i) a.in[i] = (const float*)d_in[i];
    a.out = (float*)d_out; a.ws = (unsigned char*)d_ws;
#if MK_ONE_LAUNCH
    a.ph_lo = 0; a.ph_hi = NPHASE;
    void* args[] = {&a};
    hipError_t e = hipLaunchCooperativeKernel((const void*)fwd_kernel, dim3(grid), dim3(NTHREADS), args, LDS_BYTES, stream);
    if (e != hipSuccess) fprintf(stderr, "kernel_launch: cooperative launch failed: %s (grid %d)\n", hipGetErrorString(e), grid);
#else
    for (int ph = 0; ph < NPHASE; ++ph) { a.ph_lo = ph; a.ph_hi = ph + 1; hipLaunchKernelGGL(fwd_kernel, dim3(grid), dim3(NTHREADS), LDS_BYTES, stream, a); }
#endif
}
```

```cpp
#include <hip/hip_runtime.h>
#include <hip/hip_cooperative_groups.h>
#include <cstdio>
#include <cstdint>
namespace cg = cooperative_groups;

#define LAS __attribute__((address_space(3)))
#define GAS __attribute__((address_space(1)))
typedef unsigned short bf16_t;
typedef short bf16x8 __attribute__((ext_vector_type(8)));
typedef short s16x4 __attribute__((ext_vector_type(4)));
typedef float f32x4 __attribute__((ext_vector_type(4)));
typedef float f32x2 __attribute__((ext_vector_type(2)));
typedef float f32x16 __attribute__((ext_vector_type(16)));
typedef unsigned u32x4 __attribute__((ext_vector_type(4)));
typedef unsigned u32x2 __attribute__((ext_vector_type(2)));

#ifndef MK_ONE_LAUNCH
#define MK_ONE_LAUNCH 1
#endif

constexpr int DM = 1024, NBATCH = 8, SEQ = 2048, CTXL = 256;
constexpr int TL = NBATCH * SEQ, TC = NBATCH * CTXL, TT = TL + TC;
constexpr int NIN = 2464, NINP = 2560, NGATE = 4096, NBG = NINP + NGATE;
constexpr int QP = 3072;
constexpr int NEXP = 32, MAXTILES = 176;
constexpr float EPS = 1e-6f, LOG2E = 1.4426950408889634f;
constexpr int P_RET = 0, P_MLA = 1024, P_GQA = 1440, P_WIN = 1952;
constexpr int Q_RETQ = 0, Q_RETK = 256, Q_RETV = 512, Q_RETG = 768;
constexpr int Q_MLAQ = 1024, Q_MLAK = 1408, Q_MLAV = 1792;
constexpr int Q_GQAQ = 2048, Q_GQAK = 2304, Q_GQAV = 2432;
constexpr int Q_WINQ = 2560, Q_WINK = 2816, Q_WINV = 2944;

constexpr size_t MiB = 1u << 20;
constexpr size_t WS_CTL = 0, CTL_ZERO_BYTES = 1 * MiB;
constexpr size_t WS_ADA = 1 * MiB;
constexpr size_t WS_ROPE = WS_ADA + 512 * 1024;
constexpr size_t WS_WRP = WS_ROPE + 768 * 1024;
constexpr size_t WS_TOKINV = 3 * MiB;
constexpr size_t WS_TOKE = WS_TOKINV + (size_t)NEXP * TT * 4;
constexpr size_t WS_TOKW = WS_TOKE + (size_t)TT * 2 * 4;
constexpr size_t WS_WSM = 6 * MiB;
constexpr size_t WS_WIN = 8 * MiB;
constexpr size_t WS_WBR = 34 * MiB;
constexpr size_t WS_WOUT = 38 * MiB;
constexpr size_t WS_W13 = 42 * MiB;
constexpr size_t WS_W2 = 298 * MiB;
constexpr size_t WS_X = 426 * MiB;
constexpr size_t WS_H = 498 * MiB;
constexpr size_t WS_QKV = 534 * MiB;
constexpr size_t WS_Y = 642 * MiB;
constexpr size_t WS_MRG = 678 * MiB;
constexpr size_t WS_P = 714 * MiB;
constexpr size_t WS_G = 804 * MiB;
constexpr size_t WS_HID = 714 * MiB;
constexpr size_t WS_Y2 = 804 * MiB;
constexpr size_t WS_END = 948 * MiB;
static_assert(WS_TOKW + (size_t)TT * 8 <= WS_WSM && WS_HID + (size_t)MAXTILES * 256 * 2048 <= WS_Y2 && WS_Y2 + (size_t)MAXTILES * 256 * 2048 <= WS_END, "ws map");
static_assert(WS_P + (size_t)TT * NINP * 2 <= WS_G && WS_G + (size_t)TT * NGATE * 2 <= WS_END && WS_END <= 1024 * MiB, "ws map");
constexpr int CW_BAR = 4096;
constexpr int CW_CNT = 16384;
constexpr int CW_WQ = 16640;

constexpr int LDS_MISC = 131072, LDS_BYTES = 147456;

__device__ __forceinline__ unsigned f2bf(float f) { unsigned u = __builtin_bit_cast(unsigned, f); return (u + 0x7fffu + ((u >> 16) & 1u)) >> 16; }
__device__ __forceinline__ unsigned pk2(float lo, float hi) { typedef __bf16 bf2 __attribute__((ext_vector_type(2))); f32x2 v = {lo, hi}; bf2 b = __builtin_convertvector(v, bf2); return __builtin_bit_cast(unsigned, b); }
__device__ __forceinline__ f32x4 xres_ld(const bf16_t* p) { const u32x2 w = *(const GAS u32x2*)p; f32x4 v; v.x = __builtin_bit_cast(float, w.x << 16); v.y = __builtin_bit_cast(float, w.x & 0xffff0000u); v.z = __builtin_bit_cast(float, w.y << 16); v.w = __builtin_bit_cast(float, w.y & 0xffff0000u); return v; }
__device__ __forceinline__ void xres_st(bf16_t* p, f32x4 v) { u32x2 w; w.x = pk2(v.x, v.y); w.y = pk2(v.z, v.w); *(GAS u32x2*)p = w; }
__device__ __forceinline__ unsigned pk4_fp8(float a, float b, float c, float d) { int p = __builtin_amdgcn_cvt_pk_fp8_f32(a, b, 0, false); p = __builtin_amdgcn_cvt_pk_fp8_f32(c, d, p, true); return (unsigned)p; }
__device__ __forceinline__ float bf2f(unsigned short b) { return __builtin_bit_cast(float, (unsigned)b << 16); }
__device__ __forceinline__ float bflo(unsigned w) { return __builtin_bit_cast(float, w << 16); }
__device__ __forceinline__ float bfhi(unsigned w) { return __builtin_bit_cast(float, w & 0xffff0000u); }
template <int M> __device__ __forceinline__ float xadd(float v) {
    if constexpr (M == 32) { unsigned a = __builtin_bit_cast(unsigned, v), b = a; asm volatile("" : "+v"(b));
        auto r = __builtin_amdgcn_permlane32_swap(a, b, false, false); const unsigned r0 = r[0], r1 = r[1];
        return __uint_as_float(r0) + __uint_as_float(r1); }
    else return v + __builtin_bit_cast(float, __builtin_amdgcn_ds_swizzle(__builtin_bit_cast(int, v), (M << 10) | 0x1f));
}
__device__ __forceinline__ float xmax32(float v) { unsigned a = __builtin_bit_cast(unsigned, v), b = a; asm volatile("" : "+v"(b));
    auto r = __builtin_amdgcn_permlane32_swap(a, b, false, false); const unsigned r0 = r[0], r1 = r[1]; return fmaxf(__uint_as_float(r0), __uint_as_float(r1)); }
__device__ __forceinline__ float wave_sum(float v) { v = xadd<1>(v); v = xadd<2>(v); v = xadd<4>(v); v = xadd<8>(v); v = xadd<16>(v); return xadd<32>(v); }
__device__ __forceinline__ float fast_exp2(float x) { return __builtin_amdgcn_exp2f(x); }
__device__ __forceinline__ float fast_rcp(float x) { return __builtin_amdgcn_rcpf(x); }
__device__ __forceinline__ float sigmoidf_(float x) { return fast_rcp(1.f + fast_exp2(-x * LOG2E)); }
__device__ __forceinline__ int lane_id() { return (int)__builtin_amdgcn_mbcnt_hi(~0u, __builtin_amdgcn_mbcnt_lo(~0u, 0u)); }
__device__ __forceinline__ void glds16(const void* gsrc, unsigned lds_dst) { unsigned keep;
    asm volatile("s_mov_b32 %0, m0\n\ts_mov_b32 m0, %2\n\ts_nop 0\n\tglobal_load_lds_dwordx4 %1, off\n\ts_mov_b32 m0, %0" : "=&s"(keep) : "v"(gsrc), "s"(lds_dst) : "memory"); }
__device__ __forceinline__ const char* uniform_ptr(const char* p) { const unsigned long long v = (unsigned long long)(uintptr_t)p; const unsigned lo = (unsigned)__builtin_amdgcn_readfirstlane((int)(unsigned)v), hi = (unsigned)__builtin_amdgcn_readfirstlane((int)(unsigned)(v >> 32)); return (const char*)(uintptr_t)(((unsigned long long)hi << 32) | lo); }
__device__ __forceinline__ void glds16_sv(const void* sbase, unsigned voff, unsigned lds_dst) { unsigned keep;
    asm volatile("s_mov_b32 %0, m0\n\ts_mov_b32 m0, %3\n\ts_nop 0\n\tglobal_load_lds_dwordx4 %1, %2\n\ts_mov_b32 m0, %0" : "=&s"(keep) : "v"(voff), "s"(sbase), "s"(lds_dst) : "memory"); }
#define LDS_WAIT() asm volatile("s_waitcnt lgkmcnt(0)" ::: "memory")
#define VM_WAIT() asm volatile("s_waitcnt vmcnt(0)" ::: "memory")

#define XB_TMO      128
#define XB_XCNT(j)  (256  + 64 * (j))
#define XB_XSUB(j)  (1280 + 64 * (j))
#define XB_XGEN(j)  (2304 + 64 * (j))
#define XB_TOP      3328
#define XB_TOPGEN   3392
#define XCD_BAR_WORDS 3456
#define XB_SPIN_CAP (1u << 18)
__device__ __forceinline__ unsigned xb_ld(unsigned* p)              { return __hip_atomic_load(p, __ATOMIC_RELAXED, __HIP_MEMORY_SCOPE_AGENT); }
__device__ __forceinline__ unsigned xb_add(unsigned* p, unsigned v) { return __hip_atomic_fetch_add(p, v, __ATOMIC_RELAXED, __HIP_MEMORY_SCOPE_AGENT); }
__device__ __forceinline__ unsigned xb_xcc_id() { return (unsigned)__builtin_amdgcn_s_getreg((3 << 11) | 20) & 0xFu; }
#define XB_SPIN(cond, bar) do { unsigned _sp = 0; while (cond) { __builtin_amdgcn_s_sleep(1); \
    if ((++_sp & 255u) == 0u) { if (xb_ld(&(bar)[XB_TMO])) break; if (_sp > XB_SPIN_CAP) { atomicAdd(&(bar)[XB_TMO], 1u); break; } } } } while (0)
struct XcdBarrier { unsigned* bar; unsigned x; volatile LAS unsigned* st; int wave; };
__device__ __forceinline__ XcdBarrier xcd_barrier_post(unsigned* bar, volatile LAS unsigned* st, int wave) {
    XcdBarrier b; b.bar = bar; b.x = xb_xcc_id(); b.st = st; b.wave = wave;
    if (wave == 0 && lane_id() == 0) (void)xb_add(&bar[XB_XCNT(b.x)], 1u);
    return b;
}
__device__ __forceinline__ void xcd_barrier_complete(unsigned* bar, unsigned x, unsigned& nloc, unsigned& nx) {
    const unsigned G = gridDim.x * gridDim.y * gridDim.z;
    unsigned sum, cnt, mine, sp = 0u;
    for (;;) {
        sum = 0u; cnt = 0u; mine = 0u;
#pragma unroll
        for (unsigned j = 0; j < 16; ++j) { const unsigned c = xb_ld(&bar[XB_XCNT(j)]); sum += c; cnt += (c > 0u) ? 1u : 0u; }
        mine = xb_ld(&bar[XB_XCNT(x)]);
        if (sum == G) break;
        __builtin_amdgcn_s_sleep(1);
        if ((++sp & 255u) == 0u) { if (xb_ld(&bar[XB_TMO])) break; if (sp > XB_SPIN_CAP) { atomicAdd(&bar[XB_TMO], 1u); break; } }
    }
    nloc = mine > 0u ? mine : 1u; nx = cnt > 0u ? cnt : 1u;
}
__device__ __forceinline__ void xcd_barrier(const XcdBarrier& b) {
    asm volatile("s_waitcnt vmcnt(0)" ::: "memory");
    __syncthreads();
    if (b.wave == 0 && lane_id() == 0) {
        unsigned* bar = b.bar; asm volatile("" : "+s"(bar));
        __builtin_amdgcn_s_waitcnt(0);
        unsigned nloc = b.st[0], nx = b.st[1];
        if (nloc == 0u) { xcd_barrier_complete(bar, b.x, nloc, nx); b.st[0] = nloc; b.st[1] = nx; }
        const unsigned old = xb_add(&bar[XB_XSUB(b.x)], 1u);
        const unsigned gen = old / nloc;
        if (old + 1u == (gen + 1u) * nloc) {
            __builtin_amdgcn_fence(__ATOMIC_RELEASE, "agent");
            asm volatile("s_waitcnt vmcnt(0)" ::: "memory");
            const unsigned og = xb_add(&bar[XB_TOP], 1u);
            const unsigned tg = og / nx;
            if (og + 1u == (tg + 1u) * nx) xb_add(&bar[XB_TOPGEN], 1u);
            else XB_SPIN(xb_ld(&bar[XB_TOPGEN]) == tg, bar);
            __builtin_amdgcn_fence(__ATOMIC_ACQUIRE, "agent");
            xb_add(&bar[XB_XGEN(b.x)], 1u);
            asm volatile("s_waitcnt vmcnt(0)" ::: "memory");
        } else {
            XB_SPIN(xb_ld(&bar[XB_XGEN(b.x)]) == gen, bar);
            __builtin_amdgcn_fence(__ATOMIC_ACQUIRE, "agent");
            asm volatile("s_waitcnt vmcnt(0)" ::: "memory");
        }
    }
    __syncthreads();
}

namespace pg8 {
constexpr int BM = 256, BK = 64, HALF = 128, HTB = HALF * BK * 2, STAGE_BYTES = 8 * HTB;
__host__ __device__ __forceinline__ int lds_byte(int r, int c) { const int st = (r >> 4) * 2 + (c >> 5), rr = r & 15, cc = c & 31, ob = rr * 64 + cc * 2; return st * 1024 + (ob ^ (((ob >> 9) & 1) << 5)); }
__host__ __device__ __forceinline__ void stage_rc(int b, int& R, int& C) { const int st = b / 1024, sb = b % 1024, swz = sb ^ (((sb >> 9) & 1) << 5); R = (st >> 1) * 16 + swz / 64; C = (st & 1) * 32 + (swz % 64) / 2; }
__host__ __device__ __forceinline__ int perm32(int rho) { const int n = rho >> 4, i = rho & 15; return 8 * (i >> 2) + 4 * n + (i & 3); }
struct Unit { int pm, pn, aux; };
__device__ __forceinline__ void tile_order(int L, int nM, int nN, int& pm, int& pn) {
    const int nwg = nM * nN; int wgid = L; { const int q = nwg / 8, r = nwg % 8, xcd = wgid % 8, off = wgid / 8; wgid = (xcd < r ? xcd * (q + 1) : r * (q + 1) + (xcd - r) * q) + off; }
    const int nig = 8 * nN, gid = wgid / nig, fm = gid * 8, gsz = (nM - fm) < 8 ? (nM - fm) : 8;
    pm = fm + ((wgid % nig) % gsz); pn = (wgid % nig) / gsz;
}
typedef int i32x8 __attribute__((ext_vector_type(8)));
typedef int i32x4 __attribute__((ext_vector_type(4)));
struct Frag2 { bf16x8 k[2]; };
template <bool F8> struct FragT { typedef Frag2 type; };
template <> struct FragT<true> { typedef i32x8 type; };
__device__ __forceinline__ void frag_set(Frag2& f, int k, i32x4 v) { f.k[k] = __builtin_bit_cast(bf16x8, v); }
__device__ __forceinline__ void frag_set(i32x8& f, int k, i32x4 v) { if (k == 0) { f[0] = v[0]; f[1] = v[1]; f[2] = v[2]; f[3] = v[3]; } else { f[4] = v[0]; f[5] = v[1]; f[6] = v[2]; f[7] = v[3]; } }
__device__ __forceinline__ f32x4 mma1(const Frag2& w, const Frag2& x, f32x4 c, int, int) { c = __builtin_amdgcn_mfma_f32_16x16x32_bf16(w.k[0], x.k[0], c, 0, 0, 0); return __builtin_amdgcn_mfma_f32_16x16x32_bf16(w.k[1], x.k[1], c, 0, 0, 0); }
#ifndef FP8_ASM_MMA
#define FP8_ASM_MMA 1
#endif
__device__ __forceinline__ f32x4 mma1(const i32x8& w, const i32x8& x, f32x4 c, int sw, int sx) {
#if FP8_ASM_MMA
    asm volatile("v_mfma_scale_f32_16x16x128_f8f6f4 %0, %1, %2, %0, %3, %4 op_sel_hi:[0,0,0]" : "+v"(c) : "v"(w), "v"(x), "v"(sw), "v"(sx));
    return c;
#else
    return __builtin_amdgcn_mfma_scale_f32_16x16x128_f8f6f4(w, x, c, 0, 0, 0, sw, 0, sx);
#endif
}
template <class Epi, class Sched, bool GATHER, bool FP8 = false, int SW = 0x7f7f7f7f, int SX = 0x7f7f7f7f>
__device__ __forceinline__ void gemm_phase(LAS unsigned char* lds, const int tid, const int kb, const int lda, const int ldb, const Sched& S, const Epi& E) {
    const int wid = __builtin_amdgcn_readfirstlane(tid >> 6), lane = tid & 63, wr = wid >> 2, wc = wid & 3, fr = lane & 15, fq = lane >> 4;
    const int nt = kb / 128;
    int sR[2], sC[2]; unsigned voffB[2];
#pragma unroll
    for (int i = 0; i < 2; ++i) { int R, C; stage_rc(tid * 16 + i * 8192, R, C); sR[i] = R; sC[i] = C; const int Rb = Epi::PERM ? ((R & ~31) + perm32(R & 31)) : R; voffB[i] = (unsigned)(Rb * ldb + C * 2); }
    const size_t kstep = (size_t)(BK * 2);
    const size_t hstepB = (size_t)HALF * ldb;
    const unsigned ldsw = (unsigned)wid * 1024u; const unsigned ldsb_ = (unsigned)(uintptr_t)lds;
    const int aoff = lds_byte(wr * 64 + fr, fq * 8), boff = lds_byte(wc * 32 + fr, fq * 8);
#define PG8_SA(b, h) (((b) * 2 + (h)) * HTB)
#define PG8_SB(b, h) ((4 + (b) * 2 + (h)) * HTB)
#define PG8_STAGE_B(bufoff, gbase) do { _Pragma("unroll") for (int _i = 0; _i < 2; ++_i) \
        glds16_sv((const void*)(gbase), voffB[_i], (unsigned)__builtin_amdgcn_readfirstlane((int)(ldsb_ + (bufoff) + ldsw + _i * 8192))); } while (0)
#define PG8_STAGE_A(bufoff, gbase, off) do { _Pragma("unroll") for (int _i = 0; _i < 2; ++_i) \
        glds16_sv((const void*)(gbase), (off)[_i], (unsigned)__builtin_amdgcn_readfirstlane((int)(ldsb_ + (bufoff) + ldsw + _i * 8192))); } while (0)
#define PG8_LDA(dst, b, h) do { _Pragma("unroll") for (int m = 0; m < 4; ++m) _Pragma("unroll") for (int k = 0; k < 2; ++k) frag_set(dst[m], k, *(const LAS i32x4*)(lds + PG8_SA(b, h) + aoff + m * 2048 + k * 1024)); } while (0)
#define PG8_LDB(dst, b, h) do { _Pragma("unroll") for (int n = 0; n < 2; ++n) _Pragma("unroll") for (int k = 0; k < 2; ++k) frag_set(dst[n], k, *(const LAS i32x4*)(lds + PG8_SB(b, h) + boff + n * 2048 + k * 1024)); } while (0)
#define PG8_MMA(ai, bj, At, Bt) do { __builtin_amdgcn_s_setprio(1); _Pragma("unroll") for (int m = 0; m < 4; ++m) _Pragma("unroll") for (int n = 0; n < 2; ++n) { \
        acc[ai][bj][m][n] = mma1(Bt[n], At[m], acc[ai][bj][m][n], SW, SX); } \
        __builtin_amdgcn_s_setprio(0); } while (0)
#define PG8_WAIT_V(n) asm volatile("s_waitcnt vmcnt(" #n ")" ::: "memory")
#define PG8_WAIT_L(n) asm volatile("s_waitcnt lgkmcnt(" #n ")" ::: "memory")
#define PG8_BAR __builtin_amdgcn_s_barrier()
#define PG8_SCHED __builtin_amdgcn_sched_barrier(0)
#define PG8_OFFS(dst, u) do { _Pragma("unroll") for (int _h = 0; _h < 2; ++_h) _Pragma("unroll") for (int _i = 0; _i < 2; ++_i) { \
        const int _r = sR[_i] + _h * HALF; const int _row = GATHER ? S.arow(u, _r) : _r; dst[_h][_i] = (unsigned)(_row * lda + sC[_i] * 2); } } while (0)
    Unit cur, nxt; int ui = 0;
    if (!S.next(0, cur)) return;
    f32x4 acc[2][2][4][2];
#pragma unroll
    for (int a = 0; a < 2; ++a)
#pragma unroll
        for (int b = 0; b < 2; ++b)
#pragma unroll
            for (int m = 0; m < 4; ++m)
#pragma unroll
                for (int n = 0; n < 2; ++n) acc[a][b][m][n] = (f32x4){0.f, 0.f, 0.f, 0.f};
    typedef typename FragT<FP8>::type frag_t;
    frag_t At[4], B0[2], B1[2];
    const char* cA; const char* cB; S.ptrs(cur, cA, cB); cA = uniform_ptr(cA); cB = uniform_ptr(cB);
    asm volatile("s_nop 4" ::: "memory");
    unsigned offC[2][2], offN[2][2];
    PG8_OFFS(offC, cur);
    PG8_STAGE_B(PG8_SB(0, 0), cB); PG8_STAGE_B(PG8_SB(0, 1), cB + hstepB); PG8_STAGE_A(PG8_SA(0, 0), cA, offC[0]); PG8_STAGE_A(PG8_SA(0, 1), cA, offC[1]);
    if (wr == 1) PG8_BAR;
    PG8_WAIT_V(2); PG8_BAR;
    PG8_STAGE_B(PG8_SB(1, 0), cB + kstep); PG8_STAGE_A(PG8_SA(1, 0), cA + kstep, offC[0]); PG8_STAGE_B(PG8_SB(1, 1), cB + hstepB + kstep);
    PG8_WAIT_V(6); PG8_BAR;
    for (;;) {
        const bool has_next = S.next(ui + 1, nxt);
        const char* nA = cA; const char* nB = cB;
        if (has_next) { S.ptrs(nxt, nA, nB); nA = uniform_ptr(nA); nB = uniform_ptr(nB); asm volatile("s_nop 4" ::: "memory"); PG8_OFFS(offN, nxt); }
        else {
#pragma unroll
            for (int h = 0; h < 2; ++h)
#pragma unroll
                for (int i = 0; i < 2; ++i) offN[h][i] = offC[h][i];
        }
#pragma unroll 1
        for (int tsec = 0; tsec < nt; tsec += (Epi::MID ? 4 : nt)) {
        if constexpr (Epi::MID) { if (tsec != 0) { unsigned z_ = 0u; asm volatile("" : "+v"(z_)); const int l2_ = (int)__builtin_amdgcn_mbcnt_hi(~0u, __builtin_amdgcn_mbcnt_lo(~0u, z_)); E.mid(acc, cur, tsec >> 2, wr, wc, l2_ & 15, l2_ >> 4); } }
#pragma unroll 1
        for (int t = tsec; t < tsec + (Epi::MID ? 4 : nt); t += 2) {
            const bool last = (t == nt - 2);
            const char* a1 = cA + (size_t)(t + 1) * kstep;
            const char* a2 = last ? nA : cA + (size_t)(t + 2) * kstep; const char* b2 = last ? nB : cB + (size_t)(t + 2) * kstep;
            const char* a3 = a2 + kstep; const char* b3 = b2 + kstep;
            unsigned o2[2][2];
#pragma unroll
            for (int h = 0; h < 2; ++h)
#pragma unroll
                for (int i = 0; i < 2; ++i) o2[h][i] = last ? offN[h][i] : offC[h][i];
            PG8_LDB(B0, 0, 0); PG8_LDB(B1, 0, 1); PG8_SCHED; PG8_LDA(At, 0, 0); PG8_STAGE_A(PG8_SA(1, 1), a1, offC[1]);
            PG8_WAIT_V(8); PG8_WAIT_L(0); PG8_BAR; PG8_MMA(0, 0, At, B0); PG8_MMA(0, 1, At, B1); PG8_BAR; PG8_SCHED;
            PG8_LDA(At, 0, 1); PG8_STAGE_B(PG8_SB(0, 0), b2); PG8_STAGE_B(PG8_SB(0, 1), b2 + hstepB); PG8_STAGE_A(PG8_SA(0, 0), a2, o2[0]);
            PG8_WAIT_V(8); PG8_WAIT_L(0); PG8_BAR; PG8_MMA(1, 0, At, B0); PG8_MMA(1, 1, At, B1); PG8_BAR; PG8_SCHED;
            PG8_LDB(B0, 1, 0); PG8_LDB(B1, 1, 1); PG8_SCHED; PG8_LDA(At, 1, 0); PG8_STAGE_A(PG8_SA(0, 1), a2, o2[1]);
            PG8_WAIT_V(8); PG8_WAIT_L(0); PG8_BAR; PG8_MMA(0, 0, At, B0); PG8_MMA(0, 1, At, B1); PG8_BAR; PG8_SCHED;
            PG8_LDA(At, 1, 1); PG8_STAGE_B(PG8_SB(1, 0), b3); PG8_STAGE_B(PG8_SB(1, 1), b3 + hstepB); PG8_STAGE_A(PG8_SA(1, 0), a3, o2[0]);
            PG8_WAIT_V(8); PG8_WAIT_L(0); PG8_BAR; PG8_MMA(1, 0, At, B0); PG8_MMA(1, 1, At, B1); PG8_BAR; PG8_SCHED;
        }
        }
        if (wr == 0) PG8_BAR;
        if constexpr (FP8) asm volatile("s_nop 15\n\ts_nop 7" ::: "memory");
        { unsigned z_ = 0u; asm volatile("" : "+v"(z_)); const int l2_ = (int)__builtin_amdgcn_mbcnt_hi(~0u, __builtin_amdgcn_mbcnt_lo(~0u, z_)); E(acc, cur, wr, wc, l2_ & 15, l2_ >> 4); }
        if (!has_next) break;
        if (S.fresh(nxt)) {
#pragma unroll
            for (int a = 0; a < 2; ++a)
#pragma unroll
                for (int b = 0; b < 2; ++b)
#pragma unroll
                    for (int m = 0; m < 4; ++m)
#pragma unroll
                        for (int n = 0; n < 2; ++n) acc[a][b][m][n] = (f32x4){0.f, 0.f, 0.f, 0.f};
        }
        cur = nxt; cA = nA; cB = nB; ++ui;
#pragma unroll
        for (int h = 0; h < 2; ++h)
#pragma unroll
            for (int i = 0; i < 2; ++i) offC[h][i] = offN[h][i];
        if (wr == 1) PG8_BAR;
    }
    PG8_WAIT_V(0);
    PG8_BAR;
#undef PG8_SA
#undef PG8_SB
#undef PG8_STAGE_A
#undef PG8_STAGE_B
#undef PG8_LDA
#undef PG8_LDB
#undef PG8_MMA
#undef PG8_WAIT_V
#undef PG8_WAIT_L
#undef PG8_BAR
#undef PG8_SCHED
#undef PG8_OFFS
}
}

struct Args { const float* in[26]; float* out; unsigned char* ws; int ph_lo, ph_hi; };
typedef const __attribute__((address_space(4))) Args* KArgs;
enum { I_X = 0, I_C, I_CTX, I_CCTX, I_WADA, I_BADA, I_N1G, I_N2G, I_WIN, I_WGATE, I_WBR, I_WOUT, I_DECAY, I_QNG, I_WUQ, I_KVNG, I_WUKV, I_GQN, I_GKN, I_SINK, I_WR, I_BR, I_W1, I_W3, I_W2, I_FNG };
constexpr int NWAVES = 8, NTHREADS = 512;

struct CvtDesc { const float* src; const float* kscale; bf16_t* dst; int N, k0, n0, Kd, nvalid, rmap, fp8; };
__device__ __forceinline__ void cvt_load(const CvtDesc& d, int lane, f32x4 (&v)[16]) {
    const int kk = lane >> 4, n4 = lane & 15, ncol = d.n0 + 4 * n4;
#pragma unroll
    for (int j = 0; j < 16; ++j) {
        const int k = d.k0 + 16 * kk + j;
        v[j] = (4 * n4 < d.nvalid) ? __builtin_nontemporal_load((const GAS f32x4*)(d.src + (size_t)k * d.N + ncol)) : (f32x4){0.f, 0.f, 0.f, 0.f};
    }
}
__device__ __forceinline__ void cvt_store(const CvtDesc& d, f32x4 (&v)[16], LAS unsigned char* scr, int lane) {
    const int kk = lane >> 4, n4 = lane & 15;
    if (d.kscale) {
#pragma unroll
        for (int j = 0; j < 16; ++j) v[j] = v[j] * d.kscale[d.k0 + 16 * kk + j];
    }
    if (d.fp8) {
#pragma unroll
        for (int i = 0; i < 4; ++i) { u32x4 w;
            w.x = pk4_fp8(32.f * v[0][i], 32.f * v[1][i], 32.f * v[2][i], 32.f * v[3][i]); w.y = pk4_fp8(32.f * v[4][i], 32.f * v[5][i], 32.f * v[6][i], 32.f * v[7][i]);
            w.z = pk4_fp8(32.f * v[8][i], 32.f * v[9][i], 32.f * v[10][i], 32.f * v[11][i]); w.w = pk4_fp8(32.f * v[12][i], 32.f * v[13][i], 32.f * v[14][i], 32.f * v[15][i]);
            *(LAS u32x4*)(scr + (4 * n4 + i) * 80 + 16 * kk) = w; }
        LDS_WAIT(); asm volatile("" ::: "memory");
        const int c = lane & 3;
#pragma unroll
        for (int jj = 0; jj < 4; ++jj) {
            const int n = (lane >> 2) + 16 * jj;
            const u32x4 o = *(const LAS u32x4*)(scr + n * 80 + 16 * c);
            const int prow = d.rmap == 0 ? n : (d.rmap == 1 ? (n & 31) + 128 * (n >> 5) : 32 * (n >> 4) + 8 * ((n >> 2) & 3) + (n & 3));
            *(GAS u32x4*)((unsigned char*)d.dst + (size_t)prow * d.Kd + d.k0 + 16 * c) = o;
        }
        LDS_WAIT(); asm volatile("" ::: "memory");
        return;
    }
#pragma unroll
    for (int i = 0; i < 4; ++i) { u32x4 w0, w1;
        w0.x = pk2(v[0][i], v[1][i]); w0.y = pk2(v[2][i], v[3][i]); w0.z = pk2(v[4][i], v[5][i]); w0.w = pk2(v[6][i], v[7][i]);
        w1.x = pk2(v[8][i], v[9][i]); w1.y = pk2(v[10][i], v[11][i]); w1.z = pk2(v[12][i], v[13][i]); w1.w = pk2(v[14][i], v[15][i]);
        *(LAS u32x4*)(scr + (4 * n4 + i) * 144 + 32 * kk) = w0; *(LAS u32x4*)(scr + (4 * n4 + i) * 144 + 32 * kk + 16) = w1; }
    LDS_WAIT(); asm volatile("" ::: "memory");
    const int c = lane & 7;
#pragma unroll
    for (int jj = 0; jj < 8; ++jj) {
        const int n = (lane >> 3) + 8 * jj;
        const u32x4 o = *(const LAS u32x4*)(scr + n * 144 + 16 * c);
        const int prow = d.rmap == 0 ? n : (d.rmap == 1 ? (n & 31) + 128 * (n >> 5) : 32 * (n >> 4) + 8 * ((n >> 2) & 3) + (n & 3));
        *(GAS u32x4*)(d.dst + (size_t)prow * d.Kd + d.k0 + 8 * c) = o;
    }
    LDS_WAIT(); asm volatile("" ::: "memory");
}
constexpr int CV_EXP_ITEMS = 2 * 32 * 3 * 256;
constexpr int CV_IN = 16 * 40, CV_GT = 16 * 64, CV_BRN = 4 * 16, CV_OUT = 16 * 16, CV_UQ = 4 * 6, CV_UKV = 2 * 8;
constexpr int CV_PER_L = CV_IN + CV_GT + 4 * CV_BRN + CV_OUT + CV_UQ + CV_UKV;
constexpr int CV_NITEMS = CV_EXP_ITEMS + 2 * CV_PER_L;
constexpr int CV_E0_SHARE = 12288;
__device__ __forceinline__ void cvt_decode(KArgs a, unsigned char* ws, int it, CvtDesc& d) {
    d.kscale = nullptr; d.N = 1024; d.Kd = 1024; d.nvalid = 64; d.rmap = 0; d.fp8 = 0;
    if (it < CV_EXP_ITEMS) {
        d.fp8 = 1;
        const int j = it >> 8, r = it & 255, l = j / 96, jj = j % 96, e = jj / 3, kind = jj % 3, kb = r >> 4, nb = r & 15;
        const size_t eo = ((size_t)l * 32 + e) * 1048576;
        d.k0 = kb * 64; d.n0 = nb * 64;
        if (kind < 2) { d.src = (kind == 0 ? a->in[I_W1] : a->in[I_W3]) + eo;
            d.dst = (bf16_t*)(ws + WS_W13 + ((size_t)l * 32 + e) * 2097152 + (size_t)(256 * (nb >> 1) + 128 * kind + 64 * (nb & 1)) * 1024); }
        else { d.src = a->in[I_W2] + eo; d.dst = (bf16_t*)(ws + WS_W2 + eo + (size_t)(nb * 64) * 1024); }
        return;
    }
    int r = it - CV_EXP_ITEMS; const int l = r / CV_PER_L; r -= l * CV_PER_L;
    if (r < CV_IN) {
        const int kb = r / 40, hb = r % 40, t = hb >> 2, wc = hb & 3; int src0 = -1, nv = 64;
        if (t < 5) src0 = 256 * t + 64 * wc;
        else if (t == 5) { if (wc < 2) src0 = 1280 + 64 * wc; else if (wc == 2) { src0 = 1408; nv = 32; } }
        else if (t == 6) src0 = P_GQA + 64 * wc;
        else if (t == 7) src0 = wc < 2 ? P_GQA + 256 + 64 * wc : P_GQA + 384 + 64 * (wc - 2);
        else if (t == 8) src0 = P_WIN + 64 * wc;
        else src0 = wc < 2 ? P_WIN + 256 + 64 * wc : P_WIN + 384 + 64 * (wc - 2);
        d.src = a->in[I_WIN] + (size_t)l * 1024 * NIN; d.N = NIN; d.k0 = kb * 64; d.n0 = src0 < 0 ? 0 : src0; d.nvalid = src0 < 0 ? 0 : nv; d.rmap = 1;
        d.fp8 = 1; d.dst = (bf16_t*)(ws + WS_WIN + ((size_t)l * NBG + 256 * t + 32 * wc) * 1024); return; } r -= CV_IN;
    if (r < CV_GT) {
        const int kb = r >> 6, nb = r & 63, i = nb >> 4, tg = nb & 15;
        d.src = a->in[I_WGATE] + (size_t)l * 1024 * 4096; d.N = 4096; d.k0 = kb * 64; d.n0 = i * 1024 + 64 * tg; d.rmap = 2;
        d.fp8 = 1; d.dst = (bf16_t*)(ws + WS_WIN + ((size_t)l * NBG + NINP + 256 * tg + 128 * (i >> 1) + 4 * (i & 1)) * 1024); return; } r -= CV_GT;
    if (r < 4 * CV_BRN) { const int i = r / CV_BRN, rr = r % CV_BRN, kb = rr >> 4, nb = rr & 15; d.src = a->in[I_WBR] + ((size_t)l * 4 + i) * 256 * 1024; d.k0 = kb * 64; d.n0 = nb * 64;
        d.dst = (bf16_t*)(ws + WS_WBR) + ((size_t)l * 1024 + nb * 64) * 1024 + 256 * i; return; } r -= 4 * CV_BRN;
    if (r < CV_OUT) { const int kb = r >> 4, nb = r & 15; d.src = a->in[I_WOUT] + (size_t)l * 1048576; d.k0 = kb * 64; d.n0 = nb * 64; d.dst = (bf16_t*)(ws + WS_WOUT) + (size_t)l * 1048576 + (size_t)(nb * 64) * 1024; return; } r -= CV_OUT;
    if (r < CV_UQ) { const int kb = r / 6, nb = r % 6; d.src = a->in[I_WUQ] + (size_t)l * 256 * 384; d.N = 384; d.k0 = kb * 64; d.n0 = nb * 64; d.kscale = a->in[I_QNG] + l * 256; d.dst = (bf16_t*)(ws + WS_WSM) + ((size_t)l * 384 + nb * 64) * 256; d.Kd = 256; return; } r -= CV_UQ;
    { const int kb = r >> 3, nb = r & 7; d.src = a->in[I_WUKV] + (size_t)l * 128 * 512; d.N = 512; d.k0 = kb * 64; d.n0 = nb * 64; d.kscale = a->in[I_KVNG] + l * 128; d.dst = (bf16_t*)(ws + WS_WSM) + 2 * 384 * 256 + ((size_t)l * 512 + nb * 64) * 128; d.Kd = 128; }
}

__device__ __forceinline__ void cvt_run(KArgs a, unsigned char* ws, LAS unsigned char* lds, int lane, int wave, int first, int last, int start, int stride) {
    LAS unsigned char* scr = lds + 57344 + wave * 9216;
    int it = first + start;
    if (it < last) {
        CvtDesc dA, dB; f32x4 va[16], vb[16];
        cvt_decode(a, ws, it, dA); cvt_load(dA, lane, va);
        for (;;) {
            const int itB = it + stride; const bool hasB = itB < last;
            if (hasB) { cvt_decode(a, ws, itB, dB); cvt_load(dB, lane, vb); }
            cvt_store(dA, va, scr, lane);
            if (!hasB) break;
            const int itA = itB + stride; const bool hasA = itA < last;
            if (hasA) { cvt_decode(a, ws, itA, dA); cvt_load(dA, lane, va); }
            cvt_store(dB, vb, scr, lane);
            if (!hasA) break;
            it = itA;
        }
    }
}
__device__ __forceinline__ void p0_prologue(KArgs a, LAS unsigned char* lds, int tid, int lane, int wave, int G, int c) {
    unsigned char* ws = a->ws;
    if (c < 192) {
        LAS float* st = (LAS float*)lds;
        LAS float* red = (LAS float*)(lds + 36864);
        for (int idx = tid; idx < 9 * 1024; idx += NTHREADS) { const int r = idx >> 10, k = idx & 1023; const float v = r < 8 ? a->in[I_C][r * 1024 + k] : a->in[I_CCTX][k]; st[idx] = v / (1.f + __expf(-v)); }
        __syncthreads();
        const int l = c / 96, n0 = (c % 96) * 64;
        float acc[9];
#pragma unroll
        for (int r = 0; r < 9; ++r) acc[r] = 0.f;
        const float* wp = a->in[I_WADA] + ((size_t)l * 1024 + wave * 128) * 6144 + n0 + lane;
#pragma unroll 4
        for (int k = 0; k < 128; ++k) { const float wv = wp[(size_t)k * 6144];
#pragma unroll
            for (int r = 0; r < 9; ++r) acc[r] += st[r * 1024 + wave * 128 + k] * wv; }
#pragma unroll
        for (int r = 0; r < 9; ++r) red[(wave * 9 + r) * 64 + lane] = acc[r];
        __syncthreads();
        for (int idx = tid; idx < 9 * 64; idx += NTHREADS) { const int r = idx >> 6, n = idx & 63; float s = 0.f;
#pragma unroll
            for (int w = 0; w < 8; ++w) s += red[(w * 9 + r) * 64 + n];
            ((float*)(ws + WS_ADA))[((size_t)l * 9 + r) * 6144 + n0 + n] = s + a->in[I_BADA][l * 6144 + n0 + n]; }
        __syncthreads();
    }
    const int gw = c * NWAVES + wave, NGW = G * NWAVES;
    {
        float* rope = (float*)(ws + WS_ROPE);
        for (int idx = gw * 64 + lane; idx < 2048 * 48; idx += NGW * 64) {
            const int pos = idx / 48, j = idx % 48, row = pos >> 6, col = pos & 63;
            if (j < 32) { const int i = j, f = i & 15; const float inv = powf(10000.f, -(float)f / 16.f); const float ang = (float)(i < 16 ? row : col) * inv;
                rope[pos * 32 + i] = cosf(ang); rope[2048 * 32 + pos * 32 + i] = sinf(ang); }
            else { const int i = j - 32, f = i & 7; const float inv = powf(10000.f, -(float)f / 8.f); const float ang = (float)(i < 8 ? row : col) * inv;
                rope[2 * 2048 * 32 + pos * 16 + i] = cosf(ang); rope[2 * 2048 * 32 + 2048 * 16 + pos * 16 + i] = sinf(ang); }
        }
        float* wrp = (float*)(ws + WS_WRP);
        for (int idx = gw * 64 + lane; idx < 32768; idx += NGW * 64) { const int half = idx >> 14, w = (idx >> 11) & 7, q = (idx >> 9) & 3, e = (idx >> 5) & 15, s = idx & 31;
            wrp[idx] = a->in[I_WR][(128 * w + 32 * q + s) * 32 + 16 * half + e]; }
    }
    cvt_run(a, ws, lds, lane, wave, 0, CV_EXP_ITEMS / 2, gw, NGW);
    cvt_run(a, ws, lds, lane, wave, CV_EXP_ITEMS, CV_NITEMS, gw, NGW);
}

__device__ __forceinline__ void moe_tables(const unsigned* ctl, int l, LAS unsigned char* lds, int tid) {
    LAS int* tb = (LAS int*)(lds + LDS_MISC + 1024); LAS int* cn = (LAS int*)(lds + LDS_MISC + 2304);
    __syncthreads();
    if (tid < 32) cn[tid] = (int)__hip_atomic_load(ctl + CW_CNT + l * 32 + tid, __ATOMIC_RELAXED, __HIP_MEMORY_SCOPE_AGENT);
    __syncthreads();
    if (tid == 0) { int s = 0; for (int e = 0; e < 32; ++e) { tb[e] = s; s += (cn[e] + 255) >> 8; } tb[32] = s; }
    __syncthreads();
    if (tid < MAXTILES) { LAS int* te = (LAS int*)(lds + LDS_MISC + 1024 + 48 * 4); int e = 0; for (int k = 1; k < 32; ++k) e += (tid >= tb[k]) ? 1 : 0; te[tid] = e | ((tid - tb[e]) << 8); }
    __syncthreads();
}

__device__ __forceinline__ void phase_rownorm(KArgs a, int mode, LAS unsigned char* lds, int lane, int wave, int G, int c) {
    unsigned char* ws = a->ws;
    const int gw = c * NWAVES + wave, NGW = G * NWAVES;
    const float* ada = (const float*)(ws + WS_ADA);
    bf16_t* X = (bf16_t*)(ws + WS_X);
    const LAS int* tb = (const LAS int*)(lds + LDS_MISC + 1024);
    const int nrows = (mode == 2) ? TL : TT;
    const int lprev = mode - 1, lcur = (mode == 2) ? 0 : mode;
    constexpr int R = 3;
    for (int base = gw; base < nrows; base += R * NGW) {
        f32x4 v[R][4]; int rows[R]; bool ok[R];
#pragma unroll
        for (int r = 0; r < R; ++r) { rows[r] = base + r * NGW; ok[r] = rows[r] < nrows; if (!ok[r]) rows[r] = base; }
#pragma unroll
        for (int r = 0; r < R; ++r) {
            const int row = rows[r];
            if (mode == 0) { const float* src = row < TL ? a->in[I_X] + (size_t)row * 1024 : a->in[I_CTX] + (size_t)(row - TL) * 1024;
#pragma unroll
                for (int j = 0; j < 4; ++j) v[r][j] = *(const GAS f32x4*)(src + 4 * lane + 256 * j); }
            else {
#pragma unroll
                for (int j = 0; j < 4; ++j) v[r][j] = xres_ld(X + (size_t)row * 1024 + 4 * lane + 256 * j); }
        }
        if (mode != 0) {
            const int* te = (const int*)(ws + WS_TOKE); const float* tw = (const float*)(ws + WS_TOKW);
            const bf16_t* Y2 = (const bf16_t*)(ws + WS_Y2);
            u32x2 y0[R][4], y1[R][4]; float w0[R], w1[R];
#pragma unroll
            for (int r = 0; r < R; ++r) {
                const int row = rows[r];
                const int e0 = te[row * 2], e1 = te[row * 2 + 1]; w0[r] = tw[row * 2]; w1[r] = tw[row * 2 + 1];
                const size_t s0 = (size_t)(tb[e0 >> 20] * 256 + (e0 & 0xfffff)), s1 = (size_t)(tb[e1 >> 20] * 256 + (e1 & 0xfffff));
#pragma unroll
                for (int j = 0; j < 4; ++j) { y0[r][j] = *(const GAS u32x2*)(Y2 + s0 * 1024 + 4 * lane + 256 * j); y1[r][j] = *(const GAS u32x2*)(Y2 + s1 * 1024 + 4 * lane + 256 * j); }
            }
#pragma unroll
            for (int r = 0; r < R; ++r) {
                const int row = rows[r]; const int b = row < TL ? (row >> 11) : 8;
                const float* g2 = ada + ((size_t)lprev * 9 + b) * 6144 + 5120;
#pragma unroll
                for (int j = 0; j < 4; ++j) {
                    const f32x4 gg = *(const GAS f32x4*)(g2 + 4 * lane + 256 * j);
                    f32x4 f; f.x = w0[r] * bflo(y0[r][j].x) + w1[r] * bflo(y1[r][j].x); f.y = w0[r] * bfhi(y0[r][j].x) + w1[r] * bfhi(y1[r][j].x);
                    f.z = w0[r] * bflo(y0[r][j].y) + w1[r] * bflo(y1[r][j].y); f.w = w0[r] * bfhi(y0[r][j].y) + w1[r] * bfhi(y1[r][j].y);
                    v[r][j] = v[r][j] + gg * f;
                }
                if (mode == 1 && ok[r]) {
#pragma unroll
                    for (int j = 0; j < 4; ++j) xres_st(X + (size_t)row * 1024 + 4 * lane + 256 * j, v[r][j]);
                }
            }
        }
#pragma unroll
        for (int r = 0; r < R; ++r) {
            const int row = rows[r]; const int b = row < TL ? (row >> 11) : 8;
            float ss = 0.f;
#pragma unroll
            for (int j = 0; j < 4; ++j) ss += (v[r][j].x * v[r][j].x + v[r][j].y * v[r][j].y) + (v[r][j].z * v[r][j].z + v[r][j].w * v[r][j].w);
            const float rstd = 1.0f / sqrtf(wave_sum(ss) * (1.f / 1024.f) + EPS);
            if (ok[r]) {
                if (mode == 2) {
#pragma unroll
                    for (int j = 0; j < 4; ++j) { const f32x4 g = *(const GAS f32x4*)(a->in[I_FNG] + 4 * lane + 256 * j); *(GAS f32x4*)(a->out + (size_t)row * 1024 + 4 * lane + 256 * j) = v[r][j] * rstd * g; }
                } else {
                    const float* gn = a->in[I_N1G] + lcur * 1024; const float* sh = ada + ((size_t)lcur * 9 + b) * 6144; const float* sc = sh + 1024;
                    unsigned char* H = (unsigned char*)(ws + WS_H) + (size_t)row * 1024;
#pragma unroll
                    for (int j = 0; j < 4; ++j) { const int cc = 4 * lane + 256 * j; const f32x4 g = *(const GAS f32x4*)(gn + cc), s1 = *(const GAS f32x4*)(sc + cc), s0 = *(const GAS f32x4*)(sh + cc);
                        const f32x4 h = v[r][j] * rstd * g * (s1 + 1.0f) + s0; *(GAS unsigned*)(H + cc) = pk4_fp8(h.x, h.y, h.z, h.w); }
                }
            }
        }
    }
}

using pg8::Unit;
struct SchedB {
    int layer, G, c; const char* H; const char* W;
    __device__ __forceinline__ bool next(int i, Unit& u) const {
        const int L = i * G + c; u.aux = 0;
        if (layer == 0) { if (L >= 72 * 26) return false; pg8::tile_order(L, 72, 26, u.pm, u.pn); return true; }
        if (L < 64 * 16) { pg8::tile_order(L, 64, 16, u.pm, u.pn); u.pn += 10; return true; }
        const int L2 = L - 64 * 16; if (L2 >= 72 * 10) return false; pg8::tile_order(L2, 72, 10, u.pm, u.pn); return true;
    }
    __device__ __forceinline__ void ptrs(const Unit& u, const char*& A, const char*& B) const { A = H + (size_t)u.pm * 256 * 1024; B = W + (size_t)u.pn * 256 * 1024; }
    __device__ __forceinline__ int arow(const Unit&, int r) const { return r; }
    __device__ __forceinline__ bool fresh(const Unit&) const { return true; }
};
struct EpiB {
    static constexpr bool PERM = true, MID = false;
    bf16_t* P; bf16_t* Gt; bf16_t* Q; const float* cos64; const float* sin64; const float* qng; const float* kng;
    __device__ __forceinline__ void operator()(f32x4 (&acc)[2][2][4][2], const Unit& u, int wr, int wc, int fr, int fq) const {
        const int row0 = u.pm * 256 + wr * 64 + fr;
        if (u.pn >= 10) {
            const int d0 = (u.pn - 10) * 64 + 16 * wc + 4 * fq;
#pragma unroll
            for (int ai = 0; ai < 2; ++ai)
#pragma unroll
                for (int m = 0; m < 4; ++m) { bf16_t* gp = Gt + (size_t)(row0 + ai * 128 + m * 16) * NGATE + d0;
                    f32x4 g[4];
#pragma unroll
                    for (int i = 0; i < 4; ++i)
#pragma unroll
                        for (int j = 0; j < 4; ++j) g[i][j] = fmaxf(sigmoidf_(acc[ai][i >> 1][m][i & 1][j]), 1e-6f);
#pragma unroll
                    for (int i = 0; i < 4; ++i) { f32x4 r = g[i];
                        if (i < 3) {
#pragma unroll
                            for (int j = 0; j < 4; ++j) r[j] *= fast_rcp(g[i + 1][j]); }
                        u32x2 w; w.x = pk2(r[0], r[1]); w.y = pk2(r[2], r[3]); *(GAS u32x2*)(gp + i * 1024) = w; } }
            return;
        }
        const int t = u.pn;
        bf16_t* dst; size_t ld; int col; int mode = 0;
        float scale = 1.f; const float* gain = nullptr;
        if (t == 4) { dst = P; ld = NINP; col = P_MLA + 64 * wc; }
        else if (t == 5) { dst = P; ld = NINP; col = 1280 + 64 * wc; mode = wc < 3 ? 0 : 3; }
        else { dst = Q; ld = QP;
            if (t == 0) { col = Q_RETQ + 64 * wc; mode = 1; scale = 0.125f; }
            else if (t == 1) { col = Q_RETK + 64 * wc; mode = 1; }
            else if (t == 2) col = Q_RETV + 64 * wc;
            else if (t == 3) col = Q_RETG + 64 * wc;
            else if (t == 6) { col = Q_GQAQ + 64 * wc; mode = 2; scale = 0.125f * LOG2E; gain = qng; }
            else if (t == 7) { if (wc < 2) { col = Q_GQAK + 64 * wc; mode = 2; gain = kng; } else col = Q_GQAV + 64 * (wc - 2); }
            else if (t == 8) { col = Q_WINQ + 64 * wc; mode = 1; scale = 0.125f * LOG2E; }
            else { if (wc < 2) { col = Q_WINK + 64 * wc; mode = 1; } else col = Q_WINV + 64 * (wc - 2); } }
        if (mode == 3) return;
        f32x4 ga0 = {1.f, 1.f, 1.f, 1.f}, ga1 = ga0, gb0 = ga0, gb1 = ga0;
        if (mode == 2) { ga0 = *(const GAS f32x4*)(gain + 8 * fq); ga1 = *(const GAS f32x4*)(gain + 8 * fq + 4); gb0 = *(const GAS f32x4*)(gain + 32 + 8 * fq); gb1 = *(const GAS f32x4*)(gain + 32 + 8 * fq + 4); }
        const bool half_only = (t == 5 && wc == 2);
#pragma unroll
        for (int ai = 0; ai < 2; ++ai)
#pragma unroll
            for (int m = 0; m < 4; ++m) {
                const int row = row0 + ai * 128 + m * 16;
                f32x4 a0 = acc[ai][0][m][0], a1 = acc[ai][0][m][1], b0 = acc[ai][1][m][0], b1 = acc[ai][1][m][1];
                if (mode == 2) {
                    float ss = 0.f;
#pragma unroll
                    for (int j = 0; j < 4; ++j) ss += a0[j] * a0[j] + a1[j] * a1[j] + b0[j] * b0[j] + b1[j] * b1[j];
                    ss = xadd<16>(ss); ss = xadd<32>(ss);
                    const float rstd = __builtin_amdgcn_rsqf(ss * (1.f / 64.f) + EPS);
                    a0 = a0 * rstd * ga0; a1 = a1 * rstd * ga1; b0 = b0 * rstd * gb0; b1 = b1 * rstd * gb1;
                }
                if (mode >= 1) {
                    if (row < TL) { const int pos = row & 2047;
                        const f32x4 c0 = *(const GAS f32x4*)(cos64 + pos * 32 + 8 * fq), c1 = *(const GAS f32x4*)(cos64 + pos * 32 + 8 * fq + 4);
                        const f32x4 s0 = *(const GAS f32x4*)(sin64 + pos * 32 + 8 * fq), s1 = *(const GAS f32x4*)(sin64 + pos * 32 + 8 * fq + 4);
                        const f32x4 o0 = a0 * c0 - b0 * s0, o1 = a1 * c1 - b1 * s1, p0 = b0 * c0 + a0 * s0, p1 = b1 * c1 + a1 * s1;
                        a0 = o0; a1 = o1; b0 = p0; b1 = p1; }
                    a0 = a0 * scale; a1 = a1 * scale; b0 = b0 * scale; b1 = b1 * scale;
                }
                bf16_t* rp = dst + (size_t)row * ld + col + 8 * fq;
                u32x4 w; w.x = pk2(a0[0], a0[1]); w.y = pk2(a0[2], a0[3]); w.z = pk2(a1[0], a1[1]); w.w = pk2(a1[2], a1[3]);
                *(GAS u32x4*)rp = w;
                if (!half_only) { u32x4 w2; w2.x = pk2(b0[0], b0[1]); w2.y = pk2(b0[2], b0[3]); w2.z = pk2(b1[0], b1[1]); w2.w = pk2(b1[2], b1[3]); *(GAS u32x4*)(rp + 32) = w2; }
                asm volatile("" ::: "memory");
            }
    }
};
struct SchedE {
    int G, c, nM; const char* Y; const char* W;
    __device__ __forceinline__ bool next(int i, Unit& u) const { const int L = i * G + c; u.aux = 0; if (L >= nM * 4) return false; pg8::tile_order(L, nM, 4, u.pm, u.pn); return true; }
    __device__ __forceinline__ void ptrs(const Unit& u, const char*& A, const char*& B) const { A = Y + (size_t)u.pm * 256 * 1024 * 2; B = W + (size_t)u.pn * 256 * 1024 * 2; }
    __device__ __forceinline__ int arow(const Unit&, int r) const { return r; }
    __device__ __forceinline__ bool fresh(const Unit&) const { return true; }
};
struct EpiE {
    static constexpr bool PERM = true, MID = true;
    const bf16_t* Gt; bf16_t* M;
    __device__ __forceinline__ void mid(f32x4 (&acc)[2][2][4][2], const Unit& u, int i, int wr, int wc, int fr, int fq) const {
        const int row0 = u.pm * 256 + wr * 64 + fr;
        const int col0 = u.pn * 256 + wc * 32 + 8 * fq;
        const bf16_t* gp0 = Gt + (size_t)row0 * NGATE + (i - 1) * 1024 + col0;
        u32x4 g[2][4][2];
#pragma unroll
        for (int ai = 0; ai < 2; ++ai)
#pragma unroll
            for (int m = 0; m < 4; ++m)
#pragma unroll
                for (int bj = 0; bj < 2; ++bj) g[ai][m][bj] = *(const GAS u32x4*)(gp0 + (size_t)(ai * 128 + m * 16) * NGATE + bj * 128);
#pragma unroll
        for (int ai = 0; ai < 2; ++ai)
#pragma unroll
            for (int m = 0; m < 4; ++m)
#pragma unroll
                for (int bj = 0; bj < 2; ++bj) { const u32x4 gg = g[ai][m][bj];
                    const f32x4 s0 = {bflo(gg.x), bfhi(gg.x), bflo(gg.y), bfhi(gg.y)}, s1 = {bflo(gg.z), bfhi(gg.z), bflo(gg.w), bfhi(gg.w)};
                    acc[ai][bj][m][0] = acc[ai][bj][m][0] * s0; acc[ai][bj][m][1] = acc[ai][bj][m][1] * s1; }
    }
    __device__ __forceinline__ void operator()(f32x4 (&acc)[2][2][4][2], const Unit& u, int wr, int wc, int fr, int fq) const {
        const int row0 = u.pm * 256 + wr * 64 + fr, col0 = u.pn * 256 + wc * 32 + 8 * fq;
#pragma unroll
        for (int ai = 0; ai < 2; ++ai)
#pragma unroll
            for (int m = 0; m < 4; ++m) { const size_t row = (size_t)(row0 + ai * 128 + m * 16);
#pragma unroll
                for (int bj = 0; bj < 2; ++bj) {
                    const u32x4 g = *(const GAS u32x4*)(Gt + row * NGATE + 3 * 1024 + col0 + bj * 128);
                    const f32x4 s0 = {bflo(g.x), bfhi(g.x), bflo(g.y), bfhi(g.y)}, s1 = {bflo(g.z), bfhi(g.z), bflo(g.w), bfhi(g.w)};
                    const f32x4 v0 = acc[ai][bj][m][0] * s0, v1 = acc[ai][bj][m][1] * s1;
                    u32x4 w; w.x = pk2(v0[0], v0[1]); w.y = pk2(v0[2], v0[3]); w.z = pk2(v1[0], v1[1]); w.w = pk2(v1[2], v1[3]);
                    *(GAS u32x4*)(M + row * 1024 + col0 + bj * 128) = w;
                } }
    }
};
struct SchedF {
    int G, c, nM; const char* A0; const char* W;
    __device__ __forceinline__ bool next(int i, Unit& u) const { const int L = i * G + c; u.aux = 0; if (L >= nM * 4) return false; pg8::tile_order(L, nM, 4, u.pm, u.pn); return true; }
    __device__ __forceinline__ void ptrs(const Unit& u, const char*& A, const char*& B) const { A = A0 + (size_t)u.pm * 256 * 1024 * 2; B = W + (size_t)u.pn * 256 * 1024 * 2; }
    __device__ __forceinline__ int arow(const Unit&, int r) const { return r; }
    __device__ __forceinline__ bool fresh(const Unit&) const { return true; }
};
struct EpiF {
    static constexpr bool PERM = false, MID = false;
    const float* xin; const float* cin; const bf16_t* Xs; bf16_t* X; const float* ada_l; int layer;
    __device__ __forceinline__ void operator()(f32x4 (&acc)[2][2][4][2], const Unit& u, int wr, int wc, int fr, int fq) const {
        const int row0 = u.pm * 256 + wr * 64 + fr, col0 = u.pn * 256 + wc * 32 + 4 * fq;
#pragma unroll
        for (int ai = 0; ai < 2; ++ai)
#pragma unroll
            for (int m = 0; m < 4; ++m) { const int row = row0 + ai * 128 + m * 16; const int b = row < TL ? (row >> 11) : 8;
                const float* src = row < TL ? xin + (size_t)row * 1024 : cin + (size_t)(row - TL) * 1024;
                const float* g1 = ada_l + (size_t)b * 6144 + 2048;
#pragma unroll
                for (int bj = 0; bj < 2; ++bj)
#pragma unroll
                    for (int n = 0; n < 2; ++n) { const int c = col0 + bj * 128 + n * 16;
                        const f32x4 xs = (layer == 0) ? *(const GAS f32x4*)(src + c) : xres_ld(Xs + (size_t)row * 1024 + c); const f32x4 gg = *(const GAS f32x4*)(g1 + c);
                        xres_st(X + (size_t)row * 1024 + c, xs + gg * acc[ai][bj][m][n]); } }
    }
};
struct SchedMoe {
    int G, c, npn, gather; const LAS int* tb; const LAS int* cn; const int* tokinv; const char* A0; const char* W; size_t wstride;
    __device__ __forceinline__ bool next(int i, Unit& u) const {
        const int L = i * G + c; if (L >= __builtin_amdgcn_readfirstlane(tb[32]) * npn) return false;
        const int rt = L / npn; u.pm = rt; u.pn = L - rt * npn; u.aux = __builtin_amdgcn_readfirstlane(tb[48 + rt]); return true;
    }
    __device__ __forceinline__ void ptrs(const Unit& u, const char*& A, const char*& B) const {
        A = gather ? A0 : A0 + (size_t)u.pm * 256 * 1024; B = W + (size_t)(u.aux & 255) * wstride + (size_t)u.pn * 256 * 1024; }
    __device__ __forceinline__ int arow(const Unit& u, int r) const { const int e = u.aux & 255, idx = (u.aux >> 8) * 256 + r; return idx < cn[e] ? tokinv[(size_t)e * TT + idx] : 0; }
    __device__ __forceinline__ bool fresh(const Unit&) const { return true; }
};
struct EpiH {
    static constexpr bool PERM = true, MID = false;
    unsigned char* HID;
    __device__ __forceinline__ void operator()(f32x4 (&acc)[2][2][4][2], const Unit& u, int wr, int wc, int fr, int fq) const {
        const int row0 = u.pm * 256 + wr * 64 + fr, col0 = u.pn * 128 + wc * 32 + 8 * fq;
#pragma unroll
        for (int ai = 0; ai < 2; ++ai)
#pragma unroll
            for (int m = 0; m < 4; ++m) { f32x4 h0, h1;
#pragma unroll
                for (int j = 0; j < 4; ++j) { const float a0 = acc[ai][0][m][0][j], a1 = acc[ai][0][m][1][j];
                    h0[j] = a0 * sigmoidf_(a0) * acc[ai][1][m][0][j]; h1[j] = a1 * sigmoidf_(a1) * acc[ai][1][m][1][j]; }
                u32x2 w; w.x = pk4_fp8(4.f * h0[0], 4.f * h0[1], 4.f * h0[2], 4.f * h0[3]); w.y = pk4_fp8(4.f * h1[0], 4.f * h1[1], 4.f * h1[2], 4.f * h1[3]);
                *(GAS u32x2*)(HID + (size_t)(row0 + ai * 128 + m * 16) * 1024 + col0) = w; }
    }
};
struct EpiI {
    static constexpr bool PERM = true, MID = false;
    bf16_t* Y2;
    __device__ __forceinline__ void operator()(f32x4 (&acc)[2][2][4][2], const Unit& u, int wr, int wc, int fr, int fq) const {
        const int row0 = u.pm * 256 + wr * 64 + fr, col0 = u.pn * 256 + wc * 32 + 8 * fq;
#pragma unroll
        for (int ai = 0; ai < 2; ++ai)
#pragma unroll
            for (int m = 0; m < 4; ++m)
#pragma unroll
                for (int bj = 0; bj < 2; ++bj) { const f32x4 v0 = acc[ai][bj][m][0], v1 = acc[ai][bj][m][1];
                    u32x4 w; w.x = pk2(v0[0], v0[1]); w.y = pk2(v0[2], v0[3]); w.z = pk2(v1[0], v1[1]); w.w = pk2(v1[2], v1[3]);
                    *(GAS u32x4*)(Y2 + (size_t)(row0 + ai * 128 + m * 16) * 1024 + col0 + bj * 128) = w; }
    }
};

__device__ __forceinline__ void rope_item_desc(int item, int& src, int& dst, float& scale, int& normsel) {
    normsel = 0; scale = 1.f;
    if (item < 4) { src = P_RET + item * 64; dst = Q_RETQ + item * 64; scale = 0.125f; }
    else if (item < 8) { src = P_RET + 256 + (item - 4) * 64; dst = Q_RETK + (item - 4) * 64; }
    else if (item < 12) { src = P_GQA + (item - 8) * 64; dst = Q_GQAQ + (item - 8) * 64; scale = 0.125f * LOG2E; normsel = 1; }
    else if (item < 14) { src = P_GQA + 256 + (item - 12) * 64; dst = Q_GQAK + (item - 12) * 64; normsel = 2; }
    else if (item < 16) { src = P_WIN + 256 + (item - 14) * 64; dst = Q_WINK + (item - 14) * 64; }
    else { src = P_WIN + (item - 16) * 64; dst = Q_WINQ + (item - 16) * 64; scale = 0.125f * LOG2E; }
}
__device__ __forceinline__ void phase_post(KArgs a, int l, LAS unsigned char* lds, int lane, int wave, int G, int c) {
    unsigned char* ws = a->ws;
    const bf16_t* P = (const bf16_t*)(ws + WS_P); bf16_t* Q = (bf16_t*)(ws + WS_QKV);
    const float* cos32 = (const float*)(ws + WS_ROPE) + 2 * 2048 * 32; const float* sin32 = cos32 + 2048 * 16;
    const bf16_t* Wuq = (const bf16_t*)(ws + WS_WSM) + (size_t)l * 384 * 256; const bf16_t* Wukv = (const bf16_t*)(ws + WS_WSM) + 2 * 384 * 256 + (size_t)l * 512 * 128;
    const float qscale = 0.10206207261596577f * LOG2E;
    const unsigned ldsb = (unsigned)(uintptr_t)lds;
    constexpr int LQ = 0, LKV = 49152;
    constexpr int NU = (TT / 128) * 4;
    const int tk = lane & 15, kq = lane >> 4;
    int hcur = -1;
    bf16x8 zqN[8], zkvN[4]; u32x2 kr1N, kr2N; f32x4 crN, srN;
#define PP_LOAD(u_) do { const int row_ = ((u_) >> 2) * 128 + wave * 16 + tk; const bf16_t* prow_ = P + (size_t)row_ * NINP + P_MLA; \
        _Pragma("unroll") for (int s2 = 0; s2 < 8; ++s2) zqN[s2] = *(const GAS bf16x8*)(prow_ + 32 * s2 + 8 * kq); \
        _Pragma("unroll") for (int s2 = 0; s2 < 4; ++s2) zkvN[s2] = *(const GAS bf16x8*)(prow_ + 256 + 32 * s2 + 8 * kq); \
        kr1N = *(const GAS u32x2*)(prow_ + 384 + 4 * kq); kr2N = *(const GAS u32x2*)(prow_ + 400 + 4 * kq); \
        crN = (f32x4){1.f, 1.f, 1.f, 1.f}; srN = (f32x4){0.f, 0.f, 0.f, 0.f}; \
        if (row_ < TL) { const int pos_ = row_ & 2047; crN = *(const GAS f32x4*)(cos32 + pos_ * 16 + 4 * kq); srN = *(const GAS f32x4*)(sin32 + pos_ * 16 + 4 * kq); } } while (0)
    if (c < NU) PP_LOAD(c);
    for (int u = c; u < NU; u += G) {
        const int h = u & 3, rb = u >> 2;
        if (h != hcur) {
            asm volatile("s_waitcnt lgkmcnt(0)\n\ts_barrier" ::: "memory");
            for (int p = wave; p < 80; p += NWAVES) {
                if (p < 48) { const int row = 2 * p + (lane >> 5), ch = (lane & 31) ^ (row & 15);
                    glds16(Wuq + (size_t)(96 * h + row) * 256 + 8 * ch, (unsigned)__builtin_amdgcn_readfirstlane((int)(ldsb + LQ + p * 1024))); }
                else { const int p2 = p - 48, row = 4 * p2 + (lane >> 4), ch = (lane & 15) ^ (row & 15);
                    glds16(Wukv + (size_t)(128 * h + row) * 128 + 8 * ch, (unsigned)__builtin_amdgcn_readfirstlane((int)(ldsb + LKV + p2 * 1024))); }
            }
            asm volatile("s_waitcnt vmcnt(0)\n\ts_barrier" ::: "memory");
            hcur = h;
        }
        const int row = rb * 128 + wave * 16 + tk;
        bf16_t* qrow = Q + (size_t)row * QP;
        bf16x8 zq[8], zkv[4];
#pragma unroll
        for (int s2 = 0; s2 < 8; ++s2) zq[s2] = zqN[s2];
#pragma unroll
        for (int s2 = 0; s2 < 4; ++s2) zkv[s2] = zkvN[s2];
        const u32x2 kr1 = kr1N, kr2 = kr2N; const f32x4 cr = crN, sr = srN;
        if (u + G < NU) PP_LOAD(u + G);
        float sq = 0.f, skv = 0.f;
#pragma unroll
        for (int s2 = 0; s2 < 8; ++s2)
#pragma unroll
            for (int j = 0; j < 8; ++j) { const float f = bf2f((unsigned short)zq[s2][j]); sq += f * f; }
#pragma unroll
        for (int s2 = 0; s2 < 4; ++s2)
#pragma unroll
            for (int j = 0; j < 8; ++j) { const float f = bf2f((unsigned short)zkv[s2][j]); skv += f * f; }
        sq = xadd<16>(sq); sq = xadd<32>(sq); skv = xadd<16>(skv); skv = xadd<32>(skv);
        const float rq = (1.0f / sqrtf(sq * (1.f / 256.f) + EPS)) * qscale, rkv = 1.0f / sqrtf(skv * (1.f / 128.f) + EPS);
        f32x4 acc[6];
#pragma unroll
        for (int p = 0; p < 6; p += 2) {
            bf16x8 w0[8], w1[8];
#pragma unroll
            for (int s2 = 0; s2 < 8; ++s2) { w0[s2] = *(const LAS bf16x8*)(lds + LQ + (16 * p + tk) * 512 + (((4 * s2 + kq) ^ tk) * 16)); w1[s2] = *(const LAS bf16x8*)(lds + LQ + (16 * (p + 1) + tk) * 512 + (((4 * s2 + kq) ^ tk) * 16)); }
            acc[p] = (f32x4){0.f, 0.f, 0.f, 0.f}; acc[p + 1] = (f32x4){0.f, 0.f, 0.f, 0.f};
#pragma unroll
            for (int s2 = 0; s2 < 8; ++s2) { acc[p] = __builtin_amdgcn_mfma_f32_16x16x32_bf16(w0[s2], zq[s2], acc[p], 0, 0, 0); acc[p + 1] = __builtin_amdgcn_mfma_f32_16x16x32_bf16(w1[s2], zq[s2], acc[p + 1], 0, 0, 0); }
        }
#pragma unroll
        for (int p = 0; p < 4; ++p) { const f32x4 v = acc[p] * rq; u32x2 o; o.x = pk2(v[0], v[1]); o.y = pk2(v[2], v[3]); *(GAS u32x2*)(qrow + Q_MLAQ + h * 96 + 16 * p + 4 * kq) = o; }
        { const f32x4 x1 = acc[4] * rq, x2 = acc[5] * rq; const f32x4 o1 = x1 * cr - x2 * sr, o2 = x2 * cr + x1 * sr;
          u32x2 w1; w1.x = pk2(o1[0], o1[1]); w1.y = pk2(o1[2], o1[3]); u32x2 w2; w2.x = pk2(o2[0], o2[1]); w2.y = pk2(o2[2], o2[3]);
          *(GAS u32x2*)(qrow + Q_MLAQ + h * 96 + 64 + 4 * kq) = w1; *(GAS u32x2*)(qrow + Q_MLAQ + h * 96 + 80 + 4 * kq) = w2; }
#pragma unroll
        for (int p = 0; p < 8; p += 2) {
            bf16x8 w0[4], w1[4];
#pragma unroll
            for (int s2 = 0; s2 < 4; ++s2) { w0[s2] = *(const LAS bf16x8*)(lds + LKV + (16 * p + tk) * 256 + (((4 * s2 + kq) ^ tk) * 16)); w1[s2] = *(const LAS bf16x8*)(lds + LKV + (16 * (p + 1) + tk) * 256 + (((4 * s2 + kq) ^ tk) * 16)); }
            f32x4 a0 = {0.f, 0.f, 0.f, 0.f}, a1 = a0;
#pragma unroll
            for (int s2 = 0; s2 < 4; ++s2) { a0 = __builtin_amdgcn_mfma_f32_16x16x32_bf16(w0[s2], zkv[s2], a0, 0, 0, 0); a1 = __builtin_amdgcn_mfma_f32_16x16x32_bf16(w1[s2], zkv[s2], a1, 0, 0, 0); }
#pragma unroll
            for (int e = 0; e < 2; ++e) { const int pp = p + e; const f32x4 v = (e ? a1 : a0) * rkv; u32x2 o; o.x = pk2(v[0], v[1]); o.y = pk2(v[2], v[3]);
                const int col = pp < 4 ? Q_MLAK + h * 96 + 16 * pp + 4 * kq : Q_MLAV + h * 64 + 16 * (pp - 4) + 4 * kq;
                *(GAS u32x2*)(qrow + col) = o; }
        }
        if (h == 0) {
            const f32x4 x1 = {bflo(kr1.x), bfhi(kr1.x), bflo(kr1.y), bfhi(kr1.y)}, x2 = {bflo(kr2.x), bfhi(kr2.x), bflo(kr2.y), bfhi(kr2.y)};
            const f32x4 o1 = x1 * cr - x2 * sr, o2 = x2 * cr + x1 * sr;
            u32x2 w1; w1.x = pk2(o1[0], o1[1]); w1.y = pk2(o1[2], o1[3]); u32x2 w2; w2.x = pk2(o2[0], o2[1]); w2.y = pk2(o2[2], o2[3]);
#pragma unroll
            for (int hh = 0; hh < 4; ++hh) { *(GAS u32x2*)(qrow + Q_MLAK + hh * 96 + 64 + 4 * kq) = w1; *(GAS u32x2*)(qrow + Q_MLAK + hh * 96 + 80 + 4 * kq) = w2; }
        }
    }
#undef PP_LOAD
    asm volatile("s_waitcnt lgkmcnt(0)\n\ts_barrier" ::: "memory");
}

__device__ __forceinline__ void phase_router(KArgs a, int l, int nrows, LAS unsigned char* lds, int tid, int lane, int wave, int G, int c) {
    unsigned char* ws = a->ws;
    const bf16_t* X = (const bf16_t*)(ws + WS_X); unsigned char* H = (unsigned char*)(ws + WS_H);
    const float* ada = (const float*)(ws + WS_ADA); const float* wrp = (const float*)(ws + WS_WRP);
    const float* gn = a->in[I_N2G] + l * 1024; const float* brt = a->in[I_BR];
    unsigned* ctl = (unsigned*)(ws + WS_CTL);
    int* tokinv = (int*)(ws + WS_TOKINV); int* toke = (int*)(ws + WS_TOKE); float* tokw = (float*)(ws + WS_TOKW);
    const int tk = lane & 15, q = lane >> 4;
    f32x4 wr0[8], wr1[8];
    { const float* p0 = wrp + (((0 * 8 + wave) * 4 + q) * 16 + tk) * 32; const float* p1 = wrp + (((1 * 8 + wave) * 4 + q) * 16 + tk) * 32;
#pragma unroll
      for (int s = 0; s < 8; ++s) { wr0[s] = *(const GAS f32x4*)(p0 + 4 * s); wr1[s] = *(const GAS f32x4*)(p1 + 4 * s); } }
    LAS float* hb = (LAS float*)lds;
    LAS float* part = (LAS float*)(lds + 16 * 4112);
    LAS float* lgs = part + 8 * 16 * 32;
    for (int g = c; g < nrows / 16; g += G) {
        f32x4 v[2][4];
#pragma unroll
        for (int rr = 0; rr < 2; ++rr) { const bf16_t* xr = X + (size_t)(g * 16 + 2 * wave + rr) * 1024;
#pragma unroll
            for (int j = 0; j < 4; ++j) v[rr][j] = xres_ld(xr + 4 * lane + 256 * j); }
#pragma unroll
        for (int rr = 0; rr < 2; ++rr) {
            const int row = g * 16 + 2 * wave + rr, b = row < TL ? (row >> 11) : 8;
            float ss = 0.f;
#pragma unroll
            for (int j = 0; j < 4; ++j) ss += (v[rr][j].x * v[rr][j].x + v[rr][j].y * v[rr][j].y) + (v[rr][j].z * v[rr][j].z + v[rr][j].w * v[rr][j].w);
            const float rstd = 1.0f / sqrtf(wave_sum(ss) * (1.f / 1024.f) + EPS);
            const float* sh = ada + ((size_t)l * 9 + b) * 6144 + 3072; const float* sc = sh + 1024;
#pragma unroll
            for (int j = 0; j < 4; ++j) { const int cc = 4 * lane + 256 * j; const f32x4 gg = *(const GAS f32x4*)(gn + cc), s1 = *(const GAS f32x4*)(sc + cc), s0 = *(const GAS f32x4*)(sh + cc);
                const f32x4 h = v[rr][j] * rstd * gg * (s1 + 1.0f) + s0;
                *(GAS unsigned*)(H + (size_t)row * 1024 + cc) = pk4_fp8(h.x, h.y, h.z, h.w);
                *(LAS f32x4*)(hb + (2 * wave + rr) * 1028 + cc) = h; }
        }
        __syncthreads();
        f32x4 acc0 = {0.f, 0.f, 0.f, 0.f}, acc1 = {0.f, 0.f, 0.f, 0.f};
#pragma unroll
        for (int s = 0; s < 8; ++s) { const f32x4 a4 = *(const LAS f32x4*)(hb + tk * 1028 + 128 * wave + 32 * q + 4 * s);
#pragma unroll
            for (int j = 0; j < 4; ++j) { acc0 = __builtin_amdgcn_mfma_f32_16x16x4f32(a4[j], wr0[s][j], acc0, 0, 0, 0); acc1 = __builtin_amdgcn_mfma_f32_16x16x4f32(a4[j], wr1[s][j], acc1, 0, 0, 0); } }
#pragma unroll
        for (int r = 0; r < 4; ++r) { part[(wave * 16 + 4 * q + r) * 32 + tk] = acc0[r]; part[(wave * 16 + 4 * q + r) * 32 + 16 + tk] = acc1[r]; }
        __syncthreads();
        LAS float* selv = lgs + 512;
        { float sum = 0.f;
#pragma unroll
          for (int w = 0; w < 8; ++w) sum += part[w * 512 + tid];
          const float sg = 1.0f / (1.0f + __expf(-sum)); lgs[tid] = sg; selv[tid] = sg + brt[tid & 31]; }
        __syncthreads();
        if (wave == 0 && lane < 16) {
            const LAS float* my = selv + lane * 32; const LAS float* mys = lgs + lane * 32;
            float gs[4];
#pragma unroll
            for (int g4 = 0; g4 < 4; ++g4) { float m1 = -1e30f, m2 = -1e30f;
#pragma unroll
                for (int j = 0; j < 8; ++j) { const float vv = my[g4 * 8 + j];
                    if (vv > m1) { m2 = m1; m1 = vv; } else if (vv > m2) m2 = vv; }
                gs[g4] = m1 + m2; }
            int gsel = 0; float gb = gs[0];
#pragma unroll
            for (int g4 = 1; g4 < 4; ++g4) if (gs[g4] > gb) { gb = gs[g4]; gsel = g4; }
            float v1 = -1e30f, v2 = -1e30f, s1v = 0.f, s2v = 0.f; int e1 = 0, e2 = 0;
#pragma unroll
            for (int j = 0; j < 8; ++j) { const int e = gsel * 8 + j; const float sg = mys[e]; const float vv = my[e];
                if (vv > v1) { v2 = v1; e2 = e1; s2v = s1v; v1 = vv; e1 = e; s1v = sg; } else if (vv > v2) { v2 = vv; e2 = e; s2v = sg; } }
            const float inv = 1.0f / (s1v + s2v);
            const int myrow = g * 16 + lane;
            const int p1 = (int)__hip_atomic_fetch_add(ctl + CW_CNT + l * 32 + e1, 1u, __ATOMIC_RELAXED, __HIP_MEMORY_SCOPE_AGENT);
            const int p2 = (int)__hip_atomic_fetch_add(ctl + CW_CNT + l * 32 + e2, 1u, __ATOMIC_RELAXED, __HIP_MEMORY_SCOPE_AGENT);
            tokinv[(size_t)e1 * TT + p1] = myrow; tokinv[(size_t)e2 * TT + p2] = myrow;
            toke[myrow * 2] = (e1 << 20) | p1; toke[myrow * 2 + 1] = (e2 << 20) | p2;
            tokw[myrow * 2] = s1v * inv; tokw[myrow * 2 + 1] = s2v * inv;
        }
    }
    __syncthreads();
}

__device__ __forceinline__ float max3f(float a, float b, float c) { float r; asm("v_max3_f32 %0, %1, %2, %3" : "=v"(r) : "v"(a), "v"(b), "v"(c)); return r; }
__device__ __forceinline__ int crow(int r, int hi) { return (r & 3) + 8 * (r >> 2) + 4 * hi; }
__device__ __forceinline__ s16x4 tr_read(const LAS unsigned char* p) { typedef short v4s __attribute__((ext_vector_type(4))); return __builtin_bit_cast(s16x4, __builtin_amdgcn_ds_read_tr16_b64_v4i16((LAS v4s*)p)); }
constexpr int AT_FAC = 124928, AT_SCRW = 8448;
__device__ __forceinline__ void at_wait_bar(int n) {
    switch (n) {
        case 0: asm volatile("s_waitcnt vmcnt(0)\n\ts_barrier" ::: "memory"); break;
        case 2: asm volatile("s_waitcnt vmcnt(2)\n\ts_barrier" ::: "memory"); break;
        case 3: asm volatile("s_waitcnt vmcnt(3)\n\ts_barrier" ::: "memory"); break;
        case 4: asm volatile("s_waitcnt vmcnt(4)\n\ts_barrier" ::: "memory"); break;
        case 6: asm volatile("s_waitcnt vmcnt(6)\n\ts_barrier" ::: "memory"); break;
        case 8: asm volatile("s_waitcnt vmcnt(8)\n\ts_barrier" ::: "memory"); break;
        case 9: asm volatile("s_waitcnt vmcnt(9)\n\ts_barrier" ::: "memory"); break;
        default: asm volatile("s_waitcnt vmcnt(0)\n\ts_barrier" ::: "memory"); break;
    }
}
__device__ __forceinline__ void at_wait_bar2(int n) {
    switch (n) {
        case 0: asm volatile("s_waitcnt vmcnt(0) lgkmcnt(0)\n\ts_barrier" ::: "memory"); break;
        case 2: asm volatile("s_waitcnt vmcnt(2) lgkmcnt(0)\n\ts_barrier" ::: "memory"); break;
        case 3: asm volatile("s_waitcnt vmcnt(3) lgkmcnt(0)\n\ts_barrier" ::: "memory"); break;
        case 4: asm volatile("s_waitcnt vmcnt(4) lgkmcnt(0)\n\ts_barrier" ::: "memory"); break;
        case 6: asm volatile("s_waitcnt vmcnt(6) lgkmcnt(0)\n\ts_barrier" ::: "memory"); break;
        default: if (n < 0) asm volatile("s_waitcnt lgkmcnt(0)\n\ts_barrier" ::: "memory"); else asm volatile("s_waitcnt vmcnt(0) lgkmcnt(0)\n\ts_barrier" ::: "memory"); break;
    }
}
template <int kind>
__device__ __forceinline__ void attn_unit(const bf16_t* Q, bf16_t* Y, const int b, const int hq, const int qb, const bool ctxq, const float sinkl2, const float lf2, const float lb2,
                                          LAS unsigned char* lds, const int tid, const int lane, const int wave, const int tilecap) {
    constexpr int DQK = kind == 0 ? 96 : 64;
    constexpr int KS = DQK == 64 ? 128 : 256, NS = DQK / 16, SLOTK = 64 * KS, SLOT = SLOTK + 8192, NL = DQK == 64 ? 2 : 3, NSLOT = DQK == 64 ? 6 : 5;
    constexpr float THR = 8.0f;
    constexpr int KW = 2, KP = NS / KW;
    static_assert(NSLOT * SLOT <= AT_FAC && 8 * AT_SCRW <= AT_FAC && AT_FAC + 1024 <= LDS_MISC, "attention LDS map");
    int qcol, kcol, vcol, ycol, gcol = 0;
    if (kind == 0) { qcol = Q_MLAQ + hq * 96; kcol = Q_MLAK + hq * 96; vcol = Q_MLAV + hq * 64; ycol = 256 + hq * 64; }
    else if (kind == 1) { qcol = Q_GQAQ + hq * 64; kcol = Q_GQAK + (hq >> 1) * 64; vcol = Q_GQAV + (hq >> 1) * 64; ycol = 512 + hq * 64; }
    else if (kind == 2) { qcol = Q_RETQ + hq * 64; kcol = Q_RETK + hq * 64; vcol = Q_RETV + hq * 64; ycol = hq * 64; gcol = Q_RETG + hq * 64; }
    else { qcol = Q_WINQ + hq * 64; kcol = Q_WINK + (hq >> 1) * 64; vcol = Q_WINV + (hq >> 1) * 64; ycol = 768 + hq * 64; }
    const int r32 = lane & 31, hi = lane >> 5;
    const int qrow0 = (ctxq ? TL + b * 256 : b * 2048 + qb * 256) + 32 * wave;
    const int qpos = (ctxq ? 0 : qb * 256) + 32 * wave + r32;
    int lt0 = 0, nlat = 32;
    if (ctxq) nlat = 0;
    else if (kind == 3) { lt0 = 4 * qb - 2 < 0 ? 0 : 4 * qb - 2; const int lt1 = 4 * qb + 6 > 32 ? 32 : 4 * qb + 6; nlat = lt1 - lt0; }
    const int ntile = (4 + nlat) < tilecap ? (4 + nlat) : tilecap;
    bf16x8 qf[NS];
#pragma unroll
    for (int s = 0; s < NS; ++s) qf[s] = *(const GAS bf16x8*)(Q + (size_t)(qrow0 + r32) * QP + qcol + 16 * s + 8 * hi);
    f32x4 cfa = {}, cfq = {}, cba = {}, cbq = {}; float g32f = 0.f, g32b = 0.f;
    if constexpr (kind == 2) {
#pragma unroll
        for (int i = 0; i < 4; ++i) { cfa[i] = __builtin_bit_cast(float, __builtin_amdgcn_readfirstlane(__builtin_bit_cast(int, fast_exp2(lf2 * (float)(3 - i))))); cfq[i] = fast_exp2(lf2 * (float)(28 - 4 * hi - 8 * i));
            cba[i] = __builtin_bit_cast(float, __builtin_amdgcn_readfirstlane(__builtin_bit_cast(int, fast_exp2(lb2 * (float)i)))); cbq[i] = fast_exp2(lb2 * (float)(8 * i + 4 * hi)); }
        g32f = __builtin_bit_cast(float, __builtin_amdgcn_readfirstlane(__builtin_bit_cast(int, fast_exp2(32.f * lf2)))); g32b = __builtin_bit_cast(float, __builtin_amdgcn_readfirstlane(__builtin_bit_cast(int, fast_exp2(32.f * lb2))));
    }
#define AT_TILE_ROW0(t) ((t) < 4 ? TL + b * 256 + 64 * (t) : b * 2048 + 64 * (lt0 + (t) - 4))
#define AT_ISSUE(t) do { const bf16_t* tb_ = Q + (size_t)AT_TILE_ROW0(t) * QP; const unsigned sl_ = (unsigned)__builtin_amdgcn_readfirstlane((int)(ldsb + ((t) % NSLOT) * SLOT + wave * 1024 * (DQK == 64 ? 1 : 2))); \
        int ln_ = lane; asm volatile("" : "+v"(ln_)); \
        const int vrow_ = 8 * wave + (ln_ >> 3); const int vsrc_ = vrow_ * QP + vcol + 8 * ((ln_ & 7) ^ (((vrow_ >> 1) & 1) << 2)); \
        if constexpr (DQK == 64) { const int ks_ = vrow_ * QP + kcol + 8 * ((ln_ & 7) ^ ((vrow_ >> 1) & 7)); glds16(tb_ + ks_, sl_); glds16(tb_ + vsrc_, sl_ + SLOTK); } \
        else { const int kr0_ = 8 * wave + (ln_ >> 4), kr1_ = kr0_ + 4; int c0_ = (ln_ & 15) ^ (kr0_ & 15), c1_ = (ln_ & 15) ^ (kr1_ & 15); if (c0_ >= 12) c0_ = 0; if (c1_ >= 12) c1_ = 0; \
            glds16(tb_ + kr0_ * QP + kcol + 8 * c0_, sl_); glds16(tb_ + kr1_ * QP + kcol + 8 * c1_, sl_ + 1024); \
            glds16(tb_ + vsrc_, (unsigned)__builtin_amdgcn_readfirstlane((int)(ldsb + ((t) % NSLOT) * SLOT + SLOTK + wave * 1024))); } } while (0)
    const unsigned ldsb = (unsigned)(uintptr_t)lds;
    const int kkey = DQK == 64 ? ((r32 >> 1) & 7) : (r32 & 15);
    const unsigned krd = r32 * KS + 16 * (hi ^ (kkey & 1)) + 32 * (kkey >> 1);
#define AT_KLOAD(KF, t, S0, S1) do { unsigned ka_ = (unsigned)(uintptr_t)(lds + ((t) % NSLOT) * SLOT) + krd; asm volatile("" : "+v"(ka_)); \
        _Pragma("unroll") for (int s = (S0); s < (S1); ++s) { const LAS unsigned char* kp_ = (const LAS unsigned char*)(uintptr_t)(ka_ ^ (unsigned)(32 * s)); \
            KF[2 * (s - (S0))] = *(const LAS bf16x8*)(kp_); KF[2 * (s - (S0)) + 1] = *(const LAS bf16x8*)(kp_ + 32 * KS); } } while (0)
#define AT_QKMR(P0, P1, KF, PART) do { _Pragma("unroll") for (int s = (PART) * KW; s < ((PART) + 1) * KW; ++s) { \
        if ((PART) == 0 && s == 0) { const f32x16 z_ = {}; P0 = __builtin_amdgcn_mfma_f32_32x32x16_bf16(KF[0], qf[0], z_, 0, 0, 0); P1 = __builtin_amdgcn_mfma_f32_32x32x16_bf16(KF[1], qf[0], z_, 0, 0, 0); } \
        else { P0 = __builtin_amdgcn_mfma_f32_32x32x16_bf16(KF[2 * (s - (PART) * KW)], qf[s], P0, 0, 0, 0); P1 = __builtin_amdgcn_mfma_f32_32x32x16_bf16(KF[2 * (s - (PART) * KW) + 1], qf[s], P1, 0, 0, 0); } } } while (0)
#define AT_KPART(KF, t, PART) AT_KLOAD(KF, t, (PART) * KW, ((PART) + 1) * KW)
#define AT_QK(P0, P1, t) do { bf16x8 kf_[2 * KW]; _Pragma("unroll") for (int p_ = 0; p_ < KP; ++p_) { AT_KPART(kf_, t, p_); AT_QKMR(P0, P1, kf_, p_); } } while (0)
    const int qw0_ = qb * 256 + 32 * wave;
#define AT_SKIP(t) ((kind == 3 && (t) >= 4) && ((64 * (lt0 + (t) - 4) + 63 < qw0_ - 128) || (64 * (lt0 + (t) - 4) > qw0_ + 31 + 128)))
    LAS float* stage = (LAS float*)(lds + wave * AT_SCRW); LAS float* fac = (LAS float*)(lds + AT_FAC) + wave * 32;
    const int i16 = lane & 15, q4 = i16 >> 2, p4 = i16 & 3, g1 = (lane >> 4) & 1;
    const unsigned vrd = SLOTK + (4 * hi + q4) * 128 + (16 * g1 + 4 * p4) * 2 + 64 * ((q4 >> 1) & 1);
#define CR(r) (((r) & 3) + 8 * ((r) >> 2))
#define SB0() __builtin_amdgcn_sched_barrier(0)
#define AT_PIN(x) asm volatile("" : "+v"(x))
#define AT_MF(a_, b_, c_) __builtin_amdgcn_mfma_f32_32x32x16_bf16(a_, b_, c_, 0, 0, 0)
#define AT_SLOTA(t) ((unsigned)(uintptr_t)(lds + ((t) % NSLOT) * SLOT))
#define AT_KRD(KF, KB, s) do { const LAS unsigned char* kp_ = (const LAS unsigned char*)(uintptr_t)((KB) ^ (unsigned)(32 * (s))); KF[2 * (s)] = *(const LAS bf16x8*)(kp_); KF[2 * (s) + 1] = *(const LAS bf16x8*)(kp_ + 32 * KS); } while (0)
#define AT_VRD(VF, VB, VX, i) do { const LAS unsigned char* vp_ = (const LAS unsigned char*)(uintptr_t)(((i) & 1) ? (VX) : (VB)) + ((i) >> 2) * 4096 + (((i) >> 1) & 1) * 2048; \
        const s16x4 lo_ = tr_read(vp_), h2_ = tr_read(vp_ + 1024); VF[i] = (bf16x8){lo_[0], lo_[1], lo_[2], lo_[3], h2_[0], h2_[1], h2_[2], h2_[3]}; } while (0)
#define AT_PAF(j) __builtin_bit_cast(bf16x8, pw[(j) >> 1])
#define AT_GAPA(MF, P, g) do { AT_VRD(vf, vb_, vx_, g); SB0(); MF; \
        if (kind != 2) { lsum += P[4 * ((g) & 3)]; lsum += P[4 * ((g) & 3) + 1]; lsum += P[4 * ((g) & 3) + 2]; lsum += P[4 * ((g) & 3) + 3]; } \
        pw[2 * ((g) >> 2) + (((g) & 3) >> 1)][2 * ((g) & 1)] = pk2(P[4 * ((g) & 3)], P[4 * ((g) & 3) + 1]); pw[2 * ((g) >> 2) + (((g) & 3) >> 1)][2 * ((g) & 1) + 1] = pk2(P[4 * ((g) & 3) + 2], P[4 * ((g) & 3) + 3]); \
        AT_PIN(pw[2 * ((g) >> 2) + (((g) & 3) >> 1)]); AT_PIN(lsum); SB0(); } while (0)
#define AT_GAPB(j, X) do { if ((j) & 1) o1 = AT_MF(AT_PAF(j), vf[j], o1); else o0 = AT_MF(AT_PAF(j), vf[j], o0); \
        if (kind != 2) { X[4 * ((j) & 3)] = fast_exp2(X[4 * ((j) & 3)]); X[4 * ((j) & 3) + 1] = fast_exp2(X[4 * ((j) & 3) + 1]); X[4 * ((j) & 3) + 2] = fast_exp2(X[4 * ((j) & 3) + 2]); X[4 * ((j) & 3) + 3] = fast_exp2(X[4 * ((j) & 3) + 3]); } \
        AT_PIN(X); SB0(); } while (0)
#define AT_KRDG(s) do { if (more) { AT_KRD(kf, kbn_, s); SB0(); } } while (0)
#define AT_MID(C0, C1, s, FIRST) \
        { const int nx_ = (s) + NSLOT - 2; if (nx_ < ntile) AT_ISSUE(nx_); } \
        const bool isctx = (s) < 4; const int kpos0 = isctx ? 64 * (s) : 64 * (lt0 + (s) - 4); \
        int dbase = kpos0 + 4 * hi - qpos; asm volatile("" : "+v"(dbase)); \
        bool resc = false; int tcls = 0; float mf0 = 0.f, mf1 = 0.f, mb0 = 0.f, mb1 = 0.f; \
        if (kind == 2) { \
            const int qw0r = (ctxq ? 0 : qb * 256) + 32 * wave; \
            tcls = (isctx && !ctxq) ? 3 : ((kpos0 + 63 <= qw0r) ? 0 : ((kpos0 >= qw0r + 32) ? 1 : 2)); \
            if (tcls == 0) { mf1 = fast_exp2(lf2 * (float)(qpos - kpos0 - 63)); mf0 = mf1 * g32f; } \
            else if (tcls == 1) { mb0 = fast_exp2(lb2 * (float)(kpos0 - qpos)); mb1 = mb0 * g32b; } \
            else if (tcls == 3) { mf1 = fast_exp2(lf2 * (float)(256 + qpos - kpos0 - 63)); mf0 = mf1 * g32f; mb0 = fast_exp2(lb2 * (float)(2048 - qpos + kpos0)); mb1 = mb0 * g32b; } \
        } else { \
            if (kind == 3 && !isctx) { \
                _Pragma("unroll") for (int r = 0; r < 16; ++r) { const int d0 = dbase + CR(r), d1 = d0 + 32; \
                    if (d0 > 128 || d0 < -128) C0[r] = -INFINITY; if (d1 > 128 || d1 < -128) C1[r] = -INFINITY; } \
            } \
            float tm = max3f(C0[0], C1[0], C0[1]), tm2 = max3f(C1[1], C0[2], C1[2]); \
            _Pragma("unroll") for (int r = 3; r < 15; r += 2) { tm = max3f(tm, C0[r], C1[r]); tm2 = max3f(tm2, C0[r + 1], C1[r + 1]); } \
            tm = max3f(tm, C0[15], C1[15]); tm = max3f(tm, tm2, tm2); \
            tm = xmax32(tm) - mref; \
            if (__any(tm > THR)) { \
                const float dl = (tm > THR) ? tm : 0.f; \
                mref += dl; shifted = true; resc = !(FIRST); \
                const float f = fast_exp2(-dl); lsum *= f; \
                if (hi == 0) fac[r32] = f; \
            } \
            if (shifted) { _Pragma("unroll") for (int r = 0; r < 16; ++r) { C0[r] -= mref; C1[r] -= mref; } } \
        } \
        SB0();
#define AT_RESC() do { if (kind != 2 && resc) { LDS_WAIT(); asm volatile("" ::: "memory"); _Pragma("unroll") for (int r = 0; r < 16; ++r) { const float fr_ = fac[crow(r, hi)]; o0[r] *= fr_; o1[r] *= fr_; } } } while (0)
#define AT_ENDW(s) do { int nw_ = -1; if ((s) + 2 < ntile) { const int lastis_ = (ntile - 1 < (s) + NSLOT - 2) ? ntile - 1 : (s) + NSLOT - 2; nw_ = (lastis_ - ((s) + 2)) * NL; } at_wait_bar2(nw_); } while (0)
#define AT_DIAG(C0, C1) do { _Pragma("unroll") for (int r = 0; r < 16; ++r) { const int d0 = -(dbase + CR(r)); C0[r] *= fast_exp2((d0 >= 0 ? lf2 : -lb2) * (float)d0); } \
        _Pragma("unroll") for (int r = 0; r < 16; ++r) { const int d1 = -(dbase + CR(r)) - 32; C1[r] *= fast_exp2((d1 >= 0 ? lf2 : -lb2) * (float)d1); } } while (0)
#define AT_STEP(C0, C1, P0, P1, s) do { SB0(); \
        const bool more = (s) + 1 < ntile; \
        unsigned vb_ = AT_SLOTA((s) - 1) + vrd; asm volatile("" : "+v"(vb_)); unsigned vx_ = vb_ ^ 64u; asm volatile("" : "+v"(vx_)); \
        unsigned kbc_ = AT_SLOTA(s) + krd; asm volatile("" : "+v"(kbc_)); (void)kbc_; \
        { const f32x16 z_ = {}; \
          AT_GAPA(C0 = AT_MF(kf[0], qf[0], z_), P0, 0); AT_GAPA(C1 = AT_MF(kf[1], qf[0], z_), P0, 1); } \
        AT_GAPA(C0 = AT_MF(kf[2], qf[1], C0), P0, 2); AT_GAPA(C1 = AT_MF(kf[3], qf[1], C1), P0, 3); \
        if (NS == 6) { AT_KRD(kf, kbc_, 4); SB0(); } AT_GAPA(C0 = AT_MF(kf[4], qf[2], C0), P1, 4); if (NS == 6) { AT_KRD(kf, kbc_, 5); SB0(); } AT_GAPA(C1 = AT_MF(kf[5], qf[2], C1), P1, 5); \
        AT_GAPA(C0 = AT_MF(kf[6], qf[3], C0), P1, 6); AT_GAPA(C1 = AT_MF(kf[7], qf[3], C1), P1, 7); \
        if (NS == 6) { C0 = AT_MF(kf[2 * (NS - 2)], qf[NS - 2], C0); C1 = AT_MF(kf[2 * (NS - 2) + 1], qf[NS - 2], C1); C0 = AT_MF(kf[2 * (NS - 1)], qf[NS - 1], C0); C1 = AT_MF(kf[2 * (NS - 1) + 1], qf[NS - 1], C1); SB0(); } \
        AT_MID(C0, C1, s, false) \
        unsigned kbn_ = AT_SLOTA((s) + 1) + krd; asm volatile("" : "+v"(kbn_)); \
        if (kind == 2) {        \
            if (more) { _Pragma("unroll") for (int s_ = 0; s_ < 4; ++s_) AT_KRD(kf, kbn_, s_); } SB0(); \
            _Pragma("unroll") for (int j = 0; j < 8; ++j) { if (j & 1) o1 = AT_MF(AT_PAF(j), vf[j], o1); else o0 = AT_MF(AT_PAF(j), vf[j], o0); } SB0(); \
            if (tcls == 2) { AT_DIAG(C0, C1); } \
            else { { const f32x4 fq_ = cfq * mf0, bq_ = cbq * mb0; _Pragma("unroll") for (int r = 0; r < 16; ++r) C0[r] *= cfa[r & 3] * fq_[r >> 2] + cba[r & 3] * bq_[r >> 2]; } \
                   { const f32x4 fq_ = cfq * mf1, bq_ = cbq * mb1; _Pragma("unroll") for (int r = 0; r < 16; ++r) C1[r] *= cfa[r & 3] * fq_[r >> 2] + cba[r & 3] * bq_[r >> 2]; } } \
        } else { \
            AT_GAPB(0, C0); AT_GAPB(1, C0); AT_KRDG(0); AT_GAPB(2, C0); AT_KRDG(1); AT_GAPB(3, C0); \
            AT_KRDG(2); AT_GAPB(4, C1); AT_KRDG(3); AT_GAPB(5, C1); AT_GAPB(6, C1); AT_GAPB(7, C1); \
        } \
        AT_RESC(); AT_ENDW(s); \
        } while (0)
#pragma unroll
    for (int t = 0; t < NSLOT - 2; ++t) if (t < ntile) AT_ISSUE(t);
    { const int lastis = (ntile - 1 < NSLOT - 3 ? ntile - 1 : NSLOT - 3); at_wait_bar((lastis - 1 > 0 ? lastis - 1 : 0) * NL); }
    float mref = 0.f, lsum = 0.f;
    bool shifted = false;
    f32x16 o0 = {}, o1 = {}, pa0, pa1, pb0 = {}, pb1 = {};
    bf16x8 kf[2 * NS], vf[8]; u32x4 pw[4] = {};
    { unsigned kb0_ = AT_SLOTA(0) + krd; asm volatile("" : "+v"(kb0_));
#pragma unroll
      for (int s_ = 0; s_ < NS; ++s_) AT_KRD(kf, kb0_, s_); }
    {
        const bool more = 1 < ntile;
        unsigned kbn_ = AT_SLOTA(1) + krd; asm volatile("" : "+v"(kbn_));
        { const f32x16 z_ = {}; pa0 = AT_MF(kf[0], qf[0], z_); pa1 = AT_MF(kf[1], qf[0], z_); }
#pragma unroll
        for (int s_ = 1; s_ < NS; ++s_) { pa0 = AT_MF(kf[2 * s_], qf[s_], pa0); pa1 = AT_MF(kf[2 * s_ + 1], qf[s_], pa1); }
        SB0();
        AT_MID(pa0, pa1, 0, true)
        if (more) {
#pragma unroll
            for (int s_ = 0; s_ < 4; ++s_) AT_KRD(kf, kbn_, s_); }
        if (kind == 2) { if (tcls == 2) { AT_DIAG(pa0, pa1); } else {
#pragma unroll
            for (int r = 0; r < 16; ++r) { pa0[r] *= cfa[r & 3] * (cfq[r >> 2] * mf0) + cba[r & 3] * (cbq[r >> 2] * mb0); pa1[r] *= cfa[r & 3] * (cfq[r >> 2] * mf1) + cba[r & 3] * (cbq[r >> 2] * mb1); } } }
        else {
#pragma unroll
            for (int r = 0; r < 16; ++r) { pa0[r] = fast_exp2(pa0[r]); pa1[r] = fast_exp2(pa1[r]); } }
        AT_ENDW(0);
    }
    for (int s = 1; s < ntile; s += 2) {
        AT_STEP(pb0, pb1, pa0, pa1, s);
        if (s + 1 < ntile) AT_STEP(pa0, pa1, pb0, pb1, s + 1);
    }
#define AT_DRAIN(P0, P1) do { unsigned vb_ = AT_SLOTA(ntile - 1) + vrd; asm volatile("" : "+v"(vb_)); unsigned vx_ = vb_ ^ 64u; asm volatile("" : "+v"(vx_)); \
        _Pragma("unroll") for (int i = 0; i < 8; ++i) AT_VRD(vf, vb_, vx_, i); \
        if (kind != 2) { float sa_ = 0.f; _Pragma("unroll") for (int r = 0; r < 16; ++r) sa_ += P0[r] + P1[r]; lsum += sa_; } \
        _Pragma("unroll") for (int h_ = 0; h_ < 2; ++h_) { pw[h_].x = pk2(P0[8 * h_], P0[8 * h_ + 1]); pw[h_].y = pk2(P0[8 * h_ + 2], P0[8 * h_ + 3]); pw[h_].z = pk2(P0[8 * h_ + 4], P0[8 * h_ + 5]); pw[h_].w = pk2(P0[8 * h_ + 6], P0[8 * h_ + 7]); \
            pw[2 + h_].x = pk2(P1[8 * h_], P1[8 * h_ + 1]); pw[2 + h_].y = pk2(P1[8 * h_ + 2], P1[8 * h_ + 3]); pw[2 + h_].z = pk2(P1[8 * h_ + 4], P1[8 * h_ + 5]); pw[2 + h_].w = pk2(P1[8 * h_ + 6], P1[8 * h_ + 7]); } \
        _Pragma("unroll") for (int j = 0; j < 8; ++j) { if (j & 1) o1 = AT_MF(AT_PAF(j), vf[j], o1); else o0 = AT_MF(AT_PAF(j), vf[j], o0); } } while (0)
    if ((ntile - 1) & 1) AT_DRAIN(pb0, pb1); else AT_DRAIN(pa0, pa1);
#undef AT_DRAIN
#undef AT_STEP
#undef AT_DIAG
#undef AT_ENDW
#undef AT_RESC
#undef AT_MID
#undef AT_KRDG
#undef AT_GAPB
#undef AT_GAPA
#undef AT_PAF
#undef AT_VRD
#undef AT_KRD
#undef AT_SLOTA
#undef AT_MF
#undef AT_PIN
#undef AT_KLOAD
#undef AT_QKMR
#undef AT_KPART
#undef SB0
#undef AT_ISSUE
#undef AT_TILE_ROW0
#undef AT_QK
#undef AT_SKIP
#undef CR
    asm volatile("s_waitcnt lgkmcnt(0)\n\ts_barrier" ::: "memory");
#pragma unroll
    for (int r = 0; r < 16; ++r) { stage[crow(r, hi) * 65 + r32] = o0[r]; stage[crow(r, hi) * 65 + 32 + r32] = o1[r]; }
    LDS_WAIT(); asm volatile("" ::: "memory");
    float x[32];
#pragma unroll
    for (int j = 0; j < 32; ++j) x[j] = stage[r32 * 65 + 32 * hi + j];
    int orow_i = qrow0 + r32; asm volatile("" : "+v"(orow_i));
    const size_t orow = (size_t)orow_i;
    if (kind == 2) {
        float s = 0.f;
#pragma unroll
        for (int j = 0; j < 32; ++j) s += x[j];
        s = xadd<32>(s); const float mean = s * (1.f / 64.f); float v = 0.f;
#pragma unroll
        for (int j = 0; j < 32; ++j) { x[j] -= mean; v += x[j] * x[j]; }
        v = xadd<32>(v); const float rstd = 1.0f / sqrtf(v * (1.f / 64.f) + EPS);
        const bf16_t* gp = Q + orow * QP + gcol + 32 * hi;
#pragma unroll
        for (int c = 0; c < 4; ++c) { const u32x4 gw = *(const GAS u32x4*)(gp + 8 * c);
#pragma unroll
            for (int j = 0; j < 4; ++j) { const float ga = bflo(gw[j]), gb = bfhi(gw[j]); x[8 * c + 2 * j] *= rstd * ga * sigmoidf_(ga); x[8 * c + 2 * j + 1] *= rstd * gb * sigmoidf_(gb); } }
    } else {
        float lt = xadd<32>(lsum);
        if (kind == 3) lt += fast_exp2(sinkl2 - mref);
        const float inv = 1.0f / fmaxf(lt, 1e-30f);
#pragma unroll
        for (int j = 0; j < 32; ++j) x[j] *= inv;
    }
    bf16_t* yp = Y + orow * 1024 + ycol + 32 * hi;
#pragma unroll
    for (int c = 0; c < 4; ++c) { u32x4 w; w.x = pk2(x[8 * c], x[8 * c + 1]); w.y = pk2(x[8 * c + 2], x[8 * c + 3]); w.z = pk2(x[8 * c + 4], x[8 * c + 5]); w.w = pk2(x[8 * c + 6], x[8 * c + 7]); *(GAS u32x4*)(yp + 8 * c) = w; }
    asm volatile("s_waitcnt lgkmcnt(0)\n\ts_barrier" ::: "memory");
}
#ifndef PROBE_KMASK
#define PROBE_KMASK 0x1f
#endif
#ifndef PROBE_TILECAP
#define PROBE_TILECAP 1000
#endif
__device__ __forceinline__ void phase_mix(KArgs a, int lq, LAS unsigned char* lds, int tid, int lane, int wave, int G, int c) {
    const int l = lq & 1; const int kmask = (lq >= 2) ? PROBE_KMASK : 0x1f; const int tilecap = (lq >= 2) ? PROBE_TILECAP : 1000;
    unsigned char* ws = a->ws;
    const bf16_t* Q = (const bf16_t*)(ws + WS_QKV); bf16_t* Y = (bf16_t*)(ws + (lq >= 2 ? WS_MRG : WS_Y));
    const int nunits = l == 0 ? 1152 : 1024;
    const int vc = (G == 256) ? ((c & 7) * 32 + (c >> 3)) : c;
    for (int j = 0; ; ++j) {
        const int u = j * G + vc;
        if (u >= nunits) break;
        int kind, b, hq, qb; bool ctxq;
        if (u < 1024) { kind = u >> 8; const int r = u & 255; b = r >> 5; hq = (r >> 3) & 3; qb = r & 7; ctxq = false; }
        else { const int r = u - 1024; kind = r >> 5; b = (r >> 2) & 7; hq = r & 3; qb = 0; ctxq = true; }
        if (!((kmask >> (ctxq ? 4 : kind)) & 1)) continue;
        float lf2 = 0.f, lb2 = 0.f, sk = 0.f;
        if (kind == 2) { lf2 = __builtin_bit_cast(float, __builtin_amdgcn_readfirstlane(__builtin_bit_cast(int, -__expf(a->in[I_DECAY][l * 8 + hq]) * LOG2E)));
                         lb2 = __builtin_bit_cast(float, __builtin_amdgcn_readfirstlane(__builtin_bit_cast(int, -__expf(a->in[I_DECAY][l * 8 + 4 + hq]) * LOG2E))); }
        if (kind == 3) sk = __builtin_bit_cast(float, __builtin_amdgcn_readfirstlane(__builtin_bit_cast(int, a->in[I_SINK][l * 4 + hq] * LOG2E)));
        int tid2 = tid; asm volatile("" : "+v"(tid2));
        const int lane2 = tid2 & 63;
        if (kind == 0) attn_unit<0>(Q, Y, b, hq, qb, ctxq, sk, lf2, lb2, lds, tid2, lane2, wave, tilecap);
        else if (kind == 1) attn_unit<1>(Q, Y, b, hq, qb, ctxq, sk, lf2, lb2, lds, tid2, lane2, wave, tilecap);
        else if (kind == 2) attn_unit<2>(Q, Y, b, hq, qb, ctxq, sk, lf2, lb2, lds, tid2, lane2, wave, tilecap);
        else attn_unit<3>(Q, Y, b, hq, qb, ctxq, sk, lf2, lb2, lds, tid2, lane2, wave, tilecap);
    }
}

#ifndef MK_BAR_XCD
#define MK_BAR_XCD 1
#endif
constexpr int NPHASE = 20;
#ifndef PH_MASK
#define PH_MASK 0x3ff
#endif
#define PH_ON(b) ((PH_MASK >> (b)) & 1)
#ifndef PROBE_REPEAT
#define PROBE_REPEAT 0
#endif
__global__ void __launch_bounds__(NTHREADS, 2) fwd_kernel(Args a_byval) {
    extern __shared__ __attribute__((aligned(16))) unsigned char lds_raw[];
    LAS unsigned char* lds0 = (LAS unsigned char*)lds_raw;
    const int wave0 = __builtin_amdgcn_readfirstlane((int)threadIdx.x >> 6);
    { LAS unsigned char* lds = lds0; const int t0 = wave0 * 64 + lane_id(); for (int u = t0; u < (LDS_BYTES - LDS_MISC) / 4; u += NTHREADS) ((LAS unsigned*)(lds + LDS_MISC))[u] = 0u; }
    __syncthreads();
    const int ph_lo = a_byval.ph_lo, ph_hi = a_byval.ph_hi;
#if MK_ONE_LAUNCH && MK_BAR_XCD
    XcdBarrier bar = xcd_barrier_post((unsigned*)(a_byval.ws + WS_CTL) + CW_BAR, (volatile LAS unsigned*)(lds0 + LDS_MISC), wave0);
#endif
    for (int ph = ph_lo; ph < ph_hi; ++ph) {
#if PROBE_REPEAT
      const int nrep = 1 + ((PROBE_REPEAT >> ph) & 1);
      for (int rep = 0; rep < nrep; ++rep) {
#else
      constexpr int nrep = 1, rep = 0; {
#endif
#define PHASE_IDS \
        KArgs a = (KArgs)__builtin_amdgcn_kernarg_segment_ptr(); asm volatile("" : "+s"(a)); \
        int wave = wave0; asm volatile("" : "+s"(wave)); unsigned z_ = 0u; asm volatile("" : "+v"(z_)); \
        const int lane = (int)__builtin_amdgcn_mbcnt_hi(~0u, __builtin_amdgcn_mbcnt_lo(~0u, z_)); const int tid = wave * 64 + lane; \
        unsigned ldso = 0; asm volatile("" : "+s"(ldso)); LAS unsigned char* lds = lds0 + ldso; \
        int G = gridDim.x, c = blockIdx.x; asm volatile("" : "+s"(G), "+s"(c)); \
        unsigned char* ws = a->ws; unsigned* ctl = (unsigned*)(ws + WS_CTL); const float* ada = (const float*)(ws + WS_ADA); (void)ctl; (void)ada; (void)tid; (void)lane; (void)lds; (void)G; (void)c;
        if (ph == 0) { if (PH_ON(0)) { PHASE_IDS p0_prologue(a, lds, tid, lane, wave, G, c); } }
        else if (ph == NPHASE - 1) { if (PH_ON(1)) { PHASE_IDS moe_tables(ctl, 1, lds, tid); phase_rownorm(a, 2, lds, lane, wave, G, c); } }
        else {
            const int l = (ph - 1) / 9, k = (ph - 1) % 9;
            if (k == 0) { if (PH_ON(1)) { PHASE_IDS if (l == 1) moe_tables(ctl, 0, lds, tid); phase_rownorm(a, l, lds, lane, wave, G, c); } }
            else if (k == 1) { if (PH_ON(2)) { PHASE_IDS
                SchedB S{l, G, c, (const char*)(ws + WS_H), (const char*)(ws + WS_WIN) + (size_t)l * NBG * 1024};
                const float* rope_ = (const float*)(ws + WS_ROPE);
                EpiB E{(bf16_t*)(ws + WS_P), (bf16_t*)(ws + WS_G), (bf16_t*)(ws + WS_QKV), rope_, rope_ + 2048 * 32, a->in[I_GQN] + l * 64, a->in[I_GKN] + l * 64};
                pg8::gemm_phase<EpiB, SchedB, false, true, 0x7a7a7a7a, 0x7f7f7f7f>(lds, tid, 1024, 1024, 1024, S, E); }
            } else if (k == 2) { if (PH_ON(3)) { PHASE_IDS phase_post(a, l, lds, lane, wave, G, c); } }
            else if (k == 3) { if (PH_ON(4)) { PHASE_IDS phase_mix(a, l + 2 * rep, lds, tid, lane, wave, G, c); } }
            else if (k == 4) { if (PH_ON(5)) { PHASE_IDS
                SchedE S{G, c, l == 0 ? 72 : 64, (const char*)(ws + WS_Y), (const char*)(ws + WS_WBR) + (size_t)l * 1048576 * 2};
                EpiE E{(const bf16_t*)(ws + WS_G), (bf16_t*)(ws + WS_MRG)};
                pg8::gemm_phase<EpiE, SchedE, false>(lds, tid, 2048, 2048, 2048, S, E);
                if (l == 0 && G == 256 && c >= 32) cvt_run(a, ws, lds, lane, wave, CV_EXP_ITEMS / 2, CV_EXP_ITEMS / 2 + CV_E0_SHARE, (c - 32) * NWAVES + wave, 224 * NWAVES); }
            } else if (k == 5) { if (PH_ON(6)) { PHASE_IDS
                SchedF S{G, c, l == 0 ? 72 : 64, (const char*)(ws + WS_MRG), (const char*)(ws + WS_WOUT) + (size_t)l * 1048576 * 2};
                EpiF E{a->in[I_X], a->in[I_CTX], (const bf16_t*)(ws + WS_X), (bf16_t*)(ws + WS_X), ada + (size_t)l * 9 * 6144, l};
                pg8::gemm_phase<EpiF, SchedF, false>(lds, tid, 2048, 2048, 2048, S, E);
                if (l == 0) { if (G == 256 && c >= 32) cvt_run(a, ws, lds, lane, wave, CV_EXP_ITEMS / 2 + CV_E0_SHARE, CV_EXP_ITEMS, (c - 32) * NWAVES + wave, 224 * NWAVES);
                              else if (G != 256) { cvt_run(a, ws, lds, lane, wave, CV_EXP_ITEMS / 2, CV_EXP_ITEMS, c * NWAVES + wave, G * NWAVES); } } }
            } else if (k == 6) { if (PH_ON(7)) { PHASE_IDS phase_router(a, l, l == 0 ? TT : TL, lds, tid, lane, wave, G, c); } }
            else if (k == 7) { if (PH_ON(8)) { PHASE_IDS
                moe_tables(ctl, l, lds, tid);
                SchedMoe S{G, c, 8, 1, (const LAS int*)(lds + LDS_MISC + 1024), (const LAS int*)(lds + LDS_MISC + 2304), (const int*)(ws + WS_TOKINV), (const char*)(ws + WS_H), (const char*)(ws + WS_W13) + (size_t)l * 32 * 2 * MiB, 2 * MiB};
                EpiH E{(unsigned char*)(ws + WS_HID)};
                pg8::gemm_phase<EpiH, SchedMoe, true, true, 0x7a7a7a7a, 0x7f7f7f7f>(lds, tid, 1024, 1024, 1024, S, E); }
            } else if (PH_ON(9)) { PHASE_IDS
                moe_tables(ctl, l, lds, tid);
                SchedMoe S{G, c, 4, 0, (const LAS int*)(lds + LDS_MISC + 1024), (const LAS int*)(lds + LDS_MISC + 2304), (const int*)(ws + WS_TOKINV), (const char*)(ws + WS_HID), (const char*)(ws + WS_W2) + (size_t)l * 32 * 1 * MiB, 1 * MiB};
                EpiI E{(bf16_t*)(ws + WS_Y2)};
                pg8::gemm_phase<EpiI, SchedMoe, false, true, 0x7a7a7a7a, 0x7d7d7d7d>(lds, tid, 1024, 1024, 1024, S, E);
            }
        }
#if MK_ONE_LAUNCH
        if (ph + 1 < ph_hi || rep + 1 < nrep) {
#if MK_BAR_XCD
            if (ph == ph_lo) cg::this_grid().sync(); else xcd_barrier(bar);
#else
            cg::this_grid().sync();
#endif
        }
#endif
      }
    }
}

extern "C" void kernel_launch(void* const* d_in, const int* in_sizes, int n_in, void* d_out, int out_size, void* d_ws, size_t ws_size, hipStream_t stream) {
    static int grid = 0;
    if (grid == 0) {
        if (n_in != 26 || out_size != TL * DM || ws_size < WS_END) { fprintf(stderr, "kernel_launch: unexpected problem (n_in %d, out %d, ws %zu)\n", n_in, out_size, ws_size); grid = -1; return; }
        int dev = 0, cus = 0, per_cu = 0;
        (void)hipGetDevice(&dev); (void)hipDeviceGetAttribute(&cus, hipDeviceAttributeMultiprocessorCount, dev);
        if (hipFuncSetAttribute((const void*)fwd_kernel, hipFuncAttributeMaxDynamicSharedMemorySize, LDS_BYTES) != hipSuccess) { fprintf(stderr, "kernel_launch: hipFuncSetAttribute failed\n"); grid = -1; return; }
        if (hipOccupancyMaxActiveBlocksPerMultiprocessor(&per_cu, (const void*)fwd_kernel, NTHREADS, LDS_BYTES) != hipSuccess || per_cu < 1) { fprintf(stderr, "kernel_launch: occupancy query says %d blocks per CU\n", per_cu); (void)hipGetLastError(); per_cu = 1; }
        grid = cus;
        if (grid < 1) grid = 256;
    }
    if (grid < 0) return;
    (void)hipMemsetAsync((char*)d_ws + WS_CTL, 0, CTL_ZERO_BYTES, stream);
    Args a{};
    for (int i = 0; i < 26; ++i) a.in[i] = (const float*)d_in[i];
    a.out = (float*)d_out; a.ws = (unsigned char*)d_ws;
#if MK_ONE_LAUNCH
    a.ph_lo = 0; a.ph_hi = NPHASE;
    void* args[] = {&a};
    hipError_t e = hipLaunchCooperativeKernel((const void*)fwd_kernel, dim3(grid), dim3(NTHREADS), args, LDS_BYTES, stream);
    if (e != hipSuccess) fprintf(stderr, "kernel_launch: cooperative launch failed: %s (grid %d)\n", hipGetErrorString(e), grid);
#else
    for (int ph = 0; ph < NPHASE; ++ph) { a.ph_lo = ph; a.ph_hi = ph + 1; hipLaunchKernelGGL(fwd_kernel, dim3(grid), dim3(NTHREADS), LDS_BYTES, stream, a); }
#endif
}
```
